# Optimizing an MI355X kernel written in HIP

```python
import functools
import jax, jax.numpy as jnp
from jax import lax
import numpy as np

D_MODEL = 1024
BATCH = 2
SEQ = 8192
DEPTH = 1
DEC_BATCH = 128
DEC_SEQ = 1
PAST_LEN = 16384
PAGE_SIZE = 128

PLE_DIM = 256
D_FF = 2816
MLA_HEADS = 8
MLA_NOPE = 64
MLA_ROPE = 32
MLA_V = 64
Q_LORA = 256
KV_LORA = 128
RET_HEADS = 4
RET_DK = 128
RET_DV = 128
RET_CHUNK = 128
Q_BLOCK = 128
ROPE_THETA = 10000.0
EPS = 1e-6
IN_SPLITS = (Q_LORA, KV_LORA, MLA_ROPE, RET_HEADS * RET_DK, RET_HEADS * RET_DK,
             RET_HEADS * RET_DV, RET_HEADS * RET_DV, D_MODEL, D_MODEL)
IN_COLS = Q_LORA + KV_LORA + MLA_ROPE + 2 * RET_HEADS * RET_DK + 2 * RET_HEADS * RET_DV + 2 * D_MODEL

kernel_name = 'mla_retention_gated_hybrid_step'


def _split_points():
    pts, acc = [], 0
    for s in IN_SPLITS[:-1]:
        acc += s
        pts.append(acc)
    return pts


def rmsnorm(x, g):
    xf = x.astype(jnp.float32)
    y = xf * lax.rsqrt(jnp.mean(xf * xf, axis=-1, keepdims=True) + EPS)
    return (y * g.astype(jnp.float32)).astype(x.dtype)


def head_layernorm(o, g):
    mu = jnp.mean(o, axis=-1, keepdims=True)
    d = o - mu
    var = jnp.mean(d * d, axis=-1, keepdims=True)
    return d * lax.rsqrt(var + EPS) * g.astype(jnp.float32)[None, None]


def rope(x, pos):
    half = x.shape[-1] // 2
    inv = ROPE_THETA ** (-jnp.arange(half, dtype=jnp.float32) / half)
    ang = pos.astype(jnp.float32)[:, None] * inv[None, :]
    cos = jnp.cos(ang)[None, :, None, :]
    sin = jnp.sin(ang)[None, :, None, :]
    xf = x.astype(jnp.float32)
    x1, x2 = xf[..., :half], xf[..., half:]
    return jnp.concatenate([x1 * cos - x2 * sin, x1 * sin + x2 * cos], axis=-1).astype(x.dtype)


def swiglu_half(x, g, w_gate, w_up, w_down):
    u = rmsnorm(x, g)
    return x + 0.5 * ((jax.nn.silu(u @ w_gate) * (u @ w_up)) @ w_down)


def retention_log_gamma():
    return jnp.log1p(-jnp.exp2(-5.0 - jnp.arange(RET_HEADS, dtype=jnp.float32)))


def retention_chunk(s0, q, k, v, log_gamma):
    q = q.astype(jnp.float32)
    k = k.astype(jnp.float32)
    v = v.astype(jnp.float32)
    c = q.shape[2]
    idx = jnp.arange(c, dtype=jnp.float32)
    diff = idx[:, None] - idx[None, :]
    decay = jnp.where(diff[None] >= 0, jnp.exp(log_gamma[:, None, None] * jnp.maximum(diff, 0.0)[None]), 0.0)
    scores = jnp.einsum('bhid,bhjd->bhij', q, k) * decay[None]
    inner = jnp.einsum('bhij,bhjv->bhiv', scores, v)
    q_decay = jnp.exp(log_gamma[:, None] * (idx + 1.0)[None, :])
    cross = jnp.einsum('bhid,bhdv->bhiv', q, s0) * q_decay[None, :, :, None]
    k_decay = jnp.exp(log_gamma[:, None] * (c - 1.0 - idx)[None, :])
    s_new = jnp.exp(log_gamma * c)[None, :, None, None] * s0 + jnp.einsum('bhjd,bhjv->bhdv', k * k_decay[None, :, :, None], v)
    return inner + cross, s_new


def retention_prompt(q, k, v, log_gamma):
    b, t = q.shape[:2]
    nc = t // RET_CHUNK

    def to_chunks(a):
        a = a.transpose(0, 2, 1, 3)
        a = a.reshape(b, RET_HEADS, nc, RET_CHUNK, a.shape[-1])
        return jnp.moveaxis(a, 2, 0)

    def step(s, blk):
        o, s = retention_chunk(s, blk[0], blk[1], blk[2], log_gamma)
        return s, o

    s0 = jnp.zeros((b, RET_HEADS, RET_DK, RET_DV), jnp.float32)
    s_fin, o = lax.scan(step, s0, (to_chunks(q), to_chunks(k), to_chunks(v)))
    o = jnp.moveaxis(o, 0, 2).reshape(b, RET_HEADS, t, RET_DV).transpose(0, 2, 1, 3)
    return o, s_fin


def retention_sample(q, k, v, state, log_gamma):
    o, s_new = retention_chunk(state.astype(jnp.float32), q.transpose(0, 2, 1, 3),
                               k.transpose(0, 2, 1, 3), v.transpose(0, 2, 1, 3), log_gamma)
    return o.transpose(0, 2, 1, 3), s_new


def mla_attend_prompt(q_nope, q_pe, c_kv, k_pe, w_kv_b):
    b, t = q_nope.shape[:2]
    kv = (c_kv @ w_kv_b).reshape(b, t, MLA_HEADS, MLA_NOPE + MLA_V)
    k_nope, v = kv[..., :MLA_NOPE], kv[..., MLA_NOPE:]
    nqb = t // Q_BLOCK
    qn = q_nope.reshape(b, nqb, Q_BLOCK, MLA_HEADS, MLA_NOPE).swapaxes(0, 1)
    qp = q_pe.reshape(b, nqb, Q_BLOCK, MLA_HEADS, MLA_ROPE).swapaxes(0, 1)
    kpos = jnp.arange(t)
    scale = (MLA_NOPE + MLA_ROPE) ** -0.5

    def one_block(args):
        qn_b, qp_b, bi = args
        s = (jnp.einsum('bqhd,bkhd->bhqk', qn_b, k_nope)
             + jnp.einsum('bqhr,bkr->bhqk', qp_b, k_pe)).astype(jnp.float32) * scale
        qpos = bi * Q_BLOCK + jnp.arange(Q_BLOCK)
        s = jnp.where(kpos[None, :] <= qpos[:, None], s, -jnp.inf)
        p = jax.nn.softmax(s, axis=-1).astype(v.dtype)
        return jnp.einsum('bhqk,bkhd->bqhd', p, v)

    o = lax.map(one_block, (qn, qp, jnp.arange(nqb)))
    return o.swapaxes(0, 1).reshape(b, t, MLA_HEADS * MLA_V)


def mla_attend_sample(q_nope, q_pe, c_kv, k_pe, w_kv_b, cache_ckv, cache_kpe, page_table, layer):
    b, t = q_nope.shape[:2]
    n_past = page_table.shape[1] * PAGE_SIZE
    w = w_kv_b.reshape(KV_LORA, MLA_HEADS, MLA_NOPE + MLA_V)
    w_uk, w_uv = w[..., :MLA_NOPE], w[..., MLA_NOPE:]
    q_lat = jnp.einsum('bthd,chd->bthc', q_nope, w_uk)
    past_ckv = cache_ckv[layer, page_table].reshape(b, n_past, KV_LORA).astype(c_kv.dtype)
    past_kpe = cache_kpe[layer, page_table].reshape(b, n_past, MLA_ROPE).astype(k_pe.dtype)
    scale = (MLA_NOPE + MLA_ROPE) ** -0.5
    s_past = (jnp.einsum('bthc,bkc->bhtk', q_lat, past_ckv)
              + jnp.einsum('bthr,bkr->bhtk', q_pe, past_kpe)).astype(jnp.float32) * scale
    s_new = (jnp.einsum('bthc,bkc->bhtk', q_lat, c_kv)
             + jnp.einsum('bthr,bkr->bhtk', q_pe, k_pe)).astype(jnp.float32) * scale
    tri = jnp.arange(t)[None, :] <= jnp.arange(t)[:, None]
    s_new = jnp.where(tri[None, None], s_new, -jnp.inf)
    p = jax.nn.softmax(jnp.concatenate([s_past, s_new], axis=-1), axis=-1).astype(c_kv.dtype)
    o_lat = (jnp.einsum('bhtk,bkc->bthc', p[..., :n_past], past_ckv)
             + jnp.einsum('bhtk,bkc->bthc', p[..., n_past:], c_kv))
    o = jnp.einsum('bthc,chd->bthd', o_lat, w_uv)
    return o.reshape(b, t, MLA_HEADS * MLA_V)


def hybrid_layer(x, p_emb, pos, lp, attend, retain):
    b, t = x.shape[:2]
    h = swiglu_half(x, lp['ffn1_norm'], lp['ffn1_w_gate'], lp['ffn1_w_up'], lp['ffn1_w_down'])
    u = rmsnorm(h, lp['mix_norm'])
    z = u @ lp['w_in']
    cq, ckv_raw, kpe_raw, rq, rk, rv, rg, ga, gr = jnp.split(z, _split_points(), axis=-1)
    q = (rmsnorm(cq, lp['q_a_norm']) @ lp['w_q_b']).reshape(b, t, MLA_HEADS, MLA_NOPE + MLA_ROPE)
    q_nope = q[..., :MLA_NOPE]
    q_pe = rope(q[..., MLA_NOPE:], pos)
    c_kv = rmsnorm(ckv_raw, lp['kv_a_norm'])
    k_pe = rope(kpe_raw[:, :, None, :], pos)[:, :, 0, :]
    o_att = attend(q_nope, q_pe, c_kv, k_pe)
    qr = rope(rq.reshape(b, t, RET_HEADS, RET_DK), pos)
    kr = rope(rk.reshape(b, t, RET_HEADS, RET_DK), pos) * (RET_DK ** -0.5)
    vr = rv.reshape(b, t, RET_HEADS, RET_DV)
    o_ret, s_new = retain(qr, kr, vr)
    o_ret = head_layernorm(o_ret, lp['ret_norm']).astype(x.dtype).reshape(b, t, RET_HEADS * RET_DV)
    o_ret = jax.nn.silu(rg) * o_ret
    merged = (jax.nn.sigmoid(ga) * (o_att @ lp['w_branch_att'])
              + jax.nn.sigmoid(gr) * (o_ret @ lp['w_branch_ret']))
    h = h + merged @ lp['w_out']
    h = swiglu_half(h, lp['ffn2_norm'], lp['ffn2_w_gate'], lp['ffn2_w_up'], lp['ffn2_w_down'])
    gate = jax.nn.sigmoid(rmsnorm(h, lp['ple_norm']) @ lp['w_ple_gate'])
    h = h + gate * (p_emb @ lp['w_ple_proj'])
    return h, c_kv, k_pe, s_new


def setup_inputs(seed: int = 0) -> dict:
    key = jax.random.key(seed)
    ks = iter(jax.random.split(key, 40))
    n_pages = PAST_LEN // PAGE_SIZE
    n_used = DEC_BATCH * n_pages
    n_pool = n_used + n_used // 4

    def w(shape, fan_in):
        return jax.random.normal(next(ks), shape, jnp.float32) * (fan_in ** -0.5)

    def gain(shape):
        return 1.0 + 0.02 * jax.random.normal(next(ks), shape, jnp.float32)

    d = {}
    d['x_prompt'] = jax.random.normal(next(ks), (BATCH, SEQ, D_MODEL), jnp.float32)
    d['x_sample'] = jax.random.normal(next(ks), (DEC_BATCH, DEC_SEQ, D_MODEL), jnp.float32)
    d['cache_ckv'] = jax.random.normal(next(ks), (DEPTH, n_pool, PAGE_SIZE, KV_LORA), jnp.float32)
    d['cache_kpe'] = jax.random.normal(next(ks), (DEPTH, n_pool, PAGE_SIZE, MLA_ROPE), jnp.float32)
    d['state_ret'] = 0.5 * jax.random.normal(next(ks), (DEPTH, DEC_BATCH, RET_HEADS, RET_DK, RET_DV), jnp.float32)
    d['page_table'] = jax.random.permutation(next(ks), n_pool)[:n_used].reshape(DEC_BATCH, n_pages).astype(jnp.int32)
    d['p_prompt'] = jax.random.normal(next(ks), (DEPTH, BATCH, SEQ, PLE_DIM), jnp.float32)
    d['p_sample'] = jax.random.normal(next(ks), (DEPTH, DEC_BATCH, DEC_SEQ, PLE_DIM), jnp.float32)
    d['ffn1_norm'] = gain((DEPTH, D_MODEL))
    d['ffn1_w_gate'] = w((DEPTH, D_MODEL, D_FF), D_MODEL)
    d['ffn1_w_up'] = w((DEPTH, D_MODEL, D_FF), D_MODEL)
    d['ffn1_w_down'] = w((DEPTH, D_FF, D_MODEL), D_FF)
    d['mix_norm'] = gain((DEPTH, D_MODEL))
    d['w_in'] = w((DEPTH, D_MODEL, IN_COLS), D_MODEL)
    d['q_a_norm'] = gain((DEPTH, Q_LORA))
    d['w_q_b'] = w((DEPTH, Q_LORA, MLA_HEADS * (MLA_NOPE + MLA_ROPE)), Q_LORA)
    d['kv_a_norm'] = gain((DEPTH, KV_LORA))
    d['w_kv_b'] = w((DEPTH, KV_LORA, MLA_HEADS * (MLA_NOPE + MLA_V)), KV_LORA)
    d['ret_norm'] = gain((DEPTH, RET_HEADS, RET_DV))
    d['w_branch_att'] = w((DEPTH, MLA_HEADS * MLA_V, D_MODEL), MLA_HEADS * MLA_V)
    d['w_branch_ret'] = w((DEPTH, RET_HEADS * RET_DV, D_MODEL), RET_HEADS * RET_DV)
    d['w_out'] = w((DEPTH, D_MODEL, D_MODEL), D_MODEL)
    d['ffn2_norm'] = gain((DEPTH, D_MODEL))
    d['ffn2_w_gate'] = w((DEPTH, D_MODEL, D_FF), D_MODEL)
    d['ffn2_w_up'] = w((DEPTH, D_MODEL, D_FF), D_MODEL)
    d['ffn2_w_down'] = w((DEPTH, D_FF, D_MODEL), D_FF)
    d['ple_norm'] = gain((DEPTH, D_MODEL))
    d['w_ple_gate'] = w((DEPTH, D_MODEL, D_MODEL), D_MODEL)
    d['w_ple_proj'] = w((DEPTH, PLE_DIM, D_MODEL), PLE_DIM)
    d['final_norm'] = gain((D_MODEL,))
    return d


def reference(x_prompt, x_sample, cache_ckv, cache_kpe, state_ret, page_table, p_prompt, p_sample,
              ffn1_norm, ffn1_w_gate, ffn1_w_up, ffn1_w_down, mix_norm, w_in, q_a_norm, w_q_b,
              kv_a_norm, w_kv_b, ret_norm, w_branch_att, w_branch_ret, w_out,
              ffn2_norm, ffn2_w_gate, ffn2_w_up, ffn2_w_down, ple_norm, w_ple_gate, w_ple_proj,
              final_norm):
    n_past = page_table.shape[1] * PAGE_SIZE
    pos_p = jnp.arange(x_prompt.shape[1], dtype=jnp.int32)
    pos_s = n_past + jnp.arange(x_sample.shape[1], dtype=jnp.int32)
    log_gamma = retention_log_gamma()
    hp, hs = x_prompt, x_sample
    ckv_p, kpe_p, ret_p, ckv_s, kpe_s, ret_s = [], [], [], [], [], []
    for i in range(DEPTH):
        lp = {
            'ffn1_norm': ffn1_norm[i], 'ffn1_w_gate': ffn1_w_gate[i], 'ffn1_w_up': ffn1_w_up[i],
            'ffn1_w_down': ffn1_w_down[i], 'mix_norm': mix_norm[i], 'w_in': w_in[i],
            'q_a_norm': q_a_norm[i], 'w_q_b': w_q_b[i], 'kv_a_norm': kv_a_norm[i],
            'ret_norm': ret_norm[i], 'w_branch_att': w_branch_att[i], 'w_branch_ret': w_branch_ret[i],
            'w_out': w_out[i], 'ffn2_norm': ffn2_norm[i], 'ffn2_w_gate': ffn2_w_gate[i],
            'ffn2_w_up': ffn2_w_up[i], 'ffn2_w_down': ffn2_w_down[i], 'ple_norm': ple_norm[i],
            'w_ple_gate': w_ple_gate[i], 'w_ple_proj': w_ple_proj[i],
        }
        attend_p = functools.partial(mla_attend_prompt, w_kv_b=w_kv_b[i])
        retain_p = functools.partial(retention_prompt, log_gamma=log_gamma)
        hp, c1, k1, s1 = hybrid_layer(hp, p_prompt[i], pos_p, lp, attend_p, retain_p)
        attend_s = functools.partial(mla_attend_sample, w_kv_b=w_kv_b[i], cache_ckv=cache_ckv,
                                     cache_kpe=cache_kpe, page_table=page_table, layer=i)
        retain_s = functools.partial(retention_sample, state=state_ret[i], log_gamma=log_gamma)
        hs, c2, k2, s2 = hybrid_layer(hs, p_sample[i], pos_s, lp, attend_s, retain_s)
        ckv_p.append(c1); kpe_p.append(k1); ret_p.append(s1)
        ckv_s.append(c2); kpe_s.append(k2); ret_s.append(s2)
    y_prompt = rmsnorm(hp, final_norm)
    y_sample = rmsnorm(hs, final_norm)
    new_ckv_prompt = jnp.stack(ckv_p, axis=0)
    new_kpe_prompt = jnp.stack(kpe_p, axis=0)
    new_ret_prompt = jnp.stack(ret_p, axis=0)
    new_ckv_sample = jnp.stack(ckv_s, axis=0)
    new_kpe_sample = jnp.stack(kpe_s, axis=0)
    new_ret_sample = jnp.stack(ret_s, axis=0)
    return (y_prompt, y_sample, new_ckv_prompt, new_kpe_prompt, new_ret_prompt,
            new_ckv_sample, new_kpe_sample, new_ret_sample)
```

```cpp
#include <hip/hip_runtime.h>
#include <cstdio>
#include <cstdint>

#ifndef MK_PER_PHASE
#define MK_PER_PHASE 1
#endif

constexpr int DM = 1024, TSEQ = 8192, MP = 16384, MS = 128, MT = 16640, NPAN = MT / 256;
constexpr int DFF = 2816, NGU = 2 * DFF, NIN = 4608, PLE = 256;
constexpr int NH = 8, QKD = 96, KVL = 128, RPE = 32, QL = 256;
constexpr int RH = 4, RDK = 128, RDV = 128;
constexpr int NPAGES = 128, PAGE = 128;
constexpr float EPS = 1e-6f;
constexpr float C2 = 0.10206207261596575f * 1.4426950408889634f;
constexpr size_t O_YP = 0, O_YS = 16777216, O_CKVP = 16908288, O_KPEP = 19005440, O_RETP = 19529728, O_CKVS = 19660800, O_KPES = 19677184, O_RETS = 19681280, O_END = 28069888;

constexpr size_t MiB = 1u << 20;
constexpr size_t al1(size_t x) { return (x + MiB - 1) & ~(MiB - 1); }
constexpr size_t WS_CTL = 0, CTL_ZERO_BYTES = 1 * MiB;
constexpr size_t WS_WGU1 = 2 * MiB;
constexpr size_t WS_WD1  = WS_WGU1 + al1((size_t)NGU * DM * 2);
constexpr size_t WS_WIN  = WS_WD1 + al1((size_t)DM * DFF * 2);
constexpr size_t WS_WQB  = WS_WIN + al1((size_t)NIN * DM * 2);
constexpr size_t WS_WKVB = WS_WQB + al1((size_t)768 * 256 * 2);
constexpr size_t WS_WBC  = WS_WKVB + al1((size_t)1024 * 128 * 2);
constexpr size_t WS_WOUT = WS_WBC + al1((size_t)DM * DM * 2);
constexpr size_t WS_WGU2 = WS_WOUT + al1((size_t)DM * DM * 2);
constexpr size_t WS_WD2  = WS_WGU2 + al1((size_t)NGU * DM * 2);
constexpr size_t WS_WPG  = WS_WD2 + al1((size_t)DM * DFF * 2);
constexpr size_t WS_WPP  = WS_WPG + al1((size_t)DM * DM * 2);
constexpr size_t WS_ROPE = WS_WPP + al1((size_t)DM * PLE * 2);
constexpr size_t WS_XN1  = WS_ROPE + al1((size_t)8193 * 64 * 8);
constexpr size_t WS_ACT  = WS_XN1 + al1((size_t)MT * DM * 2);
constexpr size_t WS_H1   = WS_ACT + al1((size_t)MT * DFF * 2);
constexpr size_t WS_H1B  = WS_H1 + al1((size_t)MT * DM * 4);
constexpr size_t WS_CQB  = WS_H1B + al1((size_t)MT * DM * 2);
constexpr size_t WS_CKVF = WS_CQB + al1((size_t)MT * 256 * 2);
constexpr size_t WS_CKVB = WS_CKVF + al1((size_t)MT * 128 * 4);
constexpr size_t WS_KPEB = WS_CKVB + al1((size_t)MT * 128 * 2);
constexpr size_t WS_QR   = WS_KPEB + al1((size_t)MT * 32 * 2);
constexpr size_t WS_KR   = WS_QR + al1((size_t)MT * 512 * 2);
constexpr size_t WS_RV   = WS_KR + al1((size_t)MT * 512 * 2);
constexpr size_t WS_RGS  = WS_RV + al1((size_t)MT * 512 * 2);
constexpr size_t WS_SGA  = WS_RGS + al1((size_t)MT * 512 * 2);
constexpr size_t WS_SGR  = WS_SGA + al1((size_t)MT * DM * 2);
constexpr size_t WS_QB   = WS_SGR + al1((size_t)MT * DM * 2);
constexpr size_t WS_KN   = WS_QB + al1((size_t)MT * 768 * 2);
constexpr size_t WS_VB   = WS_KN + al1((size_t)MP * 512 * 2);
constexpr size_t WS_OCAT = WS_VB + al1((size_t)MP * 512 * 2);
constexpr size_t WS_KVC  = WS_OCAT + al1((size_t)MT * DM * 2);
constexpr size_t WS_SC   = WS_KVC + al1((size_t)512 * 16384 * 4);
constexpr size_t WS_MRG  = WS_SC + al1((size_t)512 * 16384 * 2);
constexpr size_t WS_H2   = WS_MRG + al1((size_t)MT * DM * 2);
constexpr size_t WS_H2B  = WS_H2 + al1((size_t)MT * DM * 4);
constexpr size_t WS_H3   = WS_H2B + al1((size_t)MT * DM * 2);
constexpr size_t WS_H3B  = WS_H3 + al1((size_t)MT * DM * 4);
constexpr size_t WS_PB   = WS_H3B + al1((size_t)MT * DM * 2);
constexpr size_t WS_PP   = WS_PB + al1((size_t)MT * PLE * 2);
constexpr size_t WS_H4   = WS_PP + al1((size_t)MT * DM * 2);
constexpr size_t WS_DPO  = WS_H4 + al1((size_t)MT * DM * 4);
constexpr size_t WS_DML  = WS_DPO + al1((size_t)128 * 8 * 8 * 128 * 4);
constexpr size_t WS_QLAT = WS_DML + MiB;
constexpr size_t WS_SSQ  = WS_QLAT + MiB;
constexpr size_t SSQ16_BYTES = (size_t)MT * 16 * 4, SSQ4_BYTES = (size_t)MT * 4 * 4;
constexpr size_t WS_END  = WS_SSQ + al1(4 * SSQ16_BYTES + 2 * SSQ4_BYTES);
constexpr int CW_TMO = 0, CW_BAR = 4096;

constexpr int RING_BYTES = 131072, LDSCTL_OFF = RING_BYTES, MISC_OFF = LDSCTL_OFF + 320, LDS_BYTES = 147456;

#define GAS __attribute__((address_space(1)))
#define LAS __attribute__((address_space(3)))
typedef unsigned short bf16;
typedef unsigned v4u __attribute__((ext_vector_type(4)));
typedef unsigned v2u __attribute__((ext_vector_type(2)));
typedef GAS unsigned gu32;
#define RLX_AGENT __ATOMIC_RELAXED, __HIP_MEMORY_SCOPE_AGENT
#define LDS_WAIT() asm volatile("s_waitcnt lgkmcnt(0)" ::: "memory")
#define VM_WAIT() asm volatile("s_waitcnt vmcnt(0)" ::: "memory")
__device__ __forceinline__ unsigned f2bf(float f) { unsigned u = __builtin_bit_cast(unsigned, f); return (u + 0x7fffu + ((u >> 16) & 1u)) >> 16; }
__device__ __forceinline__ unsigned pk2(float lo, float hi) { return f2bf(lo) | (f2bf(hi) << 16); }
__device__ __forceinline__ float bflo(unsigned w) { return __builtin_bit_cast(float, w << 16); }
__device__ __forceinline__ float bfhi(unsigned w) { return __builtin_bit_cast(float, w & 0xffff0000u); }
__device__ __forceinline__ float bf2f(bf16 h) { return __builtin_bit_cast(float, (unsigned)h << 16); }
__device__ __forceinline__ float sigm(float x) { return __builtin_amdgcn_rcpf(1.f + __builtin_amdgcn_exp2f(-1.4426950408889634f * x)); }
__device__ __forceinline__ float wave_sum(float v) {
#pragma unroll
    for (int o = 1; o < 64; o <<= 1) v += __shfl_xor(v, o);
    return v;
}
__device__ __forceinline__ float lg2gamma(int h) { return h == 0 ? -0.04580368961312479f : h == 1 ? -0.02272007650008353f : h == 2 ? -0.011315313227834146f : -0.005646563141142063f; }
namespace pg8 {
#define PG8_LAS __attribute__((address_space(3)))
typedef unsigned short bf16_t;
typedef short bf16x8 __attribute__((ext_vector_type(8)));
typedef float f32x4 __attribute__((ext_vector_type(4)));
typedef unsigned u32x4 __attribute__((ext_vector_type(4)));
constexpr int BM = 256, BK = 64, HALF = 128, HTB = HALF * BK * 2  , STAGE_BYTES = 8 * HTB, NXCD = 8, WGM = 8;

__host__ __device__ __forceinline__ int lds_byte(int r, int c) { const int st = (r >> 4) * 2 + (c >> 5), rr = r & 15, cc = c & 31, ob = rr * 64 + cc * 2; return st * 1024 + (ob ^ (((ob >> 9) & 1) << 5)); }
__host__ __device__ __forceinline__ void stage_rc(int b, int& R, int& C) { const int st = b / 1024, sb = b % 1024, swz = sb ^ (((sb >> 9) & 1) << 5); R = (st >> 1) * 16 + swz / 64; C = (st & 1) * 32 + (swz % 64) / 2; }
__host__ __device__ __forceinline__ int perm32(int rho) { const int n = rho >> 4, i = rho & 15; return 8 * (i >> 2) + 4 * n + (i & 3); }

struct Unit { int pm, pn; };
struct Gemm { const bf16_t* A; const bf16_t* Bt; int M, N, K; };

struct StaticOrder {
    int nM, nN, nwg, G, c;
    __host__ __device__ void init(int M, int N, int G_, int c_) { nM = M / BM; nN = N / BM; nwg = nM * nN; G = G_; c = c_; }
    __host__ __device__ bool next(int i, Unit& u) const {
        const long L = (long)i * G + c; if (L >= nwg) return false;
        int wgid = (int)L; { const int q = nwg / NXCD, r = nwg % NXCD, xcd = wgid % NXCD, off = wgid / NXCD; wgid = (xcd < r ? xcd * (q + 1) : r * (q + 1) + (xcd - r) * q) + off; }
        const int nig = WGM * nN, gid = wgid / nig, fm = gid * WGM, gsz = (nM - fm) < WGM ? (nM - fm) : WGM;
        u.pm = fm + ((wgid % nig) % gsz); u.pn = (wgid % nig) / gsz; return true;
    }
    __device__ __forceinline__ void a_ready(const Unit&) const {}
    __device__ __forceinline__ void done(const Unit&) const {}
};

typedef float cvt_f32x2_t __attribute__((ext_vector_type(2))); typedef __bf16 cvt_bf16x2_t __attribute__((ext_vector_type(2)));
__device__ __forceinline__ unsigned cvt_pk_bf16(float lo, float hi) { cvt_f32x2_t v = {lo, hi}; cvt_bf16x2_t b = __builtin_convertvector(v, cvt_bf16x2_t); return __builtin_bit_cast(unsigned, b); }
typedef float f32x2 __attribute__((ext_vector_type(2)));
template <class Epi, class Sched, bool ALIGN_EPI = false, bool SP2 = false>
__device__ __forceinline__ void gemm_phase(PG8_LAS unsigned char* lds, const Gemm g, const Sched S, const Epi E) {
    int tid_ = threadIdx.x; asm volatile("" : "+v"(tid_));
    const int tid = tid_, wid = __builtin_amdgcn_readfirstlane(tid >> 6), lane = tid & 63, wr = wid >> 2, wc = wid & 3, fr = lane & 15, fq = lane >> 4;
    const int K = g.K, nt = K / BK;
    unsigned voffA[2], voffB[2];
#pragma unroll
    for (int i = 0; i < 2; ++i) { int R, C; stage_rc(tid * 16 + i * 8192, R, C); const int Rb = Epi::PERM ? ((R & ~31) + perm32(R & 31)) : R;
        voffA[i] = (unsigned)(R * K + C) * 2u; voffB[i] = (unsigned)(Rb * K + C) * 2u; }
    const size_t kstep = (size_t)(BK * 2);
    const size_t hstep = (size_t)HALF * K * 2;
    const size_t tstep = 2 * hstep;
    const unsigned ldsw = (unsigned)wid * 1024u;
    const int aoff = lds_byte(wr * 64 + fr, fq * 8), boff = lds_byte(wc * 32 + fr, fq * 8);
#define PG8_SA(b, h) (((b) * 2 + (h)) * HTB)
#define PG8_SB(b, h) ((4 + (b) * 2 + (h)) * HTB)
#define PG8_STAGE(bufoff, gbase, voff) do { _Pragma("unroll") for (int _i = 0; _i < 2; ++_i) \
        __builtin_amdgcn_global_load_lds((const unsigned*)((const char*)(gbase) + (voff)[_i]), (PG8_LAS unsigned*)(lds + (bufoff) + ldsw + _i * 8192), 16, 0, 0); } while (0)
#define PG8_LDA(dst, b, h) do { _Pragma("unroll") for (int m = 0; m < 4; ++m) _Pragma("unroll") for (int k = 0; k < 2; ++k) dst[m][k] = *(const PG8_LAS bf16x8*)(lds + PG8_SA(b, h) + aoff + m * 2048 + k * 1024); } while (0)
#define PG8_LDB(dst, b, h) do { _Pragma("unroll") for (int n = 0; n < 2; ++n) _Pragma("unroll") for (int k = 0; k < 2; ++k) dst[n][k] = *(const PG8_LAS bf16x8*)(lds + PG8_SB(b, h) + boff + n * 2048 + k * 1024); } while (0)
#define PG8_MMA(ai, bj, At, Bt) do { __builtin_amdgcn_s_setprio(1); _Pragma("unroll") for (int m = 0; m < 4; ++m) _Pragma("unroll") for (int n = 0; n < 2; ++n) _Pragma("unroll") for (int k = 0; k < 2; ++k) \
        acc[ai][bj][m][n] = __builtin_amdgcn_mfma_f32_16x16x32_bf16(Bt[n][k], At[m][k], acc[ai][bj][m][n], 0, 0, 0); __builtin_amdgcn_s_setprio(0); } while (0)
#define PG8_WAIT_V(n) asm volatile("s_waitcnt vmcnt(" #n ")" ::: "memory")
#define PG8_WAIT_L(n) asm volatile("s_waitcnt lgkmcnt(" #n ")" ::: "memory")
#define PG8_BAR __builtin_amdgcn_s_barrier()
#define PG8_SCHED __builtin_amdgcn_sched_barrier(0)
    Unit cur, nxt; int ui = 0;
    if (!S.next(0, cur)) return;
    f32x4 acc[2][2][4][2];
#pragma unroll
    for (int a = 0; a < 2; ++a)
#pragma unroll
        for (int b = 0; b < 2; ++b)
#pragma unroll
            for (int m = 0; m < 4; ++m)
#pragma unroll
                for (int n = 0; n < 2; ++n) acc[a][b][m][n] = (f32x4){0.f, 0.f, 0.f, 0.f};
    bf16x8 At[4][2], B0[2][2], B1[2][2];
    const char* cA = (const char*)g.A + (size_t)cur.pm * tstep; const char* cB = (const char*)g.Bt + (size_t)cur.pn * tstep;
    S.a_ready(cur);
    if constexpr (SP2) {
        PG8_STAGE(PG8_SB(0, 0), cB, voffB); PG8_STAGE(PG8_SB(0, 1), cB + hstep, voffB); PG8_STAGE(PG8_SA(0, 0), cA, voffA); PG8_STAGE(PG8_SA(0, 1), cA + hstep, voffA);
        if (wr == 1) PG8_BAR;
        PG8_WAIT_V(2); PG8_BAR;
        PG8_STAGE(PG8_SB(1, 0), cB + kstep, voffB); PG8_STAGE(PG8_SA(1, 0), cA + kstep, voffA); PG8_STAGE(PG8_SB(1, 1), cB + hstep + kstep, voffB);
        PG8_WAIT_V(6); PG8_BAR;
    } else {
        PG8_STAGE(PG8_SB(0, 0), cB, voffB); PG8_STAGE(PG8_SA(0, 0), cA, voffA); PG8_STAGE(PG8_SB(0, 1), cB + hstep, voffB); PG8_STAGE(PG8_SA(0, 1), cA + hstep, voffA);
        if (wr == 1) PG8_BAR;
        PG8_WAIT_V(4); PG8_BAR;
        PG8_STAGE(PG8_SB(1, 0), cB + kstep, voffB); PG8_STAGE(PG8_SA(1, 0), cA + kstep, voffA); PG8_STAGE(PG8_SB(1, 1), cB + hstep + kstep, voffB);
        PG8_WAIT_V(6); PG8_BAR;
    }
    for (;;) {
        const bool has_next = S.next(ui + 1, nxt);
        const char* nA = has_next ? (const char*)g.A + (size_t)nxt.pm * tstep : cA; const char* nB = has_next ? (const char*)g.Bt + (size_t)nxt.pn * tstep : cB;
#pragma nounroll
        for (int t = 0; t < nt; t += 2) {
            if constexpr (Epi::HAS_MID) { if (t == E.mid_t) E.mid(acc, cur, wr, wc, fr, fq); }
            const bool last = (t == nt - 2);
            const char* a1 = cA + (size_t)(t + 1) * kstep;
            const char* a2 = last ? nA : cA + (size_t)(t + 2) * kstep; const char* b2 = last ? nB : cB + (size_t)(t + 2) * kstep;
            const char* a3 = a2 + kstep; const char* b3 = b2 + kstep;
            if (last && has_next) S.a_ready(nxt);
            if constexpr (SP2) {
            PG8_LDB(B0, 0, 0); PG8_LDB(B1, 0, 1); PG8_SCHED; PG8_LDA(At, 0, 0); PG8_STAGE(PG8_SA(1, 1), a1 + hstep, voffA);
            PG8_WAIT_V(8); PG8_WAIT_L(0); PG8_BAR; PG8_MMA(0, 0, At, B0); PG8_MMA(0, 1, At, B1); PG8_BAR; PG8_SCHED;
            PG8_LDA(At, 0, 1); PG8_STAGE(PG8_SB(0, 0), b2, voffB); PG8_STAGE(PG8_SB(0, 1), b2 + hstep, voffB); PG8_STAGE(PG8_SA(0, 0), a2, voffA);
            PG8_WAIT_V(8); PG8_WAIT_L(0); PG8_BAR; PG8_MMA(1, 0, At, B0); PG8_MMA(1, 1, At, B1); PG8_BAR; PG8_SCHED;
            PG8_LDB(B0, 1, 0); PG8_LDB(B1, 1, 1); PG8_SCHED; PG8_LDA(At, 1, 0); PG8_STAGE(PG8_SA(0, 1), a2 + hstep, voffA);
            PG8_WAIT_V(8); PG8_WAIT_L(0); PG8_BAR; PG8_MMA(0, 0, At, B0); PG8_MMA(0, 1, At, B1); PG8_BAR; PG8_SCHED;
            PG8_LDA(At, 1, 1); PG8_STAGE(PG8_SB(1, 0), b3, voffB); PG8_STAGE(PG8_SB(1, 1), b3 + hstep, voffB); PG8_STAGE(PG8_SA(1, 0), a3, voffA);
            PG8_WAIT_V(8); PG8_WAIT_L(0); PG8_BAR; PG8_MMA(1, 0, At, B0); PG8_MMA(1, 1, At, B1); PG8_BAR; PG8_SCHED;
            } else {
            PG8_LDB(B0, 0, 0); PG8_SCHED; PG8_LDA(At, 0, 0); PG8_STAGE(PG8_SA(1, 1), a1 + hstep, voffA);
            PG8_WAIT_L(8); PG8_BAR; PG8_WAIT_L(0); PG8_MMA(0, 0, At, B0); PG8_BAR; PG8_SCHED;
            PG8_LDB(B1, 0, 1); PG8_STAGE(PG8_SB(0, 0), b2, voffB);
            PG8_BAR; PG8_WAIT_L(0); PG8_MMA(0, 1, At, B1); PG8_BAR;
            PG8_LDA(At, 0, 1); PG8_STAGE(PG8_SA(0, 0), a2, voffA);
            PG8_BAR; PG8_WAIT_L(0); PG8_MMA(1, 0, At, B0); PG8_BAR; PG8_SCHED;
            PG8_STAGE(PG8_SB(0, 1), b2 + hstep, voffB);
            PG8_WAIT_V(6); PG8_BAR; PG8_MMA(1, 1, At, B1); PG8_BAR;
            PG8_LDB(B0, 1, 0); PG8_SCHED; PG8_LDA(At, 1, 0); PG8_STAGE(PG8_SA(0, 1), a2 + hstep, voffA);
            PG8_WAIT_L(8); PG8_BAR; PG8_WAIT_L(0); PG8_MMA(0, 0, At, B0); PG8_BAR; PG8_SCHED;
            PG8_LDB(B1, 1, 1); PG8_STAGE(PG8_SB(1, 0), b3, voffB);
            PG8_BAR; PG8_WAIT_L(0); PG8_MMA(0, 1, At, B1); PG8_BAR;
            PG8_LDA(At, 1, 1); PG8_STAGE(PG8_SA(1, 0), a3, voffA);
            PG8_BAR; PG8_WAIT_L(0); PG8_MMA(1, 0, At, B0); PG8_BAR; PG8_SCHED;
            PG8_STAGE(PG8_SB(1, 1), b3 + hstep, voffB);
            PG8_WAIT_V(6); PG8_BAR; PG8_MMA(1, 1, At, B1); PG8_BAR;
            }
        }
        if constexpr (ALIGN_EPI) { if (wr == 0) PG8_BAR; }
        if constexpr (!Epi::AFTER_DRAIN) { E(acc, cur, wr, wc, fr, fq); S.done(cur); }
        if (!has_next) break;
#pragma unroll
        for (int a = 0; a < 2; ++a)
#pragma unroll
            for (int b = 0; b < 2; ++b)
#pragma unroll
                for (int m = 0; m < 4; ++m)
#pragma unroll
                    for (int n = 0; n < 2; ++n) acc[a][b][m][n] = (f32x4){0.f, 0.f, 0.f, 0.f};
        cur = nxt; cA = nA; cB = nB; ++ui;
        if constexpr (ALIGN_EPI) { if (wr == 1) PG8_BAR; }
    }
    PG8_WAIT_V(0);
    if constexpr (!ALIGN_EPI) { if (wr == 0) PG8_BAR; }
    PG8_BAR;
    if constexpr (Epi::AFTER_DRAIN) { E.fused(acc, cur, wr, wc, fr, fq, lds, wid, lane); S.done(cur); }
#undef PG8_SA
#undef PG8_SB
#undef PG8_STAGE
#undef PG8_LDA
#undef PG8_LDB
#undef PG8_MMA
#undef PG8_WAIT_V
#undef PG8_WAIT_L
#undef PG8_BAR
#undef PG8_SCHED
}
}
namespace pg8 {
#define EPI_ROWS(ai, m) (u.pm * BM + (ai) * HALF + wr * 64 + (m) * 16 + fr)
#define EPI_OPAQUE int fr = fr_, fq = fq_; asm volatile("" : "+v"(fr), "+v"(fq))
__device__ __forceinline__ u32x4 pack8(f32x4 a, f32x4 b) { u32x4 w; w.x = cvt_pk_bf16(a[0], a[1]); w.y = cvt_pk_bf16(a[2], a[3]); w.z = cvt_pk_bf16(b[0], b[1]); w.w = cvt_pk_bf16(b[2], b[3]); return w; }
__device__ __forceinline__ float sq4(f32x4 a) { return (a[0] * a[0] + a[1] * a[1]) + (a[2] * a[2] + a[3] * a[3]); }
template <int NS> __device__ __forceinline__ float rstd_of(const float* part, int row, float invn) {
    float s = 0.f;
#pragma unroll
    for (int i = 0; i < NS; i += 4) { const f32x4 v = *(const f32x4*)(part + (size_t)row * NS + i); s += (v[0] + v[1]) + (v[2] + v[3]); }
    return 1.0f / sqrtf(s * invn + EPS);
}
template <int NS> __device__ __forceinline__ void ssq_put(float* part, int row, int slot, float s, int fq) { s += __shfl_xor(s, 16); s += __shfl_xor(s, 32); if (fq == 0) part[(size_t)row * NS + slot] = s; }
__device__ __forceinline__ float silu_f(float x) { return x * sigm(x); }
__device__ __forceinline__ int pos_of_row(int row) { return row < MP ? (row & (TSEQ - 1)) : TSEQ; }

struct EpiSwiGLU {
    static constexpr bool PERM = true, AFTER_DRAIN = false, HAS_MID = false; int mid_t;
    bf16_t* O; const float* ssq;
    __device__ __forceinline__ void mid(f32x4 (&)[2][2][4][2], const Unit&, int, int, int, int) const {}
    __device__ __forceinline__ void operator()(const f32x4 (&acc)[2][2][4][2], const Unit& u, int wr, int wc, int fr_, int fq_) const { EPI_OPAQUE;
        const int col0 = u.pn * HALF + wc * 32 + 8 * fq;
#pragma unroll
        for (int ai = 0; ai < 2; ++ai)
#pragma unroll
            for (int m = 0; m < 4; ++m) { const int row = EPI_ROWS(ai, m); const float rs = ssq ? rstd_of<16>(ssq, row, 1.0f / DM) : 1.0f;
                f32x4 o[2];
#pragma unroll
                for (int n = 0; n < 2; ++n)
#pragma unroll
                    for (int j = 0; j < 4; ++j) o[n][j] = silu_f(acc[ai][0][m][n][j] * rs) * (acc[ai][1][m][n][j] * rs);
                *(u32x4*)(O + (size_t)row * DFF + col0) = pack8(o[0], o[1]); }
    }
};

template <bool HALFA> struct EpiResid {
    static constexpr bool PERM = true, AFTER_DRAIN = false, HAS_MID = false; int mid_t; static constexpr float alpha = HALFA ? 0.5f : 1.0f;
    const float* R; const float* Rs; int mode; float* Hf; bf16_t* Hb; float* ssq;
    __device__ __forceinline__ void mid(f32x4 (&)[2][2][4][2], const Unit&, int, int, int, int) const {}
    __device__ __forceinline__ void operator()(const f32x4 (&acc)[2][2][4][2], const Unit& u, int wr, int wc, int fr_, int fq_) const { EPI_OPAQUE;
        const int colb = u.pn * BM + wc * 32 + 8 * fq;
#pragma unroll
        for (int ai = 0; ai < 2; ++ai)
#pragma unroll
            for (int m = 0; m < 4; ++m) { const int row = EPI_ROWS(ai, m);
                const bool pad = (mode == 0) && row >= MP + MS; const float keep = pad ? 0.f : 1.f;
                const float* rp = (mode == 0 && row >= MP) ? (pad ? R : Rs + (size_t)(row - MP) * DM) : R + (size_t)row * DM;
                float s = 0.f;
#pragma unroll
                for (int bj = 0; bj < 2; ++bj) { const int col = colb + bj * HALF;
                    const f32x4 r0 = *(const f32x4*)(rp + col) * keep, r1 = *(const f32x4*)(rp + col + 4) * keep;
                    const f32x4 h0 = r0 + acc[ai][bj][m][0] * alpha, h1 = r1 + acc[ai][bj][m][1] * alpha;
                    *(f32x4*)(Hf + (size_t)row * DM + col) = h0; *(f32x4*)(Hf + (size_t)row * DM + col + 4) = h1;
                    *(u32x4*)(Hb + (size_t)row * DM + col) = pack8(h0, h1);
                    s += sq4(h0) + sq4(h1); }
                ssq_put<16>(ssq, row, u.pn * 4 + wc, s, fq); }
    }
};

__device__ __forceinline__ void rope4(const float2* tabrow, int i0, int istride, f32x4 x1, f32x4 x2, f32x4& y1, f32x4& y2) {
#pragma unroll
    for (int j = 0; j < 4; ++j) { const float2 cs = tabrow[(i0 + j) * istride]; y1[j] = x1[j] * cs.x - x2[j] * cs.y; y2[j] = x1[j] * cs.y + x2[j] * cs.x; }
}

struct EpiWin {
    static constexpr bool PERM = true, AFTER_DRAIN = false, HAS_MID = false; int mid_t;
    const float* ssq1; float* ssq_cq; float* ssq_kv; const float2* rope; float* dout;
    bf16_t *CQB, *CKVB, *KPEB, *QR, *KR, *RV, *RGS, *SGA, *SGR; float* CKVF;
    __device__ __forceinline__ void mid(f32x4 (&)[2][2][4][2], const Unit&, int, int, int, int) const {}
    __device__ __forceinline__ void operator()(const f32x4 (&acc)[2][2][4][2], const Unit& u, int wr, int wc, int fr_, int fq_) const { EPI_OPAQUE;
        const int pn = u.pn, c8 = wc * 32 + 8 * fq;
#pragma unroll
        for (int ai = 0; ai < 2; ++ai)
#pragma unroll
            for (int m = 0; m < 4; ++m) { const int row = EPI_ROWS(ai, m); const float rs = rstd_of<16>(ssq1, row, 1.0f / DM);
                if (pn == 0) {
                    float s = 0.f;
#pragma unroll
                    for (int bj = 0; bj < 2; ++bj) { const f32x4 a = acc[ai][bj][m][0] * rs, b = acc[ai][bj][m][1] * rs; s += sq4(a) + sq4(b);
                        *(u32x4*)(CQB + (size_t)row * QL + bj * HALF + c8) = pack8(a, b); }
                    ssq_put<4>(ssq_cq, row, wc, s, fq);
                } else if (pn == 1) {
                    { const f32x4 a = acc[ai][0][m][0] * rs, b = acc[ai][0][m][1] * rs;
                      *(f32x4*)(CKVF + (size_t)row * KVL + c8) = a; *(f32x4*)(CKVF + (size_t)row * KVL + c8 + 4) = b;
                      *(u32x4*)(CKVB + (size_t)row * KVL + c8) = pack8(a, b);
                      ssq_put<4>(ssq_kv, row, wc, sq4(a) + sq4(b), fq); }
                    if (wc == 0) { f32x4 y1, y2; rope4(rope + (size_t)pos_of_row(row) * 64, 4 * fq, 4, acc[ai][1][m][0] * rs, acc[ai][1][m][1] * rs, y1, y2);
                        float* o = row < MP ? dout + O_KPEP + (size_t)row * RPE : (row < MP + MS ? dout + O_KPES + (size_t)(row - MP) * RPE : nullptr);
                        if (o) { *(f32x4*)(o + 4 * fq) = y1; *(f32x4*)(o + 16 + 4 * fq) = y2; }
                        v2u w1, w2; w1.x = cvt_pk_bf16(y1[0], y1[1]); w1.y = cvt_pk_bf16(y1[2], y1[3]); w2.x = cvt_pk_bf16(y2[0], y2[1]); w2.y = cvt_pk_bf16(y2[2], y2[3]);
                        *(v2u*)(KPEB + (size_t)row * RPE + 4 * fq) = w1; *(v2u*)(KPEB + (size_t)row * RPE + 16 + 4 * fq) = w2; }
                } else if (pn < 6) {
                    const bool isk = pn >= 4; const int ic = row < MP ? (row & 127) : 0; const float2* tr = rope + (size_t)pos_of_row(row) * 64;
#pragma unroll
                    for (int bj = 0; bj < 2; ++bj) { const int hh = 2 * (pn - (isk ? 4 : 2)) + bj; const float lg = lg2gamma(hh) * (float)ic;
                        const float fs = rs * (isk ? __builtin_amdgcn_exp2f(-lg) * 0.08838834764831845f : __builtin_amdgcn_exp2f(lg));
                        f32x4 y1, y2; rope4(tr, 16 * wc + 4 * fq, 1, acc[ai][bj][m][0] * fs, acc[ai][bj][m][1] * fs, y1, y2);
                        bf16_t* o = (isk ? KR : QR) + (size_t)row * 512 + hh * 128 + 16 * wc + 4 * fq;
                        v2u w1, w2; w1.x = cvt_pk_bf16(y1[0], y1[1]); w1.y = cvt_pk_bf16(y1[2], y1[3]); w2.x = cvt_pk_bf16(y2[0], y2[1]); w2.y = cvt_pk_bf16(y2[2], y2[3]);
                        *(v2u*)o = w1; *(v2u*)(o + 64) = w2; }
                } else if (pn < 8) {
#pragma unroll
                    for (int bj = 0; bj < 2; ++bj) *(u32x4*)(RV + (size_t)row * 512 + (pn - 6) * BM + bj * HALF + c8) = pack8(acc[ai][bj][m][0] * rs, acc[ai][bj][m][1] * rs);
                } else if (pn < 10) {
#pragma unroll
                    for (int bj = 0; bj < 2; ++bj) { f32x4 a = acc[ai][bj][m][0] * rs, b = acc[ai][bj][m][1] * rs;
#pragma unroll
                        for (int j = 0; j < 4; ++j) { a[j] = silu_f(a[j]); b[j] = silu_f(b[j]); }
                        *(u32x4*)(RGS + (size_t)row * 512 + (pn - 8) * BM + bj * HALF + c8) = pack8(a, b); }
                } else {
                    bf16_t* base = pn < 14 ? SGA + (size_t)(pn - 10) * BM : SGR + (size_t)(pn - 14) * BM;
#pragma unroll
                    for (int bj = 0; bj < 2; ++bj) { f32x4 a = acc[ai][bj][m][0] * rs, b = acc[ai][bj][m][1] * rs;
#pragma unroll
                        for (int j = 0; j < 4; ++j) { a[j] = sigm(a[j]); b[j] = sigm(b[j]); }
                        *(u32x4*)(base + (size_t)row * DM + bj * HALF + c8) = pack8(a, b); }
                }
            }
    }
};

struct EpiQB {
    static constexpr bool PERM = true, AFTER_DRAIN = false, HAS_MID = false; int mid_t;
    const float* ssq_cq; const float2* rope; bf16_t* QB;
    __device__ __forceinline__ void mid(f32x4 (&)[2][2][4][2], const Unit&, int, int, int, int) const {}
    __device__ __forceinline__ void operator()(const f32x4 (&acc)[2][2][4][2], const Unit& u, int wr, int wc, int fr_, int fq_) const { EPI_OPAQUE;
#pragma unroll
        for (int ai = 0; ai < 2; ++ai)
#pragma unroll
            for (int m = 0; m < 4; ++m) { const int row = EPI_ROWS(ai, m); const float rs = rstd_of<4>(ssq_cq, row, 1.0f / QL);
                bf16_t* qrow = QB + (size_t)row * 768;
                if (u.pn < 2) {
#pragma unroll
                    for (int bj = 0; bj < 2; ++bj) { const int cidx = bj * HALF + wc * 32 + 8 * fq, hh = u.pn * 4 + (cidx >> 6), d = cidx & 63;
                        *(u32x4*)(qrow + hh * QKD + d) = pack8(acc[ai][bj][m][0] * rs, acc[ai][bj][m][1] * rs); }
                } else { const float2* tr = rope + (size_t)pos_of_row(row) * 64;
#pragma unroll
                    for (int bj = 0; bj < 2; ++bj) { const int hh = bj * 4 + wc; f32x4 y1, y2; rope4(tr, 4 * fq, 4, acc[ai][bj][m][0] * rs, acc[ai][bj][m][1] * rs, y1, y2);
                        v2u w1, w2; w1.x = cvt_pk_bf16(y1[0], y1[1]); w1.y = cvt_pk_bf16(y1[2], y1[3]); w2.x = cvt_pk_bf16(y2[0], y2[1]); w2.y = cvt_pk_bf16(y2[2], y2[3]);
                        *(v2u*)(qrow + hh * QKD + 64 + 4 * fq) = w1; *(v2u*)(qrow + hh * QKD + 80 + 4 * fq) = w2; }
                }
                asm volatile("" ::: "memory");
            }
    }
};

struct EpiPlain {
    static constexpr bool PERM = true, AFTER_DRAIN = false, HAS_MID = false; int mid_t;
    bf16_t* O0; bf16_t* O1; int ld; int split_tiles; const float* ssq; float invn;
    __device__ __forceinline__ void mid(f32x4 (&)[2][2][4][2], const Unit&, int, int, int, int) const {}
    __device__ __forceinline__ void operator()(const f32x4 (&acc)[2][2][4][2], const Unit& u, int wr, int wc, int fr_, int fq_) const { EPI_OPAQUE;
        bf16_t* base = u.pn < split_tiles ? O0 + (size_t)u.pn * BM : O1 + (size_t)(u.pn - split_tiles) * BM;
#pragma unroll
        for (int ai = 0; ai < 2; ++ai)
#pragma unroll
            for (int m = 0; m < 4; ++m) { const int row = EPI_ROWS(ai, m); const float rs = ssq ? rstd_of<4>(ssq, row, invn) : 1.0f;
#pragma unroll
                for (int bj = 0; bj < 2; ++bj) *(u32x4*)(base + (size_t)row * ld + bj * HALF + wc * 32 + 8 * fq) = pack8(acc[ai][bj][m][0] * rs, acc[ai][bj][m][1] * rs); }
    }
};

struct EpiMerge {
    static constexpr bool PERM = true, AFTER_DRAIN = false, HAS_MID = true; int mid_t;
    const bf16_t* SGA; const bf16_t* SGR; bf16_t* O;
    __device__ __forceinline__ void mid(f32x4 (&acc)[2][2][4][2], const Unit& u, int wr, int wc, int fr_, int fq) const {
        int fr = fr_; asm volatile("" : "+v"(fr));
#pragma unroll
        for (int ai = 0; ai < 2; ++ai)
#pragma unroll
            for (int m = 0; m < 4; ++m) { const int row = EPI_ROWS(ai, m);
#pragma unroll
                for (int bj = 0; bj < 2; ++bj) { const size_t off = (size_t)row * DM + u.pn * BM + bj * HALF + wc * 32 + 8 * fq;
                    const u32x4 a = *(const u32x4*)(SGA + off), r = *(const u32x4*)(SGR + off);
#pragma unroll
                    for (int q = 0; q < 4; ++q) { const float alo = bflo(a[q]), ahi = bfhi(a[q]), rlo = fmaxf(bflo(r[q]), 1e-30f), rhi = fmaxf(bfhi(r[q]), 1e-30f);
                        acc[ai][bj][m][q >> 1][(q & 1) * 2] *= alo * __builtin_amdgcn_rcpf(rlo); acc[ai][bj][m][q >> 1][(q & 1) * 2 + 1] *= ahi * __builtin_amdgcn_rcpf(rhi); } }
                asm volatile("" ::: "memory"); }
    }
    __device__ __forceinline__ void operator()(const f32x4 (&acc)[2][2][4][2], const Unit& u, int wr, int wc, int fr_, int fq_) const { EPI_OPAQUE;
#pragma unroll
        for (int ai = 0; ai < 2; ++ai)
#pragma unroll
            for (int m = 0; m < 4; ++m) { const int row = EPI_ROWS(ai, m);
#pragma unroll
                for (int bj = 0; bj < 2; ++bj) { const size_t off = (size_t)row * DM + u.pn * BM + bj * HALF + wc * 32 + 8 * fq;
                    const u32x4 r = *(const u32x4*)(SGR + off); f32x4 o0, o1;
                    o0[0] = acc[ai][bj][m][0][0] * fmaxf(bflo(r[0]), 1e-30f); o0[1] = acc[ai][bj][m][0][1] * fmaxf(bfhi(r[0]), 1e-30f);
                    o0[2] = acc[ai][bj][m][0][2] * fmaxf(bflo(r[1]), 1e-30f); o0[3] = acc[ai][bj][m][0][3] * fmaxf(bfhi(r[1]), 1e-30f);
                    o1[0] = acc[ai][bj][m][1][0] * fmaxf(bflo(r[2]), 1e-30f); o1[1] = acc[ai][bj][m][1][1] * fmaxf(bfhi(r[2]), 1e-30f);
                    o1[2] = acc[ai][bj][m][1][2] * fmaxf(bflo(r[3]), 1e-30f); o1[3] = acc[ai][bj][m][1][3] * fmaxf(bfhi(r[3]), 1e-30f);
                    *(u32x4*)(O + off) = pack8(o0, o1); }
                asm volatile("" ::: "memory"); }
    }
};

struct EpiPle {
    static constexpr bool PERM = true, AFTER_DRAIN = false, HAS_MID = false; int mid_t;
    const float* H3; const bf16_t* PP; const float* ssq3; float* H4; float* ssq4;
    __device__ __forceinline__ void mid(f32x4 (&)[2][2][4][2], const Unit&, int, int, int, int) const {}
    __device__ __forceinline__ void operator()(const f32x4 (&acc)[2][2][4][2], const Unit& u, int wr, int wc, int fr_, int fq_) const { EPI_OPAQUE;
#pragma unroll
        for (int ai = 0; ai < 2; ++ai)
#pragma unroll
            for (int m = 0; m < 4; ++m) { const int row = EPI_ROWS(ai, m); const float rs = rstd_of<16>(ssq3, row, 1.0f / DM); float s = 0.f;
#pragma unroll
                for (int bj = 0; bj < 2; ++bj) { const size_t off = (size_t)row * DM + u.pn * BM + bj * HALF + wc * 32 + 8 * fq;
                    const u32x4 p = *(const u32x4*)(PP + off); const f32x4 r0 = *(const f32x4*)(H3 + off), r1 = *(const f32x4*)(H3 + off + 4);
                    f32x4 h0, h1;
                    h0[0] = r0[0] + sigm(acc[ai][bj][m][0][0] * rs) * bflo(p[0]); h0[1] = r0[1] + sigm(acc[ai][bj][m][0][1] * rs) * bfhi(p[0]);
                    h0[2] = r0[2] + sigm(acc[ai][bj][m][0][2] * rs) * bflo(p[1]); h0[3] = r0[3] + sigm(acc[ai][bj][m][0][3] * rs) * bfhi(p[1]);
                    h1[0] = r1[0] + sigm(acc[ai][bj][m][1][0] * rs) * bflo(p[2]); h1[1] = r1[1] + sigm(acc[ai][bj][m][1][1] * rs) * bfhi(p[2]);
                    h1[2] = r1[2] + sigm(acc[ai][bj][m][1][2] * rs) * bflo(p[3]); h1[3] = r1[3] + sigm(acc[ai][bj][m][1][3] * rs) * bfhi(p[3]);
                    *(f32x4*)(H4 + off) = h0; *(f32x4*)(H4 + off + 4) = h1; s += sq4(h0) + sq4(h1); }
                ssq_put<16>(ssq4, row, u.pn * 4 + wc, s, fq); }
    }
};
#undef EPI_ROWS
#undef EPI_OPAQUE
}
namespace att {
using bf16x8 = __attribute__((ext_vector_type(8))) short;
using s16x4 = __attribute__((ext_vector_type(4))) short;
using f32x16 = __attribute__((ext_vector_type(16))) float;
using u32x4 = __attribute__((ext_vector_type(4))) unsigned;
typedef __attribute__((address_space(3))) const char* lds_cptr;
typedef __attribute__((address_space(3))) char* lds_ptr;
constexpr int KSLOT = 12288, VSLOT = 8192;
constexpr int L_K = 0, L_V = 2 * KSLOT, L_WS = L_V + 2 * VSLOT, L_OST = L_WS + 8 * 256, L_END = L_OST + 8 * 4096;
static_assert(L_END <= RING_BYTES, "attention LDS");
__device__ __forceinline__ int crow(int r, int hi) { return (r & 3) + 8 * (r >> 2) + 4 * hi; }
__device__ __forceinline__ void glds16(const void* gsrc, unsigned lds_dst) { unsigned keep;
    asm volatile("s_mov_b32 %0, m0\n\ts_mov_b32 m0, %2\n\ts_nop 0\n\tglobal_load_lds_dwordx4 %1, off\n\ts_mov_b32 m0, %0" : "=&s"(keep) : "v"(gsrc), "s"(lds_dst) : "memory"); }
typedef float f32x2_t __attribute__((ext_vector_type(2))); typedef __bf16 bf16x2_t __attribute__((ext_vector_type(2)));
__device__ __forceinline__ unsigned cvtpk_s(float lo, float hi) { f32x2_t v = {lo, hi}; bf16x2_t b = __builtin_convertvector(v, bf16x2_t); return __builtin_bit_cast(unsigned, b); }
__device__ __forceinline__ float swap32_max(float m) { auto rr = __builtin_amdgcn_permlane32_swap(__float_as_uint(m), __float_as_uint(m), false, false); return fmaxf(__uint_as_float(rr[0]), __uint_as_float(rr[1])); }
__device__ __forceinline__ float swap32_sum(float m) { auto rr = __builtin_amdgcn_permlane32_swap(__float_as_uint(m), __float_as_uint(m), false, false); return __uint_as_float(rr[0]) + __uint_as_float(rr[1]); }

__device__ __forceinline__ void pv(f32x16* o, int vb, bf16x8 pa0, bf16x8 pa1, bf16x8 pa2, bf16x8 pa3) {
#pragma unroll
    for (int d0 = 0; d0 < 2; ++d0) { s16x4 lo[4], hi[4];
#pragma unroll
        for (int ks = 0; ks < 4; ++ks) {
            asm volatile("ds_read_b64_tr_b16 %0,%1 offset:%c2" : "=&v"(lo[ks]) : "v"(vb), "i"(d0 * 4096 + ks * 1024) : "memory");
            asm volatile("ds_read_b64_tr_b16 %0,%1 offset:%c2" : "=&v"(hi[ks]) : "v"(vb), "i"(d0 * 4096 + ks * 1024 + 512) : "memory"); }
        asm volatile("s_waitcnt lgkmcnt(0)" ::: "memory"); __builtin_amdgcn_sched_barrier(0);
#define PK(k) (bf16x8){lo[k][0], lo[k][1], lo[k][2], lo[k][3], hi[k][0], hi[k][1], hi[k][2], hi[k][3]}
        o[d0] = __builtin_amdgcn_mfma_f32_32x32x16_bf16(pa0, PK(0), o[d0], 0, 0, 0);
        o[d0] = __builtin_amdgcn_mfma_f32_32x32x16_bf16(pa1, PK(1), o[d0], 0, 0, 0);
        o[d0] = __builtin_amdgcn_mfma_f32_32x32x16_bf16(pa2, PK(2), o[d0], 0, 0, 0);
        o[d0] = __builtin_amdgcn_mfma_f32_32x32x16_bf16(pa3, PK(3), o[d0], 0, 0, 0);
#undef PK
    }
}

__device__ __forceinline__ void attn_unit(int b, int h, int qb, const bf16* Q, const bf16* KN, const bf16* KPE, const bf16* VB, bf16* O, char* shm) {
    int tid_ = threadIdx.x; asm volatile("" : "+v"(tid_)); const int tid = tid_, lane = tid & 63, r32 = lane & 31, hi = lane >> 5; const int wid = __builtin_amdgcn_readfirstlane(tid >> 6);
    const long rowbase = (long)b * TSEQ; const int q0 = qb * 256;
    const bf16* Qw = Q + (rowbase + q0 + wid * 32) * 768 + h * QKD;
    const unsigned lds0 = (unsigned)(uintptr_t)shm;
    const lds_ptr shm3 = (lds_ptr)shm;
    LAS float* wsf = (LAS float*)(shm3 + L_WS) + wid * 64;
    const bf16* ksrc0 = KN + (rowbase + lane) * 512 + h * 64 + wid * 8;
    const bf16* ksrc1 = KPE + (rowbase + lane) * RPE + (wid & 3) * 8;
    const bf16* vsrc = VB + (rowbase + 16 * (wid & 3) + (lane >> 2)) * 512 + h * 64 + (wid >> 2) * 32 + (lane & 3) * 8;
    const unsigned kdst0 = lds0 + L_K + wid * 1024, kdst1 = lds0 + L_K + (8 + (wid & 3)) * 1024, vdst = lds0 + L_V + wid * 1024;
#define ATT_DMA(t, s) do { glds16(ksrc0 + (long)(t) * 64 * 512, (unsigned)__builtin_amdgcn_readfirstlane(kdst0 + (s) * KSLOT)); \
                           glds16(ksrc1 + (long)(t) * 64 * RPE, (unsigned)__builtin_amdgcn_readfirstlane(kdst1 + (s) * KSLOT)); \
                           glds16(vsrc + (long)(t) * 64 * 512, (unsigned)__builtin_amdgcn_readfirstlane(vdst + (s) * VSLOT)); } while (0)
    const int vb0 = (int)(lds0 + L_V) + ((lane >> 4) & 1) * 32 + (lane & 3) * 8 + (4 * hi + ((lane & 15) >> 2)) * 64;
    const lds_cptr kp0 = (lds_cptr)shm3 + L_K + hi * 1024 + r32 * 16;
    const int NT = (q0 + 256) / 64;
    ATT_DMA(0, 0);
    bf16x8 qr[6];
#pragma unroll
    for (int d0 = 0; d0 < 6; ++d0) qr[d0] = *reinterpret_cast<const bf16x8*>(&Qw[(long)r32 * 768 + d0 * 16 + hi * 8]);
    float m_run = -INFINITY, l_run = 0.f; f32x16 o[2]; o[0] = f32x16{}; o[1] = f32x16{};
    const int qrel = wid * 32 + r32;
    for (int t = 0; t < NT; ++t) {
        asm volatile("s_waitcnt vmcnt(0) lgkmcnt(0)\n\ts_barrier" ::: "memory");
        if (t + 1 < NT) ATT_DMA(t + 1, (t + 1) & 1);
        const int jb = t - (NT - 4);
        if (jb < 0 || 2 * jb <= wid) {
            const lds_cptr kp = kp0 + (t & 1) * KSLOT;
            f32x16 p0 = f32x16{}, p1 = f32x16{};
#pragma unroll
            for (int d0 = 0; d0 < 6; ++d0) {
                const bf16x8 k0 = *(const __attribute__((address_space(3))) bf16x8*)(kp + d0 * 2048);
                const bf16x8 k1 = *(const __attribute__((address_space(3))) bf16x8*)(kp + d0 * 2048 + 512);
                p0 = __builtin_amdgcn_mfma_f32_32x32x16_bf16(k0, qr[d0], p0, 0, 0, 0);
                p1 = __builtin_amdgcn_mfma_f32_32x32x16_bf16(k1, qr[d0], p1, 0, 0, 0); }
            if (jb >= 0) { const int kb = 64 * jb + 4 * hi;
#pragma unroll
                for (int r = 0; r < 16; ++r) { const int kv = kb + (r & 3) + 8 * (r >> 2); if (kv > qrel) p0[r] = -INFINITY; if (kv + 32 > qrel) p1[r] = -INFINITY; } }
            float rm = fmaxf(p0[0], p1[0]);
#pragma unroll
            for (int r = 1; r < 16; ++r) rm = fmaxf(rm, fmaxf(p0[r], p1[r]));
            rm = swap32_max(rm);
            const float mnew = fmaxf(m_run, rm);
            if (__any(mnew > m_run)) {
                const float alpha = __builtin_amdgcn_exp2f(m_run - mnew);
                l_run *= alpha; m_run = mnew;
                if (hi == 0) wsf[r32] = alpha;
                asm volatile("s_waitcnt lgkmcnt(0)" ::: "memory");
#pragma unroll
                for (int r = 0; r < 16; ++r) { const float a = wsf[crow(r, hi)]; o[0][r] *= a; o[1][r] *= a; }
            }
            float sacc = 0.f;
#pragma unroll
            for (int r = 0; r < 16; ++r) { p0[r] = __builtin_amdgcn_exp2f(p0[r] - m_run); p1[r] = __builtin_amdgcn_exp2f(p1[r] - m_run); sacc += p0[r] + p1[r]; }
            l_run += sacc;
            u32x4 pw0, pw1, pw2, pw3;
#define PKW(P, B) cvtpk_s(P[B], P[B + 1])
            pw0 = (u32x4){PKW(p0, 0), PKW(p0, 2), PKW(p0, 4), PKW(p0, 6)}; pw1 = (u32x4){PKW(p0, 8), PKW(p0, 10), PKW(p0, 12), PKW(p0, 14)};
            pw2 = (u32x4){PKW(p1, 0), PKW(p1, 2), PKW(p1, 4), PKW(p1, 6)}; pw3 = (u32x4){PKW(p1, 8), PKW(p1, 10), PKW(p1, 12), PKW(p1, 14)};
#undef PKW
            pv(o, vb0 + (t & 1) * VSLOT, __builtin_bit_cast(bf16x8, pw0), __builtin_bit_cast(bf16x8, pw1), __builtin_bit_cast(bf16x8, pw2), __builtin_bit_cast(bf16x8, pw3));
        }
    }
    l_run = swap32_sum(l_run);
    if (hi == 0) wsf[32 + r32] = l_run;
    asm volatile("s_waitcnt lgkmcnt(0)" ::: "memory");
    float rli[16];
#pragma unroll
    for (int r = 0; r < 16; ++r) rli[r] = 1.0f / wsf[32 + crow(r, hi)];
    bf16* Ow = O + (rowbase + q0 + wid * 32) * DM + h * 64;
    { LAS bf16* stg = (LAS bf16*)(shm3 + L_OST) + wid * 2048;
#pragma unroll
      for (int r = 0; r < 16; ++r) { const int orow = crow(r, hi);
#pragma unroll
          for (int d0 = 0; d0 < 2; ++d0) stg[orow * 64 + d0 * 32 + r32] = (bf16)f2bf(o[d0][r] * rli[r]); }
      asm volatile("s_waitcnt lgkmcnt(0)" ::: "memory");
#pragma unroll
      for (int i = 0; i < 4; ++i) { const int row = i * 8 + (lane >> 3), ch = lane & 7; const u32x4 v = *(const LAS u32x4*)(stg + row * 64 + ch * 8); *(u32x4*)(Ow + (long)row * DM + ch * 8) = v; } }
    asm volatile("s_waitcnt vmcnt(0) lgkmcnt(0)\n\ts_barrier" ::: "memory");
#undef ATT_DMA
}
}
namespace ret {
using bf16x8 = __attribute__((ext_vector_type(8))) short;
using s16x4 = __attribute__((ext_vector_type(4))) short;
using f32x16 = __attribute__((ext_vector_type(16))) float;
typedef short v4i16_t __attribute__((ext_vector_type(4)));
constexpr int TPB = 288, TB = 128 * TPB;
constexpr int OTP = 132;
static_assert(3 * TB <= RING_BYTES && 128 * OTP * 4 <= 2 * TB, "retention LDS");
__device__ __forceinline__ int crow(int r, int hi) { return (r & 3) + 8 * (r >> 2) + 4 * hi; }
__device__ __forceinline__ void stage_tile(LAS unsigned char* tile, const bf16* src, int pitch, int tid) {
#pragma unroll
    for (int i = 0; i < 4; ++i) { const int idx = tid + 512 * i, row = idx >> 4, ch = idx & 15;
        *(LAS v4u*)(tile + row * TPB + ch * 16) = *(const v4u*)(src + (size_t)row * pitch + ch * 8); }
}
__device__ __forceinline__ bf16x8 rowfrag(const LAS unsigned char* tile, int row0, int k0, int r32, int hi) { return *(const LAS bf16x8*)(tile + (row0 + r32) * TPB + (k0 + 8 * hi) * 2); }
__device__ __forceinline__ bf16x8 trfrag(const LAS unsigned char* tile, int k0, int c0, int lane) {
    const int h = lane >> 5, blk = (lane >> 4) & 1, q = (lane & 15) >> 2, p = lane & 3;
    const LAS unsigned char* a = tile + (k0 + 8 * h + q) * TPB + (c0 + 16 * blk + 4 * p) * 2;
    const s16x4 lo = __builtin_bit_cast(s16x4, __builtin_amdgcn_ds_read_tr16_b64_v4i16((LAS v4i16_t*)a));
    const s16x4 hi4 = __builtin_bit_cast(s16x4, __builtin_amdgcn_ds_read_tr16_b64_v4i16((LAS v4i16_t*)(a + 4 * TPB)));
    return (bf16x8){lo[0], lo[1], lo[2], lo[3], hi4[0], hi4[1], hi4[2], hi4[3]};
}

__device__ __forceinline__ void kv_unit(int u, const bf16* KR, const bf16* RV, float* KVC, LAS unsigned char* lds) {
    int tid_ = threadIdx.x; asm volatile("" : "+v"(tid_)); const int tid = tid_, lane = tid & 63, r32 = lane & 31, hi = lane >> 5, wid = __builtin_amdgcn_readfirstlane(tid >> 6), wi = wid >> 1, wj = wid & 1;
    const int bh = u >> 6, c = u & 63, b = bh >> 2, h = bh & 3; const size_t row0 = (size_t)b * TSEQ + c * 128;
    LAS unsigned char* T0 = lds; LAS unsigned char* T1 = lds + TB;
    stage_tile(T0, KR + row0 * 512 + h * 128, 512, tid); stage_tile(T1, RV + row0 * 512 + h * 128, 512, tid);
    __syncthreads();
    f32x16 acc[2]; acc[0] = f32x16{}; acc[1] = f32x16{};
#pragma unroll
    for (int ks = 0; ks < 8; ++ks) { const bf16x8 A = trfrag(T0, 16 * ks, 32 * wi, lane);
#pragma unroll
        for (int n = 0; n < 2; ++n) acc[n] = __builtin_amdgcn_mfma_f32_32x32x16_bf16(A, trfrag(T1, 16 * ks, 64 * wj + 32 * n, lane), acc[n], 0, 0, 0); }
    const float g127 = __builtin_amdgcn_exp2f(127.0f * lg2gamma(h));
    float* out = KVC + (size_t)u * 16384;
#pragma unroll
    for (int n = 0; n < 2; ++n)
#pragma unroll
        for (int r = 0; r < 16; ++r) out[(32 * wi + crow(r, hi)) * 128 + 64 * wj + 32 * n + r32] = acc[n][r] * g127;
    __syncthreads();
}

__device__ __forceinline__ void scan_items(int gtid, int gthreads, const float* KVC, bf16* SC, float* dout) {
    for (int e = gtid; e < 8 * 16384; e += gthreads) { const int bh = e >> 14, el = e & 16383; const float g128 = __builtin_amdgcn_exp2f(128.0f * lg2gamma(bh & 3));
        float s = 0.f;
        for (int c0 = 0; c0 < 64; c0 += 8) { float kv[8];
#pragma unroll
            for (int i = 0; i < 8; ++i) kv[i] = KVC[(size_t)(bh * 64 + c0 + i) * 16384 + el];
#pragma unroll
            for (int i = 0; i < 8; ++i) { SC[(size_t)(bh * 64 + c0 + i) * 16384 + el] = (bf16)f2bf(s); s = g128 * s + kv[i]; } }
        dout[O_RETP + e] = s; }
}

__device__ __forceinline__ void out_unit(int u, const bf16* QR, const bf16* KR, const bf16* RV, const bf16* SC, const bf16* RGS, const float* gnorm, bf16* OCAT, LAS unsigned char* lds) {
    int tid_ = threadIdx.x; asm volatile("" : "+v"(tid_)); const int tid = tid_, lane = tid & 63, r32 = lane & 31, hi = lane >> 5, wid = __builtin_amdgcn_readfirstlane(tid >> 6), wi = wid >> 1, wj = wid & 1;
    const int bh = u >> 6, c = u & 63, b = bh >> 2, h = bh & 3; const size_t row0 = (size_t)b * TSEQ + c * 128;
    LAS unsigned char* T0 = lds; LAS unsigned char* T1 = lds + TB; LAS unsigned char* T2 = lds + 2 * TB;
    stage_tile(T0, QR + row0 * 512 + h * 128, 512, tid); stage_tile(T1, KR + row0 * 512 + h * 128, 512, tid); stage_tile(T2, RV + row0 * 512 + h * 128, 512, tid);
    __syncthreads();
    f32x16 sr[2];
#pragma unroll
    for (int n = 0; n < 2; ++n) { const int jb = 2 * wj + n; sr[n] = f32x16{};
        if (jb <= wi) {
#pragma unroll
            for (int ks = 0; ks < 8; ++ks) sr[n] = __builtin_amdgcn_mfma_f32_32x32x16_bf16(rowfrag(T1, 32 * jb, 16 * ks, r32, hi), rowfrag(T0, 32 * wi, 16 * ks, r32, hi), sr[n], 0, 0, 0);
            if (jb == wi) {
#pragma unroll
                for (int r = 0; r < 16; ++r) if (crow(r, hi) > r32) sr[n][r] = 0.f; } } }
    __syncthreads();
#pragma unroll
    for (int n = 0; n < 2; ++n) { const int jb = 2 * wj + n;
        if (jb <= wi) {
#pragma unroll
            for (int r4 = 0; r4 < 4; ++r4) { v2u w; w.x = pg8::cvt_pk_bf16(sr[n][4 * r4], sr[n][4 * r4 + 1]); w.y = pg8::cvt_pk_bf16(sr[n][4 * r4 + 2], sr[n][4 * r4 + 3]);
                *(LAS v2u*)(T1 + (32 * wi + r32) * TPB + (32 * jb + 8 * r4 + 4 * hi) * 2) = w; } } }
    __syncthreads();
    f32x16 o1[2]; o1[0] = f32x16{}; o1[1] = f32x16{};
    for (int ks = 0; ks < 2 * (wi + 1); ++ks) { const bf16x8 A = rowfrag(T1, 32 * wi, 16 * ks, r32, hi);
#pragma unroll
        for (int n = 0; n < 2; ++n) o1[n] = __builtin_amdgcn_mfma_f32_32x32x16_bf16(A, trfrag(T2, 16 * ks, 64 * wj + 32 * n, lane), o1[n], 0, 0, 0); }
    __syncthreads();
    stage_tile(T2, SC + (size_t)u * 16384, 128, tid);
    __syncthreads();
    f32x16 o2[2]; o2[0] = f32x16{}; o2[1] = f32x16{};
#pragma unroll
    for (int ks = 0; ks < 8; ++ks) { const bf16x8 A = rowfrag(T0, 32 * wi, 16 * ks, r32, hi);
#pragma unroll
        for (int n = 0; n < 2; ++n) o2[n] = __builtin_amdgcn_mfma_f32_32x32x16_bf16(A, trfrag(T2, 16 * ks, 64 * wj + 32 * n, lane), o2[n], 0, 0, 0); }
    __syncthreads();
    const float gam = __builtin_amdgcn_exp2f(lg2gamma(h));
    LAS float* OT = (LAS float*)lds;
#pragma unroll
    for (int n = 0; n < 2; ++n)
#pragma unroll
        for (int r = 0; r < 16; ++r) OT[(32 * wi + crow(r, hi)) * OTP + 64 * wj + 32 * n + r32] = o1[n][r] + gam * o2[n][r];
    __syncthreads();
    { const int row = tid >> 2, part = tid & 3; const LAS float* orow = OT + row * OTP + part * 32; float v[32]; float s = 0.f;
#pragma unroll
      for (int k = 0; k < 32; ++k) { v[k] = orow[k]; s += v[k]; }
      s += __shfl_xor(s, 1); s += __shfl_xor(s, 2); const float mu = s * (1.0f / 128.0f); float q = 0.f;
#pragma unroll
      for (int k = 0; k < 32; ++k) { v[k] -= mu; q += v[k] * v[k]; }
      q += __shfl_xor(q, 1); q += __shfl_xor(q, 2); const float rstd = 1.0f / sqrtf(q * (1.0f / 128.0f) + EPS);
      const bf16* rg = RGS + (row0 + row) * 512 + h * 128 + part * 32; const float* gn = gnorm + h * 128 + part * 32; bf16* dst = OCAT + (row0 + row) * DM + 512 + h * 128 + part * 32;
#pragma unroll
      for (int k8 = 0; k8 < 4; ++k8) { const v4u g = *(const v4u*)(rg + 8 * k8); v4u w;
#pragma unroll
          for (int j = 0; j < 4; ++j) { const int k = 8 * k8 + 2 * j; w[j] = pk2(v[k] * rstd * gn[k] * bflo(g[j]), v[k + 1] * rstd * gn[k + 1] * bfhi(g[j])); }
          *(v4u*)(dst + 8 * k8) = w; } }
    __syncthreads();
}

__device__ __forceinline__ void sample_unit(int u, const bf16* QR, const bf16* KR, const bf16* RV, const bf16* RGS, const float* gnorm, const float* state, float* dout, bf16* OCAT, LAS unsigned char* lds) {
    int tid_ = threadIdx.x; asm volatile("" : "+v"(tid_)); const int tid = tid_, s = u >> 2, h = u & 3; const size_t row = (size_t)MP + s;
    LAS float* qf = (LAS float*)lds; LAS float* kf = qf + 128; LAS float* vf = kf + 128; LAS float* red = vf + 128; LAS float* ob = red + 512;
    if (tid < 128) { qf[tid] = bf2f(QR[row * 512 + h * 128 + tid]); kf[tid] = bf2f(KR[row * 512 + h * 128 + tid]); vf[tid] = bf2f(RV[row * 512 + h * 128 + tid]); }
    __syncthreads();
    const int dv = tid & 127, g = tid >> 7; const float gam = __builtin_amdgcn_exp2f(lg2gamma(h)); const float vv = vf[dv];
    const float* S0 = state + (size_t)u * 16384; float* Sn = dout + O_RETS + (size_t)u * 16384; float acc = 0.f;
#pragma unroll 8
    for (int i = 0; i < 32; ++i) { const int dk = 32 * g + i; const float s0 = S0[dk * 128 + dv]; acc += qf[dk] * s0; Sn[dk * 128 + dv] = gam * s0 + kf[dk] * vv; }
    red[tid] = acc;
    __syncthreads();
    if (tid < 128) { float qk = 0.f;
        for (int d = 0; d < 128; ++d) qk += qf[d] * kf[d];
        ob[tid] = qk * vv + gam * ((red[tid] + red[128 + tid]) + (red[256 + tid] + red[384 + tid])); }
    __syncthreads();
    if (tid < 128) { float sm = 0.f;
        for (int d = 0; d < 128; ++d) sm += ob[d];
        const float mu = sm * (1.0f / 128.0f); float q = 0.f;
        for (int d = 0; d < 128; ++d) { const float t = ob[d] - mu; q += t * t; }
        const float rstd = 1.0f / sqrtf(q * (1.0f / 128.0f) + EPS);
        OCAT[row * DM + 512 + h * 128 + tid] = (bf16)f2bf((ob[tid] - mu) * rstd * gnorm[h * 128 + tid] * bf2f(RGS[row * 512 + h * 128 + tid])); }
    __syncthreads();
}
}
namespace dec {
using bf16x2 = __attribute__((ext_vector_type(2))) __bf16;
using u32x4 = __attribute__((ext_vector_type(4))) unsigned;
using f32x4 = __attribute__((ext_vector_type(4))) float;
using f32x2 = __attribute__((ext_vector_type(2))) float;
constexpr int NSPLIT = 8, PPS = NPAGES / NSPLIT;
constexpr int HPL = 2, GE = 8;
constexpr int L_QL = 0, L_P = 8 * 128, L_MRG = L_P + 8 * 64 * HPL, MRG_REC = 4 + 128, L_END = L_MRG + 8 * GE * MRG_REC;
static_assert(L_END * 4 <= RING_BYTES, "decode LDS");
__device__ __forceinline__ float dot2(unsigned k, unsigned q, float acc) { return __builtin_amdgcn_fdot2_f32_bf16(__builtin_bit_cast(bf16x2, k), __builtin_bit_cast(bf16x2, q), acc, false); }
__device__ __forceinline__ unsigned cvtpk(float lo, float hi) { return pg8::cvt_pk_bf16(lo, hi); }
template <int CTRL> __device__ __forceinline__ float dpp(float x) { return __builtin_bit_cast(float, __builtin_amdgcn_mov_dpp(__builtin_bit_cast(int, x), CTRL, 0xf, 0xf, true)); }
constexpr int XOR1 = 0xB1, XOR2 = 0x4E, XOR7 = 0x141, XOR8 = 0x128, ROR4 = 0x124;
__device__ __forceinline__ float xrow16_max(float x) {
    auto s = __builtin_amdgcn_permlane16_swap(__float_as_uint(x), __float_as_uint(x), false, false); x = fmaxf(__uint_as_float(s[0]), __uint_as_float(s[1]));
    auto t = __builtin_amdgcn_permlane32_swap(__float_as_uint(x), __float_as_uint(x), false, false); return fmaxf(__uint_as_float(t[0]), __uint_as_float(t[1])); }
__device__ __forceinline__ float xrow16_sum(float x) {
    auto s = __builtin_amdgcn_permlane16_swap(__float_as_uint(x), __float_as_uint(x), false, false); x = __uint_as_float(s[0]) + __uint_as_float(s[1]);
    auto t = __builtin_amdgcn_permlane32_swap(__float_as_uint(x), __float_as_uint(x), false, false); return __uint_as_float(t[0]) + __uint_as_float(t[1]); }

__device__ __forceinline__ void qlat_token(int s, const bf16* QB, const float* wkvb, LAS float* QLs, float* QLATg, bool store) {
    int tid_ = threadIdx.x; asm volatile("" : "+v"(tid_)); const int tid = tid_, lane = tid & 63, h = __builtin_amdgcn_readfirstlane(tid >> 6);
    const bf16* q = QB + (size_t)(MP + s) * 768 + h * QKD;
#pragma unroll
    for (int cc = 0; cc < 2; ++cc) { const int c = lane + 64 * cc; const float* w = wkvb + (size_t)c * 1024 + h * 128; float a = 0.f;
#pragma unroll 4
        for (int d = 0; d < 64; d += 4) { const f32x4 wv = *(const f32x4*)(w + d); a += bf2f(q[d]) * wv[0] + bf2f(q[d + 1]) * wv[1] + bf2f(q[d + 2]) * wv[2] + bf2f(q[d + 3]) * wv[3]; }
        QLs[h * 128 + c] = a; if (store) QLATg[(size_t)s * 1024 + h * 128 + c] = a; }
}

__device__ __forceinline__ void split_unit(int s, int sp, const bf16* QB, const float* cache_ckv, const float* cache_kpe, const int* page_table, float* DPO, float* DML, LAS float* lds) {
    int tid_ = threadIdx.x; asm volatile("" : "+v"(tid_)); const int tid = tid_, lane = tid & 63, wave = __builtin_amdgcn_readfirstlane(tid >> 6), r = lane >> 4, c = lane & 15;
    const LAS float* QL = lds + L_QL;
    u32x4 qpk[GE]; unsigned qpe[GE];
#pragma unroll
    for (int g = 0; g < GE; ++g) { const LAS float* ql = QL + g * 128 + 8 * c; qpk[g] = (u32x4){cvtpk(ql[0], ql[1]), cvtpk(ql[2], ql[3]), cvtpk(ql[4], ql[5]), cvtpk(ql[6], ql[7])};
        qpe[g] = *(const unsigned*)(QB + (size_t)(MP + s) * 768 + g * QKD + 64 + 2 * c); }
    float m[HPL], l[HPL], acc[GE * 8];
#pragma unroll
    for (int j = 0; j < HPL; ++j) { m[j] = -INFINITY; l[j] = 0.f; }
#pragma unroll
    for (int k = 0; k < GE * 8; ++k) acc[k] = 0.f;
    const int ph0 = page_table[s * NPAGES + PPS * sp + wave], ph1 = page_table[s * NPAGES + PPS * sp + wave + 8];
    f32x4 Kn[4][2]; f32x2 Pn[4];
#define DEC_ISSUE(i_) do { const int ph_ = ((i_) >> 3) ? ph1 : ph0; const size_t tok_ = (size_t)ph_ * PAGE + 16 * ((i_) & 7) + r; \
        _Pragma("unroll") for (int t_ = 0; t_ < 4; ++t_) { const float* kp_ = cache_ckv + (tok_ + 4 * t_) * KVL + 8 * c; \
            Kn[t_][0] = __builtin_nontemporal_load((const f32x4*)kp_); Kn[t_][1] = __builtin_nontemporal_load((const f32x4*)(kp_ + 4)); \
            Pn[t_] = __builtin_nontemporal_load((const f32x2*)(cache_kpe + (tok_ + 4 * t_) * RPE + 2 * c)); } } while (0)
    DEC_ISSUE(0);
#pragma nounroll
    for (int i = 0; i < 16; ++i) {
        u32x4 Kc[4]; unsigned Pc[4];
#pragma unroll
        for (int t = 0; t < 4; ++t) {
            Kc[t] = (u32x4){cvtpk(Kn[t][0][0], Kn[t][0][1]), cvtpk(Kn[t][0][2], Kn[t][0][3]), cvtpk(Kn[t][1][0], Kn[t][1][1]), cvtpk(Kn[t][1][2], Kn[t][1][3])}; Pc[t] = cvtpk(Pn[t][0], Pn[t][1]); }
        if (i + 1 < 16) DEC_ISSUE(i + 1);
        float x[4 * GE];
#pragma unroll
        for (int t = 0; t < 4; ++t)
#pragma unroll
            for (int g = 0; g < GE; ++g) { float d = dot2(Pc[t], qpe[g], 0.f);
#pragma unroll
                for (int k = 0; k < 4; ++k) d = dot2(Kc[t][k], qpk[g][k], d);
                x[t * GE + g] = d; }
#define TR_STEP(HALF, CTRL, BIT) _Pragma("unroll") for (int h = 0; h < (HALF); ++h) _Pragma("unroll") for (int j = 0; j < HPL; ++j) { \
        const float lo_ = x[h * HPL + j], hi_ = x[(h + (HALF)) * HPL + j]; const float t1_ = lo_ + dpp<CTRL>(lo_), t2_ = hi_ + dpp<CTRL>(hi_); \
        x[h * HPL + j] = (c & (BIT)) ? t2_ : t1_; }
        TR_STEP(8, XOR8, 8) TR_STEP(4, XOR7, 4) TR_STEP(2, XOR2, 2) TR_STEP(1, XOR1, 1)
#undef TR_STEP
        float p[HPL], alpha[HPL];
#pragma unroll
        for (int j = 0; j < HPL; ++j) { const float sc = x[j];
            float pm = sc; pm = fmaxf(pm, dpp<ROR4>(pm)); pm = fmaxf(pm, dpp<XOR8>(pm)); pm = xrow16_max(pm);
            const float mn = fmaxf(m[j], pm);
            alpha[j] = __builtin_amdgcn_exp2f(m[j] - mn); p[j] = __builtin_amdgcn_exp2f(sc - mn);
            l[j] = fmaf(l[j], alpha[j], p[j]); m[j] = mn; }
#pragma unroll
        for (int q4 = 0; q4 < 4; ++q4)
#pragma unroll
            for (int j = 0; j < HPL; ++j) { const float al = q4 == 0 ? dpp<0x00>(alpha[j]) : q4 == 1 ? dpp<0x55>(alpha[j]) : q4 == 2 ? dpp<0xAA>(alpha[j]) : dpp<0xFF>(alpha[j]);
#pragma unroll
                for (int k = 0; k < 8; ++k) acc[(q4 * HPL + j) * 8 + k] *= al; }
        LAS float* prow = lds + L_P + (wave * 4 + r) * 16 * HPL;
#pragma unroll
        for (int j = 0; j < HPL; ++j) prow[c * HPL + j] = p[j];
        asm volatile("s_waitcnt lgkmcnt(0)" ::: "memory");
#pragma unroll
        for (int t = 0; t < 4; ++t) { float vf[8]; f32x4 pr[2]; pr[0] = *(const LAS f32x4*)(prow + 8 * t); pr[1] = *(const LAS f32x4*)(prow + 8 * t + 4);
#pragma unroll
            for (int k = 0; k < 4; ++k) { vf[2 * k] = bflo(Kc[t][k]); vf[2 * k + 1] = bfhi(Kc[t][k]); }
#pragma unroll
            for (int g = 0; g < GE; ++g) { const float pg_ = pr[g >> 2][g & 3];
#pragma unroll
                for (int k = 0; k < 8; ++k) acc[g * 8 + k] = fmaf(pg_, vf[k], acc[g * 8 + k]); } }
        asm volatile("s_waitcnt lgkmcnt(0)" ::: "memory");
    }
#undef DEC_ISSUE
#pragma unroll
    for (int k = 0; k < GE * 8; ++k) acc[k] = xrow16_sum(acc[k]);
#pragma unroll
    for (int j = 0; j < HPL; ++j) { float t = l[j]; t += dpp<ROR4>(t); t += dpp<XOR8>(t); l[j] = xrow16_sum(t); }
    LAS float* mrg = lds + L_MRG;
    if (r == 0) {
#pragma unroll
        for (int g = 0; g < GE; ++g) { LAS float* rec = mrg + (wave * GE + g) * MRG_REC;
#pragma unroll
            for (int k = 0; k < 8; k += 4) *(LAS f32x4*)(rec + 4 + 8 * c + k) = (f32x4){acc[g * 8 + k], acc[g * 8 + k + 1], acc[g * 8 + k + 2], acc[g * 8 + k + 3]};
            if (c == g / HPL) { rec[0] = m[g % HPL]; rec[1] = l[g % HPL]; } } }
    __syncthreads();
    { const int g = wave, d0 = 2 * lane;
      float M = -INFINITY;
#pragma unroll
      for (int w = 0; w < 8; ++w) M = fmaxf(M, mrg[(w * GE + g) * MRG_REC]);
      float L = 0.f, o0 = 0.f, o1 = 0.f;
#pragma unroll
      for (int w = 0; w < 8; ++w) { const LAS float* rec = mrg + (w * GE + g) * MRG_REC; const float wt = __builtin_amdgcn_exp2f(rec[0] - M);
          L = fmaf(wt, rec[1], L); o0 = fmaf(wt, rec[4 + d0], o0); o1 = fmaf(wt, rec[4 + d0 + 1], o1); }
      const size_t slot = ((size_t)s * NSPLIT + sp) * GE + g;
      *(f32x2*)(DPO + slot * 128 + d0) = (f32x2){o0, o1};
      if (lane == 0) *(f32x2*)(DML + slot * 2) = (f32x2){M, L}; }
    __syncthreads();
}

__device__ __forceinline__ void combine_unit(int s, const bf16* QB, const float* QLATg, const float* DPO, const float* DML, const float* dout, const float* wkvb, bf16* OCAT, LAS float* lds) {
    int tid_ = threadIdx.x; asm volatile("" : "+v"(tid_)); const int tid = tid_, lane = tid & 63, g = __builtin_amdgcn_readfirstlane(tid >> 6), d0 = 2 * lane;
    const float* ck = dout + O_CKVS + (size_t)s * KVL; const float* kp = dout + O_KPES + (size_t)s * RPE;
    const f32x2 ckv = *(const f32x2*)(ck + d0); const f32x2 ql = *(const f32x2*)(QLATg + (size_t)s * 1024 + g * 128 + d0);
    float part = ql[0] * ckv[0] + ql[1] * ckv[1];
    if (lane < 16) { const unsigned qp = *(const unsigned*)(QB + (size_t)(MP + s) * 768 + g * QKD + 64 + d0); part += bflo(qp) * kp[d0] + bfhi(qp) * kp[d0 + 1]; }
    const float sself = wave_sum(part);
    float M = sself;
#pragma unroll
    for (int sp = 0; sp < NSPLIT; ++sp) M = fmaxf(M, DML[(((size_t)s * NSPLIT + sp) * GE + g) * 2]);
    float L = __builtin_amdgcn_exp2f(sself - M), o0 = L * ckv[0], o1 = L * ckv[1];
#pragma unroll
    for (int sp = 0; sp < NSPLIT; ++sp) { const size_t slot = ((size_t)s * NSPLIT + sp) * GE + g; const float wt = __builtin_amdgcn_exp2f(DML[slot * 2] - M);
        const f32x2 po = *(const f32x2*)(DPO + slot * 128 + d0); L = fmaf(wt, DML[slot * 2 + 1], L); o0 = fmaf(wt, po[0], o0); o1 = fmaf(wt, po[1], o1); }
    const float inv = 1.0f / L;
    LAS float* ol = lds + g * 128;
    ol[d0] = o0 * inv; ol[d0 + 1] = o1 * inv;
    asm volatile("s_waitcnt lgkmcnt(0)" ::: "memory");
    float a = 0.f;
#pragma unroll 8
    for (int cc = 0; cc < 128; ++cc) a = fmaf(ol[cc], wkvb[(size_t)cc * 1024 + g * 128 + 64 + lane], a);
    OCAT[(size_t)(MP + s) * DM + g * 64 + lane] = (bf16)f2bf(a);
    __syncthreads();
}
}
#define XB_TMO      128
#define XB_XCNT(j)  (256  + 64 * (j))
#define XB_XSUB(j)  (1280 + 64 * (j))
#define XB_XGEN(j)  (2304 + 64 * (j))
#define XB_TOP      3328
#define XB_TOPGEN   3392
#define XCD_BAR_WORDS 3456
#define XB_SPIN_CAP (1u << 18)

__device__ __forceinline__ unsigned xb_ld(unsigned* p)              { return __hip_atomic_load(p, __ATOMIC_RELAXED, __HIP_MEMORY_SCOPE_AGENT); }
__device__ __forceinline__ unsigned xb_add(unsigned* p, unsigned v) { return __hip_atomic_fetch_add(p, v, __ATOMIC_RELAXED, __HIP_MEMORY_SCOPE_AGENT); }
__device__ __forceinline__ unsigned xb_xcc_id() { return (unsigned)__builtin_amdgcn_s_getreg((3 << 11) | 20) & 0xFu; }
#define XB_SPIN(cond, bar) do { unsigned _sp = 0; while (cond) { __builtin_amdgcn_s_sleep(1); \
    if ((++_sp & 255u) == 0u) { if (xb_ld(&(bar)[XB_TMO])) break; if (_sp > XB_SPIN_CAP) { atomicAdd(&(bar)[XB_TMO], 1u); break; } } } } while (0)

struct XcdBarrier {
    unsigned* bar; unsigned x;
    volatile LAS unsigned* st;
};

__device__ __forceinline__ XcdBarrier xcd_barrier_post(unsigned* bar, volatile LAS unsigned* st) {
    XcdBarrier b; b.bar = bar; b.x = xb_xcc_id(); b.st = st;
    if (threadIdx.x == 0) (void)xb_add(&bar[XB_XCNT(b.x)], 1u);
    return b;
}
__device__ __forceinline__ void xcd_barrier_complete(unsigned* bar, unsigned x, unsigned& nloc, unsigned& nx) {
    const unsigned G = gridDim.x * gridDim.y * gridDim.z;
    unsigned sum, cnt, mine, sp = 0u;
    for (;;) {
        sum = 0u; cnt = 0u; mine = 0u;
#pragma unroll
        for (unsigned j = 0; j < 16; ++j) { const unsigned c = xb_ld(&bar[XB_XCNT(j)]); sum += c; cnt += (c > 0u) ? 1u : 0u; mine = (j == x) ? c : mine; }
        if (sum == G) break;
        __builtin_amdgcn_s_sleep(1);
        if ((++sp & 255u) == 0u) { if (xb_ld(&bar[XB_TMO])) break; if (sp > XB_SPIN_CAP) { atomicAdd(&bar[XB_TMO], 1u); break; } }
    }
    nloc = mine > 0u ? mine : 1u; nx = cnt > 0u ? cnt : 1u;
}

__device__ __forceinline__ void xcd_barrier(const XcdBarrier& b) {
    asm volatile("s_waitcnt vmcnt(0)" ::: "memory");
    __syncthreads();
    if (threadIdx.x == 0) {
        unsigned* bar = b.bar;
        __builtin_amdgcn_s_waitcnt(0);
        unsigned nloc = b.st[0], nx = b.st[1];
        if (nloc == 0u) { xcd_barrier_complete(bar, b.x, nloc, nx); b.st[0] = nloc; b.st[1] = nx; }
        const unsigned old = xb_add(&bar[XB_XSUB(b.x)], 1u);
        const unsigned gen = old / nloc;
        if (old + 1u == (gen + 1u) * nloc) {
            __builtin_amdgcn_fence(__ATOMIC_RELEASE, "agent");
            asm volatile("s_waitcnt vmcnt(0)" ::: "memory");
            const unsigned og = xb_add(&bar[XB_TOP], 1u);
            const unsigned tg = og / nx;
            if (og + 1u == (tg + 1u) * nx) xb_add(&bar[XB_TOPGEN], 1u);
            else XB_SPIN(xb_ld(&bar[XB_TOPGEN]) == tg, bar);
            __builtin_amdgcn_fence(__ATOMIC_ACQUIRE, "agent");
            xb_add(&bar[XB_XGEN(b.x)], 1u);
            asm volatile("s_waitcnt vmcnt(0)" ::: "memory");
        } else {
            XB_SPIN(xb_ld(&bar[XB_XGEN(b.x)]) == gen, bar);
            __builtin_amdgcn_fence(__ATOMIC_ACQUIRE, "agent");
            asm volatile("s_waitcnt vmcnt(0)" ::: "memory");
        }
    }
    __syncthreads();
}
constexpr int NWAVES = 8, NPHASE = 13;
struct Args {
    const float *x_prompt, *x_sample, *cache_ckv, *cache_kpe, *state_ret; const int* page_table; const float *p_prompt, *p_sample;
    const float *ffn1_norm, *ffn1_w_gate, *ffn1_w_up, *ffn1_w_down, *mix_norm, *w_in, *q_a_norm, *w_q_b, *kv_a_norm, *w_kv_b, *ret_norm, *w_branch_att, *w_branch_ret, *w_out;
    const float *ffn2_norm, *ffn2_w_gate, *ffn2_w_up, *ffn2_w_down, *ple_norm, *w_ple_gate, *w_ple_proj, *final_norm;
    float* out; unsigned char* ws; int ph_lo, ph_hi;
};
static_assert(sizeof(Args) == 32 * 8 + 8, "Args has no padding holes");

enum { RM_ID = 0, RM_GATE, RM_UP, RM_WIN, RM_QB, RM_KVB };
__device__ __forceinline__ int rowmap(int kind, int n) {
    switch (kind) {
    case RM_GATE: return (n >> 7) * 256 + (n & 127);
    case RM_UP:   return (n >> 7) * 256 + 128 + (n & 127);
    case RM_WIN: {
        if (n < 384) return n;
        if (n < 416) { const int j = n - 384, jj = j & 15; return 384 + 8 * (jj >> 2) + 4 * (j >> 4) + (jj & 3); }
        if (n < 1440) { const bool isk = n >= 928; const int j = n - (isk ? 928 : 416), hh = j >> 7, d = j & 127, i = d & 63, n_ = d >> 6;
            return (isk ? 1024 : 512) + hh * 128 + 32 * (i >> 4) + 8 * ((i >> 2) & 3) + 4 * n_ + (i & 3); }
        if (n < 1952) return 1536 + (n - 1440);
        if (n < 2464) return 2048 + (n - 1952);
        if (n < 3488) return 2560 + (n - 2464);
        return 3584 + (n - 3488); }
    case RM_QB: { const int hh = n / 96, d = n % 96; if (d < 64) return hh * 64 + d; const int j = d - 64, jj = j & 15; return 512 + hh * 32 + 8 * (jj >> 2) + 4 * (j >> 4) + (jj & 3); }
    case RM_KVB: { const int hh = n >> 7, d = n & 127; return d < 64 ? hh * 64 + d : 512 + hh * 64 + (d - 64); }
    default: return n; }
}
__device__ __forceinline__ void tr_item(const float* W, int N, bf16* WT, int Kd, int koff, const float* gain, float scale, int kind, LAS float* scr, int item, int lane) {
    const int nblk = N / 32, kb = item / nblk, nb = item % nblk, k0 = 64 * kb, n0 = 32 * nb;
#pragma unroll 8
    for (int i = 0; i < 32; ++i) { const int kk = 2 * i + (lane >> 5); const float g = gain ? gain[k0 + kk] * scale : scale; scr[kk * 33 + (lane & 31)] = W[(size_t)(k0 + kk) * N + n0 + (lane & 31)] * g; }
    LDS_WAIT(); asm volatile("" ::: "memory");
    const int c = lane & 7;
#pragma unroll
    for (int j = 0; j < 4; ++j) { const int n = (lane >> 3) + 8 * j; const LAS float* s = scr + (8 * c) * 33 + n;
        v4u o; o.x = pk2(s[0 * 33], s[1 * 33]); o.y = pk2(s[2 * 33], s[3 * 33]); o.z = pk2(s[4 * 33], s[5 * 33]); o.w = pk2(s[6 * 33], s[7 * 33]);
        *(GAS v4u*)(WT + (size_t)rowmap(kind, n0 + n) * Kd + koff + k0 + 8 * c) = o; }
    LDS_WAIT(); asm volatile("" ::: "memory");
}
__device__ __forceinline__ void sincos_d(double a, float& c, float& s) {
    const double k = __builtin_rint(a * 0.63661977236758134308);
    double r = __builtin_fma(-k, 1.5707963267948966, a); r = __builtin_fma(-k, 6.123233995736766e-17, r);
    const double r2 = r * r;
    const double sp = r * (1.0 + r2 * (-1.0 / 6 + r2 * (1.0 / 120 + r2 * (-1.0 / 5040 + r2 * (1.0 / 362880 + r2 * (-1.0 / 39916800 + r2 * (1.0 / 6227020800.0)))))));
    const double cp = 1.0 + r2 * (-0.5 + r2 * (1.0 / 24 + r2 * (-1.0 / 720 + r2 * (1.0 / 40320 + r2 * (-1.0 / 3628800 + r2 * (1.0 / 479001600.0 + r2 * (-1.0 / 87178291200.0)))))));
    const int q = (int)((long long)k & 3);
    const double cc = q == 0 ? cp : q == 1 ? -sp : q == 2 ? -cp : sp, ss = q == 0 ? sp : q == 1 ? cp : q == 2 ? -sp : -cp;
    c = (float)cc; s = (float)ss;
}

struct Frame {
    LAS unsigned char* lds; volatile LAS unsigned* MISC; gu32* ctl; int tid, lane, wave, G, bid;
};

__device__ __forceinline__ void p0_prologue(const Args& a, Frame& F) {
    unsigned char* ws = a.ws;
    LAS float* scr = (LAS float*)(F.lds + F.wave * 16384);
    const int gw = F.bid * NWAVES + F.wave, NGW = F.G * NWAVES;
    constexpr int I_FF = 16 * 88, I_DN = 44 * 32, I_IN = 16 * 141, I_QB = 4 * 24, I_KVB = 2 * 32, I_BR = 8 * 32, I_SQ = 16 * 32, I_PP = 4 * 32;
    constexpr int NITEMS = 4 * I_FF + 2 * I_DN + I_IN + I_QB + I_KVB + 2 * I_BR + 2 * I_SQ + I_PP;
    for (int it = gw; it < NITEMS; it += NGW) {
        int r = it;
        if (r < I_FF) { tr_item(a.ffn1_w_gate, DFF, (bf16*)(ws + WS_WGU1), DM, 0, nullptr, 1.f, RM_GATE, scr, r, F.lane); continue; } r -= I_FF;
        if (r < I_FF) { tr_item(a.ffn1_w_up, DFF, (bf16*)(ws + WS_WGU1), DM, 0, nullptr, 1.f, RM_UP, scr, r, F.lane); continue; } r -= I_FF;
        if (r < I_FF) { tr_item(a.ffn2_w_gate, DFF, (bf16*)(ws + WS_WGU2), DM, 0, a.ffn2_norm, 1.f, RM_GATE, scr, r, F.lane); continue; } r -= I_FF;
        if (r < I_FF) { tr_item(a.ffn2_w_up, DFF, (bf16*)(ws + WS_WGU2), DM, 0, a.ffn2_norm, 1.f, RM_UP, scr, r, F.lane); continue; } r -= I_FF;
        if (r < I_DN) { tr_item(a.ffn1_w_down, DM, (bf16*)(ws + WS_WD1), DFF, 0, nullptr, 1.f, RM_ID, scr, r, F.lane); continue; } r -= I_DN;
        if (r < I_DN) { tr_item(a.ffn2_w_down, DM, (bf16*)(ws + WS_WD2), DFF, 0, nullptr, 1.f, RM_ID, scr, r, F.lane); continue; } r -= I_DN;
        if (r < I_IN) { tr_item(a.w_in, 4512, (bf16*)(ws + WS_WIN), DM, 0, a.mix_norm, 1.f, RM_WIN, scr, r, F.lane); continue; } r -= I_IN;
        if (r < I_QB) { tr_item(a.w_q_b, 768, (bf16*)(ws + WS_WQB), QL, 0, a.q_a_norm, C2, RM_QB, scr, r, F.lane); continue; } r -= I_QB;
        if (r < I_KVB) { tr_item(a.w_kv_b, 1024, (bf16*)(ws + WS_WKVB), KVL, 0, a.kv_a_norm, 1.f, RM_KVB, scr, r, F.lane); continue; } r -= I_KVB;
        if (r < I_BR) { tr_item(a.w_branch_att, DM, (bf16*)(ws + WS_WBC), DM, 0, nullptr, 1.f, RM_ID, scr, r, F.lane); continue; } r -= I_BR;
        if (r < I_BR) { tr_item(a.w_branch_ret, DM, (bf16*)(ws + WS_WBC), DM, 512, nullptr, 1.f, RM_ID, scr, r, F.lane); continue; } r -= I_BR;
        if (r < I_SQ) { tr_item(a.w_out, DM, (bf16*)(ws + WS_WOUT), DM, 0, nullptr, 1.f, RM_ID, scr, r, F.lane); continue; } r -= I_SQ;
        if (r < I_SQ) { tr_item(a.w_ple_gate, DM, (bf16*)(ws + WS_WPG), DM, 0, a.ple_norm, 1.f, RM_ID, scr, r, F.lane); continue; } r -= I_SQ;
        tr_item(a.w_ple_proj, DM, (bf16*)(ws + WS_WPP), PLE, 0, nullptr, 1.f, RM_ID, scr, r, F.lane);
    }
    const int gt = F.bid * (NWAVES * 64) + F.tid, NGT = F.G * NWAVES * 64;
    for (int i = gt; i < 96 * 128; i += NGT) *(v4u*)((bf16*)(ws + WS_WIN) + (size_t)416 * DM + (size_t)i * 8) = (v4u){0u, 0u, 0u, 0u};
    for (int i = gt; i < 8193 * 64; i += NGT) { const int pi = i >> 6, fi = i & 63; double inv = 1.0; for (int k = 0; k < fi; ++k) inv *= 0.8659643233600653;
        float c, s; sincos_d((double)(pi == 8192 ? 16384 : pi) * inv, c, s); ((float2*)(ws + WS_ROPE))[i] = make_float2(c, s); }
    for (int m = gw; m < MT; m += NGW) {
        bf16* orow = (bf16*)(ws + WS_XN1) + (size_t)m * DM; bf16* prow = (bf16*)(ws + WS_PB) + (size_t)m * PLE;
        if (m >= MP + MS) {
#pragma unroll
            for (int j = 0; j < 4; ++j) ((unsigned long long*)orow)[F.lane + 64 * j] = 0ull;
            ((unsigned long long*)prow)[F.lane] = 0ull; continue; }
        const float* xrow = m < MP ? a.x_prompt + (size_t)m * DM : a.x_sample + (size_t)(m - MP) * DM;
        const float* pr = m < MP ? a.p_prompt + (size_t)m * PLE : a.p_sample + (size_t)(m - MP) * PLE;
        const pg8::f32x4* xr = (const pg8::f32x4*)xrow + F.lane; pg8::f32x4 v[4]; float s = 0.f;
#pragma unroll
        for (int j = 0; j < 4; ++j) { v[j] = xr[64 * j]; s += (v[j].x * v[j].x + v[j].y * v[j].y) + (v[j].z * v[j].z + v[j].w * v[j].w); }
        const float rstd = 1.0f / sqrtf(wave_sum(s) * (1.f / DM) + EPS);
#pragma unroll
        for (int j = 0; j < 4; ++j) { const pg8::f32x4 g = ((const pg8::f32x4*)a.ffn1_norm)[F.lane + 64 * j];
            ((unsigned long long*)orow)[F.lane + 64 * j] = (unsigned long long)pk2(v[j].x * rstd * g.x, v[j].y * rstd * g.y) | ((unsigned long long)pk2(v[j].z * rstd * g.z, v[j].w * rstd * g.w) << 32); }
        const pg8::f32x4 pv = ((const pg8::f32x4*)pr)[F.lane];
        ((unsigned long long*)prow)[F.lane] = (unsigned long long)pk2(pv.x, pv.y) | ((unsigned long long)pk2(pv.z, pv.w) << 32);
    }
}

__global__ void __launch_bounds__(NWAVES * 64, 2) mk_fwd(Args args) {
    extern __shared__ __attribute__((aligned(16))) unsigned char lds[];
    Frame F;
    F.lds = (LAS unsigned char*)lds; F.MISC = (volatile LAS unsigned*)(F.lds + MISC_OFF);
    F.tid = threadIdx.x; F.lane = F.tid & 63; F.wave = __builtin_amdgcn_readfirstlane(F.tid >> 6); F.G = gridDim.x; F.bid = blockIdx.x;
    unsigned char* ws = args.ws;
    F.ctl = (gu32*)(ws + WS_CTL);
    for (int u = F.tid; u < (LDS_BYTES - LDSCTL_OFF) / 4; u += NWAVES * 64) ((LAS unsigned*)(F.lds + LDSCTL_OFF))[u] = 0u;
    __syncthreads();
    XcdBarrier bar; bar.bar = (unsigned*)(ws + WS_CTL) + CW_BAR; bar.x = 0; bar.st = nullptr;
    if (!MK_PER_PHASE) bar = xcd_barrier_post((unsigned*)(ws + WS_CTL) + CW_BAR, F.MISC + 8);
    const int lo = args.ph_lo, hi = args.ph_hi;
#ifndef PHASE_MASK
#define PHASE_MASK 0xFFFF
#endif
#define IN(k) (((PHASE_MASK >> (k)) & 1) && lo <= (k) && (k) < hi)
#define SEAM(k) do { if (IN(k) && IN((k) + 1)) { if (MK_PER_PHASE) { if (F.tid == 0) __hip_atomic_store(F.ctl + CW_TMO, 0xBADBA0u, RLX_AGENT); } else xcd_barrier(bar); } } while (0)
    float* ssq_h1 = (float*)(ws + WS_SSQ); float* ssq_h2 = (float*)(ws + WS_SSQ + SSQ16_BYTES); float* ssq_h3 = (float*)(ws + WS_SSQ + 2 * SSQ16_BYTES); float* ssq_h4 = (float*)(ws + WS_SSQ + 3 * SSQ16_BYTES);
    float* ssq_cq = (float*)(ws + WS_SSQ + 4 * SSQ16_BYTES); float* ssq_kv = (float*)(ws + WS_SSQ + 4 * SSQ16_BYTES + SSQ4_BYTES);
    const float2* rope = (const float2*)(ws + WS_ROPE);
    bf16 *XN1 = (bf16*)(ws + WS_XN1), *ACT = (bf16*)(ws + WS_ACT), *H1B = (bf16*)(ws + WS_H1B), *CQB = (bf16*)(ws + WS_CQB), *CKVB = (bf16*)(ws + WS_CKVB), *KPEB = (bf16*)(ws + WS_KPEB);
    bf16 *QR = (bf16*)(ws + WS_QR), *KR = (bf16*)(ws + WS_KR), *RV = (bf16*)(ws + WS_RV), *RGS = (bf16*)(ws + WS_RGS), *SGA = (bf16*)(ws + WS_SGA), *SGR = (bf16*)(ws + WS_SGR);
    bf16 *QB = (bf16*)(ws + WS_QB), *KN = (bf16*)(ws + WS_KN), *VB = (bf16*)(ws + WS_VB), *OCAT = (bf16*)(ws + WS_OCAT), *SC = (bf16*)(ws + WS_SC), *MRG = (bf16*)(ws + WS_MRG);
    bf16 *H2B = (bf16*)(ws + WS_H2B), *H3B = (bf16*)(ws + WS_H3B), *PB = (bf16*)(ws + WS_PB), *PP = (bf16*)(ws + WS_PP);
    float *H1 = (float*)(ws + WS_H1), *H2 = (float*)(ws + WS_H2), *H3 = (float*)(ws + WS_H3), *H4 = (float*)(ws + WS_H4), *CKVF = (float*)(ws + WS_CKVF), *KVC = (float*)(ws + WS_KVC);
    float *DPO = (float*)(ws + WS_DPO), *DML = (float*)(ws + WS_DML), *QLAT = (float*)(ws + WS_QLAT);
    const int gt = F.bid * (NWAVES * 64) + F.tid, NGT = F.G * NWAVES * 64, gw = F.bid * NWAVES + F.wave, NGW = F.G * NWAVES;

    if (IN(0)) { p0_prologue(args, F); }
    SEAM(0);
    if (IN(1)) { pg8::Gemm g{XN1, (const bf16*)(ws + WS_WGU1), MT, NGU, DM}; pg8::StaticOrder S; S.init(MT, NGU, F.G, F.bid);
        pg8::EpiSwiGLU E{0, ACT, nullptr}; pg8::gemm_phase<pg8::EpiSwiGLU, pg8::StaticOrder, true, true>(F.lds, g, S, E); }
    SEAM(1);
    if (IN(2)) { pg8::Gemm g{ACT, (const bf16*)(ws + WS_WD1), MT, DM, DFF}; pg8::StaticOrder S; S.init(MT, DM, F.G, F.bid);
        pg8::EpiResid<true> E{0, args.x_prompt, args.x_sample, 0, H1, H1B, ssq_h1}; pg8::gemm_phase<pg8::EpiResid<true>, pg8::StaticOrder, true, true>(F.lds, g, S, E); }
    SEAM(2);
    if (IN(3)) { pg8::Gemm g{H1B, (const bf16*)(ws + WS_WIN), MT, NIN, DM}; pg8::StaticOrder S; S.init(MT, NIN, F.G, F.bid);
        pg8::EpiWin E{0, ssq_h1, ssq_cq, ssq_kv, rope, args.out, CQB, CKVB, KPEB, QR, KR, RV, RGS, SGA, SGR, CKVF};
        pg8::gemm_phase<pg8::EpiWin, pg8::StaticOrder, true, true>(F.lds, g, S, E); }
    SEAM(3);
    if (IN(4)) {
#ifndef P4_MASK
#define P4_MASK 31
#endif
        if (P4_MASK & 1) { pg8::Gemm g{CQB, (const bf16*)(ws + WS_WQB), MT, 768, QL}; pg8::StaticOrder S; S.init(MT, 768, F.G, F.bid);
          pg8::EpiQB E{0, ssq_cq, rope, QB}; pg8::gemm_phase<pg8::EpiQB, pg8::StaticOrder, true, true>(F.lds, g, S, E); }
        if (P4_MASK & 2) { pg8::Gemm g{CKVB, (const bf16*)(ws + WS_WKVB), MP, DM, KVL}; pg8::StaticOrder S; S.init(MP, DM, F.G, F.bid);
          pg8::EpiPlain E{0, KN, VB, 512, 2, ssq_kv, 1.0f / KVL}; pg8::gemm_phase<pg8::EpiPlain, pg8::StaticOrder, true, true>(F.lds, g, S, E); }
        if (P4_MASK & 4) { pg8::Gemm g{PB, (const bf16*)(ws + WS_WPP), MT, DM, PLE}; pg8::StaticOrder S; S.init(MT, DM, F.G, F.bid);
          pg8::EpiPlain E{0, PP, PP, DM, 4, nullptr, 0.f}; pg8::gemm_phase<pg8::EpiPlain, pg8::StaticOrder, true, true>(F.lds, g, S, E); }
        if (P4_MASK & 8) for (int i = gt; i < (MP + MS) * 32; i += NGT) { const int row = i >> 5, c4 = (i & 31) * 4; const float rs = pg8::rstd_of<4>(ssq_kv, row, 1.0f / KVL);
            const pg8::f32x4 v = *(const pg8::f32x4*)(CKVF + (size_t)row * KVL + c4), g = *(const pg8::f32x4*)(args.kv_a_norm + c4);
            float* o = row < MP ? args.out + O_CKVP + (size_t)row * KVL : args.out + O_CKVS + (size_t)(row - MP) * KVL;
            *(pg8::f32x4*)(o + c4) = v * rs * g; }
        if (P4_MASK & 16) for (int u = F.bid; u < 512; u += F.G) ret::kv_unit(u, KR, RV, KVC, F.lds);
    }
    SEAM(4);
    if (IN(5)) {
#ifndef P5_MASK
#define P5_MASK 7
#endif
        if (P5_MASK & 1) for (int v = F.bid; v < 256; v += F.G) { const int bh = v >> 4, s = v & 15;
            att::attn_unit(bh >> 3, bh & 7, s, QB, KN, KPEB, VB, OCAT, (char*)lds);
            att::attn_unit(bh >> 3, bh & 7, 31 - s, QB, KN, KPEB, VB, OCAT, (char*)lds); }
        if (P5_MASK & 2) for (int v = F.bid; v < 256; v += F.G) { const int s = v >> 1, sg = v & 1;
            dec::qlat_token(s, QB, args.w_kv_b, (LAS float*)F.lds + dec::L_QL, QLAT, sg == 0);
            __syncthreads();
            for (int k = 0; k < 4; ++k) dec::split_unit(s, sg * 4 + k, QB, args.cache_ckv, args.cache_kpe, args.page_table, DPO, DML, (LAS float*)F.lds); }
        if (P5_MASK & 4) ret::scan_items(gt, NGT, KVC, SC, args.out);
    }
    SEAM(5);
    if (IN(6)) {
        for (int u = F.bid; u < 512; u += F.G) ret::out_unit(u, QR, KR, RV, SC, RGS, args.ret_norm, OCAT, F.lds);
        for (int u = F.bid; u < 512; u += F.G) ret::sample_unit(u, QR, KR, RV, RGS, args.ret_norm, args.state_ret, args.out, OCAT, F.lds);
        for (int s = F.bid; s < MS; s += F.G) dec::combine_unit(s, QB, QLAT, DPO, DML, args.out, args.w_kv_b, OCAT, (LAS float*)F.lds);
    }
    SEAM(6);
    if (IN(7)) { pg8::Gemm g{OCAT, (const bf16*)(ws + WS_WBC), MT, DM, DM}; pg8::StaticOrder S; S.init(MT, DM, F.G, F.bid);
        pg8::EpiMerge E{8, SGA, SGR, MRG}; pg8::gemm_phase<pg8::EpiMerge, pg8::StaticOrder, true, true>(F.lds, g, S, E); }
    SEAM(7);
    if (IN(8)) { pg8::Gemm g{MRG, (const bf16*)(ws + WS_WOUT), MT, DM, DM}; pg8::StaticOrder S; S.init(MT, DM, F.G, F.bid);
        pg8::EpiResid<false> E{0, H1, H1, 1, H2, H2B, ssq_h2}; pg8::gemm_phase<pg8::EpiResid<false>, pg8::StaticOrder, true, true>(F.lds, g, S, E); }
    SEAM(8);
    if (IN(9)) { pg8::Gemm g{H2B, (const bf16*)(ws + WS_WGU2), MT, NGU, DM}; pg8::StaticOrder S; S.init(MT, NGU, F.G, F.bid);
        pg8::EpiSwiGLU E{0, ACT, ssq_h2}; pg8::gemm_phase<pg8::EpiSwiGLU, pg8::StaticOrder, true, true>(F.lds, g, S, E); }
    SEAM(9);
    if (IN(10)) { pg8::Gemm g{ACT, (const bf16*)(ws + WS_WD2), MT, DM, DFF}; pg8::StaticOrder S; S.init(MT, DM, F.G, F.bid);
        pg8::EpiResid<true> E{0, H2, H2, 1, H3, H3B, ssq_h3}; pg8::gemm_phase<pg8::EpiResid<true>, pg8::StaticOrder, true, true>(F.lds, g, S, E); }
    SEAM(10);
    if (IN(11)) { pg8::Gemm g{H3B, (const bf16*)(ws + WS_WPG), MT, DM, DM}; pg8::StaticOrder S; S.init(MT, DM, F.G, F.bid);
        pg8::EpiPle E{0, H3, PP, ssq_h3, H4, ssq_h4}; pg8::gemm_phase<pg8::EpiPle, pg8::StaticOrder, true, true>(F.lds, g, S, E); }
    SEAM(11);
    if (IN(12)) {
        for (int m = gw; m < MP + MS; m += NGW) { const float rs = pg8::rstd_of<16>(ssq_h4, m, 1.0f / DM);
            const pg8::f32x4* hr = (const pg8::f32x4*)(H4 + (size_t)m * DM) + F.lane; pg8::f32x4* o = (pg8::f32x4*)(args.out + (m < MP ? O_YP + (size_t)m * DM : O_YS + (size_t)(m - MP) * DM)) + F.lane;
#pragma unroll
            for (int j = 0; j < 4; ++j) o[64 * j] = hr[64 * j] * rs * ((const pg8::f32x4*)args.final_norm)[F.lane + 64 * j]; }
    }
#undef IN
#undef SEAM
}

#ifdef DBG_LAST
__global__ void dbg_dump(const unsigned char* ws, float* out) {
    const size_t n = (size_t)MP * DM;
    for (size_t i = (size_t)blockIdx.x * blockDim.x + threadIdx.x; i < n; i += (size_t)gridDim.x * blockDim.x) { const size_t r = i >> 10, c = i & 1023; float v = 0.f;
        if (c < DBG_NCOLS) { if (DBG_F32) v = ((const float*)(ws + DBG_SRC))[r * DBG_PITCH + c]; else v = bf2f(((const bf16*)(ws + DBG_SRC))[r * DBG_PITCH + c]); }
#ifdef DBG_SRC2
        else v = bf2f(((const bf16*)(ws + DBG_SRC2))[r * DBG_PITCH + (c - DBG_NCOLS)]);
#endif
        out[i] = v; }
}
#endif
extern "C" void kernel_launch(void* const* d_in, const int* in_sizes, int n_in, void* d_out, int out_size, void* d_ws, size_t ws_size, hipStream_t stream) {
    static int grid = 0;
    if (grid == 0) {
        if (n_in != 30 || out_size != (int)O_END || ws_size < WS_END) { fprintf(stderr, "kernel_launch: built for 30 inputs, %zu outputs, >= %zu bytes of workspace; got n_in %d, out %d, ws %zu; nothing launched\n", (size_t)O_END, (size_t)WS_END, n_in, out_size, ws_size); grid = -1; return; }
        int dev = 0, cus = 0, per_cu = 0;
        if (hipGetDevice(&dev) != hipSuccess || hipDeviceGetAttribute(&cus, hipDeviceAttributeMultiprocessorCount, dev) != hipSuccess) { fprintf(stderr, "kernel_launch: device query failed\n"); grid = -1; return; }
        if (hipFuncSetAttribute((const void*)mk_fwd, hipFuncAttributeMaxDynamicSharedMemorySize, LDS_BYTES) != hipSuccess) { fprintf(stderr, "kernel_launch: hipFuncSetAttribute failed\n"); grid = -1; return; }
        if (hipOccupancyMaxActiveBlocksPerMultiprocessor(&per_cu, (const void*)mk_fwd, NWAVES * 64, LDS_BYTES) != hipSuccess || per_cu < 1)
            fprintf(stderr, "kernel_launch: note: occupancy query reports %d workgroups per CU\n", per_cu);
        (void)hipGetLastError();
        grid = cus;
    }
    if (grid < 0) return;
    if (hipMemsetAsync((char*)d_ws + WS_CTL, 0, CTL_ZERO_BYTES, stream) != hipSuccess) { fprintf(stderr, "kernel_launch: memset failed\n"); return; }
    Args a{};
    const float** fp = (const float**)&a;
    for (int i = 0; i < 30; ++i) fp[i] = (const float*)d_in[i];
    a.out = (float*)d_out; a.ws = (unsigned char*)d_ws;
#if MK_PER_PHASE
#ifdef DBG_LAST
    for (int k = 0; k <= DBG_LAST; ++k) { a.ph_lo = k; a.ph_hi = k + 1; hipLaunchKernelGGL(mk_fwd, dim3(grid), dim3(NWAVES * 64), LDS_BYTES, stream, a); }
    hipLaunchKernelGGL(dbg_dump, dim3(1024), dim3(256), 0, stream, (const unsigned char*)d_ws, (float*)d_out);
#else
    for (int k = 0; k < NPHASE; ++k) { a.ph_lo = k; a.ph_hi = k + 1; hipLaunchKernelGGL(mk_fwd, dim3(grid), dim3(NWAVES * 64), LDS_BYTES, stream, a); }
#endif
#else
    a.ph_lo = 0; a.ph_hi = NPHASE; hipLaunchKernelGGL(mk_fwd, dim3(grid), dim3(NWAVES * 64), LDS_BYTES, stream, a);
#endif
    const hipError_t le = hipPeekAtLastError();
    if (le != hipSuccess) fprintf(stderr, "kernel_launch: launch failed: %s\n", hipGetErrorName(le));
}
```

```cpp
#include <hip/hip_runtime.h>
#include <cstdio>
#include <cstdint>

#ifndef MK_PER_PHASE
#define MK_PER_PHASE 0
#endif

constexpr int DM = 1024, TSEQ = 8192, MP = 16384, MS = 128, MT = 16640, NPAN = MT / 256;
constexpr int DFF = 2816, NGU = 2 * DFF, NIN = 4608, PLE = 256;
constexpr int NH = 8, QKD = 96, KVL = 128, RPE = 32, QL = 256;
constexpr int RH = 4, RDK = 128, RDV = 128;
constexpr int NPAGES = 128, PAGE = 128;
constexpr float EPS = 1e-6f;
constexpr float C2 = 0.10206207261596575f * 1.4426950408889634f;
constexpr size_t O_YP = 0, O_YS = 16777216, O_CKVP = 16908288, O_KPEP = 19005440, O_RETP = 19529728, O_CKVS = 19660800, O_KPES = 19677184, O_RETS = 19681280, O_END = 28069888;

constexpr size_t MiB = 1u << 20;
constexpr size_t al1(size_t x) { return (x + MiB - 1) & ~(MiB - 1); }
constexpr size_t WS_CTL = 0, CTL_ZERO_BYTES = 1 * MiB;
constexpr size_t WS_WGU1 = 2 * MiB;
constexpr size_t WS_WD1  = WS_WGU1 + al1((size_t)NGU * DM * 2);
constexpr size_t WS_WIN  = WS_WD1 + al1((size_t)DM * DFF * 2);
constexpr size_t WS_WQB  = WS_WIN + al1((size_t)NIN * DM * 2);
constexpr size_t WS_WKVB = WS_WQB + al1((size_t)768 * 256 * 2);
constexpr size_t WS_WBC  = WS_WKVB + al1((size_t)1024 * 128 * 2);
constexpr size_t WS_WOUT = WS_WBC + al1((size_t)DM * DM * 2);
constexpr size_t WS_WGU2 = WS_WOUT + al1((size_t)DM * DM * 2);
constexpr size_t WS_WD2  = WS_WGU2 + al1((size_t)NGU * DM * 2);
constexpr size_t WS_WPG  = WS_WD2 + al1((size_t)DM * DFF * 2);
constexpr size_t WS_WPP  = WS_WPG + al1((size_t)DM * DM * 2);
constexpr size_t WS_ROPE = WS_WPP + al1((size_t)DM * PLE * 2);
constexpr size_t WS_XN1  = WS_ROPE + al1((size_t)8193 * 64 * 8);
constexpr size_t WS_ACT  = WS_XN1 + al1((size_t)MT * DM * 2);
constexpr size_t WS_H1   = WS_ACT + al1((size_t)MT * DFF * 2);
constexpr size_t WS_H1B  = WS_H1 + al1((size_t)MT * DM * 4);
constexpr size_t WS_CQB  = WS_H1B + al1((size_t)MT * DM * 2);
constexpr size_t WS_CKVF = WS_CQB + al1((size_t)MT * 256 * 2);
constexpr size_t WS_CKVB = WS_CKVF + al1((size_t)MT * 128 * 4);
constexpr size_t WS_KPEB = WS_CKVB + al1((size_t)MT * 128 * 2);
constexpr size_t WS_QR   = WS_KPEB + al1((size_t)MT * 32 * 2);
constexpr size_t WS_KR   = WS_QR + al1((size_t)MT * 512 * 2);
constexpr size_t WS_RV   = WS_KR + al1((size_t)MT * 512 * 2);
constexpr size_t WS_RGS  = WS_RV + al1((size_t)MT * 512 * 2);
constexpr size_t WS_SGA  = WS_RGS + al1((size_t)MT * 512 * 2);
constexpr size_t WS_SGR  = WS_SGA + al1((size_t)MT * DM * 2);
constexpr size_t WS_QB   = WS_SGR + al1((size_t)MT * DM * 2);
constexpr size_t WS_KN   = WS_QB + al1((size_t)MT * 768 * 2);
constexpr size_t WS_VB   = WS_KN + al1((size_t)MP * 512 * 2);
constexpr size_t WS_OCAT = WS_VB + al1((size_t)MP * 512 * 2);
constexpr size_t WS_KVC  = WS_OCAT + al1((size_t)MT * DM * 2);
constexpr size_t WS_SC   = WS_KVC + al1((size_t)512 * 16384 * 4);
constexpr size_t WS_MRG  = WS_SC + al1((size_t)512 * 16384 * 2);
constexpr size_t WS_H2   = WS_MRG + al1((size_t)MT * DM * 2);
constexpr size_t WS_H2B  = WS_H2 + al1((size_t)MT * DM * 4);
constexpr size_t WS_H3   = WS_H2B + al1((size_t)MT * DM * 2);
constexpr size_t WS_H3B  = WS_H3 + al1((size_t)MT * DM * 4);
constexpr size_t WS_PB   = WS_H3B + al1((size_t)MT * DM * 2);
constexpr size_t WS_PP   = WS_PB + al1((size_t)MT * PLE * 2);
constexpr size_t WS_H4   = WS_PP + al1((size_t)MT * DM * 2);
constexpr size_t WS_DPO  = WS_H4 + al1((size_t)MT * DM * 4);
constexpr size_t WS_DML  = WS_DPO + al1((size_t)128 * 8 * 8 * 128 * 4);
constexpr size_t WS_QLAT = WS_DML + MiB;
constexpr size_t WS_SSQ  = WS_QLAT + MiB;
constexpr size_t SSQ16_BYTES = (size_t)MT * 16 * 4, SSQ4_BYTES = (size_t)MT * 4 * 4;
constexpr size_t WS_END  = WS_SSQ + al1(4 * SSQ16_BYTES + 2 * SSQ4_BYTES);
constexpr int CW_TMO = 0, CW_BAR = 4096;

constexpr int RING_BYTES = 131072, LDSCTL_OFF = RING_BYTES, MISC_OFF = LDSCTL_OFF + 320, LDS_BYTES = 147456;

#define GAS __attribute__((address_space(1)))
#define LAS __attribute__((address_space(3)))
typedef unsigned short bf16;
typedef unsigned v4u __attribute__((ext_vector_type(4)));
typedef unsigned v2u __attribute__((ext_vector_type(2)));
typedef GAS unsigned gu32;
#define RLX_AGENT __ATOMIC_RELAXED, __HIP_MEMORY_SCOPE_AGENT
#define LDS_WAIT() asm volatile("s_waitcnt lgkmcnt(0)" ::: "memory")
#define VM_WAIT() asm volatile("s_waitcnt vmcnt(0)" ::: "memory")
__device__ __forceinline__ unsigned f2bf(float f) { unsigned u = __builtin_bit_cast(unsigned, f); return (u + 0x7fffu + ((u >> 16) & 1u)) >> 16; }
__device__ __forceinline__ unsigned pk2(float lo, float hi) { return f2bf(lo) | (f2bf(hi) << 16); }
__device__ __forceinline__ float bflo(unsigned w) { return __builtin_bit_cast(float, w << 16); }
__device__ __forceinline__ float bfhi(unsigned w) { return __builtin_bit_cast(float, w & 0xffff0000u); }
__device__ __forceinline__ float bf2f(bf16 h) { return __builtin_bit_cast(float, (unsigned)h << 16); }
__device__ __forceinline__ float sigm(float x) { return __builtin_amdgcn_rcpf(1.f + __builtin_amdgcn_exp2f(-1.4426950408889634f * x)); }
__device__ __forceinline__ float wave_sum(float v) {
#pragma unroll
    for (int o = 1; o < 64; o <<= 1) v += __shfl_xor(v, o);
    return v;
}
__device__ __forceinline__ float lg2gamma(int h) { return h == 0 ? -0.04580368961312479f : h == 1 ? -0.02272007650008353f : h == 2 ? -0.011315313227834146f : -0.005646563141142063f; }
namespace pg8 {
#define PG8_LAS __attribute__((address_space(3)))
typedef unsigned short bf16_t;
typedef short bf16x8 __attribute__((ext_vector_type(8)));
typedef float f32x4 __attribute__((ext_vector_type(4)));
typedef unsigned u32x4 __attribute__((ext_vector_type(4)));
constexpr int BM = 256, BK = 64, HALF = 128, HTB = HALF * BK * 2  , STAGE_BYTES = 8 * HTB, NXCD = 8, WGM = 8;

__host__ __device__ __forceinline__ int lds_byte(int r, int c) { const int st = (r >> 4) * 2 + (c >> 5), rr = r & 15, cc = c & 31, ob = rr * 64 + cc * 2; return st * 1024 + (ob ^ (((ob >> 9) & 1) << 5)); }
__host__ __device__ __forceinline__ void stage_rc(int b, int& R, int& C) { const int st = b / 1024, sb = b % 1024, swz = sb ^ (((sb >> 9) & 1) << 5); R = (st >> 1) * 16 + swz / 64; C = (st & 1) * 32 + (swz % 64) / 2; }
__host__ __device__ __forceinline__ int perm32(int rho) { const int n = rho >> 4, i = rho & 15; return 8 * (i >> 2) + 4 * n + (i & 3); }

struct Unit { int pm, pn; };
struct Gemm { const bf16_t* A; const bf16_t* Bt; int M, N, K; };

struct StaticOrder {
    int nM, nN, nwg, G, c;
    __host__ __device__ void init(int M, int N, int G_, int c_) { nM = M / BM; nN = N / BM; nwg = nM * nN; G = G_; c = c_; }
    __host__ __device__ bool next(int i, Unit& u) const {
        const long L = (long)i * G + c; if (L >= nwg) return false;
        int wgid = (int)L; { const int q = nwg / NXCD, r = nwg % NXCD, xcd = wgid % NXCD, off = wgid / NXCD; wgid = (xcd < r ? xcd * (q + 1) : r * (q + 1) + (xcd - r) * q) + off; }
        const int nig = WGM * nN, gid = wgid / nig, fm = gid * WGM, gsz = (nM - fm) < WGM ? (nM - fm) : WGM;
        u.pm = fm + ((wgid % nig) % gsz); u.pn = (wgid % nig) / gsz; return true;
    }
    __device__ __forceinline__ void a_ready(const Unit&) const {}
    __device__ __forceinline__ void done(const Unit&) const {}
};

typedef float cvt_f32x2_t __attribute__((ext_vector_type(2))); typedef __bf16 cvt_bf16x2_t __attribute__((ext_vector_type(2)));
__device__ __forceinline__ unsigned cvt_pk_bf16(float lo, float hi) { cvt_f32x2_t v = {lo, hi}; cvt_bf16x2_t b = __builtin_convertvector(v, cvt_bf16x2_t); return __builtin_bit_cast(unsigned, b); }
typedef float f32x2 __attribute__((ext_vector_type(2)));
template <class Epi, class Sched, bool ALIGN_EPI = false, bool SP2 = false>
__device__ __forceinline__ void gemm_phase(PG8_LAS unsigned char* lds, const Gemm g, const Sched S, const Epi E) {
    int tid_ = threadIdx.x; asm volatile("" : "+v"(tid_));
    const int tid = tid_, wid = __builtin_amdgcn_readfirstlane(tid >> 6), lane = tid & 63, wr = wid >> 2, wc = wid & 3, fr = lane & 15, fq = lane >> 4;
    const int K = g.K, nt = K / BK;
    unsigned voffA[2], voffB[2];
#pragma unroll
    for (int i = 0; i < 2; ++i) { int R, C; stage_rc(tid * 16 + i * 8192, R, C); const int Rb = Epi::PERM ? ((R & ~31) + perm32(R & 31)) : R;
        voffA[i] = (unsigned)(R * K + C) * 2u; voffB[i] = (unsigned)(Rb * K + C) * 2u; }
    const size_t kstep = (size_t)(BK * 2);
    const size_t hstep = (size_t)HALF * K * 2;
    const size_t tstep = 2 * hstep;
    const unsigned ldsw = (unsigned)wid * 1024u;
    const int aoff = lds_byte(wr * 64 + fr, fq * 8), boff = lds_byte(wc * 32 + fr, fq * 8);
#define PG8_SA(b, h) (((b) * 2 + (h)) * HTB)
#define PG8_SB(b, h) ((4 + (b) * 2 + (h)) * HTB)
#define PG8_STAGE(bufoff, gbase, voff) do { _Pragma("unroll") for (int _i = 0; _i < 2; ++_i) \
        __builtin_amdgcn_global_load_lds((const unsigned*)((const char*)(gbase) + (voff)[_i]), (PG8_LAS unsigned*)(lds + (bufoff) + ldsw + _i * 8192), 16, 0, 0); } while (0)
#define PG8_LDA(dst, b, h) do { _Pragma("unroll") for (int m = 0; m < 4; ++m) _Pragma("unroll") for (int k = 0; k < 2; ++k) dst[m][k] = *(const PG8_LAS bf16x8*)(lds + PG8_SA(b, h) + aoff + m * 2048 + k * 1024); } while (0)
#define PG8_LDB(dst, b, h) do { _Pragma("unroll") for (int n = 0; n < 2; ++n) _Pragma("unroll") for (int k = 0; k < 2; ++k) dst[n][k] = *(const PG8_LAS bf16x8*)(lds + PG8_SB(b, h) + boff + n * 2048 + k * 1024); } while (0)
#define PG8_MMA(ai, bj, At, Bt) do { __builtin_amdgcn_s_setprio(1); _Pragma("unroll") for (int m = 0; m < 4; ++m) _Pragma("unroll") for (int n = 0; n < 2; ++n) _Pragma("unroll") for (int k = 0; k < 2; ++k) \
        acc[ai][bj][m][n] = __builtin_amdgcn_mfma_f32_16x16x32_bf16(Bt[n][k], At[m][k], acc[ai][bj][m][n], 0, 0, 0); __builtin_amdgcn_s_setprio(0); } while (0)
#define PG8_WAIT_V(n) asm volatile("s_waitcnt vmcnt(" #n ")" ::: "memory")
#define PG8_WAIT_L(n) asm volatile("s_waitcnt lgkmcnt(" #n ")" ::: "memory")
#define PG8_BAR __builtin_amdgcn_s_barrier()
#define PG8_SCHED __builtin_amdgcn_sched_barrier(0)
    Unit cur, nxt; int ui = 0;
    if (!S.next(0, cur)) return;
    f32x4 acc[2][2][4][2];
#pragma unroll
    for (int a = 0; a < 2; ++a)
#pragma unroll
        for (int b = 0; b < 2; ++b)
#pragma unroll
            for (int m = 0; m < 4; ++m)
#pragma unroll
                for (int n = 0; n < 2; ++n) acc[a][b][m][n] = (f32x4){0.f, 0.f, 0.f, 0.f};
    bf16x8 At[4][2], B0[2][2], B1[2][2];
    const char* cA = (const char*)g.A + (size_t)cur.pm * tstep; const char* cB = (const char*)g.Bt + (size_t)cur.pn * tstep;
    S.a_ready(cur);
    if constexpr (SP2) {
        PG8_STAGE(PG8_SB(0, 0), cB, voffB); PG8_STAGE(PG8_SB(0, 1), cB + hstep, voffB); PG8_STAGE(PG8_SA(0, 0), cA, voffA); PG8_STAGE(PG8_SA(0, 1), cA + hstep, voffA);
        if (wr == 1) PG8_BAR;
        PG8_WAIT_V(2); PG8_BAR;
        PG8_STAGE(PG8_SB(1, 0), cB + kstep, voffB); PG8_STAGE(PG8_SA(1, 0), cA + kstep, voffA); PG8_STAGE(PG8_SB(1, 1), cB + hstep + kstep, voffB);
        PG8_WAIT_V(6); PG8_BAR;
    } else {
        PG8_STAGE(PG8_SB(0, 0), cB, voffB); PG8_STAGE(PG8_SA(0, 0), cA, voffA); PG8_STAGE(PG8_SB(0, 1), cB + hstep, voffB); PG8_STAGE(PG8_SA(0, 1), cA + hstep, voffA);
        if (wr == 1) PG8_BAR;
        PG8_WAIT_V(4); PG8_BAR;
        PG8_STAGE(PG8_SB(1, 0), cB + kstep, voffB); PG8_STAGE(PG8_SA(1, 0), cA + kstep, voffA); PG8_STAGE(PG8_SB(1, 1), cB + hstep + kstep, voffB);
        PG8_WAIT_V(6); PG8_BAR;
    }
    for (;;) {
        const bool has_next = S.next(ui + 1, nxt);
        const char* nA = has_next ? (const char*)g.A + (size_t)nxt.pm * tstep : cA; const char* nB = has_next ? (const char*)g.Bt + (size_t)nxt.pn * tstep : cB;
#pragma nounroll
        for (int t = 0; t < nt; t += 2) {
            if constexpr (Epi::HAS_MID) { if (t == E.mid_t) E.mid(acc, cur, wr, wc, fr, fq); }
            const bool last = (t == nt - 2);
            const char* a1 = cA + (size_t)(t + 1) * kstep;
            const char* a2 = last ? nA : cA + (size_t)(t + 2) * kstep; const char* b2 = last ? nB : cB + (size_t)(t + 2) * kstep;
            const char* a3 = a2 + kstep; const char* b3 = b2 + kstep;
            if (last && has_next) S.a_ready(nxt);
            if constexpr (SP2) {
            PG8_LDB(B0, 0, 0); PG8_LDB(B1, 0, 1); PG8_SCHED; PG8_LDA(At, 0, 0); PG8_STAGE(PG8_SA(1, 1), a1 + hstep, voffA);
            PG8_WAIT_V(8); PG8_WAIT_L(0); PG8_BAR; PG8_MMA(0, 0, At, B0); PG8_MMA(0, 1, At, B1); PG8_BAR; PG8_SCHED;
            PG8_LDA(At, 0, 1); PG8_STAGE(PG8_SB(0, 0), b2, voffB); PG8_STAGE(PG8_SB(0, 1), b2 + hstep, voffB); PG8_STAGE(PG8_SA(0, 0), a2, voffA);
            PG8_WAIT_V(8); PG8_WAIT_L(0); PG8_BAR; PG8_MMA(1, 0, At, B0); PG8_MMA(1, 1, At, B1); PG8_BAR; PG8_SCHED;
            PG8_LDB(B0, 1, 0); PG8_LDB(B1, 1, 1); PG8_SCHED; PG8_LDA(At, 1, 0); PG8_STAGE(PG8_SA(0, 1), a2 + hstep, voffA);
            PG8_WAIT_V(8); PG8_WAIT_L(0); PG8_BAR; PG8_MMA(0, 0, At, B0); PG8_MMA(0, 1, At, B1); PG8_BAR; PG8_SCHED;
            PG8_LDA(At, 1, 1); PG8_STAGE(PG8_SB(1, 0), b3, voffB); PG8_STAGE(PG8_SB(1, 1), b3 + hstep, voffB); PG8_STAGE(PG8_SA(1, 0), a3, voffA);
            PG8_WAIT_V(8); PG8_WAIT_L(0); PG8_BAR; PG8_MMA(1, 0, At, B0); PG8_MMA(1, 1, At, B1); PG8_BAR; PG8_SCHED;
            } else {
            PG8_LDB(B0, 0, 0); PG8_SCHED; PG8_LDA(At, 0, 0); PG8_STAGE(PG8_SA(1, 1), a1 + hstep, voffA);
            PG8_WAIT_L(8); PG8_BAR; PG8_WAIT_L(0); PG8_MMA(0, 0, At, B0); PG8_BAR; PG8_SCHED;
            PG8_LDB(B1, 0, 1); PG8_STAGE(PG8_SB(0, 0), b2, voffB);
            PG8_BAR; PG8_WAIT_L(0); PG8_MMA(0, 1, At, B1); PG8_BAR;
            PG8_LDA(At, 0, 1); PG8_STAGE(PG8_SA(0, 0), a2, voffA);
            PG8_BAR; PG8_WAIT_L(0); PG8_MMA(1, 0, At, B0); PG8_BAR; PG8_SCHED;
            PG8_STAGE(PG8_SB(0, 1), b2 + hstep, voffB);
            PG8_WAIT_V(6); PG8_BAR; PG8_MMA(1, 1, At, B1); PG8_BAR;
            PG8_LDB(B0, 1, 0); PG8_SCHED; PG8_LDA(At, 1, 0); PG8_STAGE(PG8_SA(0, 1), a2 + hstep, voffA);
            PG8_WAIT_L(8); PG8_BAR; PG8_WAIT_L(0); PG8_MMA(0, 0, At, B0); PG8_BAR; PG8_SCHED;
            PG8_LDB(B1, 1, 1); PG8_STAGE(PG8_SB(1, 0), b3, voffB);
            PG8_BAR; PG8_WAIT_L(0); PG8_MMA(0, 1, At, B1); PG8_BAR;
            PG8_LDA(At, 1, 1); PG8_STAGE(PG8_SA(1, 0), a3, voffA);
            PG8_BAR; PG8_WAIT_L(0); PG8_MMA(1, 0, At, B0); PG8_BAR; PG8_SCHED;
            PG8_STAGE(PG8_SB(1, 1), b3 + hstep, voffB);
            PG8_WAIT_V(6); PG8_BAR; PG8_MMA(1, 1, At, B1); PG8_BAR;
            }
        }
        if constexpr (ALIGN_EPI) { if (wr == 0) PG8_BAR; }
        if constexpr (!Epi::AFTER_DRAIN) { E(acc, cur, wr, wc, fr, fq); S.done(cur); }
        if (!has_next) break;
#pragma unroll
        for (int a = 0; a < 2; ++a)
#pragma unroll
            for (int b = 0; b < 2; ++b)
#pragma unroll
                for (int m = 0; m < 4; ++m)
#pragma unroll
                    for (int n = 0; n < 2; ++n) acc[a][b][m][n] = (f32x4){0.f, 0.f, 0.f, 0.f};
        cur = nxt; cA = nA; cB = nB; ++ui;
        if constexpr (ALIGN_EPI) { if (wr == 1) PG8_BAR; }
    }
    PG8_WAIT_V(0);
    if constexpr (!ALIGN_EPI) { if (wr == 0) PG8_BAR; }
    PG8_BAR;
    if constexpr (Epi::AFTER_DRAIN) { E.fused(acc, cur, wr, wc, fr, fq, lds, wid, lane); S.done(cur); }
#undef PG8_SA
#undef PG8_SB
#undef PG8_STAGE
#undef PG8_LDA
#undef PG8_LDB
#undef PG8_MMA
#undef PG8_WAIT_V
#undef PG8_WAIT_L
#undef PG8_BAR
#undef PG8_SCHED
}
}
namespace pg8 {
#define EPI_ROWS(ai, m) (u.pm * BM + (ai) * HALF + wr * 64 + (m) * 16 + fr)
#define EPI_OPAQUE int fr = fr_, fq = fq_; asm volatile("" : "+v"(fr), "+v"(fq))
__device__ __forceinline__ u32x4 pack8(f32x4 a, f32x4 b) { u32x4 w; w.x = cvt_pk_bf16(a[0], a[1]); w.y = cvt_pk_bf16(a[2], a[3]); w.z = cvt_pk_bf16(b[0], b[1]); w.w = cvt_pk_bf16(b[2], b[3]); return w; }
__device__ __forceinline__ float sq4(f32x4 a) { return (a[0] * a[0] + a[1] * a[1]) + (a[2] * a[2] + a[3] * a[3]); }
template <int NS> __device__ __forceinline__ float rstd_of(const float* part, int row, float invn) {
    float s = 0.f;
#pragma unroll
    for (int i = 0; i < NS; i += 4) { const f32x4 v = *(const f32x4*)(part + (size_t)row * NS + i); s += (v[0] + v[1]) + (v[2] + v[3]); }
    return 1.0f / sqrtf(s * invn + EPS);
}
template <int NS> __device__ __forceinline__ void ssq_put(float* part, int row, int slot, float s, int fq) { s += __shfl_xor(s, 16); s += __shfl_xor(s, 32); if (fq == 0) part[(size_t)row * NS + slot] = s; }
__device__ __forceinline__ float silu_f(float x) { return x * sigm(x); }
__device__ __forceinline__ int pos_of_row(int row) { return row < MP ? (row & (TSEQ - 1)) : TSEQ; }

struct EpiSwiGLU {
    static constexpr bool PERM = true, AFTER_DRAIN = false, HAS_MID = false; int mid_t;
    bf16_t* O; const float* ssq;
    __device__ __forceinline__ void mid(f32x4 (&)[2][2][4][2], const Unit&, int, int, int, int) const {}
    __device__ __forceinline__ void operator()(const f32x4 (&acc)[2][2][4][2], const Unit& u, int wr, int wc, int fr_, int fq_) const { EPI_OPAQUE;
        const int col0 = u.pn * HALF + wc * 32 + 8 * fq;
#pragma unroll
        for (int ai = 0; ai < 2; ++ai)
#pragma unroll
            for (int m = 0; m < 4; ++m) { const int row = EPI_ROWS(ai, m); const float rs = ssq ? rstd_of<16>(ssq, row, 1.0f / DM) : 1.0f;
                f32x4 o[2];
#pragma unroll
                for (int n = 0; n < 2; ++n)
#pragma unroll
                    for (int j = 0; j < 4; ++j) o[n][j] = silu_f(acc[ai][0][m][n][j] * rs) * (acc[ai][1][m][n][j] * rs);
                *(u32x4*)(O + (size_t)row * DFF + col0) = pack8(o[0], o[1]); }
    }
};

template <bool HALFA> struct EpiResid {
    static constexpr bool PERM = true, AFTER_DRAIN = false, HAS_MID = false; int mid_t; static constexpr float alpha = HALFA ? 0.5f : 1.0f;
    const float* R; const float* Rs; int mode; float* Hf; bf16_t* Hb; float* ssq;
    __device__ __forceinline__ void mid(f32x4 (&)[2][2][4][2], const Unit&, int, int, int, int) const {}
    __device__ __forceinline__ void operator()(const f32x4 (&acc)[2][2][4][2], const Unit& u, int wr, int wc, int fr_, int fq_) const { EPI_OPAQUE;
        const int colb = u.pn * BM + wc * 32 + 8 * fq;
#pragma unroll
        for (int ai = 0; ai < 2; ++ai)
#pragma unroll
            for (int m = 0; m < 4; ++m) { const int row = EPI_ROWS(ai, m);
                const bool pad = (mode == 0) && row >= MP + MS; const float keep = pad ? 0.f : 1.f;
                const float* rp = (mode == 0 && row >= MP) ? (pad ? R : Rs + (size_t)(row - MP) * DM) : R + (size_t)row * DM;
                float s = 0.f;
#pragma unroll
                for (int bj = 0; bj < 2; ++bj) { const int col = colb + bj * HALF;
                    const f32x4 r0 = *(const f32x4*)(rp + col) * keep, r1 = *(const f32x4*)(rp + col + 4) * keep;
                    const f32x4 h0 = r0 + acc[ai][bj][m][0] * alpha, h1 = r1 + acc[ai][bj][m][1] * alpha;
                    *(f32x4*)(Hf + (size_t)row * DM + col) = h0; *(f32x4*)(Hf + (size_t)row * DM + col + 4) = h1;
                    *(u32x4*)(Hb + (size_t)row * DM + col) = pack8(h0, h1);
                    s += sq4(h0) + sq4(h1); }
                ssq_put<16>(ssq, row, u.pn * 4 + wc, s, fq); }
    }
};

__device__ __forceinline__ void rope4(const float2* tabrow, int i0, int istride, f32x4 x1, f32x4 x2, f32x4& y1, f32x4& y2) {
#pragma unroll
    for (int j = 0; j < 4; ++j) { const float2 cs = tabrow[(i0 + j) * istride]; y1[j] = x1[j] * cs.x - x2[j] * cs.y; y2[j] = x1[j] * cs.y + x2[j] * cs.x; }
}

struct EpiWin {
    static constexpr bool PERM = true, AFTER_DRAIN = false, HAS_MID = false; int mid_t;
    const float* ssq1; float* ssq_cq; float* ssq_kv; const float2* rope; float* dout;
    bf16_t *CQB, *CKVB, *KPEB, *QR, *KR, *RV, *RGS, *SGA, *SGR; float* CKVF;
    __device__ __forceinline__ void mid(f32x4 (&)[2][2][4][2], const Unit&, int, int, int, int) const {}
    __device__ __forceinline__ void operator()(const f32x4 (&acc)[2][2][4][2], const Unit& u, int wr, int wc, int fr_, int fq_) const { EPI_OPAQUE;
        const int pn = u.pn, c8 = wc * 32 + 8 * fq;
#pragma unroll
        for (int ai = 0; ai < 2; ++ai)
#pragma unroll
            for (int m = 0; m < 4; ++m) { const int row = EPI_ROWS(ai, m); const float rs = rstd_of<16>(ssq1, row, 1.0f / DM);
                if (pn == 0) {
                    float s = 0.f;
#pragma unroll
                    for (int bj = 0; bj < 2; ++bj) { const f32x4 a = acc[ai][bj][m][0] * rs, b = acc[ai][bj][m][1] * rs; s += sq4(a) + sq4(b);
                        *(u32x4*)(CQB + (size_t)row * QL + bj * HALF + c8) = pack8(a, b); }
                    ssq_put<4>(ssq_cq, row, wc, s, fq);
                } else if (pn == 1) {
                    { const f32x4 a = acc[ai][0][m][0] * rs, b = acc[ai][0][m][1] * rs;
                      *(f32x4*)(CKVF + (size_t)row * KVL + c8) = a; *(f32x4*)(CKVF + (size_t)row * KVL + c8 + 4) = b;
                      *(u32x4*)(CKVB + (size_t)row * KVL + c8) = pack8(a, b);
                      ssq_put<4>(ssq_kv, row, wc, sq4(a) + sq4(b), fq); }
                    if (wc == 0) { f32x4 y1, y2; rope4(rope + (size_t)pos_of_row(row) * 64, 4 * fq, 4, acc[ai][1][m][0] * rs, acc[ai][1][m][1] * rs, y1, y2);
                        float* o = row < MP ? dout + O_KPEP + (size_t)row * RPE : (row < MP + MS ? dout + O_KPES + (size_t)(row - MP) * RPE : nullptr);
                        if (o) { *(f32x4*)(o + 4 * fq) = y1; *(f32x4*)(o + 16 + 4 * fq) = y2; }
                        v2u w1, w2; w1.x = cvt_pk_bf16(y1[0], y1[1]); w1.y = cvt_pk_bf16(y1[2], y1[3]); w2.x = cvt_pk_bf16(y2[0], y2[1]); w2.y = cvt_pk_bf16(y2[2], y2[3]);
                        *(v2u*)(KPEB + (size_t)row * RPE + 4 * fq) = w1; *(v2u*)(KPEB + (size_t)row * RPE + 16 + 4 * fq) = w2; }
                } else if (pn < 6) {
                    const bool isk = pn >= 4; const int ic = row < MP ? (row & 127) : 0; const float2* tr = rope + (size_t)pos_of_row(row) * 64;
#pragma unroll
                    for (int bj = 0; bj < 2; ++bj) { const int hh = 2 * (pn - (isk ? 4 : 2)) + bj; const float lg = lg2gamma(hh) * (float)ic;
                        const float fs = rs * (isk ? __builtin_amdgcn_exp2f(-lg) * 0.08838834764831845f : __builtin_amdgcn_exp2f(lg));
                        f32x4 y1, y2; rope4(tr, 16 * wc + 4 * fq, 1, acc[ai][bj][m][0] * fs, acc[ai][bj][m][1] * fs, y1, y2);
                        bf16_t* o = (isk ? KR : QR) + (size_t)row * 512 + hh * 128 + 16 * wc + 4 * fq;
                        v2u w1, w2; w1.x = cvt_pk_bf16(y1[0], y1[1]); w1.y = cvt_pk_bf16(y1[2], y1[3]); w2.x = cvt_pk_bf16(y2[0], y2[1]); w2.y = cvt_pk_bf16(y2[2], y2[3]);
                        *(v2u*)o = w1; *(v2u*)(o + 64) = w2; }
                } else if (pn < 8) {
#pragma unroll
                    for (int bj = 0; bj < 2; ++bj) *(u32x4*)(RV + (size_t)row * 512 + (pn - 6) * BM + bj * HALF + c8) = pack8(acc[ai][bj][m][0] * rs, acc[ai][bj][m][1] * rs);
                } else if (pn < 10) {
#pragma unroll
                    for (int bj = 0; bj < 2; ++bj) { f32x4 a = acc[ai][bj][m][0] * rs, b = acc[ai][bj][m][1] * rs;
#pragma unroll
                        for (int j = 0; j < 4; ++j) { a[j] = silu_f(a[j]); b[j] = silu_f(b[j]); }
                        *(u32x4*)(RGS + (size_t)row * 512 + (pn - 8) * BM + bj * HALF + c8) = pack8(a, b); }
                } else {
                    bf16_t* base = pn < 14 ? SGA + (size_t)(pn - 10) * BM : SGR + (size_t)(pn - 14) * BM;
#pragma unroll
                    for (int bj = 0; bj < 2; ++bj) { f32x4 a = acc[ai][bj][m][0] * rs, b = acc[ai][bj][m][1] * rs;
#pragma unroll
                        for (int j = 0; j < 4; ++j) { a[j] = sigm(a[j]); b[j] = sigm(b[j]); }
                        *(u32x4*)(base + (size_t)row * DM + bj * HALF + c8) = pack8(a, b); }
                }
            }
    }
};

struct EpiQB {
    static constexpr bool PERM = true, AFTER_DRAIN = false, HAS_MID = false; int mid_t;
    const float* ssq_cq; const float2* rope; bf16_t* QB;
    __device__ __forceinline__ void mid(f32x4 (&)[2][2][4][2], const Unit&, int, int, int, int) const {}
    __device__ __forceinline__ void operator()(const f32x4 (&acc)[2][2][4][2], const Unit& u, int wr, int wc, int fr_, int fq_) const { EPI_OPAQUE;
#pragma unroll
        for (int ai = 0; ai < 2; ++ai)
#pragma unroll
            for (int m = 0; m < 4; ++m) { const int row = EPI_ROWS(ai, m); const float rs = rstd_of<4>(ssq_cq, row, 1.0f / QL);
                bf16_t* qrow = QB + (size_t)row * 768;
                if (u.pn < 2) {
#pragma unroll
                    for (int bj = 0; bj < 2; ++bj) { const int cidx = bj * HALF + wc * 32 + 8 * fq, hh = u.pn * 4 + (cidx >> 6), d = cidx & 63;
                        *(u32x4*)(qrow + hh * QKD + d) = pack8(acc[ai][bj][m][0] * rs, acc[ai][bj][m][1] * rs); }
                } else { const float2* tr = rope + (size_t)pos_of_row(row) * 64;
#pragma unroll
                    for (int bj = 0; bj < 2; ++bj) { const int hh = bj * 4 + wc; f32x4 y1, y2; rope4(tr, 4 * fq, 4, acc[ai][bj][m][0] * rs, acc[ai][bj][m][1] * rs, y1, y2);
                        v2u w1, w2; w1.x = cvt_pk_bf16(y1[0], y1[1]); w1.y = cvt_pk_bf16(y1[2], y1[3]); w2.x = cvt_pk_bf16(y2[0], y2[1]); w2.y = cvt_pk_bf16(y2[2], y2[3]);
                        *(v2u*)(qrow + hh * QKD + 64 + 4 * fq) = w1; *(v2u*)(qrow + hh * QKD + 80 + 4 * fq) = w2; }
                }
                asm volatile("" ::: "memory");
            }
    }
};

struct EpiPlain {
    static constexpr bool PERM = true, AFTER_DRAIN = false, HAS_MID = false; int mid_t;
    bf16_t* O0; bf16_t* O1; int ld; int split_tiles; const float* ssq; float invn;
    __device__ __forceinline__ void mid(f32x4 (&)[2][2][4][2], const Unit&, int, int, int, int) const {}
    __device__ __forceinline__ void operator()(const f32x4 (&acc)[2][2][4][2], const Unit& u, int wr, int wc, int fr_, int fq_) const { EPI_OPAQUE;
        bf16_t* base = u.pn < split_tiles ? O0 + (size_t)u.pn * BM : O1 + (size_t)(u.pn - split_tiles) * BM;
#pragma unroll
        for (int ai = 0; ai < 2; ++ai)
#pragma unroll
            for (int m = 0; m < 4; ++m) { const int row = EPI_ROWS(ai, m); const float rs = ssq ? rstd_of<4>(ssq, row, invn) : 1.0f;
#pragma unroll
                for (int bj = 0; bj < 2; ++bj) *(u32x4*)(base + (size_t)row * ld + bj * HALF + wc * 32 + 8 * fq) = pack8(acc[ai][bj][m][0] * rs, acc[ai][bj][m][1] * rs); }
    }
};

struct EpiMerge {
    static constexpr bool PERM = true, AFTER_DRAIN = false, HAS_MID = true; int mid_t;
    const bf16_t* SGA; const bf16_t* SGR; bf16_t* O;
    __device__ __forceinline__ void mid(f32x4 (&acc)[2][2][4][2], const Unit& u, int wr, int wc, int fr_, int fq) const {
        int fr = fr_; asm volatile("" : "+v"(fr));
#pragma unroll
        for (int ai = 0; ai < 2; ++ai)
#pragma unroll
            for (int m = 0; m < 4; ++m) { const int row = EPI_ROWS(ai, m);
#pragma unroll
                for (int bj = 0; bj < 2; ++bj) { const size_t off = (size_t)row * DM + u.pn * BM + bj * HALF + wc * 32 + 8 * fq;
                    const u32x4 a = *(const u32x4*)(SGA + off), r = *(const u32x4*)(SGR + off);
#pragma unroll
                    for (int q = 0; q < 4; ++q) { const float alo = bflo(a[q]), ahi = bfhi(a[q]), rlo = fmaxf(bflo(r[q]), 1e-30f), rhi = fmaxf(bfhi(r[q]), 1e-30f);
                        acc[ai][bj][m][q >> 1][(q & 1) * 2] *= alo * __builtin_amdgcn_rcpf(rlo); acc[ai][bj][m][q >> 1][(q & 1) * 2 + 1] *= ahi * __builtin_amdgcn_rcpf(rhi); } }
                asm volatile("" ::: "memory"); }
    }
    __device__ __forceinline__ void operator()(const f32x4 (&acc)[2][2][4][2], const Unit& u, int wr, int wc, int fr_, int fq_) const { EPI_OPAQUE;
#pragma unroll
        for (int ai = 0; ai < 2; ++ai)
#pragma unroll
            for (int m = 0; m < 4; ++m) { const int row = EPI_ROWS(ai, m);
#pragma unroll
                for (int bj = 0; bj < 2; ++bj) { const size_t off = (size_t)row * DM + u.pn * BM + bj * HALF + wc * 32 + 8 * fq;
                    const u32x4 r = *(const u32x4*)(SGR + off); f32x4 o0, o1;
                    o0[0] = acc[ai][bj][m][0][0] * fmaxf(bflo(r[0]), 1e-30f); o0[1] = acc[ai][bj][m][0][1] * fmaxf(bfhi(r[0]), 1e-30f);
                    o0[2] = acc[ai][bj][m][0][2] * fmaxf(bflo(r[1]), 1e-30f); o0[3] = acc[ai][bj][m][0][3] * fmaxf(bfhi(r[1]), 1e-30f);
                    o1[0] = acc[ai][bj][m][1][0] * fmaxf(bflo(r[2]), 1e-30f); o1[1] = acc[ai][bj][m][1][1] * fmaxf(bfhi(r[2]), 1e-30f);
                    o1[2] = acc[ai][bj][m][1][2] * fmaxf(bflo(r[3]), 1e-30f); o1[3] = acc[ai][bj][m][1][3] * fmaxf(bfhi(r[3]), 1e-30f);
                    *(u32x4*)(O + off) = pack8(o0, o1); }
                asm volatile("" ::: "memory"); }
    }
};

struct EpiPle {
    static constexpr bool PERM = true, AFTER_DRAIN = false, HAS_MID = false; int mid_t;
    const float* H3; const bf16_t* PP; const float* ssq3; float* H4; float* ssq4;
    __device__ __forceinline__ void mid(f32x4 (&)[2][2][4][2], const Unit&, int, int, int, int) const {}
    __device__ __forceinline__ void operator()(const f32x4 (&acc)[2][2][4][2], const Unit& u, int wr, int wc, int fr_, int fq_) const { EPI_OPAQUE;
#pragma unroll
        for (int ai = 0; ai < 2; ++ai)
#pragma unroll
            for (int m = 0; m < 4; ++m) { const int row = EPI_ROWS(ai, m); const float rs = rstd_of<16>(ssq3, row, 1.0f / DM); float s = 0.f;
#pragma unroll
                for (int bj = 0; bj < 2; ++bj) { const size_t off = (size_t)row * DM + u.pn * BM + bj * HALF + wc * 32 + 8 * fq;
                    const u32x4 p = *(const u32x4*)(PP + off); const f32x4 r0 = *(const f32x4*)(H3 + off), r1 = *(const f32x4*)(H3 + off + 4);
                    f32x4 h0, h1;
                    h0[0] = r0[0] + sigm(acc[ai][bj][m][0][0] * rs) * bflo(p[0]); h0[1] = r0[1] + sigm(acc[ai][bj][m][0][1] * rs) * bfhi(p[0]);
                    h0[2] = r0[2] + sigm(acc[ai][bj][m][0][2] * rs) * bflo(p[1]); h0[3] = r0[3] + sigm(acc[ai][bj][m][0][3] * rs) * bfhi(p[1]);
                    h1[0] = r1[0] + sigm(acc[ai][bj][m][1][0] * rs) * bflo(p[2]); h1[1] = r1[1] + sigm(acc[ai][bj][m][1][1] * rs) * bfhi(p[2]);
                    h1[2] = r1[2] + sigm(acc[ai][bj][m][1][2] * rs) * bflo(p[3]); h1[3] = r1[3] + sigm(acc[ai][bj][m][1][3] * rs) * bfhi(p[3]);
                    *(f32x4*)(H4 + off) = h0; *(f32x4*)(H4 + off + 4) = h1; s += sq4(h0) + sq4(h1); }
                ssq_put<16>(ssq4, row, u.pn * 4 + wc, s, fq); }
    }
};
#undef EPI_ROWS
#undef EPI_OPAQUE
}
namespace att {
using bf16x8 = __attribute__((ext_vector_type(8))) short;
using s16x4 = __attribute__((ext_vector_type(4))) short;
using f32x16 = __attribute__((ext_vector_type(16))) float;
using u32x4 = __attribute__((ext_vector_type(4))) unsigned;
typedef __attribute__((address_space(3))) const char* lds_cptr;
typedef __attribute__((address_space(3))) char* lds_ptr;
constexpr int KSLOT = 12288, VSLOT = 8192;
constexpr int L_K = 0, L_V = 2 * KSLOT, L_WS = L_V + 2 * VSLOT, L_OST = L_WS + 8 * 256, L_END = L_OST + 8 * 4096;
static_assert(L_END <= RING_BYTES, "attention LDS");
__device__ __forceinline__ int crow(int r, int hi) { return (r & 3) + 8 * (r >> 2) + 4 * hi; }
__device__ __forceinline__ void glds16(const void* gsrc, unsigned lds_dst) { unsigned keep;
    asm volatile("s_mov_b32 %0, m0\n\ts_mov_b32 m0, %2\n\ts_nop 0\n\tglobal_load_lds_dwordx4 %1, off\n\ts_mov_b32 m0, %0" : "=&s"(keep) : "v"(gsrc), "s"(lds_dst) : "memory"); }
typedef float f32x2_t __attribute__((ext_vector_type(2))); typedef __bf16 bf16x2_t __attribute__((ext_vector_type(2)));
__device__ __forceinline__ unsigned cvtpk_s(float lo, float hi) { f32x2_t v = {lo, hi}; bf16x2_t b = __builtin_convertvector(v, bf16x2_t); return __builtin_bit_cast(unsigned, b); }
__device__ __forceinline__ float swap32_max(float m) { auto rr = __builtin_amdgcn_permlane32_swap(__float_as_uint(m), __float_as_uint(m), false, false); return fmaxf(__uint_as_float(rr[0]), __uint_as_float(rr[1])); }
__device__ __forceinline__ float swap32_sum(float m) { auto rr = __builtin_amdgcn_permlane32_swap(__float_as_uint(m), __float_as_uint(m), false, false); return __uint_as_float(rr[0]) + __uint_as_float(rr[1]); }

__device__ __forceinline__ void pv(f32x16* o, int vb, bf16x8 pa0, bf16x8 pa1, bf16x8 pa2, bf16x8 pa3) {
#pragma unroll
    for (int d0 = 0; d0 < 2; ++d0) { s16x4 lo[4], hi[4];
#pragma unroll
        for (int ks = 0; ks < 4; ++ks) {
            asm volatile("ds_read_b64_tr_b16 %0,%1 offset:%c2" : "=&v"(lo[ks]) : "v"(vb), "i"(d0 * 4096 + ks * 1024) : "memory");
            asm volatile("ds_read_b64_tr_b16 %0,%1 offset:%c2" : "=&v"(hi[ks]) : "v"(vb), "i"(d0 * 4096 + ks * 1024 + 512) : "memory"); }
        asm volatile("s_waitcnt lgkmcnt(0)" ::: "memory"); __builtin_amdgcn_sched_barrier(0);
#define PK(k) (bf16x8){lo[k][0], lo[k][1], lo[k][2], lo[k][3], hi[k][0], hi[k][1], hi[k][2], hi[k][3]}
        o[d0] = __builtin_amdgcn_mfma_f32_32x32x16_bf16(pa0, PK(0), o[d0], 0, 0, 0);
        o[d0] = __builtin_amdgcn_mfma_f32_32x32x16_bf16(pa1, PK(1), o[d0], 0, 0, 0);
        o[d0] = __builtin_amdgcn_mfma_f32_32x32x16_bf16(pa2, PK(2), o[d0], 0, 0, 0);
        o[d0] = __builtin_amdgcn_mfma_f32_32x32x16_bf16(pa3, PK(3), o[d0], 0, 0, 0);
#undef PK
    }
}

__device__ __forceinline__ void attn_unit(int b, int h, int qb, const bf16* Q, const bf16* KN, const bf16* KPE, const bf16* VB, bf16* O, char* shm) {
    int tid_ = threadIdx.x; asm volatile("" : "+v"(tid_)); const int tid = tid_, lane = tid & 63, r32 = lane & 31, hi = lane >> 5; const int wid = __builtin_amdgcn_readfirstlane(tid >> 6);
    const long rowbase = (long)b * TSEQ; const int q0 = qb * 256;
    const bf16* Qw = Q + (rowbase + q0 + wid * 32) * 768 + h * QKD;
    const unsigned lds0 = (unsigned)(uintptr_t)shm;
    const lds_ptr shm3 = (lds_ptr)shm;
    LAS float* wsf = (LAS float*)(shm3 + L_WS) + wid * 64;
    const bf16* ksrc0 = KN + (rowbase + lane) * 512 + h * 64 + wid * 8;
    const bf16* ksrc1 = KPE + (rowbase + lane) * RPE + (wid & 3) * 8;
    const bf16* vsrc = VB + (rowbase + 16 * (wid & 3) + (lane >> 2)) * 512 + h * 64 + (wid >> 2) * 32 + (lane & 3) * 8;
    const unsigned kdst0 = lds0 + L_K + wid * 1024, kdst1 = lds0 + L_K + (8 + (wid & 3)) * 1024, vdst = lds0 + L_V + wid * 1024;
#define ATT_DMA(t, s) do { glds16(ksrc0 + (long)(t) * 64 * 512, (unsigned)__builtin_amdgcn_readfirstlane(kdst0 + (s) * KSLOT)); \
                           glds16(ksrc1 + (long)(t) * 64 * RPE, (unsigned)__builtin_amdgcn_readfirstlane(kdst1 + (s) * KSLOT)); \
                           glds16(vsrc + (long)(t) * 64 * 512, (unsigned)__builtin_amdgcn_readfirstlane(vdst + (s) * VSLOT)); } while (0)
    const int vb0 = (int)(lds0 + L_V) + ((lane >> 4) & 1) * 32 + (lane & 3) * 8 + (4 * hi + ((lane & 15) >> 2)) * 64;
    const lds_cptr kp0 = (lds_cptr)shm3 + L_K + hi * 1024 + r32 * 16;
    const int NT = (q0 + 256) / 64;
    ATT_DMA(0, 0);
    bf16x8 qr[6];
#pragma unroll
    for (int d0 = 0; d0 < 6; ++d0) qr[d0] = *reinterpret_cast<const bf16x8*>(&Qw[(long)r32 * 768 + d0 * 16 + hi * 8]);
    float m_run = -INFINITY, l_run = 0.f; f32x16 o[2]; o[0] = f32x16{}; o[1] = f32x16{};
    const int qrel = wid * 32 + r32;
    for (int t = 0; t < NT; ++t) {
        asm volatile("s_waitcnt vmcnt(0) lgkmcnt(0)\n\ts_barrier" ::: "memory");
        if (t + 1 < NT) ATT_DMA(t + 1, (t + 1) & 1);
        const int jb = t - (NT - 4);
        if (jb < 0 || 2 * jb <= wid) {
            const lds_cptr kp = kp0 + (t & 1) * KSLOT;
            f32x16 p0 = f32x16{}, p1 = f32x16{};
#pragma unroll
            for (int d0 = 0; d0 < 6; ++d0) {
                const bf16x8 k0 = *(const __attribute__((address_space(3))) bf16x8*)(kp + d0 * 2048);
                const bf16x8 k1 = *(const __attribute__((address_space(3))) bf16x8*)(kp + d0 * 2048 + 512);
                p0 = __builtin_amdgcn_mfma_f32_32x32x16_bf16(k0, qr[d0], p0, 0, 0, 0);
                p1 = __builtin_amdgcn_mfma_f32_32x32x16_bf16(k1, qr[d0], p1, 0, 0, 0); }
            if (jb >= 0) { const int kb = 64 * jb + 4 * hi;
#pragma unroll
                for (int r = 0; r < 16; ++r) { const int kv = kb + (r & 3) + 8 * (r >> 2); if (kv > qrel) p0[r] = -INFINITY; if (kv + 32 > qrel) p1[r] = -INFINITY; } }
            float rm = fmaxf(p0[0], p1[0]);
#pragma unroll
            for (int r = 1; r < 16; ++r) rm = fmaxf(rm, fmaxf(p0[r], p1[r]));
            rm = swap32_max(rm);
            const float mnew = fmaxf(m_run, rm);
            if (__any(mnew > m_run)) {
                const float alpha = __builtin_amdgcn_exp2f(m_run - mnew);
                l_run *= alpha; m_run = mnew;
                if (hi == 0) wsf[r32] = alpha;
                asm volatile("s_waitcnt lgkmcnt(0)" ::: "memory");
#pragma unroll
                for (int r = 0; r < 16; ++r) { const float a = wsf[crow(r, hi)]; o[0][r] *= a; o[1][r] *= a; }
            }
            float sacc = 0.f;
#pragma unroll
            for (int r = 0; r < 16; ++r) { p0[r] = __builtin_amdgcn_exp2f(p0[r] - m_run); p1[r] = __builtin_amdgcn_exp2f(p1[r] - m_run); sacc += p0[r] + p1[r]; }
            l_run += sacc;
            u32x4 pw0, pw1, pw2, pw3;
#define PKW(P, B) cvtpk_s(P[B], P[B + 1])
            pw0 = (u32x4){PKW(p0, 0), PKW(p0, 2), PKW(p0, 4), PKW(p0, 6)}; pw1 = (u32x4){PKW(p0, 8), PKW(p0, 10), PKW(p0, 12), PKW(p0, 14)};
            pw2 = (u32x4){PKW(p1, 0), PKW(p1, 2), PKW(p1, 4), PKW(p1, 6)}; pw3 = (u32x4){PKW(p1, 8), PKW(p1, 10), PKW(p1, 12), PKW(p1, 14)};
#undef PKW
            pv(o, vb0 + (t & 1) * VSLOT, __builtin_bit_cast(bf16x8, pw0), __builtin_bit_cast(bf16x8, pw1), __builtin_bit_cast(bf16x8, pw2), __builtin_bit_cast(bf16x8, pw3));
        }
    }
    l_run = swap32_sum(l_run);
    if (hi == 0) wsf[32 + r32] = l_run;
    asm volatile("s_waitcnt lgkmcnt(0)" ::: "memory");
    float rli[16];
#pragma unroll
    for (int r = 0; r < 16; ++r) rli[r] = 1.0f / wsf[32 + crow(r, hi)];
    bf16* Ow = O + (rowbase + q0 + wid * 32) * DM + h * 64;
    { LAS bf16* stg = (LAS bf16*)(shm3 + L_OST) + wid * 2048;
#pragma unroll
      for (int r = 0; r < 16; ++r) { const int orow = crow(r, hi);
#pragma unroll
          for (int d0 = 0; d0 < 2; ++d0) stg[orow * 64 + d0 * 32 + r32] = (bf16)f2bf(o[d0][r] * rli[r]); }
      asm volatile("s_waitcnt lgkmcnt(0)" ::: "memory");
#pragma unroll
      for (int i = 0; i < 4; ++i) { const int row = i * 8 + (lane >> 3), ch = lane & 7; const u32x4 v = *(const LAS u32x4*)(stg + row * 64 + ch * 8); *(u32x4*)(Ow + (long)row * DM + ch * 8) = v; } }
    asm volatile("s_waitcnt vmcnt(0) lgkmcnt(0)\n\ts_barrier" ::: "memory");
#undef ATT_DMA
}
}
namespace ret {
using bf16x8 = __attribute__((ext_vector_type(8))) short;
using s16x4 = __attribute__((ext_vector_type(4))) short;
using f32x16 = __attribute__((ext_vector_type(16))) float;
typedef short v4i16_t __attribute__((ext_vector_type(4)));
constexpr int TPB = 288, TB = 128 * TPB;
constexpr int OTP = 132;
static_assert(3 * TB <= RING_BYTES && 128 * OTP * 4 <= 2 * TB, "retention LDS");
__device__ __forceinline__ int crow(int r, int hi) { return (r & 3) + 8 * (r >> 2) + 4 * hi; }
__device__ __forceinline__ void stage_tile(LAS unsigned char* tile, const bf16* src, int pitch, int tid) {
#pragma unroll
    for (int i = 0; i < 4; ++i) { const int idx = tid + 512 * i, row = idx >> 4, ch = idx & 15;
        *(LAS v4u*)(tile + row * TPB + ch * 16) = *(const v4u*)(src + (size_t)row * pitch + ch * 8); }
}
__device__ __forceinline__ bf16x8 rowfrag(const LAS unsigned char* tile, int row0, int k0, int r32, int hi) { return *(const LAS bf16x8*)(tile + (row0 + r32) * TPB + (k0 + 8 * hi) * 2); }
__device__ __forceinline__ bf16x8 trfrag(const LAS unsigned char* tile, int k0, int c0, int lane) {
    const int h = lane >> 5, blk = (lane >> 4) & 1, q = (lane & 15) >> 2, p = lane & 3;
    const LAS unsigned char* a = tile + (k0 + 8 * h + q) * TPB + (c0 + 16 * blk + 4 * p) * 2;
    const s16x4 lo = __builtin_bit_cast(s16x4, __builtin_amdgcn_ds_read_tr16_b64_v4i16((LAS v4i16_t*)a));
    const s16x4 hi4 = __builtin_bit_cast(s16x4, __builtin_amdgcn_ds_read_tr16_b64_v4i16((LAS v4i16_t*)(a + 4 * TPB)));
    return (bf16x8){lo[0], lo[1], lo[2], lo[3], hi4[0], hi4[1], hi4[2], hi4[3]};
}

__device__ __forceinline__ void kv_unit(int u, const bf16* KR, const bf16* RV, float* KVC, LAS unsigned char* lds) {
    int tid_ = threadIdx.x; asm volatile("" : "+v"(tid_)); const int tid = tid_, lane = tid & 63, r32 = lane & 31, hi = lane >> 5, wid = __builtin_amdgcn_readfirstlane(tid >> 6), wi = wid >> 1, wj = wid & 1;
    const int bh = u >> 6, c = u & 63, b = bh >> 2, h = bh & 3; const size_t row0 = (size_t)b * TSEQ + c * 128;
    LAS unsigned char* T0 = lds; LAS unsigned char* T1 = lds + TB;
    stage_tile(T0, KR + row0 * 512 + h * 128, 512, tid); stage_tile(T1, RV + row0 * 512 + h * 128, 512, tid);
    __syncthreads();
    f32x16 acc[2]; acc[0] = f32x16{}; acc[1] = f32x16{};
#pragma unroll
    for (int ks = 0; ks < 8; ++ks) { const bf16x8 A = trfrag(T0, 16 * ks, 32 * wi, lane);
#pragma unroll
        for (int n = 0; n < 2; ++n) acc[n] = __builtin_amdgcn_mfma_f32_32x32x16_bf16(A, trfrag(T1, 16 * ks, 64 * wj + 32 * n, lane), acc[n], 0, 0, 0); }
    const float g127 = __builtin_amdgcn_exp2f(127.0f * lg2gamma(h));
    float* out = KVC + (size_t)u * 16384;
#pragma unroll
    for (int n = 0; n < 2; ++n)
#pragma unroll
        for (int r = 0; r < 16; ++r) out[(32 * wi + crow(r, hi)) * 128 + 64 * wj + 32 * n + r32] = acc[n][r] * g127;
    __syncthreads();
}

__device__ __forceinline__ void scan_items(int gtid, int gthreads, const float* KVC, bf16* SC, float* dout) {
    for (int e = gtid; e < 8 * 16384; e += gthreads) { const int bh = e >> 14, el = e & 16383; const float g128 = __builtin_amdgcn_exp2f(128.0f * lg2gamma(bh & 3));
        float s = 0.f;
        for (int c0 = 0; c0 < 64; c0 += 8) { float kv[8];
#pragma unroll
            for (int i = 0; i < 8; ++i) kv[i] = KVC[(size_t)(bh * 64 + c0 + i) * 16384 + el];
#pragma unroll
            for (int i = 0; i < 8; ++i) { SC[(size_t)(bh * 64 + c0 + i) * 16384 + el] = (bf16)f2bf(s); s = g128 * s + kv[i]; } }
        dout[O_RETP + e] = s; }
}

__device__ __forceinline__ void out_unit(int u, const bf16* QR, const bf16* KR, const bf16* RV, const bf16* SC, const bf16* RGS, const float* gnorm, bf16* OCAT, LAS unsigned char* lds) {
    int tid_ = threadIdx.x; asm volatile("" : "+v"(tid_)); const int tid = tid_, lane = tid & 63, r32 = lane & 31, hi = lane >> 5, wid = __builtin_amdgcn_readfirstlane(tid >> 6), wi = wid >> 1, wj = wid & 1;
    const int bh = u >> 6, c = u & 63, b = bh >> 2, h = bh & 3; const size_t row0 = (size_t)b * TSEQ + c * 128;
    LAS unsigned char* T0 = lds; LAS unsigned char* T1 = lds + TB; LAS unsigned char* T2 = lds + 2 * TB;
    stage_tile(T0, QR + row0 * 512 + h * 128, 512, tid); stage_tile(T1, KR + row0 * 512 + h * 128, 512, tid); stage_tile(T2, RV + row0 * 512 + h * 128, 512, tid);
    __syncthreads();
    f32x16 sr[2];
#pragma unroll
    for (int n = 0; n < 2; ++n) { const int jb = 2 * wj + n; sr[n] = f32x16{};
        if (jb <= wi) {
#pragma unroll
            for (int ks = 0; ks < 8; ++ks) sr[n] = __builtin_amdgcn_mfma_f32_32x32x16_bf16(rowfrag(T1, 32 * jb, 16 * ks, r32, hi), rowfrag(T0, 32 * wi, 16 * ks, r32, hi), sr[n], 0, 0, 0);
            if (jb == wi) {
#pragma unroll
                for (int r = 0; r < 16; ++r) if (crow(r, hi) > r32) sr[n][r] = 0.f; } } }
    __syncthreads();
#pragma unroll
    for (int n = 0; n < 2; ++n) { const int jb = 2 * wj + n;
        if (jb <= wi) {
#pragma unroll
            for (int r4 = 0; r4 < 4; ++r4) { v2u w; w.x = pg8::cvt_pk_bf16(sr[n][4 * r4], sr[n][4 * r4 + 1]); w.y = pg8::cvt_pk_bf16(sr[n][4 * r4 + 2], sr[n][4 * r4 + 3]);
                *(LAS v2u*)(T1 + (32 * wi + r32) * TPB + (32 * jb + 8 * r4 + 4 * hi) * 2) = w; } } }
    __syncthreads();
    f32x16 o1[2]; o1[0] = f32x16{}; o1[1] = f32x16{};
    for (int ks = 0; ks < 2 * (wi + 1); ++ks) { const bf16x8 A = rowfrag(T1, 32 * wi, 16 * ks, r32, hi);
#pragma unroll
        for (int n = 0; n < 2; ++n) o1[n] = __builtin_amdgcn_mfma_f32_32x32x16_bf16(A, trfrag(T2, 16 * ks, 64 * wj + 32 * n, lane), o1[n], 0, 0, 0); }
    __syncthreads();
    stage_tile(T2, SC + (size_t)u * 16384, 128, tid);
    __syncthreads();
    f32x16 o2[2]; o2[0] = f32x16{}; o2[1] = f32x16{};
#pragma unroll
    for (int ks = 0; ks < 8; ++ks) { const bf16x8 A = rowfrag(T0, 32 * wi, 16 * ks, r32, hi);
#pragma unroll
        for (int n = 0; n < 2; ++n) o2[n] = __builtin_amdgcn_mfma_f32_32x32x16_bf16(A, trfrag(T2, 16 * ks, 64 * wj + 32 * n, lane), o2[n], 0, 0, 0); }
    __syncthreads();
    const float gam = __builtin_amdgcn_exp2f(lg2gamma(h));
    LAS float* OT = (LAS float*)lds;
#pragma unroll
    for (int n = 0; n < 2; ++n)
#pragma unroll
        for (int r = 0; r < 16; ++r) OT[(32 * wi + crow(r, hi)) * OTP + 64 * wj + 32 * n + r32] = o1[n][r] + gam * o2[n][r];
    __syncthreads();
    { const int row = tid >> 2, part = tid & 3; const LAS float* orow = OT + row * OTP + part * 32; float v[32]; float s = 0.f;
#pragma unroll
      for (int k = 0; k < 32; ++k) { v[k] = orow[k]; s += v[k]; }
      s += __shfl_xor(s, 1); s += __shfl_xor(s, 2); const float mu = s * (1.0f / 128.0f); float q = 0.f;
#pragma unroll
      for (int k = 0; k < 32; ++k) { v[k] -= mu; q += v[k] * v[k]; }
      q += __shfl_xor(q, 1); q += __shfl_xor(q, 2); const float rstd = 1.0f / sqrtf(q * (1.0f / 128.0f) + EPS);
      const bf16* rg = RGS + (row0 + row) * 512 + h * 128 + part * 32; const float* gn = gnorm + h * 128 + part * 32; bf16* dst = OCAT + (row0 + row) * DM + 512 + h * 128 + part * 32;
#pragma unroll
      for (int k8 = 0; k8 < 4; ++k8) { const v4u g = *(const v4u*)(rg + 8 * k8); v4u w;
#pragma unroll
          for (int j = 0; j < 4; ++j) { const int k = 8 * k8 + 2 * j; w[j] = pk2(v[k] * rstd * gn[k] * bflo(g[j]), v[k + 1] * rstd * gn[k + 1] * bfhi(g[j])); }
          *(v4u*)(dst + 8 * k8) = w; } }
    __syncthreads();
}

__device__ __forceinline__ void sample_unit(int u, const bf16* QR, const bf16* KR, const bf16* RV, const bf16* RGS, const float* gnorm, const float* state, float* dout, bf16* OCAT, LAS unsigned char* lds) {
    int tid_ = threadIdx.x; asm volatile("" : "+v"(tid_)); const int tid = tid_, s = u >> 2, h = u & 3; const size_t row = (size_t)MP + s;
    LAS float* qf = (LAS float*)lds; LAS float* kf = qf + 128; LAS float* vf = kf + 128; LAS float* red = vf + 128; LAS float* ob = red + 512;
    if (tid < 128) { qf[tid] = bf2f(QR[row * 512 + h * 128 + tid]); kf[tid] = bf2f(KR[row * 512 + h * 128 + tid]); vf[tid] = bf2f(RV[row * 512 + h * 128 + tid]); }
    __syncthreads();
    const int dv = tid & 127, g = tid >> 7; const float gam = __builtin_amdgcn_exp2f(lg2gamma(h)); const float vv = vf[dv];
    const float* S0 = state + (size_t)u * 16384; float* Sn = dout + O_RETS + (size_t)u * 16384; float acc = 0.f;
#pragma unroll 8
    for (int i = 0; i < 32; ++i) { const int dk = 32 * g + i; const float s0 = S0[dk * 128 + dv]; acc += qf[dk] * s0; Sn[dk * 128 + dv] = gam * s0 + kf[dk] * vv; }
    red[tid] = acc;
    __syncthreads();
    if (tid < 128) { float qk = 0.f;
        for (int d = 0; d < 128; ++d) qk += qf[d] * kf[d];
        ob[tid] = qk * vv + gam * ((red[tid] + red[128 + tid]) + (red[256 + tid] + red[384 + tid])); }
    __syncthreads();
    if (tid < 128) { float sm = 0.f;
        for (int d = 0; d < 128; ++d) sm += ob[d];
        const float mu = sm * (1.0f / 128.0f); float q = 0.f;
        for (int d = 0; d < 128; ++d) { const float t = ob[d] - mu; q += t * t; }
        const float rstd = 1.0f / sqrtf(q * (1.0f / 128.0f) + EPS);
        OCAT[row * DM + 512 + h * 128 + tid] = (bf16)f2bf((ob[tid] - mu) * rstd * gnorm[h * 128 + tid] * bf2f(RGS[row * 512 + h * 128 + tid])); }
    __syncthreads();
}
}
namespace dec {
using bf16x2 = __attribute__((ext_vector_type(2))) __bf16;
using u32x4 = __attribute__((ext_vector_type(4))) unsigned;
using f32x4 = __attribute__((ext_vector_type(4))) float;
using f32x2 = __attribute__((ext_vector_type(2))) float;
constexpr int NSPLIT = 8, PPS = NPAGES / NSPLIT;
constexpr int HPL = 2, GE = 8;
constexpr int L_QL = 0, L_P = 8 * 128, L_MRG = L_P + 8 * 64 * HPL, MRG_REC = 4 + 128, L_END = L_MRG + 8 * GE * MRG_REC;
static_assert(L_END * 4 <= RING_BYTES, "decode LDS");
__device__ __forceinline__ float dot2(unsigned k, unsigned q, float acc) { return __builtin_amdgcn_fdot2_f32_bf16(__builtin_bit_cast(bf16x2, k), __builtin_bit_cast(bf16x2, q), acc, false); }
__device__ __forceinline__ unsigned cvtpk(float lo, float hi) { return pg8::cvt_pk_bf16(lo, hi); }
template <int CTRL> __device__ __forceinline__ float dpp(float x) { return __builtin_bit_cast(float, __builtin_amdgcn_mov_dpp(__builtin_bit_cast(int, x), CTRL, 0xf, 0xf, true)); }
constexpr int XOR1 = 0xB1, XOR2 = 0x4E, XOR7 = 0x141, XOR8 = 0x128, ROR4 = 0x124;
__device__ __forceinline__ float xrow16_max(float x) {
    auto s = __builtin_amdgcn_permlane16_swap(__float_as_uint(x), __float_as_uint(x), false, false); x = fmaxf(__uint_as_float(s[0]), __uint_as_float(s[1]));
    auto t = __builtin_amdgcn_permlane32_swap(__float_as_uint(x), __float_as_uint(x), false, false); return fmaxf(__uint_as_float(t[0]), __uint_as_float(t[1])); }
__device__ __forceinline__ float xrow16_sum(float x) {
    auto s = __builtin_amdgcn_permlane16_swap(__float_as_uint(x), __float_as_uint(x), false, false); x = __uint_as_float(s[0]) + __uint_as_float(s[1]);
    auto t = __builtin_amdgcn_permlane32_swap(__float_as_uint(x), __float_as_uint(x), false, false); return __uint_as_float(t[0]) + __uint_as_float(t[1]); }

__device__ __forceinline__ void qlat_token(int s, const bf16* QB, const float* wkvb, LAS float* QLs, float* QLATg, bool store) {
    int tid_ = threadIdx.x; asm volatile("" : "+v"(tid_)); const int tid = tid_, lane = tid & 63, h = __builtin_amdgcn_readfirstlane(tid >> 6);
    const bf16* q = QB + (size_t)(MP + s) * 768 + h * QKD;
#pragma unroll
    for (int cc = 0; cc < 2; ++cc) { const int c = lane + 64 * cc; const float* w = wkvb + (size_t)c * 1024 + h * 128; float a = 0.f;
#pragma unroll 4
        for (int d = 0; d < 64; d += 4) { const f32x4 wv = *(const f32x4*)(w + d); a += bf2f(q[d]) * wv[0] + bf2f(q[d + 1]) * wv[1] + bf2f(q[d + 2]) * wv[2] + bf2f(q[d + 3]) * wv[3]; }
        QLs[h * 128 + c] = a; if (store) QLATg[(size_t)s * 1024 + h * 128 + c] = a; }
}

__device__ __forceinline__ void split_unit(int s, int sp, const bf16* QB, const float* cache_ckv, const float* cache_kpe, const int* page_table, float* DPO, float* DML, LAS float* lds) {
    int tid_ = threadIdx.x; asm volatile("" : "+v"(tid_)); const int tid = tid_, lane = tid & 63, wave = __builtin_amdgcn_readfirstlane(tid >> 6), r = lane >> 4, c = lane & 15;
    const LAS float* QL = lds + L_QL;
    u32x4 qpk[GE]; unsigned qpe[GE];
#pragma unroll
    for (int g = 0; g < GE; ++g) { const LAS float* ql = QL + g * 128 + 8 * c; qpk[g] = (u32x4){cvtpk(ql[0], ql[1]), cvtpk(ql[2], ql[3]), cvtpk(ql[4], ql[5]), cvtpk(ql[6], ql[7])};
        qpe[g] = *(const unsigned*)(QB + (size_t)(MP + s) * 768 + g * QKD + 64 + 2 * c); }
    float m[HPL], l[HPL], acc[GE * 8];
#pragma unroll
    for (int j = 0; j < HPL; ++j) { m[j] = -INFINITY; l[j] = 0.f; }
#pragma unroll
    for (int k = 0; k < GE * 8; ++k) acc[k] = 0.f;
    const int ph0 = page_table[s * NPAGES + PPS * sp + wave], ph1 = page_table[s * NPAGES + PPS * sp + wave + 8];
    f32x4 Kn[4][2]; f32x2 Pn[4];
#define DEC_ISSUE(i_) do { const int ph_ = ((i_) >> 3) ? ph1 : ph0; const size_t tok_ = (size_t)ph_ * PAGE + 16 * ((i_) & 7) + r; \
        _Pragma("unroll") for (int t_ = 0; t_ < 4; ++t_) { const float* kp_ = cache_ckv + (tok_ + 4 * t_) * KVL + 8 * c; \
            Kn[t_][0] = __builtin_nontemporal_load((const f32x4*)kp_); Kn[t_][1] = __builtin_nontemporal_load((const f32x4*)(kp_ + 4)); \
            Pn[t_] = __builtin_nontemporal_load((const f32x2*)(cache_kpe + (tok_ + 4 * t_) * RPE + 2 * c)); } } while (0)
    DEC_ISSUE(0);
#pragma nounroll
    for (int i = 0; i < 16; ++i) {
        u32x4 Kc[4]; unsigned Pc[4];
#pragma unroll
        for (int t = 0; t < 4; ++t) {
            Kc[t] = (u32x4){cvtpk(Kn[t][0][0], Kn[t][0][1]), cvtpk(Kn[t][0][2], Kn[t][0][3]), cvtpk(Kn[t][1][0], Kn[t][1][1]), cvtpk(Kn[t][1][2], Kn[t][1][3])}; Pc[t] = cvtpk(Pn[t][0], Pn[t][1]); }
        if (i + 1 < 16) DEC_ISSUE(i + 1);
        float x[4 * GE];
#pragma unroll
        for (int t = 0; t < 4; ++t)
#pragma unroll
            for (int g = 0; g < GE; ++g) { float d = dot2(Pc[t], qpe[g], 0.f);
#pragma unroll
                for (int k = 0; k < 4; ++k) d = dot2(Kc[t][k], qpk[g][k], d);
                x[t * GE + g] = d; }
#define TR_STEP(HALF, CTRL, BIT) _Pragma("unroll") for (int h = 0; h < (HALF); ++h) _Pragma("unroll") for (int j = 0; j < HPL; ++j) { \
        const float lo_ = x[h * HPL + j], hi_ = x[(h + (HALF)) * HPL + j]; const float t1_ = lo_ + dpp<CTRL>(lo_), t2_ = hi_ + dpp<CTRL>(hi_); \
        x[h * HPL + j] = (c & (BIT)) ? t2_ : t1_; }
        TR_STEP(8, XOR8, 8) TR_STEP(4, XOR7, 4) TR_STEP(2, XOR2, 2) TR_STEP(1, XOR1, 1)
#undef TR_STEP
        float p[HPL], alpha[HPL];
#pragma unroll
        for (int j = 0; j < HPL; ++j) { const float sc = x[j];
            float pm = sc; pm = fmaxf(pm, dpp<ROR4>(pm)); pm = fmaxf(pm, dpp<XOR8>(pm)); pm = xrow16_max(pm);
            const float mn = fmaxf(m[j], pm);
            alpha[j] = __builtin_amdgcn_exp2f(m[j] - mn); p[j] = __builtin_amdgcn_exp2f(sc - mn);
            l[j] = fmaf(l[j], alpha[j], p[j]); m[j] = mn; }
#pragma unroll
        for (int q4 = 0; q4 < 4; ++q4)
#pragma unroll
            for (int j = 0; j < HPL; ++j) { const float al = q4 == 0 ? dpp<0x00>(alpha[j]) : q4 == 1 ? dpp<0x55>(alpha[j]) : q4 == 2 ? dpp<0xAA>(alpha[j]) : dpp<0xFF>(alpha[j]);
#pragma unroll
                for (int k = 0; k < 8; ++k) acc[(q4 * HPL + j) * 8 + k] *= al; }
        LAS float* prow = lds + L_P + (wave * 4 + r) * 16 * HPL;
#pragma unroll
        for (int j = 0; j < HPL; ++j) prow[c * HPL + j] = p[j];
        asm volatile("s_waitcnt lgkmcnt(0)" ::: "memory");
#pragma unroll
        for (int t = 0; t < 4; ++t) { float vf[8]; f32x4 pr[2]; pr[0] = *(const LAS f32x4*)(prow + 8 * t); pr[1] = *(const LAS f32x4*)(prow + 8 * t + 4);
#pragma unroll
            for (int k = 0; k < 4; ++k) { vf[2 * k] = bflo(Kc[t][k]); vf[2 * k + 1] = bfhi(Kc[t][k]); }
#pragma unroll
            for (int g = 0; g < GE; ++g) { const float pg_ = pr[g >> 2][g & 3];
#pragma unroll
                for (int k = 0; k < 8; ++k) acc[g * 8 + k] = fmaf(pg_, vf[k], acc[g * 8 + k]); } }
        asm volatile("s_waitcnt lgkmcnt(0)" ::: "memory");
    }
#undef DEC_ISSUE
#pragma unroll
    for (int k = 0; k < GE * 8; ++k) acc[k] = xrow16_sum(acc[k]);
#pragma unroll
    for (int j = 0; j < HPL; ++j) { float t = l[j]; t += dpp<ROR4>(t); t += dpp<XOR8>(t); l[j] = xrow16_sum(t); }
    LAS float* mrg = lds + L_MRG;
    if (r == 0) {
#pragma unroll
        for (int g = 0; g < GE; ++g) { LAS float* rec = mrg + (wave * GE + g) * MRG_REC;
#pragma unroll
            for (int k = 0; k < 8; k += 4) *(LAS f32x4*)(rec + 4 + 8 * c + k) = (f32x4){acc[g * 8 + k], acc[g * 8 + k + 1], acc[g * 8 + k + 2], acc[g * 8 + k + 3]};
            if (c == g / HPL) { rec[0] = m[g % HPL]; rec[1] = l[g % HPL]; } } }
    __syncthreads();
    { const int g = wave, d0 = 2 * lane;
      float M = -INFINITY;
#pragma unroll
      for (int w = 0; w < 8; ++w) M = fmaxf(M, mrg[(w * GE + g) * MRG_REC]);
      float L = 0.f, o0 = 0.f, o1 = 0.f;
#pragma unroll
      for (int w = 0; w < 8; ++w) { const LAS float* rec = mrg + (w * GE + g) * MRG_REC; const float wt = __builtin_amdgcn_exp2f(rec[0] - M);
          L = fmaf(wt, rec[1], L); o0 = fmaf(wt, rec[4 + d0], o0); o1 = fmaf(wt, rec[4 + d0 + 1], o1); }
      const size_t slot = ((size_t)s * NSPLIT + sp) * GE + g;
      *(f32x2*)(DPO + slot * 128 + d0) = (f32x2){o0, o1};
      if (lane == 0) *(f32x2*)(DML + slot * 2) = (f32x2){M, L}; }
    __syncthreads();
}

__device__ __forceinline__ void combine_unit(int s, const bf16* QB, const float* QLATg, const float* DPO, const float* DML, const float* dout, const float* wkvb, bf16* OCAT, LAS float* lds) {
    int tid_ = threadIdx.x; asm volatile("" : "+v"(tid_)); const int tid = tid_, lane = tid & 63, g = __builtin_amdgcn_readfirstlane(tid >> 6), d0 = 2 * lane;
    const float* ck = dout + O_CKVS + (size_t)s * KVL; const float* kp = dout + O_KPES + (size_t)s * RPE;
    const f32x2 ckv = *(const f32x2*)(ck + d0); const f32x2 ql = *(const f32x2*)(QLATg + (size_t)s * 1024 + g * 128 + d0);
    float part = ql[0] * ckv[0] + ql[1] * ckv[1];
    if (lane < 16) { const unsigned qp = *(const unsigned*)(QB + (size_t)(MP + s) * 768 + g * QKD + 64 + d0); part += bflo(qp) * kp[d0] + bfhi(qp) * kp[d0 + 1]; }
    const float sself = wave_sum(part);
    float M = sself;
#pragma unroll
    for (int sp = 0; sp < NSPLIT; ++sp) M = fmaxf(M, DML[(((size_t)s * NSPLIT + sp) * GE + g) * 2]);
    float L = __builtin_amdgcn_exp2f(sself - M), o0 = L * ckv[0], o1 = L * ckv[1];
#pragma unroll
    for (int sp = 0; sp < NSPLIT; ++sp) { const size_t slot = ((size_t)s * NSPLIT + sp) * GE + g; const float wt = __builtin_amdgcn_exp2f(DML[slot * 2] - M);
        const f32x2 po = *(const f32x2*)(DPO + slot * 128 + d0); L = fmaf(wt, DML[slot * 2 + 1], L); o0 = fmaf(wt, po[0], o0); o1 = fmaf(wt, po[1], o1); }
    const float inv = 1.0f / L;
    LAS float* ol = lds + g * 128;
    ol[d0] = o0 * inv; ol[d0 + 1] = o1 * inv;
    asm volatile("s_waitcnt lgkmcnt(0)" ::: "memory");
    float a = 0.f;
#pragma unroll 8
    for (int cc = 0; cc < 128; ++cc) a = fmaf(ol[cc], wkvb[(size_t)cc * 1024 + g * 128 + 64 + lane], a);
    OCAT[(size_t)(MP + s) * DM + g * 64 + lane] = (bf16)f2bf(a);
    __syncthreads();
}
}
#define XB_TMO      128
#define XB_XCNT(j)  (256  + 64 * (j))
#define XB_XSUB(j)  (1280 + 64 * (j))
#define XB_XGEN(j)  (2304 + 64 * (j))
#define XB_TOP      3328
#define XB_TOPGEN   3392
#define XCD_BAR_WORDS 3456
#define XB_SPIN_CAP (1u << 18)

__device__ __forceinline__ unsigned xb_ld(unsigned* p)              { return __hip_atomic_load(p, __ATOMIC_RELAXED, __HIP_MEMORY_SCOPE_AGENT); }
__device__ __forceinline__ unsigned xb_add(unsigned* p, unsigned v) { return __hip_atomic_fetch_add(p, v, __ATOMIC_RELAXED, __HIP_MEMORY_SCOPE_AGENT); }
__device__ __forceinline__ unsigned xb_xcc_id() { return (unsigned)__builtin_amdgcn_s_getreg((3 << 11) | 20) & 0xFu; }
#define XB_SPIN(cond, bar) do { unsigned _sp = 0; while (cond) { __builtin_amdgcn_s_sleep(1); \
    if ((++_sp & 255u) == 0u) { if (xb_ld(&(bar)[XB_TMO])) break; if (_sp > XB_SPIN_CAP) { atomicAdd(&(bar)[XB_TMO], 1u); break; } } } } while (0)

struct XcdBarrier {
    unsigned* bar; unsigned x;
    volatile LAS unsigned* st;
};

__device__ __forceinline__ XcdBarrier xcd_barrier_post(unsigned* bar, volatile LAS unsigned* st) {
    XcdBarrier b; b.bar = bar; b.x = xb_xcc_id(); b.st = st;
    if (threadIdx.x == 0) (void)xb_add(&bar[XB_XCNT(b.x)], 1u);
    return b;
}
__device__ __forceinline__ void xcd_barrier_complete(unsigned* bar, unsigned x, unsigned& nloc, unsigned& nx) {
    const unsigned G = gridDim.x * gridDim.y * gridDim.z;
    unsigned sum, cnt, mine, sp = 0u;
    for (;;) {
        sum = 0u; cnt = 0u; mine = 0u;
#pragma unroll
        for (unsigned j = 0; j < 16; ++j) { const unsigned c = xb_ld(&bar[XB_XCNT(j)]); sum += c; cnt += (c > 0u) ? 1u : 0u; mine = (j == x) ? c : mine; }
        if (sum == G) break;
        __builtin_amdgcn_s_sleep(1);
        if ((++sp & 255u) == 0u) { if (xb_ld(&bar[XB_TMO])) break; if (sp > XB_SPIN_CAP) { atomicAdd(&bar[XB_TMO], 1u); break; } }
    }
    nloc = mine > 0u ? mine : 1u; nx = cnt > 0u ? cnt : 1u;
}

__device__ __forceinline__ void xcd_barrier(const XcdBarrier& b) {
    asm volatile("s_waitcnt vmcnt(0)" ::: "memory");
    __syncthreads();
    if (threadIdx.x == 0) {
        unsigned* bar = b.bar;
        __builtin_amdgcn_s_waitcnt(0);
        unsigned nloc = b.st[0], nx = b.st[1];
        if (nloc == 0u) { xcd_barrier_complete(bar, b.x, nloc, nx); b.st[0] = nloc; b.st[1] = nx; }
        const unsigned old = xb_add(&bar[XB_XSUB(b.x)], 1u);
        const unsigned gen = old / nloc;
        if (old + 1u == (gen + 1u) * nloc) {
            __builtin_amdgcn_fence(__ATOMIC_RELEASE, "agent");
            asm volatile("s_waitcnt vmcnt(0)" ::: "memory");
            const unsigned og = xb_add(&bar[XB_TOP], 1u);
            const unsigned tg = og / nx;
            if (og + 1u == (tg + 1u) * nx) xb_add(&bar[XB_TOPGEN], 1u);
            else XB_SPIN(xb_ld(&bar[XB_TOPGEN]) == tg, bar);
            __builtin_amdgcn_fence(__ATOMIC_ACQUIRE, "agent");
            xb_add(&bar[XB_XGEN(b.x)], 1u);
            asm volatile("s_waitcnt vmcnt(0)" ::: "memory");
        } else {
            XB_SPIN(xb_ld(&bar[XB_XGEN(b.x)]) == gen, bar);
            __builtin_amdgcn_fence(__ATOMIC_ACQUIRE, "agent");
            asm volatile("s_waitcnt vmcnt(0)" ::: "memory");
        }
    }
    __syncthreads();
}
constexpr int NWAVES = 8, NPHASE = 13;
struct Args {
    const float *x_prompt, *x_sample, *cache_ckv, *cache_kpe, *state_ret; const int* page_table; const float *p_prompt, *p_sample;
    const float *ffn1_norm, *ffn1_w_gate, *ffn1_w_up, *ffn1_w_down, *mix_norm, *w_in, *q_a_norm, *w_q_b, *kv_a_norm, *w_kv_b, *ret_norm, *w_branch_att, *w_branch_ret, *w_out;
    const float *ffn2_norm, *ffn2_w_gate, *ffn2_w_up, *ffn2_w_down, *ple_norm, *w_ple_gate, *w_ple_proj, *final_norm;
    float* out; unsigned char* ws; int ph_lo, ph_hi;
};
static_assert(sizeof(Args) == 32 * 8 + 8, "Args has no padding holes");

enum { RM_ID = 0, RM_GATE, RM_UP, RM_WIN, RM_QB, RM_KVB };
__device__ __forceinline__ int rowmap(int kind, int n) {
    switch (kind) {
    case RM_GATE: return (n >> 7) * 256 + (n & 127);
    case RM_UP:   return (n >> 7) * 256 + 128 + (n & 127);
    case RM_WIN: {
        if (n < 384) return n;
        if (n < 416) { const int j = n - 384, jj = j & 15; return 384 + 8 * (jj >> 2) + 4 * (j >> 4) + (jj & 3); }
        if (n < 1440) { const bool isk = n >= 928; const int j = n - (isk ? 928 : 416), hh = j >> 7, d = j & 127, i = d & 63, n_ = d >> 6;
            return (isk ? 1024 : 512) + hh * 128 + 32 * (i >> 4) + 8 * ((i >> 2) & 3) + 4 * n_ + (i & 3); }
        if (n < 1952) return 1536 + (n - 1440);
        if (n < 2464) return 2048 + (n - 1952);
        if (n < 3488) return 2560 + (n - 2464);
        return 3584 + (n - 3488); }
    case RM_QB: { const int hh = n / 96, d = n % 96; if (d < 64) return hh * 64 + d; const int j = d - 64, jj = j & 15; return 512 + hh * 32 + 8 * (jj >> 2) + 4 * (j >> 4) + (jj & 3); }
    case RM_KVB: { const int hh = n >> 7, d = n & 127; return d < 64 ? hh * 64 + d : 512 + hh * 64 + (d - 64); }
    default: return n; }
}
__device__ __forceinline__ void tr_item(const float* W, int N, bf16* WT, int Kd, int koff, const float* gain, float scale, int kind, LAS float* scr, int item, int lane) {
    const int nblk = N / 32, kb = item / nblk, nb = item % nblk, k0 = 64 * kb, n0 = 32 * nb;
#pragma unroll 8
    for (int i = 0; i < 32; ++i) { const int kk = 2 * i + (lane >> 5); const float g = gain ? gain[k0 + kk] * scale : scale; scr[kk * 33 + (lane & 31)] = W[(size_t)(k0 + kk) * N + n0 + (lane & 31)] * g; }
    LDS_WAIT(); asm volatile("" ::: "memory");
    const int c = lane & 7;
#pragma unroll
    for (int j = 0; j < 4; ++j) { const int n = (lane >> 3) + 8 * j; const LAS float* s = scr + (8 * c) * 33 + n;
        v4u o; o.x = pk2(s[0 * 33], s[1 * 33]); o.y = pk2(s[2 * 33], s[3 * 33]); o.z = pk2(s[4 * 33], s[5 * 33]); o.w = pk2(s[6 * 33], s[7 * 33]);
        *(GAS v4u*)(WT + (size_t)rowmap(kind, n0 + n) * Kd + koff + k0 + 8 * c) = o; }
    LDS_WAIT(); asm volatile("" ::: "memory");
}
__device__ __forceinline__ void sincos_d(double a, float& c, float& s) {
    const double k = __builtin_rint(a * 0.63661977236758134308);
    double r = __builtin_fma(-k, 1.5707963267948966, a); r = __builtin_fma(-k, 6.123233995736766e-17, r);
    const double r2 = r * r;
    const double sp = r * (1.0 + r2 * (-1.0 / 6 + r2 * (1.0 / 120 + r2 * (-1.0 / 5040 + r2 * (1.0 / 362880 + r2 * (-1.0 / 39916800 + r2 * (1.0 / 6227020800.0)))))));
    const double cp = 1.0 + r2 * (-0.5 + r2 * (1.0 / 24 + r2 * (-1.0 / 720 + r2 * (1.0 / 40320 + r2 * (-1.0 / 3628800 + r2 * (1.0 / 479001600.0 + r2 * (-1.0 / 87178291200.0)))))));
    const int q = (int)((long long)k & 3);
    const double cc = q == 0 ? cp : q == 1 ? -sp : q == 2 ? -cp : sp, ss = q == 0 ? sp : q == 1 ? cp : q == 2 ? -sp : -cp;
    c = (float)cc; s = (float)ss;
}

struct Frame {
    LAS unsigned char* lds; volatile LAS unsigned* MISC; gu32* ctl; int tid, lane, wave, G, bid;
};

__device__ __forceinline__ void p0_prologue(const Args& a, Frame& F) {
    unsigned char* ws = a.ws;
    LAS float* scr = (LAS float*)(F.lds + F.wave * 16384);
    const int gw = F.bid * NWAVES + F.wave, NGW = F.G * NWAVES;
    constexpr int I_FF = 16 * 88, I_DN = 44 * 32, I_IN = 16 * 141, I_QB = 4 * 24, I_KVB = 2 * 32, I_BR = 8 * 32, I_SQ = 16 * 32, I_PP = 4 * 32;
    constexpr int NITEMS = 4 * I_FF + 2 * I_DN + I_IN + I_QB + I_KVB + 2 * I_BR + 2 * I_SQ + I_PP;
    for (int it = gw; it < NITEMS; it += NGW) {
        int r = it;
        if (r < I_FF) { tr_item(a.ffn1_w_gate, DFF, (bf16*)(ws + WS_WGU1), DM, 0, nullptr, 1.f, RM_GATE, scr, r, F.lane); continue; } r -= I_FF;
        if (r < I_FF) { tr_item(a.ffn1_w_up, DFF, (bf16*)(ws + WS_WGU1), DM, 0, nullptr, 1.f, RM_UP, scr, r, F.lane); continue; } r -= I_FF;
        if (r < I_FF) { tr_item(a.ffn2_w_gate, DFF, (bf16*)(ws + WS_WGU2), DM, 0, a.ffn2_norm, 1.f, RM_GATE, scr, r, F.lane); continue; } r -= I_FF;
        if (r < I_FF) { tr_item(a.ffn2_w_up, DFF, (bf16*)(ws + WS_WGU2), DM, 0, a.ffn2_norm, 1.f, RM_UP, scr, r, F.lane); continue; } r -= I_FF;
        if (r < I_DN) { tr_item(a.ffn1_w_down, DM, (bf16*)(ws + WS_WD1), DFF, 0, nullptr, 1.f, RM_ID, scr, r, F.lane); continue; } r -= I_DN;
        if (r < I_DN) { tr_item(a.ffn2_w_down, DM, (bf16*)(ws + WS_WD2), DFF, 0, nullptr, 1.f, RM_ID, scr, r, F.lane); continue; } r -= I_DN;
        if (r < I_IN) { tr_item(a.w_in, 4512, (bf16*)(ws + WS_WIN), DM, 0, a.mix_norm, 1.f, RM_WIN, scr, r, F.lane); continue; } r -= I_IN;
        if (r < I_QB) { tr_item(a.w_q_b, 768, (bf16*)(ws + WS_WQB), QL, 0, a.q_a_norm, C2, RM_QB, scr, r, F.lane); continue; } r -= I_QB;
        if (r < I_KVB) { tr_item(a.w_kv_b, 1024, (bf16*)(ws + WS_WKVB), KVL, 0, a.kv_a_norm, 1.f, RM_KVB, scr, r, F.lane); continue; } r -= I_KVB;
        if (r < I_BR) { tr_item(a.w_branch_att, DM, (bf16*)(ws + WS_WBC), DM, 0, nullptr, 1.f, RM_ID, scr, r, F.lane); continue; } r -= I_BR;
        if (r < I_BR) { tr_item(a.w_branch_ret, DM, (bf16*)(ws + WS_WBC), DM, 512, nullptr, 1.f, RM_ID, scr, r, F.lane); continue; } r -= I_BR;
        if (r < I_SQ) { tr_item(a.w_out, DM, (bf16*)(ws + WS_WOUT), DM, 0, nullptr, 1.f, RM_ID, scr, r, F.lane); continue; } r -= I_SQ;
        if (r < I_SQ) { tr_item(a.w_ple_gate, DM, (bf16*)(ws + WS_WPG), DM, 0, a.ple_norm, 1.f, RM_ID, scr, r, F.lane); continue; } r -= I_SQ;
        tr_item(a.w_ple_proj, DM, (bf16*)(ws + WS_WPP), PLE, 0, nullptr, 1.f, RM_ID, scr, r, F.lane);
    }
    const int gt = F.bid * (NWAVES * 64) + F.tid, NGT = F.G * NWAVES * 64;
    for (int i = gt; i < 96 * 128; i += NGT) *(v4u*)((bf16*)(ws + WS_WIN) + (size_t)416 * DM + (size_t)i * 8) = (v4u){0u, 0u, 0u, 0u};
    for (int i = gt; i < 8193 * 64; i += NGT) { const int pi = i >> 6, fi = i & 63; double inv = 1.0; for (int k = 0; k < fi; ++k) inv *= 0.8659643233600653;
        float c, s; sincos_d((double)(pi == 8192 ? 16384 : pi) * inv, c, s); ((float2*)(ws + WS_ROPE))[i] = make_float2(c, s); }
    for (int m = gw; m < MT; m += NGW) {
        bf16* orow = (bf16*)(ws + WS_XN1) + (size_t)m * DM; bf16* prow = (bf16*)(ws + WS_PB) + (size_t)m * PLE;
        if (m >= MP + MS) {
#pragma unroll
            for (int j = 0; j < 4; ++j) ((unsigned long long*)orow)[F.lane + 64 * j] = 0ull;
            ((unsigned long long*)prow)[F.lane] = 0ull; continue; }
        const float* xrow = m < MP ? a.x_prompt + (size_t)m * DM : a.x_sample + (size_t)(m - MP) * DM;
        const float* pr = m < MP ? a.p_prompt + (size_t)m * PLE : a.p_sample + (size_t)(m - MP) * PLE;
        const pg8::f32x4* xr = (const pg8::f32x4*)xrow + F.lane; pg8::f32x4 v[4]; float s = 0.f;
#pragma unroll
        for (int j = 0; j < 4; ++j) { v[j] = xr[64 * j]; s += (v[j].x * v[j].x + v[j].y * v[j].y) + (v[j].z * v[j].z + v[j].w * v[j].w); }
        const float rstd = 1.0f / sqrtf(wave_sum(s) * (1.f / DM) + EPS);
#pragma unroll
        for (int j = 0; j < 4; ++j) { const pg8::f32x4 g = ((const pg8::f32x4*)a.ffn1_norm)[F.lane + 64 * j];
            ((unsigned long long*)orow)[F.lane + 64 * j] = (unsigned long long)pk2(v[j].x * rstd * g.x, v[j].y * rstd * g.y) | ((unsigned long long)pk2(v[j].z * rstd * g.z, v[j].w * rstd * g.w) << 32); }
        const pg8::f32x4 pv = ((const pg8::f32x4*)pr)[F.lane];
        ((unsigned long long*)prow)[F.lane] = (unsigned long long)pk2(pv.x, pv.y) | ((unsigned long long)pk2(pv.z, pv.w) << 32);
    }
}

__global__ void __launch_bounds__(NWAVES * 64, 2) mk_fwd(Args args) {
    extern __shared__ __attribute__((aligned(16))) unsigned char lds[];
    Frame F;
    F.lds = (LAS unsigned char*)lds; F.MISC = (volatile LAS unsigned*)(F.lds + MISC_OFF);
    F.tid = threadIdx.x; F.lane = F.tid & 63; F.wave = __builtin_amdgcn_readfirstlane(F.tid >> 6); F.G = gridDim.x; F.bid = blockIdx.x;
    unsigned char* ws = args.ws;
    F.ctl = (gu32*)(ws + WS_CTL);
    for (int u = F.tid; u < (LDS_BYTES - LDSCTL_OFF) / 4; u += NWAVES * 64) ((LAS unsigned*)(F.lds + LDSCTL_OFF))[u] = 0u;
    __syncthreads();
    XcdBarrier bar; bar.bar = (unsigned*)(ws + WS_CTL) + CW_BAR; bar.x = 0; bar.st = nullptr;
    if (!MK_PER_PHASE) bar = xcd_barrier_post((unsigned*)(ws + WS_CTL) + CW_BAR, F.MISC + 8);
    const int lo = args.ph_lo, hi = args.ph_hi;
#ifndef PHASE_MASK
#define PHASE_MASK 0xFFFF
#endif
#define IN(k) (((PHASE_MASK >> (k)) & 1) && lo <= (k) && (k) < hi)
#define SEAM(k) do { if (IN(k) && IN((k) + 1)) { if (MK_PER_PHASE) { if (F.tid == 0) __hip_atomic_store(F.ctl + CW_TMO, 0xBADBA0u, RLX_AGENT); } else xcd_barrier(bar); } } while (0)
    float* ssq_h1 = (float*)(ws + WS_SSQ); float* ssq_h2 = (float*)(ws + WS_SSQ + SSQ16_BYTES); float* ssq_h3 = (float*)(ws + WS_SSQ + 2 * SSQ16_BYTES); float* ssq_h4 = (float*)(ws + WS_SSQ + 3 * SSQ16_BYTES);
    float* ssq_cq = (float*)(ws + WS_SSQ + 4 * SSQ16_BYTES); float* ssq_kv = (float*)(ws + WS_SSQ + 4 * SSQ16_BYTES + SSQ4_BYTES);
    const float2* rope = (const float2*)(ws + WS_ROPE);
    bf16 *XN1 = (bf16*)(ws + WS_XN1), *ACT = (bf16*)(ws + WS_ACT), *H1B = (bf16*)(ws + WS_H1B), *CQB = (bf16*)(ws + WS_CQB), *CKVB = (bf16*)(ws + WS_CKVB), *KPEB = (bf16*)(ws + WS_KPEB);
    bf16 *QR = (bf16*)(ws + WS_QR), *KR = (bf16*)(ws + WS_KR), *RV = (bf16*)(ws + WS_RV), *RGS = (bf16*)(ws + WS_RGS), *SGA = (bf16*)(ws + WS_SGA), *SGR = (bf16*)(ws + WS_SGR);
    bf16 *QB = (bf16*)(ws + WS_QB), *KN = (bf16*)(ws + WS_KN), *VB = (bf16*)(ws + WS_VB), *OCAT = (bf16*)(ws + WS_OCAT), *SC = (bf16*)(ws + WS_SC), *MRG = (bf16*)(ws + WS_MRG);
    bf16 *H2B = (bf16*)(ws + WS_H2B), *H3B = (bf16*)(ws + WS_H3B), *PB = (bf16*)(ws + WS_PB), *PP = (bf16*)(ws + WS_PP);
    float *H1 = (float*)(ws + WS_H1), *H2 = (float*)(ws + WS_H2), *H3 = (float*)(ws + WS_H3), *H4 = (float*)(ws + WS_H4), *CKVF = (float*)(ws + WS_CKVF), *KVC = (float*)(ws + WS_KVC);
    float *DPO = (float*)(ws + WS_DPO), *DML = (float*)(ws + WS_DML), *QLAT = (float*)(ws + WS_QLAT);
    const int gt = F.bid * (NWAVES * 64) + F.tid, NGT = F.G * NWAVES * 64, gw = F.bid * NWAVES + F.wave, NGW = F.G * NWAVES;

    if (IN(0)) { p0_prologue(args, F); }
    SEAM(0);
    if (IN(1)) { pg8::Gemm g{XN1, (const bf16*)(ws + WS_WGU1), MT, NGU, DM}; pg8::StaticOrder S; S.init(MT, NGU, F.G, F.bid);
        pg8::EpiSwiGLU E{0, ACT, nullptr}; pg8::gemm_phase<pg8::EpiSwiGLU, pg8::StaticOrder, true, true>(F.lds, g, S, E); }
    SEAM(1);
    if (IN(2)) { pg8::Gemm g{ACT, (const bf16*)(ws + WS_WD1), MT, DM, DFF}; pg8::StaticOrder S; S.init(MT, DM, F.G, F.bid);
        pg8::EpiResid<true> E{0, args.x_prompt, args.x_sample, 0, H1, H1B, ssq_h1}; pg8::gemm_phase<pg8::EpiResid<true>, pg8::StaticOrder, true, true>(F.lds, g, S, E); }
    SEAM(2);
    if (IN(3)) { pg8::Gemm g{H1B, (const bf16*)(ws + WS_WIN), MT, NIN, DM}; pg8::StaticOrder S; S.init(MT, NIN, F.G, F.bid);
        pg8::EpiWin E{0, ssq_h1, ssq_cq, ssq_kv, rope, args.out, CQB, CKVB, KPEB, QR, KR, RV, RGS, SGA, SGR, CKVF};
        pg8::gemm_phase<pg8::EpiWin, pg8::StaticOrder, true, true>(F.lds, g, S, E); }
    SEAM(3);
    if (IN(4)) {
#ifndef P4_MASK
#define P4_MASK 31
#endif
        if (P4_MASK & 1) { pg8::Gemm g{CQB, (const bf16*)(ws + WS_WQB), MT, 768, QL}; pg8::StaticOrder S; S.init(MT, 768, F.G, F.bid);
          pg8::EpiQB E{0, ssq_cq, rope, QB}; pg8::gemm_phase<pg8::EpiQB, pg8::StaticOrder, true, true>(F.lds, g, S, E); }
        if (P4_MASK & 2) { pg8::Gemm g{CKVB, (const bf16*)(ws + WS_WKVB), MP, DM, KVL}; pg8::StaticOrder S; S.init(MP, DM, F.G, F.bid);
          pg8::EpiPlain E{0, KN, VB, 512, 2, ssq_kv, 1.0f / KVL}; pg8::gemm_phase<pg8::EpiPlain, pg8::StaticOrder, true, true>(F.lds, g, S, E); }
        if (P4_MASK & 4) { pg8::Gemm g{PB, (const bf16*)(ws + WS_WPP), MT, DM, PLE}; pg8::StaticOrder S; S.init(MT, DM, F.G, F.bid);
          pg8::EpiPlain E{0, PP, PP, DM, 4, nullptr, 0.f}; pg8::gemm_phase<pg8::EpiPlain, pg8::StaticOrder, true, true>(F.lds, g, S, E); }
        if (P4_MASK & 8) for (int i = gt; i < (MP + MS) * 32; i += NGT) { const int row = i >> 5, c4 = (i & 31) * 4; const float rs = pg8::rstd_of<4>(ssq_kv, row, 1.0f / KVL);
            const pg8::f32x4 v = *(const pg8::f32x4*)(CKVF + (size_t)row * KVL + c4), g = *(const pg8::f32x4*)(args.kv_a_norm + c4);
            float* o = row < MP ? args.out + O_CKVP + (size_t)row * KVL : args.out + O_CKVS + (size_t)(row - MP) * KVL;
            *(pg8::f32x4*)(o + c4) = v * rs * g; }
        if (P4_MASK & 16) for (int u = F.bid; u < 512; u += F.G) ret::kv_unit(u, KR, RV, KVC, F.lds);
    }
    SEAM(4);
    if (IN(5)) {
#ifndef P5_MASK
#define P5_MASK 7
#endif
        if (P5_MASK & 1) for (int v = F.bid; v < 256; v += F.G) { const int bh = v >> 4, s = v & 15;
            att::attn_unit(bh >> 3, bh & 7, s, QB, KN, KPEB, VB, OCAT, (char*)lds);
            att::attn_unit(bh >> 3, bh & 7, 31 - s, QB, KN, KPEB, VB, OCAT, (char*)lds); }
        if (P5_MASK & 2) for (int v = F.bid; v < 256; v += F.G) { const int s = v >> 1, sg = v & 1;
            dec::qlat_token(s, QB, args.w_kv_b, (LAS float*)F.lds + dec::L_QL, QLAT, sg == 0);
            __syncthreads();
            for (int k = 0; k < 4; ++k) dec::split_unit(s, sg * 4 + k, QB, args.cache_ckv, args.cache_kpe, args.page_table, DPO, DML, (LAS float*)F.lds); }
        if (P5_MASK & 4) ret::scan_items(gt, NGT, KVC, SC, args.out);
    }
    SEAM(5);
    if (IN(6)) {
        for (int u = F.bid; u < 512; u += F.G) ret::out_unit(u, QR, KR, RV, SC, RGS, args.ret_norm, OCAT, F.lds);
        for (int u = F.bid; u < 512; u += F.G) ret::sample_unit(u, QR, KR, RV, RGS, args.ret_norm, args.state_ret, args.out, OCAT, F.lds);
        for (int s = F.bid; s < MS; s += F.G) dec::combine_unit(s, QB, QLAT, DPO, DML, args.out, args.w_kv_b, OCAT, (LAS float*)F.lds);
    }
    SEAM(6);
    if (IN(7)) { pg8::Gemm g{OCAT, (const bf16*)(ws + WS_WBC), MT, DM, DM}; pg8::StaticOrder S; S.init(MT, DM, F.G, F.bid);
        pg8::EpiMerge E{8, SGA, SGR, MRG}; pg8::gemm_phase<pg8::EpiMerge, pg8::StaticOrder, true, true>(F.lds, g, S, E); }
    SEAM(7);
    if (IN(8)) { pg8::Gemm g{MRG, (const bf16*)(ws + WS_WOUT), MT, DM, DM}; pg8::StaticOrder S; S.init(MT, DM, F.G, F.bid);
        pg8::EpiResid<false> E{0, H1, H1, 1, H2, H2B, ssq_h2}; pg8::gemm_phase<pg8::EpiResid<false>, pg8::StaticOrder, true, true>(F.lds, g, S, E); }
    SEAM(8);
    if (IN(9)) { pg8::Gemm g{H2B, (const bf16*)(ws + WS_WGU2), MT, NGU, DM}; pg8::StaticOrder S; S.init(MT, NGU, F.G, F.bid);
        pg8::EpiSwiGLU E{0, ACT, ssq_h2}; pg8::gemm_phase<pg8::EpiSwiGLU, pg8::StaticOrder, true, true>(F.lds, g, S, E); }
    SEAM(9);
    if (IN(10)) { pg8::Gemm g{ACT, (const bf16*)(ws + WS_WD2), MT, DM, DFF}; pg8::StaticOrder S; S.init(MT, DM, F.G, F.bid);
        pg8::EpiResid<true> E{0, H2, H2, 1, H3, H3B, ssq_h3}; pg8::gemm_phase<pg8::EpiResid<true>, pg8::StaticOrder, true, true>(F.lds, g, S, E); }
    SEAM(10);
    if (IN(11)) { pg8::Gemm g{H3B, (const bf16*)(ws + WS_WPG), MT, DM, DM}; pg8::StaticOrder S; S.init(MT, DM, F.G, F.bid);
        pg8::EpiPle E{0, H3, PP, ssq_h3, H4, ssq_h4}; pg8::gemm_phase<pg8::EpiPle, pg8::StaticOrder, true, true>(F.lds, g, S, E); }
    SEAM(11);
    if (IN(12)) {
        for (int m = gw; m < MP + MS; m += NGW) { const float rs = pg8::rstd_of<16>(ssq_h4, m, 1.0f / DM);
            const pg8::f32x4* hr = (const pg8::f32x4*)(H4 + (size_t)m * DM) + F.lane; pg8::f32x4* o = (pg8::f32x4*)(args.out + (m < MP ? O_YP + (size_t)m * DM : O_YS + (size_t)(m - MP) * DM)) + F.lane;
#pragma unroll
            for (int j = 0; j < 4; ++j) o[64 * j] = hr[64 * j] * rs * ((const pg8::f32x4*)args.final_norm)[F.lane + 64 * j]; }
    }
#undef IN
#undef SEAM
}

#ifdef DBG_LAST
__global__ void dbg_dump(const unsigned char* ws, float* out) {
    const size_t n = (size_t)MP * DM;
    for (size_t i = (size_t)blockIdx.x * blockDim.x + threadIdx.x; i < n; i += (size_t)gridDim.x * blockDim.x) { const size_t r = i >> 10, c = i & 1023; float v = 0.f;
        if (c < DBG_NCOLS) { if (DBG_F32) v = ((const float*)(ws + DBG_SRC))[r * DBG_PITCH + c]; else v = bf2f(((const bf16*)(ws + DBG_SRC))[r * DBG_PITCH + c]); }
#ifdef DBG_SRC2
        else v = bf2f(((const bf16*)(ws + DBG_SRC2))[r * DBG_PITCH + (c - DBG_NCOLS)]);
#endif
        out[i] = v; }
}
#endif
extern "C" void kernel_launch(void* const* d_in, const int* in_sizes, int n_in, void* d_out, int out_size, void* d_ws, size_t ws_size, hipStream_t stream) {
    static int grid = 0;
    if (grid == 0) {
        if (n_in != 30 || out_size != (int)O_END || ws_size < WS_END) { fprintf(stderr, "kernel_launch: built for 30 inputs, %zu outputs, >= %zu bytes of workspace; got n_in %d, out %d, ws %zu; nothing launched\n", (size_t)O_END, (size_t)WS_END, n_in, out_size, ws_size); grid = -1; return; }
        int dev = 0, cus = 0, per_cu = 0;
        if (hipGetDevice(&dev) != hipSuccess || hipDeviceGetAttribute(&cus, hipDeviceAttributeMultiprocessorCount, dev) != hipSuccess) { fprintf(stderr, "kernel_launch: device query failed\n"); grid = -1; return; }
        if (hipFuncSetAttribute((const void*)mk_fwd, hipFuncAttributeMaxDynamicSharedMemorySize, LDS_BYTES) != hipSuccess) { fprintf(stderr, "kernel_launch: hipFuncSetAttribute failed\n"); grid = -1; return; }
        if (hipOccupancyMaxActiveBlocksPerMultiprocessor(&per_cu, (const void*)mk_fwd, NWAVES * 64, LDS_BYTES) != hipSuccess || per_cu < 1)
            fprintf(stderr, "kernel_launch: note: occupancy query reports %d workgroups per CU\n", per_cu);
        (void)hipGetLastError();
        grid = cus;
    }
    if (grid < 0) return;
    if (hipMemsetAsync((char*)d_ws + WS_CTL, 0, CTL_ZERO_BYTES, stream) != hipSuccess) { fprintf(stderr, "kernel_launch: memset failed\n"); return; }
    Args a{};
    const float** fp = (const float**)&a;
    for (int i = 0; i < 30; ++i) fp[i] = (const float*)d_in[i];
    a.out = (float*)d_out; a.ws = (unsigned char*)d_ws;
#if MK_PER_PHASE
#ifdef DBG_LAST
    for (int k = 0; k <= DBG_LAST; ++k) { a.ph_lo = k; a.ph_hi = k + 1; hipLaunchKernelGGL(mk_fwd, dim3(grid), dim3(NWAVES * 64), LDS_BYTES, stream, a); }
    hipLaunchKernelGGL(dbg_dump, dim3(1024), dim3(256), 0, stream, (const unsigned char*)d_ws, (float*)d_out);
#else
    for (int k = 0; k < NPHASE; ++k) { a.ph_lo = k; a.ph_hi = k + 1; hipLaunchKernelGGL(mk_fwd, dim3(grid), dim3(NWAVES * 64), LDS_BYTES, stream, a); }
#endif
#else
    a.ph_lo = 0; a.ph_hi = NPHASE; hipLaunchKernelGGL(mk_fwd, dim3(grid), dim3(NWAVES * 64), LDS_BYTES, stream, a);
#endif
    const hipError_t le = hipPeekAtLastError();
    if (le != hipSuccess) fprintf(stderr, "kernel_launch: launch failed: %s\n", hipGetErrorName(le));
}
```

```cpp
#include <hip/hip_runtime.h>
#include <cstdio>
#include <cstdint>

#ifndef MK_PER_PHASE
#define MK_PER_PHASE 0
#endif

constexpr int DM = 1024, TSEQ = 8192, MP = 16384, MS = 128, MT = 16640, NPAN = MT / 256;
constexpr int DFF = 2816, NGU = 2 * DFF, NIN = 4608, PLE = 256;
constexpr int NH = 8, QKD = 96, KVL = 128, RPE = 32, QL = 256;
constexpr int RH = 4, RDK = 128, RDV = 128;
constexpr int NPAGES = 128, PAGE = 128;
constexpr float EPS = 1e-6f;
constexpr float C2 = 0.10206207261596575f * 1.4426950408889634f;
constexpr size_t O_YP = 0, O_YS = 16777216, O_CKVP = 16908288, O_KPEP = 19005440, O_RETP = 19529728, O_CKVS = 19660800, O_KPES = 19677184, O_RETS = 19681280, O_END = 28069888;

constexpr size_t MiB = 1u << 20;
constexpr size_t al1(size_t x) { return (x + MiB - 1) & ~(MiB - 1); }
constexpr size_t WS_CTL = 0, CTL_ZERO_BYTES = 1 * MiB;
constexpr size_t WS_WGU1 = 2 * MiB;
constexpr size_t WS_WD1  = WS_WGU1 + al1((size_t)NGU * DM * 2);
constexpr size_t WS_WIN  = WS_WD1 + al1((size_t)DM * DFF * 2);
constexpr size_t WS_WQB  = WS_WIN + al1((size_t)NIN * DM * 2);
constexpr size_t WS_WKVB = WS_WQB + al1((size_t)768 * 256 * 2);
constexpr size_t WS_WBC  = WS_WKVB + al1((size_t)1024 * 128 * 2);
constexpr size_t WS_WOUT = WS_WBC + al1((size_t)DM * DM * 2);
constexpr size_t WS_WGU2 = WS_WOUT + al1((size_t)DM * DM * 2);
constexpr size_t WS_WD2  = WS_WGU2 + al1((size_t)NGU * DM * 2);
constexpr size_t WS_WPG  = WS_WD2 + al1((size_t)DM * DFF * 2);
constexpr size_t WS_WPP  = WS_WPG + al1((size_t)DM * DM * 2);
constexpr size_t WS_ROPE = WS_WPP + al1((size_t)DM * PLE * 2);
constexpr size_t WS_XN1  = WS_ROPE + al1((size_t)8193 * 64 * 8);
constexpr size_t WS_ACT  = WS_XN1 + al1((size_t)MT * DM * 2);
constexpr size_t WS_H1   = WS_ACT + al1((size_t)MT * DFF * 2);
constexpr size_t WS_H1B  = WS_H1 + al1((size_t)MT * DM * 4);
constexpr size_t WS_CQB  = WS_H1B + al1((size_t)MT * DM * 2);
constexpr size_t WS_CKVF = WS_CQB + al1((size_t)MT * 256 * 2);
constexpr size_t WS_CKVB = WS_CKVF + al1((size_t)MT * 128 * 4);
constexpr size_t WS_KPEB = WS_CKVB + al1((size_t)MT * 128 * 2);
constexpr size_t WS_QR   = WS_KPEB + al1((size_t)MT * 32 * 2);
constexpr size_t WS_KR   = WS_QR + al1((size_t)MT * 512 * 2);
constexpr size_t WS_RV   = WS_KR + al1((size_t)MT * 512 * 2);
constexpr size_t WS_RGS  = WS_RV + al1((size_t)MT * 512 * 2);
constexpr size_t WS_SGA  = WS_RGS + al1((size_t)MT * 512 * 2);
constexpr size_t WS_SGR  = WS_SGA + al1((size_t)MT * DM * 2);
constexpr size_t WS_QB   = WS_SGR + al1((size_t)MT * DM * 2);
constexpr size_t WS_KN   = WS_QB + al1((size_t)MT * 768 * 2);
constexpr size_t WS_VB   = WS_KN + al1((size_t)MP * 512 * 2);
constexpr size_t WS_OCAT = WS_VB + al1((size_t)MP * 512 * 2);
constexpr size_t WS_KVC  = WS_OCAT + al1((size_t)MT * DM * 2);
constexpr size_t WS_SC   = WS_KVC + al1((size_t)512 * 16384 * 4);
constexpr size_t WS_MRG  = WS_SC + al1((size_t)512 * 16384 * 2);
constexpr size_t WS_H2   = WS_MRG + al1((size_t)MT * DM * 2);
constexpr size_t WS_H2B  = WS_H2 + al1((size_t)MT * DM * 4);
constexpr size_t WS_H3   = WS_H2B + al1((size_t)MT * DM * 2);
constexpr size_t WS_H3B  = WS_H3 + al1((size_t)MT * DM * 4);
constexpr size_t WS_PB   = WS_H3B + al1((size_t)MT * DM * 2);
constexpr size_t WS_PP   = WS_PB + al1((size_t)MT * PLE * 2);
constexpr size_t WS_H4   = WS_PP + al1((size_t)MT * DM * 2);
constexpr size_t WS_DPO  = WS_H4 + al1((size_t)MT * DM * 4);
constexpr size_t WS_DML  = WS_DPO + al1((size_t)128 * 8 * 8 * 128 * 4);
constexpr size_t WS_QLAT = WS_DML + MiB;
constexpr size_t WS_SSQ  = WS_QLAT + MiB;
constexpr size_t SSQ16_BYTES = (size_t)MT * 16 * 4, SSQ4_BYTES = (size_t)MT * 4 * 4;
constexpr size_t WS_END  = WS_SSQ + al1(4 * SSQ16_BYTES + 2 * SSQ4_BYTES);
constexpr int CW_TMO = 0, CW_BAR = 4096;

constexpr int RING_BYTES = 131072, LDSCTL_OFF = RING_BYTES, MISC_OFF = LDSCTL_OFF + 320, LDS_BYTES = 147456;

#define GAS __attribute__((address_space(1)))
#define LAS __attribute__((address_space(3)))
typedef unsigned short bf16;
typedef unsigned v4u __attribute__((ext_vector_type(4)));
typedef unsigned v2u __attribute__((ext_vector_type(2)));
typedef GAS unsigned gu32;
#define RLX_AGENT __ATOMIC_RELAXED, __HIP_MEMORY_SCOPE_AGENT
#define LDS_WAIT() asm volatile("s_waitcnt lgkmcnt(0)" ::: "memory")
#define VM_WAIT() asm volatile("s_waitcnt vmcnt(0)" ::: "memory")
__device__ __forceinline__ unsigned f2bf(float f) { unsigned u = __builtin_bit_cast(unsigned, f); return (u + 0x7fffu + ((u >> 16) & 1u)) >> 16; }
__device__ __forceinline__ unsigned pk2(float lo, float hi) { return f2bf(lo) | (f2bf(hi) << 16); }
__device__ __forceinline__ float bflo(unsigned w) { return __builtin_bit_cast(float, w << 16); }
__device__ __forceinline__ float bfhi(unsigned w) { return __builtin_bit_cast(float, w & 0xffff0000u); }
__device__ __forceinline__ float bf2f(bf16 h) { return __builtin_bit_cast(float, (unsigned)h << 16); }
__device__ __forceinline__ float sigm(float x) { return __builtin_amdgcn_rcpf(1.f + __builtin_amdgcn_exp2f(-1.4426950408889634f * x)); }
__device__ __forceinline__ float wave_sum(float v) {
#pragma unroll
    for (int o = 1; o < 64; o <<= 1) v += __shfl_xor(v, o);
    return v;
}
__device__ __forceinline__ float lg2gamma(int h) { return h == 0 ? -0.04580368961312479f : h == 1 ? -0.02272007650008353f : h == 2 ? -0.011315313227834146f : -0.005646563141142063f; }
namespace pg8 {
#define PG8_LAS __attribute__((address_space(3)))
typedef unsigned short bf16_t;
typedef short bf16x8 __attribute__((ext_vector_type(8)));
typedef float f32x4 __attribute__((ext_vector_type(4)));
typedef unsigned u32x4 __attribute__((ext_vector_type(4)));
constexpr int BM = 256, BK = 64, HALF = 128, HTB = HALF * BK * 2  , STAGE_BYTES = 8 * HTB, NXCD = 8, WGM = 8;

__host__ __device__ __forceinline__ int lds_byte(int r, int c) { const int st = (r >> 4) * 2 + (c >> 5), rr = r & 15, cc = c & 31, ob = rr * 64 + cc * 2; return st * 1024 + (ob ^ (((ob >> 9) & 1) << 5)); }
__host__ __device__ __forceinline__ void stage_rc(int b, int& R, int& C) { const int st = b / 1024, sb = b % 1024, swz = sb ^ (((sb >> 9) & 1) << 5); R = (st >> 1) * 16 + swz / 64; C = (st & 1) * 32 + (swz % 64) / 2; }
__host__ __device__ __forceinline__ int perm32(int rho) { const int n = rho >> 4, i = rho & 15; return 8 * (i >> 2) + 4 * n + (i & 3); }

struct Unit { int pm, pn; };
struct Gemm { const bf16_t* A; const bf16_t* Bt; int M, N, K; };

struct StaticOrder {
    int nM, nN, nwg, G, c;
    __host__ __device__ void init(int M, int N, int G_, int c_) { nM = M / BM; nN = N / BM; nwg = nM * nN; G = G_; c = c_; }
    __host__ __device__ bool next(int i, Unit& u) const {
        const long L = (long)i * G + c; if (L >= nwg) return false;
        int wgid = (int)L; { const int q = nwg / NXCD, r = nwg % NXCD, xcd = wgid % NXCD, off = wgid / NXCD; wgid = (xcd < r ? xcd * (q + 1) : r * (q + 1) + (xcd - r) * q) + off; }
        const int nig = WGM * nN, gid = wgid / nig, fm = gid * WGM, gsz = (nM - fm) < WGM ? (nM - fm) : WGM;
        u.pm = fm + ((wgid % nig) % gsz); u.pn = (wgid % nig) / gsz; return true;
    }
    __device__ __forceinline__ void a_ready(const Unit&) const {}
    __device__ __forceinline__ void done(const Unit&) const {}
};

typedef float cvt_f32x2_t __attribute__((ext_vector_type(2))); typedef __bf16 cvt_bf16x2_t __attribute__((ext_vector_type(2)));
__device__ __forceinline__ unsigned cvt_pk_bf16(float lo, float hi) { cvt_f32x2_t v = {lo, hi}; cvt_bf16x2_t b = __builtin_convertvector(v, cvt_bf16x2_t); return __builtin_bit_cast(unsigned, b); }
typedef float f32x2 __attribute__((ext_vector_type(2)));
template <class Epi, class Sched, bool ALIGN_EPI = false, bool SP2 = false>
__device__ __forceinline__ void gemm_phase(PG8_LAS unsigned char* lds, const Gemm g, const Sched S, const Epi E) {
    int tid_ = threadIdx.x; asm volatile("" : "+v"(tid_));
    const int tid = tid_, wid = __builtin_amdgcn_readfirstlane(tid >> 6), lane = tid & 63, wr = wid >> 2, wc = wid & 3, fr = lane & 15, fq = lane >> 4;
    const int K = g.K, nt = K / BK;
    unsigned voffA[2], voffB[2];
#pragma unroll
    for (int i = 0; i < 2; ++i) { int R, C; stage_rc(tid * 16 + i * 8192, R, C); const int Rb = Epi::PERM ? ((R & ~31) + perm32(R & 31)) : R;
        voffA[i] = (unsigned)(R * K + C) * 2u; voffB[i] = (unsigned)(Rb * K + C) * 2u; }
    const size_t kstep = (size_t)(BK * 2);
    const size_t hstep = (size_t)HALF * K * 2;
    const size_t tstep = 2 * hstep;
    const unsigned ldsw = (unsigned)wid * 1024u;
    const int aoff = lds_byte(wr * 64 + fr, fq * 8), boff = lds_byte(wc * 32 + fr, fq * 8);
#define PG8_SA(b, h) (((b) * 2 + (h)) * HTB)
#define PG8_SB(b, h) ((4 + (b) * 2 + (h)) * HTB)
#define PG8_STAGE(bufoff, gbase, voff) do { _Pragma("unroll") for (int _i = 0; _i < 2; ++_i) \
        __builtin_amdgcn_global_load_lds((const unsigned*)((const char*)(gbase) + (voff)[_i]), (PG8_LAS unsigned*)(lds + (bufoff) + ldsw + _i * 8192), 16, 0, 0); } while (0)
#define PG8_LDA(dst, b, h) do { _Pragma("unroll") for (int m = 0; m < 4; ++m) _Pragma("unroll") for (int k = 0; k < 2; ++k) dst[m][k] = *(const PG8_LAS bf16x8*)(lds + PG8_SA(b, h) + aoff + m * 2048 + k * 1024); } while (0)
#define PG8_LDB(dst, b, h) do { _Pragma("unroll") for (int n = 0; n < 2; ++n) _Pragma("unroll") for (int k = 0; k < 2; ++k) dst[n][k] = *(const PG8_LAS bf16x8*)(lds + PG8_SB(b, h) + boff + n * 2048 + k * 1024); } while (0)
#define PG8_MMA(ai, bj, At, Bt) do { __builtin_amdgcn_s_setprio(1); _Pragma("unroll") for (int m = 0; m < 4; ++m) _Pragma("unroll") for (int n = 0; n < 2; ++n) _Pragma("unroll") for (int k = 0; k < 2; ++k) \
        acc[ai][bj][m][n] = __builtin_amdgcn_mfma_f32_16x16x32_bf16(Bt[n][k], At[m][k], acc[ai][bj][m][n], 0, 0, 0); __builtin_amdgcn_s_setprio(0); } while (0)
#define PG8_WAIT_V(n) asm volatile("s_waitcnt vmcnt(" #n ")" ::: "memory")
#define PG8_WAIT_L(n) asm volatile("s_waitcnt lgkmcnt(" #n ")" ::: "memory")
#define PG8_BAR __builtin_amdgcn_s_barrier()
#define PG8_SCHED __builtin_amdgcn_sched_barrier(0)
    Unit cur, nxt; int ui = 0;
    if (!S.next(0, cur)) return;
    f32x4 acc[2][2][4][2];
#pragma unroll
    for (int a = 0; a < 2; ++a)
#pragma unroll
        for (int b = 0; b < 2; ++b)
#pragma unroll
            for (int m = 0; m < 4; ++m)
#pragma unroll
                for (int n = 0; n < 2; ++n) acc[a][b][m][n] = (f32x4){0.f, 0.f, 0.f, 0.f};
    bf16x8 At[4][2], B0[2][2], B1[2][2];
    const char* cA = (const char*)g.A + (size_t)cur.pm * tstep; const char* cB = (const char*)g.Bt + (size_t)cur.pn * tstep;
    S.a_ready(cur);
    if constexpr (SP2) {
        PG8_STAGE(PG8_SB(0, 0), cB, voffB); PG8_STAGE(PG8_SB(0, 1), cB + hstep, voffB); PG8_STAGE(PG8_SA(0, 0), cA, voffA); PG8_STAGE(PG8_SA(0, 1), cA + hstep, voffA);
        if (wr == 1) PG8_BAR;
        PG8_WAIT_V(2); PG8_BAR;
        PG8_STAGE(PG8_SB(1, 0), cB + kstep, voffB); PG8_STAGE(PG8_SA(1, 0), cA + kstep, voffA); PG8_STAGE(PG8_SB(1, 1), cB + hstep + kstep, voffB);
        PG8_WAIT_V(6); PG8_BAR;
    } else {
        PG8_STAGE(PG8_SB(0, 0), cB, voffB); PG8_STAGE(PG8_SA(0, 0), cA, voffA); PG8_STAGE(PG8_SB(0, 1), cB + hstep, voffB); PG8_STAGE(PG8_SA(0, 1), cA + hstep, voffA);
        if (wr == 1) PG8_BAR;
        PG8_WAIT_V(4); PG8_BAR;
        PG8_STAGE(PG8_SB(1, 0), cB + kstep, voffB); PG8_STAGE(PG8_SA(1, 0), cA + kstep, voffA); PG8_STAGE(PG8_SB(1, 1), cB + hstep + kstep, voffB);
        PG8_WAIT_V(6); PG8_BAR;
    }
    for (;;) {
        const bool has_next = S.next(ui + 1, nxt);
        const char* nA = has_next ? (const char*)g.A + (size_t)nxt.pm * tstep : cA; const char* nB = has_next ? (const char*)g.Bt + (size_t)nxt.pn * tstep : cB;
#pragma nounroll
        for (int t = 0; t < nt; t += 2) {
            if constexpr (Epi::HAS_MID) { if (t == E.mid_t) E.mid(acc, cur, wr, wc, fr, fq); }
            const bool last = (t == nt - 2);
            const char* a1 = cA + (size_t)(t + 1) * kstep;
            const char* a2 = last ? nA : cA + (size_t)(t + 2) * kstep; const char* b2 = last ? nB : cB + (size_t)(t + 2) * kstep;
            const char* a3 = a2 + kstep; const char* b3 = b2 + kstep;
            if (last && has_next) S.a_ready(nxt);
            if constexpr (SP2) {
            PG8_LDB(B0, 0, 0); PG8_LDB(B1, 0, 1); PG8_SCHED; PG8_LDA(At, 0, 0); PG8_STAGE(PG8_SA(1, 1), a1 + hstep, voffA);
            PG8_WAIT_V(8); PG8_WAIT_L(0); PG8_BAR; PG8_MMA(0, 0, At, B0); PG8_MMA(0, 1, At, B1); PG8_BAR; PG8_SCHED;
            PG8_LDA(At, 0, 1); PG8_STAGE(PG8_SB(0, 0), b2, voffB); PG8_STAGE(PG8_SB(0, 1), b2 + hstep, voffB); PG8_STAGE(PG8_SA(0, 0), a2, voffA);
            PG8_WAIT_V(8); PG8_WAIT_L(0); PG8_BAR; PG8_MMA(1, 0, At, B0); PG8_MMA(1, 1, At, B1); PG8_BAR; PG8_SCHED;
            PG8_LDB(B0, 1, 0); PG8_LDB(B1, 1, 1); PG8_SCHED; PG8_LDA(At, 1, 0); PG8_STAGE(PG8_SA(0, 1), a2 + hstep, voffA);
            PG8_WAIT_V(8); PG8_WAIT_L(0); PG8_BAR; PG8_MMA(0, 0, At, B0); PG8_MMA(0, 1, At, B1); PG8_BAR; PG8_SCHED;
            PG8_LDA(At, 1, 1); PG8_STAGE(PG8_SB(1, 0), b3, voffB); PG8_STAGE(PG8_SB(1, 1), b3 + hstep, voffB); PG8_STAGE(PG8_SA(1, 0), a3, voffA);
            PG8_WAIT_V(8); PG8_WAIT_L(0); PG8_BAR; PG8_MMA(1, 0, At, B0); PG8_MMA(1, 1, At, B1); PG8_BAR; PG8_SCHED;
            } else {
            PG8_LDB(B0, 0, 0); PG8_SCHED; PG8_LDA(At, 0, 0); PG8_STAGE(PG8_SA(1, 1), a1 + hstep, voffA);
            PG8_WAIT_L(8); PG8_BAR; PG8_WAIT_L(0); PG8_MMA(0, 0, At, B0); PG8_BAR; PG8_SCHED;
            PG8_LDB(B1, 0, 1); PG8_STAGE(PG8_SB(0, 0), b2, voffB);
            PG8_BAR; PG8_WAIT_L(0); PG8_MMA(0, 1, At, B1); PG8_BAR;
            PG8_LDA(At, 0, 1); PG8_STAGE(PG8_SA(0, 0), a2, voffA);
            PG8_BAR; PG8_WAIT_L(0); PG8_MMA(1, 0, At, B0); PG8_BAR; PG8_SCHED;
            PG8_STAGE(PG8_SB(0, 1), b2 + hstep, voffB);
            PG8_WAIT_V(6); PG8_BAR; PG8_MMA(1, 1, At, B1); PG8_BAR;
            PG8_LDB(B0, 1, 0); PG8_SCHED; PG8_LDA(At, 1, 0); PG8_STAGE(PG8_SA(0, 1), a2 + hstep, voffA);
            PG8_WAIT_L(8); PG8_BAR; PG8_WAIT_L(0); PG8_MMA(0, 0, At, B0); PG8_BAR; PG8_SCHED;
            PG8_LDB(B1, 1, 1); PG8_STAGE(PG8_SB(1, 0), b3, voffB);
            PG8_BAR; PG8_WAIT_L(0); PG8_MMA(0, 1, At, B1); PG8_BAR;
            PG8_LDA(At, 1, 1); PG8_STAGE(PG8_SA(1, 0), a3, voffA);
            PG8_BAR; PG8_WAIT_L(0); PG8_MMA(1, 0, At, B0); PG8_BAR; PG8_SCHED;
            PG8_STAGE(PG8_SB(1, 1), b3 + hstep, voffB);
            PG8_WAIT_V(6); PG8_BAR; PG8_MMA(1, 1, At, B1); PG8_BAR;
            }
        }
        if constexpr (ALIGN_EPI) { if (wr == 0) PG8_BAR; }
        if constexpr (!Epi::AFTER_DRAIN) { E(acc, cur, wr, wc, fr, fq); S.done(cur); }
        if (!has_next) break;
#pragma unroll
        for (int a = 0; a < 2; ++a)
#pragma unroll
            for (int b = 0; b < 2; ++b)
#pragma unroll
                for (int m = 0; m < 4; ++m)
#pragma unroll
                    for (int n = 0; n < 2; ++n) acc[a][b][m][n] = (f32x4){0.f, 0.f, 0.f, 0.f};
        cur = nxt; cA = nA; cB = nB; ++ui;
        if constexpr (ALIGN_EPI) { if (wr == 1) PG8_BAR; }
    }
    PG8_WAIT_V(0);
    if constexpr (!ALIGN_EPI) { if (wr == 0) PG8_BAR; }
    PG8_BAR;
    if constexpr (Epi::AFTER_DRAIN) { E.fused(acc, cur, wr, wc, fr, fq, lds, wid, lane); S.done(cur); }
#undef PG8_SA
#undef PG8_SB
#undef PG8_STAGE
#undef PG8_LDA
#undef PG8_LDB
#undef PG8_MMA
#undef PG8_WAIT_V
#undef PG8_WAIT_L
#undef PG8_BAR
#undef PG8_SCHED
}
}
namespace pg8 {
#define EPI_ROWS(ai, m) (u.pm * BM + (ai) * HALF + wr * 64 + (m) * 16 + fr)
#define EPI_OPAQUE int fr = fr_, fq = fq_; asm volatile("" : "+v"(fr), "+v"(fq))
__device__ __forceinline__ u32x4 pack8(f32x4 a, f32x4 b) { u32x4 w; w.x = cvt_pk_bf16(a[0], a[1]); w.y = cvt_pk_bf16(a[2], a[3]); w.z = cvt_pk_bf16(b[0], b[1]); w.w = cvt_pk_bf16(b[2], b[3]); return w; }
__device__ __forceinline__ float sq4(f32x4 a) { return (a[0] * a[0] + a[1] * a[1]) + (a[2] * a[2] + a[3] * a[3]); }
template <int NS> __device__ __forceinline__ float rstd_of(const float* part, int row, float invn) {
    float s = 0.f;
#pragma unroll
    for (int i = 0; i < NS; i += 4) { const f32x4 v = *(const f32x4*)(part + (size_t)row * NS + i); s += (v[0] + v[1]) + (v[2] + v[3]); }
    return 1.0f / sqrtf(s * invn + EPS);
}
template <int NS> __device__ __forceinline__ void ssq_put(float* part, int row, int slot, float s, int fq) { s += __shfl_xor(s, 16); s += __shfl_xor(s, 32); if (fq == 0) part[(size_t)row * NS + slot] = s; }
__device__ __forceinline__ float silu_f(float x) { return x * sigm(x); }
__device__ __forceinline__ int pos_of_row(int row) { return row < MP ? (row & (TSEQ - 1)) : TSEQ; }

struct EpiSwiGLU {
    static constexpr bool PERM = true, AFTER_DRAIN = false, HAS_MID = false; int mid_t;
    bf16_t* O; const float* ssq;
    __device__ __forceinline__ void mid(f32x4 (&)[2][2][4][2], const Unit&, int, int, int, int) const {}
    __device__ __forceinline__ void operator()(const f32x4 (&acc)[2][2][4][2], const Unit& u, int wr, int wc, int fr_, int fq_) const { EPI_OPAQUE;
        const int col0 = u.pn * HALF + wc * 32 + 8 * fq;
#pragma unroll
        for (int ai = 0; ai < 2; ++ai)
#pragma unroll
            for (int m = 0; m < 4; ++m) { const int row = EPI_ROWS(ai, m); const float rs = ssq ? rstd_of<16>(ssq, row, 1.0f / DM) : 1.0f;
                f32x4 o[2];
#pragma unroll
                for (int n = 0; n < 2; ++n)
#pragma unroll
                    for (int j = 0; j < 4; ++j) o[n][j] = silu_f(acc[ai][0][m][n][j] * rs) * (acc[ai][1][m][n][j] * rs);
                *(u32x4*)(O + (size_t)row * DFF + col0) = pack8(o[0], o[1]); }
    }
};

template <bool HALFA> struct EpiResid {
    static constexpr bool PERM = true, AFTER_DRAIN = false, HAS_MID = false; int mid_t; static constexpr float alpha = HALFA ? 0.5f : 1.0f;
    const float* R; const float* Rs; int mode; float* Hf; bf16_t* Hb; float* ssq;
    __device__ __forceinline__ void mid(f32x4 (&)[2][2][4][2], const Unit&, int, int, int, int) const {}
    __device__ __forceinline__ void operator()(const f32x4 (&acc)[2][2][4][2], const Unit& u, int wr, int wc, int fr_, int fq_) const { EPI_OPAQUE;
        const int colb = u.pn * BM + wc * 32 + 8 * fq;
#pragma unroll
        for (int ai = 0; ai < 2; ++ai)
#pragma unroll
            for (int m = 0; m < 4; ++m) { const int row = EPI_ROWS(ai, m);
                const bool pad = (mode == 0) && row >= MP + MS; const float keep = pad ? 0.f : 1.f;
                const float* rp = (mode == 0 && row >= MP) ? (pad ? R : Rs + (size_t)(row - MP) * DM) : R + (size_t)row * DM;
                float s = 0.f;
#pragma unroll
                for (int bj = 0; bj < 2; ++bj) { const int col = colb + bj * HALF;
                    const f32x4 r0 = *(const f32x4*)(rp + col) * keep, r1 = *(const f32x4*)(rp + col + 4) * keep;
                    const f32x4 h0 = r0 + acc[ai][bj][m][0] * alpha, h1 = r1 + acc[ai][bj][m][1] * alpha;
                    *(f32x4*)(Hf + (size_t)row * DM + col) = h0; *(f32x4*)(Hf + (size_t)row * DM + col + 4) = h1;
                    *(u32x4*)(Hb + (size_t)row * DM + col) = pack8(h0, h1);
                    s += sq4(h0) + sq4(h1); }
                ssq_put<16>(ssq, row, u.pn * 4 + wc, s, fq); }
    }
};

__device__ __forceinline__ void rope4(const float2* tabrow, int i0, int istride, f32x4 x1, f32x4 x2, f32x4& y1, f32x4& y2) {
#pragma unroll
    for (int j = 0; j < 4; ++j) { const float2 cs = tabrow[(i0 + j) * istride]; y1[j] = x1[j] * cs.x - x2[j] * cs.y; y2[j] = x1[j] * cs.y + x2[j] * cs.x; }
}

struct EpiWin {
    static constexpr bool PERM = true, AFTER_DRAIN = false, HAS_MID = false; int mid_t;
    const float* ssq1; float* ssq_cq; float* ssq_kv; const float2* rope; float* dout;
    bf16_t *CQB, *CKVB, *KPEB, *QR, *KR, *RV, *RGS, *SGA, *SGR; float* CKVF;
    __device__ __forceinline__ void mid(f32x4 (&)[2][2][4][2], const Unit&, int, int, int, int) const {}
    __device__ __forceinline__ void operator()(const f32x4 (&acc)[2][2][4][2], const Unit& u, int wr, int wc, int fr_, int fq_) const { EPI_OPAQUE;
        const int pn = u.pn, c8 = wc * 32 + 8 * fq;
#pragma unroll
        for (int ai = 0; ai < 2; ++ai)
#pragma unroll
            for (int m = 0; m < 4; ++m) { const int row = EPI_ROWS(ai, m); const float rs = rstd_of<16>(ssq1, row, 1.0f / DM);
                if (pn == 0) {
                    float s = 0.f;
#pragma unroll
                    for (int bj = 0; bj < 2; ++bj) { const f32x4 a = acc[ai][bj][m][0] * rs, b = acc[ai][bj][m][1] * rs; s += sq4(a) + sq4(b);
                        *(u32x4*)(CQB + (size_t)row * QL + bj * HALF + c8) = pack8(a, b); }
                    ssq_put<4>(ssq_cq, row, wc, s, fq);
                } else if (pn == 1) {
                    { const f32x4 a = acc[ai][0][m][0] * rs, b = acc[ai][0][m][1] * rs;
                      *(f32x4*)(CKVF + (size_t)row * KVL + c8) = a; *(f32x4*)(CKVF + (size_t)row * KVL + c8 + 4) = b;
                      *(u32x4*)(CKVB + (size_t)row * KVL + c8) = pack8(a, b);
                      ssq_put<4>(ssq_kv, row, wc, sq4(a) + sq4(b), fq); }
                    if (wc == 0) { f32x4 y1, y2; rope4(rope + (size_t)pos_of_row(row) * 64, 4 * fq, 4, acc[ai][1][m][0] * rs, acc[ai][1][m][1] * rs, y1, y2);
                        float* o = row < MP ? dout + O_KPEP + (size_t)row * RPE : (row < MP + MS ? dout + O_KPES + (size_t)(row - MP) * RPE : nullptr);
                        if (o) { *(f32x4*)(o + 4 * fq) = y1; *(f32x4*)(o + 16 + 4 * fq) = y2; }
                        v2u w1, w2; w1.x = cvt_pk_bf16(y1[0], y1[1]); w1.y = cvt_pk_bf16(y1[2], y1[3]); w2.x = cvt_pk_bf16(y2[0], y2[1]); w2.y = cvt_pk_bf16(y2[2], y2[3]);
                        *(v2u*)(KPEB + (size_t)row * RPE + 4 * fq) = w1; *(v2u*)(KPEB + (size_t)row * RPE + 16 + 4 * fq) = w2; }
                } else if (pn < 6) {
                    const bool isk = pn >= 4; const int ic = row < MP ? (row & 127) : 0; const float2* tr = rope + (size_t)pos_of_row(row) * 64;
#pragma unroll
                    for (int bj = 0; bj < 2; ++bj) { const int hh = 2 * (pn - (isk ? 4 : 2)) + bj; const float lg = lg2gamma(hh) * (float)ic;
                        const float fs = rs * (isk ? __builtin_amdgcn_exp2f(-lg) * 0.08838834764831845f : __builtin_amdgcn_exp2f(lg));
                        f32x4 y1, y2; rope4(tr, 16 * wc + 4 * fq, 1, acc[ai][bj][m][0] * fs, acc[ai][bj][m][1] * fs, y1, y2);
                        bf16_t* o = (isk ? KR : QR) + (size_t)row * 512 + hh * 128 + 16 * wc + 4 * fq;
                        v2u w1, w2; w1.x = cvt_pk_bf16(y1[0], y1[1]); w1.y = cvt_pk_bf16(y1[2], y1[3]); w2.x = cvt_pk_bf16(y2[0], y2[1]); w2.y = cvt_pk_bf16(y2[2], y2[3]);
                        *(v2u*)o = w1; *(v2u*)(o + 64) = w2; }
                } else if (pn < 8) {
#pragma unroll
                    for (int bj = 0; bj < 2; ++bj) *(u32x4*)(RV + (size_t)row * 512 + (pn - 6) * BM + bj * HALF + c8) = pack8(acc[ai][bj][m][0] * rs, acc[ai][bj][m][1] * rs);
                } else if (pn < 10) {
#pragma unroll
                    for (int bj = 0; bj < 2; ++bj) { f32x4 a = acc[ai][bj][m][0] * rs, b = acc[ai][bj][m][1] * rs;
#pragma unroll
                        for (int j = 0; j < 4; ++j) { a[j] = silu_f(a[j]); b[j] = silu_f(b[j]); }
                        *(u32x4*)(RGS + (size_t)row * 512 + (pn - 8) * BM + bj * HALF + c8) = pack8(a, b); }
                } else {
                    bf16_t* base = pn < 14 ? SGA + (size_t)(pn - 10) * BM : SGR + (size_t)(pn - 14) * BM;
#pragma unroll
                    for (int bj = 0; bj < 2; ++bj) { f32x4 a = acc[ai][bj][m][0] * rs, b = acc[ai][bj][m][1] * rs;
#pragma unroll
                        for (int j = 0; j < 4; ++j) { a[j] = sigm(a[j]); b[j] = sigm(b[j]); }
                        *(u32x4*)(base + (size_t)row * DM + bj * HALF + c8) = pack8(a, b); }
                }
            }
    }
};

struct EpiQB {
    static constexpr bool PERM = true, AFTER_DRAIN = false, HAS_MID = false; int mid_t;
    const float* ssq_cq; const float2* rope; bf16_t* QB;
    __device__ __forceinline__ void mid(f32x4 (&)[2][2][4][2], const Unit&, int, int, int, int) const {}
    __device__ __forceinline__ void operator()(const f32x4 (&acc)[2][2][4][2], const Unit& u, int wr, int wc, int fr_, int fq_) const { EPI_OPAQUE;
#pragma unroll
        for (int ai = 0; ai < 2; ++ai)
#pragma unroll
            for (int m = 0; m < 4; ++m) { const int row = EPI_ROWS(ai, m); const float rs = rstd_of<4>(ssq_cq, row, 1.0f / QL);
                bf16_t* qrow = QB + (size_t)row * 768;
                if (u.pn < 2) {
#pragma unroll
                    for (int bj = 0; bj < 2; ++bj) { const int cidx = bj * HALF + wc * 32 + 8 * fq, hh = u.pn * 4 + (cidx >> 6), d = cidx & 63;
                        *(u32x4*)(qrow + hh * QKD + d) = pack8(acc[ai][bj][m][0] * rs, acc[ai][bj][m][1] * rs); }
                } else { const float2* tr = rope + (size_t)pos_of_row(row) * 64;
#pragma unroll
                    for (int bj = 0; bj < 2; ++bj) { const int hh = bj * 4 + wc; f32x4 y1, y2; rope4(tr, 4 * fq, 4, acc[ai][bj][m][0] * rs, acc[ai][bj][m][1] * rs, y1, y2);
                        v2u w1, w2; w1.x = cvt_pk_bf16(y1[0], y1[1]); w1.y = cvt_pk_bf16(y1[2], y1[3]); w2.x = cvt_pk_bf16(y2[0], y2[1]); w2.y = cvt_pk_bf16(y2[2], y2[3]);
                        *(v2u*)(qrow + hh * QKD + 64 + 4 * fq) = w1; *(v2u*)(qrow + hh * QKD + 80 + 4 * fq) = w2; }
                }
                asm volatile("" ::: "memory");
            }
    }
};

struct EpiPlain {
    static constexpr bool PERM = true, AFTER_DRAIN = false, HAS_MID = false; int mid_t;
    bf16_t* O0; bf16_t* O1; int ld; int split_tiles; const float* ssq; float invn;
    __device__ __forceinline__ void mid(f32x4 (&)[2][2][4][2], const Unit&, int, int, int, int) const {}
    __device__ __forceinline__ void operator()(const f32x4 (&acc)[2][2][4][2], const Unit& u, int wr, int wc, int fr_, int fq_) const { EPI_OPAQUE;
        bf16_t* base = u.pn < split_tiles ? O0 + (size_t)u.pn * BM : O1 + (size_t)(u.pn - split_tiles) * BM;
#pragma unroll
        for (int ai = 0; ai < 2; ++ai)
#pragma unroll
            for (int m = 0; m < 4; ++m) { const int row = EPI_ROWS(ai, m); const float rs = ssq ? rstd_of<4>(ssq, row, invn) : 1.0f;
#pragma unroll
                for (int bj = 0; bj < 2; ++bj) *(u32x4*)(base + (size_t)row * ld + bj * HALF + wc * 32 + 8 * fq) = pack8(acc[ai][bj][m][0] * rs, acc[ai][bj][m][1] * rs); }
    }
};

struct EpiMerge {
    static constexpr bool PERM = true, AFTER_DRAIN = false, HAS_MID = true; int mid_t;
    const bf16_t* SGA; const bf16_t* SGR; bf16_t* O;
    __device__ __forceinline__ void mid(f32x4 (&acc)[2][2][4][2], const Unit& u, int wr, int wc, int fr_, int fq) const {
        int fr = fr_; asm volatile("" : "+v"(fr));
#pragma unroll
        for (int ai = 0; ai < 2; ++ai)
#pragma unroll
            for (int m = 0; m < 4; ++m) { const int row = EPI_ROWS(ai, m);
#pragma unroll
                for (int bj = 0; bj < 2; ++bj) { const size_t off = (size_t)row * DM + u.pn * BM + bj * HALF + wc * 32 + 8 * fq;
                    const u32x4 a = *(const u32x4*)(SGA + off), r = *(const u32x4*)(SGR + off);
#pragma unroll
                    for (int q = 0; q < 4; ++q) { const float alo = bflo(a[q]), ahi = bfhi(a[q]), rlo = fmaxf(bflo(r[q]), 1e-30f), rhi = fmaxf(bfhi(r[q]), 1e-30f);
                        acc[ai][bj][m][q >> 1][(q & 1) * 2] *= alo * __builtin_amdgcn_rcpf(rlo); acc[ai][bj][m][q >> 1][(q & 1) * 2 + 1] *= ahi * __builtin_amdgcn_rcpf(rhi); } }
                asm volatile("" ::: "memory"); }
    }
    __device__ __forceinline__ void operator()(const f32x4 (&acc)[2][2][4][2], const Unit& u, int wr, int wc, int fr_, int fq_) const { EPI_OPAQUE;
#pragma unroll
        for (int ai = 0; ai < 2; ++ai)
#pragma unroll
            for (int m = 0; m < 4; ++m) { const int row = EPI_ROWS(ai, m);
#pragma unroll
                for (int bj = 0; bj < 2; ++bj) { const size_t off = (size_t)row * DM + u.pn * BM + bj * HALF + wc * 32 + 8 * fq;
                    const u32x4 r = *(const u32x4*)(SGR + off); f32x4 o0, o1;
                    o0[0] = acc[ai][bj][m][0][0] * fmaxf(bflo(r[0]), 1e-30f); o0[1] = acc[ai][bj][m][0][1] * fmaxf(bfhi(r[0]), 1e-30f);
                    o0[2] = acc[ai][bj][m][0][2] * fmaxf(bflo(r[1]), 1e-30f); o0[3] = acc[ai][bj][m][0][3] * fmaxf(bfhi(r[1]), 1e-30f);
                    o1[0] = acc[ai][bj][m][1][0] * fmaxf(bflo(r[2]), 1e-30f); o1[1] = acc[ai][bj][m][1][1] * fmaxf(bfhi(r[2]), 1e-30f);
                    o1[2] = acc[ai][bj][m][1][2] * fmaxf(bflo(r[3]), 1e-30f); o1[3] = acc[ai][bj][m][1][3] * fmaxf(bfhi(r[3]), 1e-30f);
                    *(u32x4*)(O + off) = pack8(o0, o1); }
                asm volatile("" ::: "memory"); }
    }
};

struct EpiPle {
    static constexpr bool PERM = true, AFTER_DRAIN = false, HAS_MID = false; int mid_t;
    const float* H3; const bf16_t* PP; const float* ssq3; float* H4; float* ssq4;
    __device__ __forceinline__ void mid(f32x4 (&)[2][2][4][2], const Unit&, int, int, int, int) const {}
    __device__ __forceinline__ void operator()(const f32x4 (&acc)[2][2][4][2], const Unit& u, int wr, int wc, int fr_, int fq_) const { EPI_OPAQUE;
#pragma unroll
        for (int ai = 0; ai < 2; ++ai)
#pragma unroll
            for (int m = 0; m < 4; ++m) { const int row = EPI_ROWS(ai, m); const float rs = rstd_of<16>(ssq3, row, 1.0f / DM); float s = 0.f;
#pragma unroll
                for (int bj = 0; bj < 2; ++bj) { const size_t off = (size_t)row * DM + u.pn * BM + bj * HALF + wc * 32 + 8 * fq;
                    const u32x4 p = *(const u32x4*)(PP + off); const f32x4 r0 = *(const f32x4*)(H3 + off), r1 = *(const f32x4*)(H3 + off + 4);
                    f32x4 h0, h1;
                    h0[0] = r0[0] + sigm(acc[ai][bj][m][0][0] * rs) * bflo(p[0]); h0[1] = r0[1] + sigm(acc[ai][bj][m][0][1] * rs) * bfhi(p[0]);
                    h0[2] = r0[2] + sigm(acc[ai][bj][m][0][2] * rs) * bflo(p[1]); h0[3] = r0[3] + sigm(acc[ai][bj][m][0][3] * rs) * bfhi(p[1]);
                    h1[0] = r1[0] + sigm(acc[ai][bj][m][1][0] * rs) * bflo(p[2]); h1[1] = r1[1] + sigm(acc[ai][bj][m][1][1] * rs) * bfhi(p[2]);
                    h1[2] = r1[2] + sigm(acc[ai][bj][m][1][2] * rs) * bflo(p[3]); h1[3] = r1[3] + sigm(acc[ai][bj][m][1][3] * rs) * bfhi(p[3]);
                    *(f32x4*)(H4 + off) = h0; *(f32x4*)(H4 + off + 4) = h1; s += sq4(h0) + sq4(h1); }
                ssq_put<16>(ssq4, row, u.pn * 4 + wc, s, fq); }
    }
};
#undef EPI_ROWS
#undef EPI_OPAQUE
}
namespace att {
using bf16x8 = __attribute__((ext_vector_type(8))) short;
using s16x4 = __attribute__((ext_vector_type(4))) short;
using f32x16 = __attribute__((ext_vector_type(16))) float;
using u32x4 = __attribute__((ext_vector_type(4))) unsigned;
typedef __attribute__((address_space(3))) const char* lds_cptr;
typedef __attribute__((address_space(3))) char* lds_ptr;
constexpr int KSLOT = 12288, VSLOT = 8192;
constexpr int L_K = 0, L_V = 2 * KSLOT, L_WS = L_V + 2 * VSLOT, L_OST = L_WS + 8 * 256, L_END = L_OST + 8 * 4096;
static_assert(L_END <= RING_BYTES, "attention LDS");
__device__ __forceinline__ int crow(int r, int hi) { return (r & 3) + 8 * (r >> 2) + 4 * hi; }
__device__ __forceinline__ void glds16(const void* gsrc, unsigned lds_dst) { unsigned keep;
    asm volatile("s_mov_b32 %0, m0\n\ts_mov_b32 m0, %2\n\ts_nop 0\n\tglobal_load_lds_dwordx4 %1, off\n\ts_mov_b32 m0, %0" : "=&s"(keep) : "v"(gsrc), "s"(lds_dst) : "memory"); }
typedef float f32x2_t __attribute__((ext_vector_type(2))); typedef __bf16 bf16x2_t __attribute__((ext_vector_type(2)));
__device__ __forceinline__ unsigned cvtpk_s(float lo, float hi) { f32x2_t v = {lo, hi}; bf16x2_t b = __builtin_convertvector(v, bf16x2_t); return __builtin_bit_cast(unsigned, b); }
__device__ __forceinline__ float swap32_max(float m) { auto rr = __builtin_amdgcn_permlane32_swap(__float_as_uint(m), __float_as_uint(m), false, false); return fmaxf(__uint_as_float(rr[0]), __uint_as_float(rr[1])); }
__device__ __forceinline__ float swap32_sum(float m) { auto rr = __builtin_amdgcn_permlane32_swap(__float_as_uint(m), __float_as_uint(m), false, false); return __uint_as_float(rr[0]) + __uint_as_float(rr[1]); }

__device__ __forceinline__ void pv(f32x16* o, int vb, bf16x8 pa0, bf16x8 pa1, bf16x8 pa2, bf16x8 pa3) {
#pragma unroll
    for (int d0 = 0; d0 < 2; ++d0) { s16x4 lo[4], hi[4];
#pragma unroll
        for (int ks = 0; ks < 4; ++ks) {
            asm volatile("ds_read_b64_tr_b16 %0,%1 offset:%c2" : "=&v"(lo[ks]) : "v"(vb), "i"(d0 * 4096 + ks * 1024) : "memory");
            asm volatile("ds_read_b64_tr_b16 %0,%1 offset:%c2" : "=&v"(hi[ks]) : "v"(vb), "i"(d0 * 4096 + ks * 1024 + 512) : "memory"); }
        asm volatile("s_waitcnt lgkmcnt(0)" ::: "memory"); __builtin_amdgcn_sched_barrier(0);
#define PK(k) (bf16x8){lo[k][0], lo[k][1], lo[k][2], lo[k][3], hi[k][0], hi[k][1], hi[k][2], hi[k][3]}
        o[d0] = __builtin_amdgcn_mfma_f32_32x32x16_bf16(pa0, PK(0), o[d0], 0, 0, 0);
        o[d0] = __builtin_amdgcn_mfma_f32_32x32x16_bf16(pa1, PK(1), o[d0], 0, 0, 0);
        o[d0] = __builtin_amdgcn_mfma_f32_32x32x16_bf16(pa2, PK(2), o[d0], 0, 0, 0);
        o[d0] = __builtin_amdgcn_mfma_f32_32x32x16_bf16(pa3, PK(3), o[d0], 0, 0, 0);
#undef PK
    }
}

__device__ __forceinline__ void attn_unit(int b, int h, int qb, const bf16* Q, const bf16* KN, const bf16* KPE, const bf16* VB, bf16* O, char* shm) {
    int tid_ = threadIdx.x; asm volatile("" : "+v"(tid_)); const int tid = tid_, lane = tid & 63, r32 = lane & 31, hi = lane >> 5; const int wid = __builtin_amdgcn_readfirstlane(tid >> 6);
    const long rowbase = (long)b * TSEQ; const int q0 = qb * 256;
    const bf16* Qw = Q + (rowbase + q0 + wid * 32) * 768 + h * QKD;
    const unsigned lds0 = (unsigned)(uintptr_t)shm;
    const lds_ptr shm3 = (lds_ptr)shm;
    LAS float* wsf = (LAS float*)(shm3 + L_WS) + wid * 64;
    const bf16* ksrc0 = KN + (rowbase + lane) * 512 + h * 64 + wid * 8;
    const bf16* ksrc1 = KPE + (rowbase + lane) * RPE + (wid & 3) * 8;
    const bf16* vsrc = VB + (rowbase + 16 * (wid & 3) + (lane >> 2)) * 512 + h * 64 + (wid >> 2) * 32 + (lane & 3) * 8;
    const unsigned kdst0 = lds0 + L_K + wid * 1024, kdst1 = lds0 + L_K + (8 + (wid & 3)) * 1024, vdst = lds0 + L_V + wid * 1024;
#define ATT_DMA(t, s) do { glds16(ksrc0 + (long)(t) * 64 * 512, (unsigned)__builtin_amdgcn_readfirstlane(kdst0 + (s) * KSLOT)); \
                           glds16(ksrc1 + (long)(t) * 64 * RPE, (unsigned)__builtin_amdgcn_readfirstlane(kdst1 + (s) * KSLOT)); \
                           glds16(vsrc + (long)(t) * 64 * 512, (unsigned)__builtin_amdgcn_readfirstlane(vdst + (s) * VSLOT)); } while (0)
    const int vb0 = (int)(lds0 + L_V) + ((lane >> 4) & 1) * 32 + (lane & 3) * 8 + (4 * hi + ((lane & 15) >> 2)) * 64;
    const lds_cptr kp0 = (lds_cptr)shm3 + L_K + hi * 1024 + r32 * 16;
    const int NT = (q0 + 256) / 64;
    ATT_DMA(0, 0);
    bf16x8 qr[6];
#pragma unroll
    for (int d0 = 0; d0 < 6; ++d0) qr[d0] = *reinterpret_cast<const bf16x8*>(&Qw[(long)r32 * 768 + d0 * 16 + hi * 8]);
    float m_run = -INFINITY, l_run = 0.f; f32x16 o[2]; o[0] = f32x16{}; o[1] = f32x16{};
    const int qrel = wid * 32 + r32;
    for (int t = 0; t < NT; ++t) {
        asm volatile("s_waitcnt vmcnt(0) lgkmcnt(0)\n\ts_barrier" ::: "memory");
        if (t + 1 < NT) ATT_DMA(t + 1, (t + 1) & 1);
        const int jb = t - (NT - 4);
        if (jb < 0 || 2 * jb <= wid) {
            const lds_cptr kp = kp0 + (t & 1) * KSLOT;
            f32x16 p0 = f32x16{}, p1 = f32x16{};
#pragma unroll
            for (int d0 = 0; d0 < 6; ++d0) {
                const bf16x8 k0 = *(const __attribute__((address_space(3))) bf16x8*)(kp + d0 * 2048);
                const bf16x8 k1 = *(const __attribute__((address_space(3))) bf16x8*)(kp + d0 * 2048 + 512);
                p0 = __builtin_amdgcn_mfma_f32_32x32x16_bf16(k0, qr[d0], p0, 0, 0, 0);
                p1 = __builtin_amdgcn_mfma_f32_32x32x16_bf16(k1, qr[d0], p1, 0, 0, 0); }
            if (jb >= 0) { const int kb = 64 * jb + 4 * hi;
#pragma unroll
                for (int r = 0; r < 16; ++r) { const int kv = kb + (r & 3) + 8 * (r >> 2); if (kv > qrel) p0[r] = -INFINITY; if (kv + 32 > qrel) p1[r] = -INFINITY; } }
            float rm = fmaxf(p0[0], p1[0]);
#pragma unroll
            for (int r = 1; r < 16; ++r) rm = fmaxf(rm, fmaxf(p0[r], p1[r]));
            rm = swap32_max(rm);
            const float mnew = fmaxf(m_run, rm);
            if (__any(mnew > m_run)) {
                const float alpha = __builtin_amdgcn_exp2f(m_run - mnew);
                l_run *= alpha; m_run = mnew;
                if (hi == 0) wsf[r32] = alpha;
                asm volatile("s_waitcnt lgkmcnt(0)" ::: "memory");
#pragma unroll
                for (int r = 0; r < 16; ++r) { const float a = wsf[crow(r, hi)]; o[0][r] *= a; o[1][r] *= a; }
            }
            float sacc = 0.f;
#pragma unroll
            for (int r = 0; r < 16; ++r) { p0[r] = __builtin_amdgcn_exp2f(p0[r] - m_run); p1[r] = __builtin_amdgcn_exp2f(p1[r] - m_run); sacc += p0[r] + p1[r]; }
            l_run += sacc;
            u32x4 pw0, pw1, pw2, pw3;
#define PKW(P, B) cvtpk_s(P[B], P[B + 1])
            pw0 = (u32x4){PKW(p0, 0), PKW(p0, 2), PKW(p0, 4), PKW(p0, 6)}; pw1 = (u32x4){PKW(p0, 8), PKW(p0, 10), PKW(p0, 12), PKW(p0, 14)};
            pw2 = (u32x4){PKW(p1, 0), PKW(p1, 2), PKW(p1, 4), PKW(p1, 6)}; pw3 = (u32x4){PKW(p1, 8), PKW(p1, 10), PKW(p1, 12), PKW(p1, 14)};
#undef PKW
            pv(o, vb0 + (t & 1) * VSLOT, __builtin_bit_cast(bf16x8, pw0), __builtin_bit_cast(bf16x8, pw1), __builtin_bit_cast(bf16x8, pw2), __builtin_bit_cast(bf16x8, pw3));
        }
    }
    l_run = swap32_sum(l_run);
    if (hi == 0) wsf[32 + r32] = l_run;
    asm volatile("s_waitcnt lgkmcnt(0)" ::: "memory");
    float rli[16];
#pragma unroll
    for (int r = 0; r < 16; ++r) rli[r] = 1.0f / wsf[32 + crow(r, hi)];
    bf16* Ow = O + (rowbase + q0 + wid * 32) * DM + h * 64;
    { LAS bf16* stg = (LAS bf16*)(shm3 + L_OST) + wid * 2048;
#pragma unroll
      for (int r = 0; r < 16; ++r) { const int orow = crow(r, hi);
#pragma unroll
          for (int d0 = 0; d0 < 2; ++d0) stg[orow * 64 + d0 * 32 + r32] = (bf16)f2bf(o[d0][r] * rli[r]); }
      asm volatile("s_waitcnt lgkmcnt(0)" ::: "memory");
#pragma unroll
      for (int i = 0; i < 4; ++i) { const int row = i * 8 + (lane >> 3), ch = lane & 7; const u32x4 v = *(const LAS u32x4*)(stg + row * 64 + ch * 8); *(u32x4*)(Ow + (long)row * DM + ch * 8) = v; } }
    asm volatile("s_waitcnt vmcnt(0) lgkmcnt(0)\n\ts_barrier" ::: "memory");
#undef ATT_DMA
}
}
namespace ret {
using bf16x8 = __attribute__((ext_vector_type(8))) short;
using s16x4 = __attribute__((ext_vector_type(4))) short;
using f32x16 = __attribute__((ext_vector_type(16))) float;
typedef short v4i16_t __attribute__((ext_vector_type(4)));
constexpr int TPB = 288, TB = 128 * TPB;
constexpr int OTP = 132;
static_assert(3 * TB <= RING_BYTES && 128 * OTP * 4 <= 2 * TB, "retention LDS");
__device__ __forceinline__ int crow(int r, int hi) { return (r & 3) + 8 * (r >> 2) + 4 * hi; }
__device__ __forceinline__ void stage_tile(LAS unsigned char* tile, const bf16* src, int pitch, int tid) {
#pragma unroll
    for (int i = 0; i < 4; ++i) { const int idx = tid + 512 * i, row = idx >> 4, ch = idx & 15;
        *(LAS v4u*)(tile + row * TPB + ch * 16) = *(const v4u*)(src + (size_t)row * pitch + ch * 8); }
}
__device__ __forceinline__ bf16x8 rowfrag(const LAS unsigned char* tile, int row0, int k0, int r32, int hi) { return *(const LAS bf16x8*)(tile + (row0 + r32) * TPB + (k0 + 8 * hi) * 2); }
__device__ __forceinline__ bf16x8 trfrag(const LAS unsigned char* tile, int k0, int c0, int lane) {
    const int h = lane >> 5, blk = (lane >> 4) & 1, q = (lane & 15) >> 2, p = lane & 3;
    const LAS unsigned char* a = tile + (k0 + 8 * h + q) * TPB + (c0 + 16 * blk + 4 * p) * 2;
    const s16x4 lo = __builtin_bit_cast(s16x4, __builtin_amdgcn_ds_read_tr16_b64_v4i16((LAS v4i16_t*)a));
    const s16x4 hi4 = __builtin_bit_cast(s16x4, __builtin_amdgcn_ds_read_tr16_b64_v4i16((LAS v4i16_t*)(a + 4 * TPB)));
    return (bf16x8){lo[0], lo[1], lo[2], lo[3], hi4[0], hi4[1], hi4[2], hi4[3]};
}

__device__ __forceinline__ void kv_unit(int u, const bf16* KR, const bf16* RV, float* KVC, LAS unsigned char* lds) {
    int tid_ = threadIdx.x; asm volatile("" : "+v"(tid_)); const int tid = tid_, lane = tid & 63, r32 = lane & 31, hi = lane >> 5, wid = __builtin_amdgcn_readfirstlane(tid >> 6), wi = wid >> 1, wj = wid & 1;
    const int bh = u >> 6, c = u & 63, b = bh >> 2, h = bh & 3; const size_t row0 = (size_t)b * TSEQ + c * 128;
    LAS unsigned char* T0 = lds; LAS unsigned char* T1 = lds + TB;
    stage_tile(T0, KR + row0 * 512 + h * 128, 512, tid); stage_tile(T1, RV + row0 * 512 + h * 128, 512, tid);
    __syncthreads();
    f32x16 acc[2]; acc[0] = f32x16{}; acc[1] = f32x16{};
#pragma unroll
    for (int ks = 0; ks < 8; ++ks) { const bf16x8 A = trfrag(T0, 16 * ks, 32 * wi, lane);
#pragma unroll
        for (int n = 0; n < 2; ++n) acc[n] = __builtin_amdgcn_mfma_f32_32x32x16_bf16(A, trfrag(T1, 16 * ks, 64 * wj + 32 * n, lane), acc[n], 0, 0, 0); }
    const float g127 = __builtin_amdgcn_exp2f(127.0f * lg2gamma(h));
    float* out = KVC + (size_t)u * 16384;
#pragma unroll
    for (int n = 0; n < 2; ++n)
#pragma unroll
        for (int r = 0; r < 16; ++r) out[(32 * wi + crow(r, hi)) * 128 + 64 * wj + 32 * n + r32] = acc[n][r] * g127;
    __syncthreads();
}

__device__ __forceinline__ void scan_items(int gtid, int gthreads, const float* KVC, bf16* SC, float* dout) {
    for (int e = gtid; e < 8 * 16384; e += gthreads) { const int bh = e >> 14, el = e & 16383; const float g128 = __builtin_amdgcn_exp2f(128.0f * lg2gamma(bh & 3));
        float s = 0.f;
        for (int c0 = 0; c0 < 64; c0 += 8) { float kv[8];
#pragma unroll
            for (int i = 0; i < 8; ++i) kv[i] = KVC[(size_t)(bh * 64 + c0 + i) * 16384 + el];
#pragma unroll
            for (int i = 0; i < 8; ++i) { SC[(size_t)(bh * 64 + c0 + i) * 16384 + el] = (bf16)f2bf(s); s = g128 * s + kv[i]; } }
        dout[O_RETP + e] = s; }
}

__device__ __forceinline__ void out_unit(int u, const bf16* QR, const bf16* KR, const bf16* RV, const bf16* SC, const bf16* RGS, const float* gnorm, bf16* OCAT, LAS unsigned char* lds) {
    int tid_ = threadIdx.x; asm volatile("" : "+v"(tid_)); const int tid = tid_, lane = tid & 63, r32 = lane & 31, hi = lane >> 5, wid = __builtin_amdgcn_readfirstlane(tid >> 6), wi = wid >> 1, wj = wid & 1;
    const int bh = u >> 6, c = u & 63, b = bh >> 2, h = bh & 3; const size_t row0 = (size_t)b * TSEQ + c * 128;
    LAS unsigned char* T0 = lds; LAS unsigned char* T1 = lds + TB; LAS unsigned char* T2 = lds + 2 * TB;
    stage_tile(T0, QR + row0 * 512 + h * 128, 512, tid); stage_tile(T1, KR + row0 * 512 + h * 128, 512, tid); stage_tile(T2, RV + row0 * 512 + h * 128, 512, tid);
    __syncthreads();
    f32x16 sr[2];
#pragma unroll
    for (int n = 0; n < 2; ++n) { const int jb = 2 * wj + n; sr[n] = f32x16{};
        if (jb <= wi) {
#pragma unroll
            for (int ks = 0; ks < 8; ++ks) sr[n] = __builtin_amdgcn_mfma_f32_32x32x16_bf16(rowfrag(T1, 32 * jb, 16 * ks, r32, hi), rowfrag(T0, 32 * wi, 16 * ks, r32, hi), sr[n], 0, 0, 0);
            if (jb == wi) {
#pragma unroll
                for (int r = 0; r < 16; ++r) if (crow(r, hi) > r32) sr[n][r] = 0.f; } } }
    __syncthreads();
#pragma unroll
    for (int n = 0; n < 2; ++n) { const int jb = 2 * wj + n;
        if (jb <= wi) {
#pragma unroll
            for (int r4 = 0; r4 < 4; ++r4) { v2u w; w.x = pg8::cvt_pk_bf16(sr[n][4 * r4], sr[n][4 * r4 + 1]); w.y = pg8::cvt_pk_bf16(sr[n][4 * r4 + 2], sr[n][4 * r4 + 3]);
                *(LAS v2u*)(T1 + (32 * wi + r32) * TPB + (32 * jb + 8 * r4 + 4 * hi) * 2) = w; } } }
    __syncthreads();
    f32x16 o1[2]; o1[0] = f32x16{}; o1[1] = f32x16{};
    for (int ks = 0; ks < 2 * (wi + 1); ++ks) { const bf16x8 A = rowfrag(T1, 32 * wi, 16 * ks, r32, hi);
#pragma unroll
        for (int n = 0; n < 2; ++n) o1[n] = __builtin_amdgcn_mfma_f32_32x32x16_bf16(A, trfrag(T2, 16 * ks, 64 * wj + 32 * n, lane), o1[n], 0, 0, 0); }
    __syncthreads();
    stage_tile(T2, SC + (size_t)u * 16384, 128, tid);
    __syncthreads();
    f32x16 o2[2]; o2[0] = f32x16{}; o2[1] = f32x16{};
#pragma unroll
    for (int ks = 0; ks < 8; ++ks) { const bf16x8 A = rowfrag(T0, 32 * wi, 16 * ks, r32, hi);
#pragma unroll
        for (int n = 0; n < 2; ++n) o2[n] = __builtin_amdgcn_mfma_f32_32x32x16_bf16(A, trfrag(T2, 16 * ks, 64 * wj + 32 * n, lane), o2[n], 0, 0, 0); }
    __syncthreads();
    const float gam = __builtin_amdgcn_exp2f(lg2gamma(h));
    LAS float* OT = (LAS float*)lds;
#pragma unroll
    for (int n = 0; n < 2; ++n)
#pragma unroll
        for (int r = 0; r < 16; ++r) OT[(32 * wi + crow(r, hi)) * OTP + 64 * wj + 32 * n + r32] = o1[n][r] + gam * o2[n][r];
    __syncthreads();
    { const int row = tid >> 2, part = tid & 3; const LAS float* orow = OT + row * OTP + part * 32; float v[32]; float s = 0.f;
#pragma unroll
      for (int k = 0; k < 32; ++k) { v[k] = orow[k]; s += v[k]; }
      s += __shfl_xor(s, 1); s += __shfl_xor(s, 2); const float mu = s * (1.0f / 128.0f); float q = 0.f;
#pragma unroll
      for (int k = 0; k < 32; ++k) { v[k] -= mu; q += v[k] * v[k]; }
      q += __shfl_xor(q, 1); q += __shfl_xor(q, 2); const float rstd = 1.0f / sqrtf(q * (1.0f / 128.0f) + EPS);
      const bf16* rg = RGS + (row0 + row) * 512 + h * 128 + part * 32; const float* gn = gnorm + h * 128 + part * 32; bf16* dst = OCAT + (row0 + row) * DM + 512 + h * 128 + part * 32;
#pragma unroll
      for (int k8 = 0; k8 < 4; ++k8) { const v4u g = *(const v4u*)(rg + 8 * k8); v4u w;
#pragma unroll
          for (int j = 0; j < 4; ++j) { const int k = 8 * k8 + 2 * j; w[j] = pk2(v[k] * rstd * gn[k] * bflo(g[j]), v[k + 1] * rstd * gn[k + 1] * bfhi(g[j])); }
          *(v4u*)(dst + 8 * k8) = w; } }
    __syncthreads();
}

__device__ __forceinline__ void sample_unit(int u, const bf16* QR, const bf16* KR, const bf16* RV, const bf16* RGS, const float* gnorm, const float* state, float* dout, bf16* OCAT, LAS unsigned char* lds) {
    int tid_ = threadIdx.x; asm volatile("" : "+v"(tid_)); const int tid = tid_, s = u >> 2, h = u & 3; const size_t row = (size_t)MP + s;
    LAS float* qf = (LAS float*)lds; LAS float* kf = qf + 128; LAS float* vf = kf + 128; LAS float* red = vf + 128; LAS float* ob = red + 512;
    if (tid < 128) { qf[tid] = bf2f(QR[row * 512 + h * 128 + tid]); kf[tid] = bf2f(KR[row * 512 + h * 128 + tid]); vf[tid] = bf2f(RV[row * 512 + h * 128 + tid]); }
    __syncthreads();
    const int dv = tid & 127, g = tid >> 7; const float gam = __builtin_amdgcn_exp2f(lg2gamma(h)); const float vv = vf[dv];
    const float* S0 = state + (size_t)u * 16384; float* Sn = dout + O_RETS + (size_t)u * 16384; float acc = 0.f;
#pragma unroll 8
    for (int i = 0; i < 32; ++i) { const int dk = 32 * g + i; const float s0 = S0[dk * 128 + dv]; acc += qf[dk] * s0; Sn[dk * 128 + dv] = gam * s0 + kf[dk] * vv; }
    red[tid] = acc;
    __syncthreads();
    if (tid < 128) { float qk = 0.f;
        for (int d = 0; d < 128; ++d) qk += qf[d] * kf[d];
        ob[tid] = qk * vv + gam * ((red[tid] + red[128 + tid]) + (red[256 + tid] + red[384 + tid])); }
    __syncthreads();
    if (tid < 128) { float sm = 0.f;
        for (int d = 0; d < 128; ++d) sm += ob[d];
        const float mu = sm * (1.0f / 128.0f); float q = 0.f;
        for (int d = 0; d < 128; ++d) { const float t = ob[d] - mu; q += t * t; }
        const float rstd = 1.0f / sqrtf(q * (1.0f / 128.0f) + EPS);
        OCAT[row * DM + 512 + h * 128 + tid] = (bf16)f2bf((ob[tid] - mu) * rstd * gnorm[h * 128 + tid] * bf2f(RGS[row * 512 + h * 128 + tid])); }
    __syncthreads();
}
}
namespace sk {
using bf16x8 = __attribute__((ext_vector_type(8))) short;
using f32x4 = __attribute__((ext_vector_type(4))) float;
using f32x2 = __attribute__((ext_vector_type(2))) float;
template <int K, bool DUAL, bool STAT, class Epi>
__device__ __forceinline__ void skinny_unit(int u, const bf16* A, const bf16* Bt, float* ssq, LAS float* lds, const Epi E) {
    int tid_ = threadIdx.x; asm volatile("" : "+v"(tid_)); const int tid = tid_, lane = tid & 63, wave = __builtin_amdgcn_readfirstlane(tid >> 6), fr = lane & 15, fq = lane >> 4;
    const int rb = u >> 4, cg = u & 15;
    constexpr int KW = K / 8, NS = KW / 32; static_assert(KW % 32 == 0, "K split");
    const bf16* ap = A + (size_t)(MP + 16 * rb + fr) * K + wave * KW + 8 * fq;
    const bf16* bp = Bt + (size_t)(64 * cg + fr) * K + wave * KW + 8 * fq;
    f32x4 acc[4];
#pragma unroll
    for (int n = 0; n < 4; ++n) acc[n] = (f32x4){0.f, 0.f, 0.f, 0.f};
#pragma unroll 4
    for (int s = 0; s < NS; ++s) { const bf16x8 a = *(const bf16x8*)(ap + 32 * s);
#pragma unroll
        for (int n = 0; n < 4; ++n) acc[n] = __builtin_amdgcn_mfma_f32_16x16x32_bf16(a, *(const bf16x8*)(bp + (size_t)16 * n * K + 32 * s), acc[n], 0, 0, 0); }
    LAS float* P = lds + wave * 1024;
#pragma unroll
    for (int n = 0; n < 4; ++n)
#pragma unroll
        for (int r = 0; r < 4; ++r) P[(4 * fq + r) * 64 + 16 * n + fr] = acc[n][r];
    __syncthreads();
    { const int row = tid >> 5, c2 = (tid & 31) * 2; float a0 = 0.f, a1 = 0.f, b0 = 0.f, b1 = 0.f;
#pragma unroll
      for (int w = 0; w < 8; ++w) { const f32x2 v = *(const LAS f32x2*)(lds + w * 1024 + row * 64 + c2); if (DUAL && w >= 4) { b0 += v[0]; b1 += v[1]; } else { a0 += v[0]; a1 += v[1]; } }
      const f32x2 h = E(MP + 16 * rb + row, 64 * cg + c2, a0, a1, b0, b1);
      if (STAT) { float s = h[0] * h[0] + h[1] * h[1];
#pragma unroll
          for (int o = 1; o < 32; o <<= 1) s += __shfl_xor(s, o);
          if ((tid & 31) == 0) ssq[(size_t)(MP + 16 * rb + row) * 16 + cg] = s; } }
    __syncthreads();
}
struct SkResid { const float* R; float alpha; float* Hf; bf16* Hb;
    __device__ __forceinline__ f32x2 operator()(int row, int col, float a0, float a1, float, float) const {
        const f32x2 r = *(const f32x2*)(R + (size_t)row * DM + col); const f32x2 h = {r[0] + alpha * a0, r[1] + alpha * a1};
        *(f32x2*)(Hf + (size_t)row * DM + col) = h; *(unsigned*)(Hb + (size_t)row * DM + col) = pg8::cvt_pk_bf16(h[0], h[1]); return h; } };
struct SkResidX { const float* xs; float* Hf; bf16* Hb;
    __device__ __forceinline__ f32x2 operator()(int row, int col, float a0, float a1, float, float) const {
        const f32x2 r = *(const f32x2*)(xs + (size_t)(row - MP) * DM + col); const f32x2 h = {r[0] + 0.5f * a0, r[1] + 0.5f * a1};
        *(f32x2*)(Hf + (size_t)row * DM + col) = h; *(unsigned*)(Hb + (size_t)row * DM + col) = pg8::cvt_pk_bf16(h[0], h[1]); return h; } };
struct SkMerge { const bf16* SGA; const bf16* SGR; bf16* O;
    __device__ __forceinline__ f32x2 operator()(int row, int col, float a0, float a1, float b0, float b1) const {
        const unsigned ga = *(const unsigned*)(SGA + (size_t)row * DM + col), gr = *(const unsigned*)(SGR + (size_t)row * DM + col);
        const f32x2 m = {bflo(ga) * a0 + bflo(gr) * b0, bfhi(ga) * a1 + bfhi(gr) * b1};
        *(unsigned*)(O + (size_t)row * DM + col) = pg8::cvt_pk_bf16(m[0], m[1]); return m; } };
struct SkPlain { bf16* O;
    __device__ __forceinline__ f32x2 operator()(int row, int col, float a0, float a1, float, float) const {
        *(unsigned*)(O + (size_t)row * DM + col) = pg8::cvt_pk_bf16(a0, a1); return (f32x2){a0, a1}; } };
struct SkPle { const float* H3; const bf16* PP; const float* ssq3; float* H4;
    __device__ __forceinline__ f32x2 operator()(int row, int col, float a0, float a1, float, float) const {
        const float rs = pg8::rstd_of<16>(ssq3, row, 1.0f / DM); const f32x2 r = *(const f32x2*)(H3 + (size_t)row * DM + col); const unsigned p = *(const unsigned*)(PP + (size_t)row * DM + col);
        const f32x2 h = {r[0] + sigm(a0 * rs) * bflo(p), r[1] + sigm(a1 * rs) * bfhi(p)};
        *(f32x2*)(H4 + (size_t)row * DM + col) = h; return h; } };
}
namespace dec {
using bf16x2 = __attribute__((ext_vector_type(2))) __bf16;
using u32x4 = __attribute__((ext_vector_type(4))) unsigned;
using f32x4 = __attribute__((ext_vector_type(4))) float;
using f32x2 = __attribute__((ext_vector_type(2))) float;
constexpr int NSPLIT = 8, PPS = NPAGES / NSPLIT;
constexpr int HPL = 2, GE = 8;
constexpr int L_QL = 0, L_P = 8 * 128, L_MRG = L_P + 8 * 64 * HPL, MRG_REC = 4 + 128, L_END = L_MRG + 8 * GE * MRG_REC;
static_assert(L_END * 4 <= RING_BYTES, "decode LDS");
__device__ __forceinline__ float dot2(unsigned k, unsigned q, float acc) { return __builtin_amdgcn_fdot2_f32_bf16(__builtin_bit_cast(bf16x2, k), __builtin_bit_cast(bf16x2, q), acc, false); }
__device__ __forceinline__ unsigned cvtpk(float lo, float hi) { return pg8::cvt_pk_bf16(lo, hi); }
template <int CTRL> __device__ __forceinline__ float dpp(float x) { return __builtin_bit_cast(float, __builtin_amdgcn_mov_dpp(__builtin_bit_cast(int, x), CTRL, 0xf, 0xf, true)); }
constexpr int XOR1 = 0xB1, XOR2 = 0x4E, XOR7 = 0x141, XOR8 = 0x128, ROR4 = 0x124;
__device__ __forceinline__ float xrow16_max(float x) {
    auto s = __builtin_amdgcn_permlane16_swap(__float_as_uint(x), __float_as_uint(x), false, false); x = fmaxf(__uint_as_float(s[0]), __uint_as_float(s[1]));
    auto t = __builtin_amdgcn_permlane32_swap(__float_as_uint(x), __float_as_uint(x), false, false); return fmaxf(__uint_as_float(t[0]), __uint_as_float(t[1])); }
__device__ __forceinline__ float xrow16_sum(float x) {
    auto s = __builtin_amdgcn_permlane16_swap(__float_as_uint(x), __float_as_uint(x), false, false); x = __uint_as_float(s[0]) + __uint_as_float(s[1]);
    auto t = __builtin_amdgcn_permlane32_swap(__float_as_uint(x), __float_as_uint(x), false, false); return __uint_as_float(t[0]) + __uint_as_float(t[1]); }

__device__ __forceinline__ void qlat_token(int s, const bf16* QB, const float* wkvb, LAS float* QLs, float* QLATg, bool store) {
    int tid_ = threadIdx.x; asm volatile("" : "+v"(tid_)); const int tid = tid_, lane = tid & 63, h = __builtin_amdgcn_readfirstlane(tid >> 6);
    const bf16* q = QB + (size_t)(MP + s) * 768 + h * QKD;
#pragma unroll
    for (int cc = 0; cc < 2; ++cc) { const int c = lane + 64 * cc; const float* w = wkvb + (size_t)c * 1024 + h * 128; float a = 0.f;
#pragma unroll 4
        for (int d = 0; d < 64; d += 4) { const f32x4 wv = *(const f32x4*)(w + d); a += bf2f(q[d]) * wv[0] + bf2f(q[d + 1]) * wv[1] + bf2f(q[d + 2]) * wv[2] + bf2f(q[d + 3]) * wv[3]; }
        QLs[h * 128 + c] = a; if (store) QLATg[(size_t)s * 1024 + h * 128 + c] = a; }
}

__device__ __forceinline__ void split_unit(int s, int sp, const bf16* QB, const float* cache_ckv, const float* cache_kpe, const int* page_table, float* DPO, float* DML, LAS float* lds) {
    int tid_ = threadIdx.x; asm volatile("" : "+v"(tid_)); const int tid = tid_, lane = tid & 63, wave = __builtin_amdgcn_readfirstlane(tid >> 6), r = lane >> 4, c = lane & 15;
    const LAS float* QL = lds + L_QL;
    u32x4 qpk[GE]; unsigned qpe[GE];
#pragma unroll
    for (int g = 0; g < GE; ++g) { const LAS float* ql = QL + g * 128 + 8 * c; qpk[g] = (u32x4){cvtpk(ql[0], ql[1]), cvtpk(ql[2], ql[3]), cvtpk(ql[4], ql[5]), cvtpk(ql[6], ql[7])};
        qpe[g] = *(const unsigned*)(QB + (size_t)(MP + s) * 768 + g * QKD + 64 + 2 * c); }
    float m[HPL], l[HPL], acc[GE * 8];
#pragma unroll
    for (int j = 0; j < HPL; ++j) { m[j] = -INFINITY; l[j] = 0.f; }
#pragma unroll
    for (int k = 0; k < GE * 8; ++k) acc[k] = 0.f;
    const int ph0 = page_table[s * NPAGES + PPS * sp + wave], ph1 = page_table[s * NPAGES + PPS * sp + wave + 8];
    f32x4 Kn[4][2]; f32x2 Pn[4];
#define DEC_ISSUE(i_) do { const int ph_ = ((i_) >> 3) ? ph1 : ph0; const size_t tok_ = (size_t)ph_ * PAGE + 16 * ((i_) & 7) + r; \
        _Pragma("unroll") for (int t_ = 0; t_ < 4; ++t_) { const float* kp_ = cache_ckv + (tok_ + 4 * t_) * KVL + 8 * c; \
            Kn[t_][0] = __builtin_nontemporal_load((const f32x4*)kp_); Kn[t_][1] = __builtin_nontemporal_load((const f32x4*)(kp_ + 4)); \
            Pn[t_] = __builtin_nontemporal_load((const f32x2*)(cache_kpe + (tok_ + 4 * t_) * RPE + 2 * c)); } } while (0)
    DEC_ISSUE(0);
#pragma nounroll
    for (int i = 0; i < 16; ++i) {
        u32x4 Kc[4]; unsigned Pc[4];
#pragma unroll
        for (int t = 0; t < 4; ++t) {
            Kc[t] = (u32x4){cvtpk(Kn[t][0][0], Kn[t][0][1]), cvtpk(Kn[t][0][2], Kn[t][0][3]), cvtpk(Kn[t][1][0], Kn[t][1][1]), cvtpk(Kn[t][1][2], Kn[t][1][3])}; Pc[t] = cvtpk(Pn[t][0], Pn[t][1]); }
        if (i + 1 < 16) DEC_ISSUE(i + 1);
        float x[4 * GE];
#pragma unroll
        for (int t = 0; t < 4; ++t)
#pragma unroll
            for (int g = 0; g < GE; ++g) { float d = dot2(Pc[t], qpe[g], 0.f);
#pragma unroll
                for (int k = 0; k < 4; ++k) d = dot2(Kc[t][k], qpk[g][k], d);
                x[t * GE + g] = d; }
#define TR_STEP(HALF, CTRL, BIT) _Pragma("unroll") for (int h = 0; h < (HALF); ++h) _Pragma("unroll") for (int j = 0; j < HPL; ++j) { \
        const float lo_ = x[h * HPL + j], hi_ = x[(h + (HALF)) * HPL + j]; const float t1_ = lo_ + dpp<CTRL>(lo_), t2_ = hi_ + dpp<CTRL>(hi_); \
        x[h * HPL + j] = (c & (BIT)) ? t2_ : t1_; }
        TR_STEP(8, XOR8, 8) TR_STEP(4, XOR7, 4) TR_STEP(2, XOR2, 2) TR_STEP(1, XOR1, 1)
#undef TR_STEP
        float p[HPL], alpha[HPL];
#pragma unroll
        for (int j = 0; j < HPL; ++j) { const float sc = x[j];
            float pm = sc; pm = fmaxf(pm, dpp<ROR4>(pm)); pm = fmaxf(pm, dpp<XOR8>(pm)); pm = xrow16_max(pm);
            const float mn = fmaxf(m[j], pm);
            alpha[j] = __builtin_amdgcn_exp2f(m[j] - mn); p[j] = __builtin_amdgcn_exp2f(sc - mn);
            l[j] = fmaf(l[j], alpha[j], p[j]); m[j] = mn; }
#pragma unroll
        for (int q4 = 0; q4 < 4; ++q4)
#pragma unroll
            for (int j = 0; j < HPL; ++j) { const float al = q4 == 0 ? dpp<0x00>(alpha[j]) : q4 == 1 ? dpp<0x55>(alpha[j]) : q4 == 2 ? dpp<0xAA>(alpha[j]) : dpp<0xFF>(alpha[j]);
#pragma unroll
                for (int k = 0; k < 8; ++k) acc[(q4 * HPL + j) * 8 + k] *= al; }
        LAS float* prow = lds + L_P + (wave * 4 + r) * 16 * HPL;
#pragma unroll
        for (int j = 0; j < HPL; ++j) prow[c * HPL + j] = p[j];
        asm volatile("s_waitcnt lgkmcnt(0)" ::: "memory");
#pragma unroll
        for (int t = 0; t < 4; ++t) { float vf[8]; f32x4 pr[2]; pr[0] = *(const LAS f32x4*)(prow + 8 * t); pr[1] = *(const LAS f32x4*)(prow + 8 * t + 4);
#pragma unroll
            for (int k = 0; k < 4; ++k) { vf[2 * k] = bflo(Kc[t][k]); vf[2 * k + 1] = bfhi(Kc[t][k]); }
#pragma unroll
            for (int g = 0; g < GE; ++g) { const float pg_ = pr[g >> 2][g & 3];
#pragma unroll
                for (int k = 0; k < 8; ++k) acc[g * 8 + k] = fmaf(pg_, vf[k], acc[g * 8 + k]); } }
        asm volatile("s_waitcnt lgkmcnt(0)" ::: "memory");
    }
#undef DEC_ISSUE
#pragma unroll
    for (int k = 0; k < GE * 8; ++k) acc[k] = xrow16_sum(acc[k]);
#pragma unroll
    for (int j = 0; j < HPL; ++j) { float t = l[j]; t += dpp<ROR4>(t); t += dpp<XOR8>(t); l[j] = xrow16_sum(t); }
    LAS float* mrg = lds + L_MRG;
    if (r == 0) {
#pragma unroll
        for (int g = 0; g < GE; ++g) { LAS float* rec = mrg + (wave * GE + g) * MRG_REC;
#pragma unroll
            for (int k = 0; k < 8; k += 4) *(LAS f32x4*)(rec + 4 + 8 * c + k) = (f32x4){acc[g * 8 + k], acc[g * 8 + k + 1], acc[g * 8 + k + 2], acc[g * 8 + k + 3]};
            if (c == g / HPL) { rec[0] = m[g % HPL]; rec[1] = l[g % HPL]; } } }
    __syncthreads();
    { const int g = wave, d0 = 2 * lane;
      float M = -INFINITY;
#pragma unroll
      for (int w = 0; w < 8; ++w) M = fmaxf(M, mrg[(w * GE + g) * MRG_REC]);
      float L = 0.f, o0 = 0.f, o1 = 0.f;
#pragma unroll
      for (int w = 0; w < 8; ++w) { const LAS float* rec = mrg + (w * GE + g) * MRG_REC; const float wt = __builtin_amdgcn_exp2f(rec[0] - M);
          L = fmaf(wt, rec[1], L); o0 = fmaf(wt, rec[4 + d0], o0); o1 = fmaf(wt, rec[4 + d0 + 1], o1); }
      const size_t slot = ((size_t)s * NSPLIT + sp) * GE + g;
      *(f32x2*)(DPO + slot * 128 + d0) = (f32x2){o0, o1};
      if (lane == 0) *(f32x2*)(DML + slot * 2) = (f32x2){M, L}; }
    __syncthreads();
}

__device__ __forceinline__ void combine_unit(int s, const bf16* QB, const float* QLATg, const float* DPO, const float* DML, const float* dout, const float* wkvb, bf16* OCAT, LAS float* lds) {
    int tid_ = threadIdx.x; asm volatile("" : "+v"(tid_)); const int tid = tid_, lane = tid & 63, g = __builtin_amdgcn_readfirstlane(tid >> 6), d0 = 2 * lane;
    const float* ck = dout + O_CKVS + (size_t)s * KVL; const float* kp = dout + O_KPES + (size_t)s * RPE;
    const f32x2 ckv = *(const f32x2*)(ck + d0); const f32x2 ql = *(const f32x2*)(QLATg + (size_t)s * 1024 + g * 128 + d0);
    float part = ql[0] * ckv[0] + ql[1] * ckv[1];
    if (lane < 16) { const unsigned qp = *(const unsigned*)(QB + (size_t)(MP + s) * 768 + g * QKD + 64 + d0); part += bflo(qp) * kp[d0] + bfhi(qp) * kp[d0 + 1]; }
    const float sself = wave_sum(part);
    float M = sself;
#pragma unroll
    for (int sp = 0; sp < NSPLIT; ++sp) M = fmaxf(M, DML[(((size_t)s * NSPLIT + sp) * GE + g) * 2]);
    float L = __builtin_amdgcn_exp2f(sself - M), o0 = L * ckv[0], o1 = L * ckv[1];
#pragma unroll
    for (int sp = 0; sp < NSPLIT; ++sp) { const size_t slot = ((size_t)s * NSPLIT + sp) * GE + g; const float wt = __builtin_amdgcn_exp2f(DML[slot * 2] - M);
        const f32x2 po = *(const f32x2*)(DPO + slot * 128 + d0); L = fmaf(wt, DML[slot * 2 + 1], L); o0 = fmaf(wt, po[0], o0); o1 = fmaf(wt, po[1], o1); }
    const float inv = 1.0f / L;
    LAS float* ol = lds + g * 128;
    ol[d0] = o0 * inv; ol[d0 + 1] = o1 * inv;
    asm volatile("s_waitcnt lgkmcnt(0)" ::: "memory");
    float a = 0.f;
#pragma unroll 8
    for (int cc = 0; cc < 128; ++cc) a = fmaf(ol[cc], wkvb[(size_t)cc * 1024 + g * 128 + 64 + lane], a);
    OCAT[(size_t)(MP + s) * DM + g * 64 + lane] = (bf16)f2bf(a);
    __syncthreads();
}
}
#define XB_TMO      128
#define XB_XCNT(j)  (256  + 64 * (j))
#define XB_XSUB(j)  (1280 + 64 * (j))
#define XB_XGEN(j)  (2304 + 64 * (j))
#define XB_TOP      3328
#define XB_TOPGEN   3392
#define XCD_BAR_WORDS 3456
#define XB_SPIN_CAP (1u << 18)

__device__ __forceinline__ unsigned xb_ld(unsigned* p)              { return __hip_atomic_load(p, __ATOMIC_RELAXED, __HIP_MEMORY_SCOPE_AGENT); }
__device__ __forceinline__ unsigned xb_add(unsigned* p, unsigned v) { return __hip_atomic_fetch_add(p, v, __ATOMIC_RELAXED, __HIP_MEMORY_SCOPE_AGENT); }
__device__ __forceinline__ unsigned xb_xcc_id() { return (unsigned)__builtin_amdgcn_s_getreg((3 << 11) | 20) & 0xFu; }
#define XB_SPIN(cond, bar) do { unsigned _sp = 0; while (cond) { __builtin_amdgcn_s_sleep(1); \
    if ((++_sp & 255u) == 0u) { if (xb_ld(&(bar)[XB_TMO])) break; if (_sp > XB_SPIN_CAP) { atomicAdd(&(bar)[XB_TMO], 1u); break; } } } } while (0)

struct XcdBarrier {
    unsigned* bar; unsigned x;
    volatile LAS unsigned* st;
};

__device__ __forceinline__ XcdBarrier xcd_barrier_post(unsigned* bar, volatile LAS unsigned* st) {
    XcdBarrier b; b.bar = bar; b.x = xb_xcc_id(); b.st = st;
    if (threadIdx.x == 0) (void)xb_add(&bar[XB_XCNT(b.x)], 1u);
    return b;
}
__device__ __forceinline__ void xcd_barrier_complete(unsigned* bar, unsigned x, unsigned& nloc, unsigned& nx) {
    const unsigned G = gridDim.x * gridDim.y * gridDim.z;
    unsigned sum, cnt, mine, sp = 0u;
    for (;;) {
        sum = 0u; cnt = 0u; mine = 0u;
#pragma unroll
        for (unsigned j = 0; j < 16; ++j) { const unsigned c = xb_ld(&bar[XB_XCNT(j)]); sum += c; cnt += (c > 0u) ? 1u : 0u; mine = (j == x) ? c : mine; }
        if (sum == G) break;
        __builtin_amdgcn_s_sleep(1);
        if ((++sp & 255u) == 0u) { if (xb_ld(&bar[XB_TMO])) break; if (sp > XB_SPIN_CAP) { atomicAdd(&bar[XB_TMO], 1u); break; } }
    }
    nloc = mine > 0u ? mine : 1u; nx = cnt > 0u ? cnt : 1u;
}

__device__ __forceinline__ void xcd_barrier(const XcdBarrier& b) {
    asm volatile("s_waitcnt vmcnt(0)" ::: "memory");
    __syncthreads();
    if (threadIdx.x == 0) {
        unsigned* bar = b.bar;
        __builtin_amdgcn_s_waitcnt(0);
        unsigned nloc = b.st[0], nx = b.st[1];
        if (nloc == 0u) { xcd_barrier_complete(bar, b.x, nloc, nx); b.st[0] = nloc; b.st[1] = nx; }
        const unsigned old = xb_add(&bar[XB_XSUB(b.x)], 1u);
        const unsigned gen = old / nloc;
        if (old + 1u == (gen + 1u) * nloc) {
            __builtin_amdgcn_fence(__ATOMIC_RELEASE, "agent");
            asm volatile("s_waitcnt vmcnt(0)" ::: "memory");
            const unsigned og = xb_add(&bar[XB_TOP], 1u);
            const unsigned tg = og / nx;
            if (og + 1u == (tg + 1u) * nx) xb_add(&bar[XB_TOPGEN], 1u);
            else XB_SPIN(xb_ld(&bar[XB_TOPGEN]) == tg, bar);
            __builtin_amdgcn_fence(__ATOMIC_ACQUIRE, "agent");
            xb_add(&bar[XB_XGEN(b.x)], 1u);
            asm volatile("s_waitcnt vmcnt(0)" ::: "memory");
        } else {
            XB_SPIN(xb_ld(&bar[XB_XGEN(b.x)]) == gen, bar);
            __builtin_amdgcn_fence(__ATOMIC_ACQUIRE, "agent");
            asm volatile("s_waitcnt vmcnt(0)" ::: "memory");
        }
    }
    __syncthreads();
}
constexpr int NWAVES = 8, NPHASE = 13;
struct Args {
    const float *x_prompt, *x_sample, *cache_ckv, *cache_kpe, *state_ret; const int* page_table; const float *p_prompt, *p_sample;
    const float *ffn1_norm, *ffn1_w_gate, *ffn1_w_up, *ffn1_w_down, *mix_norm, *w_in, *q_a_norm, *w_q_b, *kv_a_norm, *w_kv_b, *ret_norm, *w_branch_att, *w_branch_ret, *w_out;
    const float *ffn2_norm, *ffn2_w_gate, *ffn2_w_up, *ffn2_w_down, *ple_norm, *w_ple_gate, *w_ple_proj, *final_norm;
    float* out; unsigned char* ws; int ph_lo, ph_hi;
};
static_assert(sizeof(Args) == 32 * 8 + 8, "Args has no padding holes");

enum { RM_ID = 0, RM_GATE, RM_UP, RM_WIN, RM_QB, RM_KVB };
__device__ __forceinline__ int rowmap(int kind, int n) {
    switch (kind) {
    case RM_GATE: return (n >> 7) * 256 + (n & 127);
    case RM_UP:   return (n >> 7) * 256 + 128 + (n & 127);
    case RM_WIN: {
        if (n < 384) return n;
        if (n < 416) { const int j = n - 384, jj = j & 15; return 384 + 8 * (jj >> 2) + 4 * (j >> 4) + (jj & 3); }
        if (n < 1440) { const bool isk = n >= 928; const int j = n - (isk ? 928 : 416), hh = j >> 7, d = j & 127, i = d & 63, n_ = d >> 6;
            return (isk ? 1024 : 512) + hh * 128 + 32 * (i >> 4) + 8 * ((i >> 2) & 3) + 4 * n_ + (i & 3); }
        if (n < 1952) return 1536 + (n - 1440);
        if (n < 2464) return 2048 + (n - 1952);
        if (n < 3488) return 2560 + (n - 2464);
        return 3584 + (n - 3488); }
    case RM_QB: { const int hh = n / 96, d = n % 96; if (d < 64) return hh * 64 + d; const int j = d - 64, jj = j & 15; return 512 + hh * 32 + 8 * (jj >> 2) + 4 * (j >> 4) + (jj & 3); }
    case RM_KVB: { const int hh = n >> 7, d = n & 127; return d < 64 ? hh * 64 + d : 512 + hh * 64 + (d - 64); }
    default: return n; }
}
__device__ __forceinline__ void tr_item(const float* W, int N, bf16* WT, int Kd, int koff, const float* gain, float scale, int kind, LAS float* scr, int item, int lane) {
    const int nblk = N / 32, kb = item / nblk, nb = item % nblk, k0 = 64 * kb, n0 = 32 * nb;
#pragma unroll 8
    for (int i = 0; i < 32; ++i) { const int kk = 2 * i + (lane >> 5); const float g = gain ? gain[k0 + kk] * scale : scale; scr[kk * 33 + (lane & 31)] = W[(size_t)(k0 + kk) * N + n0 + (lane & 31)] * g; }
    LDS_WAIT(); asm volatile("" ::: "memory");
    const int c = lane & 7;
#pragma unroll
    for (int j = 0; j < 4; ++j) { const int n = (lane >> 3) + 8 * j; const LAS float* s = scr + (8 * c) * 33 + n;
        v4u o; o.x = pk2(s[0 * 33], s[1 * 33]); o.y = pk2(s[2 * 33], s[3 * 33]); o.z = pk2(s[4 * 33], s[5 * 33]); o.w = pk2(s[6 * 33], s[7 * 33]);
        *(GAS v4u*)(WT + (size_t)rowmap(kind, n0 + n) * Kd + koff + k0 + 8 * c) = o; }
    LDS_WAIT(); asm volatile("" ::: "memory");
}
__device__ __forceinline__ void sincos_d(double a, float& c, float& s) {
    const double k = __builtin_rint(a * 0.63661977236758134308);
    double r = __builtin_fma(-k, 1.5707963267948966, a); r = __builtin_fma(-k, 6.123233995736766e-17, r);
    const double r2 = r * r;
    const double sp = r * (1.0 + r2 * (-1.0 / 6 + r2 * (1.0 / 120 + r2 * (-1.0 / 5040 + r2 * (1.0 / 362880 + r2 * (-1.0 / 39916800 + r2 * (1.0 / 6227020800.0)))))));
    const double cp = 1.0 + r2 * (-0.5 + r2 * (1.0 / 24 + r2 * (-1.0 / 720 + r2 * (1.0 / 40320 + r2 * (-1.0 / 3628800 + r2 * (1.0 / 479001600.0 + r2 * (-1.0 / 87178291200.0)))))));
    const int q = (int)((long long)k & 3);
    const double cc = q == 0 ? cp : q == 1 ? -sp : q == 2 ? -cp : sp, ss = q == 0 ? sp : q == 1 ? cp : q == 2 ? -sp : -cp;
    c = (float)cc; s = (float)ss;
}

struct Frame {
    LAS unsigned char* lds; volatile LAS unsigned* MISC; gu32* ctl; int tid, lane, wave, G, bid;
};

__device__ __forceinline__ void p0_prologue(const Args& a, Frame& F) {
    unsigned char* ws = a.ws;
    LAS float* scr = (LAS float*)(F.lds + F.wave * 16384);
    const int gw = F.bid * NWAVES + F.wave, NGW = F.G * NWAVES;
    constexpr int I_FF = 16 * 88, I_DN = 44 * 32, I_IN = 16 * 141, I_QB = 4 * 24, I_KVB = 2 * 32, I_BR = 8 * 32, I_SQ = 16 * 32, I_PP = 4 * 32;
    constexpr int NITEMS = 4 * I_FF + 2 * I_DN + I_IN + I_QB + I_KVB + 2 * I_BR + 2 * I_SQ + I_PP;
    for (int it = gw; it < NITEMS; it += NGW) {
        int r = it;
        if (r < I_FF) { tr_item(a.ffn1_w_gate, DFF, (bf16*)(ws + WS_WGU1), DM, 0, nullptr, 1.f, RM_GATE, scr, r, F.lane); continue; } r -= I_FF;
        if (r < I_FF) { tr_item(a.ffn1_w_up, DFF, (bf16*)(ws + WS_WGU1), DM, 0, nullptr, 1.f, RM_UP, scr, r, F.lane); continue; } r -= I_FF;
        if (r < I_FF) { tr_item(a.ffn2_w_gate, DFF, (bf16*)(ws + WS_WGU2), DM, 0, a.ffn2_norm, 1.f, RM_GATE, scr, r, F.lane); continue; } r -= I_FF;
        if (r < I_FF) { tr_item(a.ffn2_w_up, DFF, (bf16*)(ws + WS_WGU2), DM, 0, a.ffn2_norm, 1.f, RM_UP, scr, r, F.lane); continue; } r -= I_FF;
        if (r < I_DN) { tr_item(a.ffn1_w_down, DM, (bf16*)(ws + WS_WD1), DFF, 0, nullptr, 1.f, RM_ID, scr, r, F.lane); continue; } r -= I_DN;
        if (r < I_DN) { tr_item(a.ffn2_w_down, DM, (bf16*)(ws + WS_WD2), DFF, 0, nullptr, 1.f, RM_ID, scr, r, F.lane); continue; } r -= I_DN;
        if (r < I_IN) { tr_item(a.w_in, 4512, (bf16*)(ws + WS_WIN), DM, 0, a.mix_norm, 1.f, RM_WIN, scr, r, F.lane); continue; } r -= I_IN;
        if (r < I_QB) { tr_item(a.w_q_b, 768, (bf16*)(ws + WS_WQB), QL, 0, a.q_a_norm, C2, RM_QB, scr, r, F.lane); continue; } r -= I_QB;
        if (r < I_KVB) { tr_item(a.w_kv_b, 1024, (bf16*)(ws + WS_WKVB), KVL, 0, a.kv_a_norm, 1.f, RM_KVB, scr, r, F.lane); continue; } r -= I_KVB;
        if (r < I_BR) { tr_item(a.w_branch_att, DM, (bf16*)(ws + WS_WBC), DM, 0, nullptr, 1.f, RM_ID, scr, r, F.lane); continue; } r -= I_BR;
        if (r < I_BR) { tr_item(a.w_branch_ret, DM, (bf16*)(ws + WS_WBC), DM, 512, nullptr, 1.f, RM_ID, scr, r, F.lane); continue; } r -= I_BR;
        if (r < I_SQ) { tr_item(a.w_out, DM, (bf16*)(ws + WS_WOUT), DM, 0, nullptr, 1.f, RM_ID, scr, r, F.lane); continue; } r -= I_SQ;
        if (r < I_SQ) { tr_item(a.w_ple_gate, DM, (bf16*)(ws + WS_WPG), DM, 0, a.ple_norm, 1.f, RM_ID, scr, r, F.lane); continue; } r -= I_SQ;
        tr_item(a.w_ple_proj, DM, (bf16*)(ws + WS_WPP), PLE, 0, nullptr, 1.f, RM_ID, scr, r, F.lane);
    }
    const int gt = F.bid * (NWAVES * 64) + F.tid, NGT = F.G * NWAVES * 64;
    for (int i = gt; i < 96 * 128; i += NGT) *(v4u*)((bf16*)(ws + WS_WIN) + (size_t)416 * DM + (size_t)i * 8) = (v4u){0u, 0u, 0u, 0u};
    for (int i = gt; i < 8193 * 64; i += NGT) { const int pi = i >> 6, fi = i & 63; double inv = 1.0; for (int k = 0; k < fi; ++k) inv *= 0.8659643233600653;
        float c, s; sincos_d((double)(pi == 8192 ? 16384 : pi) * inv, c, s); ((float2*)(ws + WS_ROPE))[i] = make_float2(c, s); }
    for (int m = gw; m < MT; m += NGW) {
        bf16* orow = (bf16*)(ws + WS_XN1) + (size_t)m * DM; bf16* prow = (bf16*)(ws + WS_PB) + (size_t)m * PLE;
        if (m >= MP + MS) {
#pragma unroll
            for (int j = 0; j < 4; ++j) ((unsigned long long*)orow)[F.lane + 64 * j] = 0ull;
            ((unsigned long long*)prow)[F.lane] = 0ull; continue; }
        const float* xrow = m < MP ? a.x_prompt + (size_t)m * DM : a.x_sample + (size_t)(m - MP) * DM;
        const float* pr = m < MP ? a.p_prompt + (size_t)m * PLE : a.p_sample + (size_t)(m - MP) * PLE;
        const pg8::f32x4* xr = (const pg8::f32x4*)xrow + F.lane; pg8::f32x4 v[4]; float s = 0.f;
#pragma unroll
        for (int j = 0; j < 4; ++j) { v[j] = xr[64 * j]; s += (v[j].x * v[j].x + v[j].y * v[j].y) + (v[j].z * v[j].z + v[j].w * v[j].w); }
        const float rstd = 1.0f / sqrtf(wave_sum(s) * (1.f / DM) + EPS);
#pragma unroll
        for (int j = 0; j < 4; ++j) { const pg8::f32x4 g = ((const pg8::f32x4*)a.ffn1_norm)[F.lane + 64 * j];
            ((unsigned long long*)orow)[F.lane + 64 * j] = (unsigned long long)pk2(v[j].x * rstd * g.x, v[j].y * rstd * g.y) | ((unsigned long long)pk2(v[j].z * rstd * g.z, v[j].w * rstd * g.w) << 32); }
        const pg8::f32x4 pv = ((const pg8::f32x4*)pr)[F.lane];
        ((unsigned long long*)prow)[F.lane] = (unsigned long long)pk2(pv.x, pv.y) | ((unsigned long long)pk2(pv.z, pv.w) << 32);
    }
}

__global__ void __launch_bounds__(NWAVES * 64, 2) mk_fwd(Args args) {
    extern __shared__ __attribute__((aligned(16))) unsigned char lds[];
    Frame F;
    F.lds = (LAS unsigned char*)lds; F.MISC = (volatile LAS unsigned*)(F.lds + MISC_OFF);
    F.tid = threadIdx.x; F.lane = F.tid & 63; F.wave = __builtin_amdgcn_readfirstlane(F.tid >> 6); F.G = gridDim.x; F.bid = blockIdx.x;
    unsigned char* ws = args.ws;
    F.ctl = (gu32*)(ws + WS_CTL);
    for (int u = F.tid; u < (LDS_BYTES - LDSCTL_OFF) / 4; u += NWAVES * 64) ((LAS unsigned*)(F.lds + LDSCTL_OFF))[u] = 0u;
    __syncthreads();
    XcdBarrier bar; bar.bar = (unsigned*)(ws + WS_CTL) + CW_BAR; bar.x = 0; bar.st = nullptr;
    if (!MK_PER_PHASE) bar = xcd_barrier_post((unsigned*)(ws + WS_CTL) + CW_BAR, F.MISC + 8);
    const int lo = args.ph_lo, hi = args.ph_hi;
#ifndef PHASE_MASK
#define PHASE_MASK 0xFFFF
#endif
#define IN(k) (((PHASE_MASK >> (k)) & 1) && lo <= (k) && (k) < hi)
#define SEAM(k) do { if (IN(k) && IN((k) + 1)) { if (MK_PER_PHASE) { if (F.tid == 0) __hip_atomic_store(F.ctl + CW_TMO, 0xBADBA0u, RLX_AGENT); } else xcd_barrier(bar); } } while (0)
    float* ssq_h1 = (float*)(ws + WS_SSQ); float* ssq_h2 = (float*)(ws + WS_SSQ + SSQ16_BYTES); float* ssq_h3 = (float*)(ws + WS_SSQ + 2 * SSQ16_BYTES); float* ssq_h4 = (float*)(ws + WS_SSQ + 3 * SSQ16_BYTES);
    float* ssq_cq = (float*)(ws + WS_SSQ + 4 * SSQ16_BYTES); float* ssq_kv = (float*)(ws + WS_SSQ + 4 * SSQ16_BYTES + SSQ4_BYTES);
    const float2* rope = (const float2*)(ws + WS_ROPE);
    bf16 *XN1 = (bf16*)(ws + WS_XN1), *ACT = (bf16*)(ws + WS_ACT), *H1B = (bf16*)(ws + WS_H1B), *CQB = (bf16*)(ws + WS_CQB), *CKVB = (bf16*)(ws + WS_CKVB), *KPEB = (bf16*)(ws + WS_KPEB);
    bf16 *QR = (bf16*)(ws + WS_QR), *KR = (bf16*)(ws + WS_KR), *RV = (bf16*)(ws + WS_RV), *RGS = (bf16*)(ws + WS_RGS), *SGA = (bf16*)(ws + WS_SGA), *SGR = (bf16*)(ws + WS_SGR);
    bf16 *QB = (bf16*)(ws + WS_QB), *KN = (bf16*)(ws + WS_KN), *VB = (bf16*)(ws + WS_VB), *OCAT = (bf16*)(ws + WS_OCAT), *SC = (bf16*)(ws + WS_SC), *MRG = (bf16*)(ws + WS_MRG);
    bf16 *H2B = (bf16*)(ws + WS_H2B), *H3B = (bf16*)(ws + WS_H3B), *PB = (bf16*)(ws + WS_PB), *PP = (bf16*)(ws + WS_PP);
    float *H1 = (float*)(ws + WS_H1), *H2 = (float*)(ws + WS_H2), *H3 = (float*)(ws + WS_H3), *H4 = (float*)(ws + WS_H4), *CKVF = (float*)(ws + WS_CKVF), *KVC = (float*)(ws + WS_KVC);
    float *DPO = (float*)(ws + WS_DPO), *DML = (float*)(ws + WS_DML), *QLAT = (float*)(ws + WS_QLAT);
    const int gt = F.bid * (NWAVES * 64) + F.tid, NGT = F.G * NWAVES * 64, gw = F.bid * NWAVES + F.wave, NGW = F.G * NWAVES;

    if (IN(0)) { p0_prologue(args, F); }
    SEAM(0);
    if (IN(1)) { pg8::Gemm g{XN1, (const bf16*)(ws + WS_WGU1), MT, NGU, DM}; pg8::StaticOrder S; S.init(MT, NGU, F.G, F.bid);
        pg8::EpiSwiGLU E{0, ACT, nullptr}; pg8::gemm_phase<pg8::EpiSwiGLU, pg8::StaticOrder, true, true>(F.lds, g, S, E); }
    SEAM(1);
    if (IN(2)) { pg8::Gemm g{ACT, (const bf16*)(ws + WS_WD1), MP, DM, DFF}; pg8::StaticOrder S; S.init(MP, DM, F.G, F.bid);
        pg8::EpiResid<true> E{0, args.x_prompt, args.x_sample, 0, H1, H1B, ssq_h1}; pg8::gemm_phase<pg8::EpiResid<true>, pg8::StaticOrder, true, true>(F.lds, g, S, E);
        for (int u = F.bid; u < 128; u += F.G) sk::skinny_unit<DFF, false, true>(u, ACT, (const bf16*)(ws + WS_WD1), ssq_h1, (LAS float*)F.lds, sk::SkResidX{args.x_sample, H1, H1B}); }
    SEAM(2);
    if (IN(3)) { pg8::Gemm g{H1B, (const bf16*)(ws + WS_WIN), MT, NIN, DM}; pg8::StaticOrder S; S.init(MT, NIN, F.G, F.bid);
        pg8::EpiWin E{0, ssq_h1, ssq_cq, ssq_kv, rope, args.out, CQB, CKVB, KPEB, QR, KR, RV, RGS, SGA, SGR, CKVF};
        pg8::gemm_phase<pg8::EpiWin, pg8::StaticOrder, true, true>(F.lds, g, S, E); }
    SEAM(3);
    if (IN(4)) {
#ifndef P4_MASK
#define P4_MASK 31
#endif
        if (P4_MASK & 1) { pg8::Gemm g{CQB, (const bf16*)(ws + WS_WQB), MT, 768, QL}; pg8::StaticOrder S; S.init(MT, 768, F.G, F.bid);
          pg8::EpiQB E{0, ssq_cq, rope, QB}; pg8::gemm_phase<pg8::EpiQB, pg8::StaticOrder, true, true>(F.lds, g, S, E); }
        if (P4_MASK & 2) { pg8::Gemm g{CKVB, (const bf16*)(ws + WS_WKVB), MP, DM, KVL}; pg8::StaticOrder S; S.init(MP, DM, F.G, F.bid);
          pg8::EpiPlain E{0, KN, VB, 512, 2, ssq_kv, 1.0f / KVL}; pg8::gemm_phase<pg8::EpiPlain, pg8::StaticOrder, true, true>(F.lds, g, S, E); }
        if (P4_MASK & 4) { pg8::Gemm g{PB, (const bf16*)(ws + WS_WPP), MP, DM, PLE}; pg8::StaticOrder S; S.init(MP, DM, F.G, F.bid);
          pg8::EpiPlain E{0, PP, PP, DM, 4, nullptr, 0.f}; pg8::gemm_phase<pg8::EpiPlain, pg8::StaticOrder, true, true>(F.lds, g, S, E);
          for (int u = F.bid; u < 128; u += F.G) sk::skinny_unit<PLE, false, false>(u, PB, (const bf16*)(ws + WS_WPP), nullptr, (LAS float*)F.lds, sk::SkPlain{PP}); }
        if (P4_MASK & 8) for (int i = gt; i < (MP + MS) * 32; i += NGT) { const int row = i >> 5, c4 = (i & 31) * 4; const float rs = pg8::rstd_of<4>(ssq_kv, row, 1.0f / KVL);
            const pg8::f32x4 v = *(const pg8::f32x4*)(CKVF + (size_t)row * KVL + c4), g = *(const pg8::f32x4*)(args.kv_a_norm + c4);
            float* o = row < MP ? args.out + O_CKVP + (size_t)row * KVL : args.out + O_CKVS + (size_t)(row - MP) * KVL;
            *(pg8::f32x4*)(o + c4) = v * rs * g; }
        if (P4_MASK & 16) for (int u = F.bid; u < 512; u += F.G) ret::kv_unit(u, KR, RV, KVC, F.lds);
    }
    SEAM(4);
    if (IN(5)) {
#ifndef P5_MASK
#define P5_MASK 7
#endif
        if (P5_MASK & 1) for (int v = F.bid; v < 256; v += F.G) { const int bh = v >> 4, s = v & 15;
            att::attn_unit(bh >> 3, bh & 7, s, QB, KN, KPEB, VB, OCAT, (char*)lds);
            att::attn_unit(bh >> 3, bh & 7, 31 - s, QB, KN, KPEB, VB, OCAT, (char*)lds); }
        if (P5_MASK & 2) for (int v = F.bid; v < 256; v += F.G) { const int s = v >> 1, sg = v & 1;
            dec::qlat_token(s, QB, args.w_kv_b, (LAS float*)F.lds + dec::L_QL, QLAT, sg == 0);
            __syncthreads();
            for (int k = 0; k < 4; ++k) dec::split_unit(s, sg * 4 + k, QB, args.cache_ckv, args.cache_kpe, args.page_table, DPO, DML, (LAS float*)F.lds); }
        if (P5_MASK & 4) ret::scan_items(gt, NGT, KVC, SC, args.out);
    }
    SEAM(5);
    if (IN(6)) {
        for (int u = F.bid; u < 512; u += F.G) ret::out_unit(u, QR, KR, RV, SC, RGS, args.ret_norm, OCAT, F.lds);
        for (int u = F.bid; u < 512; u += F.G) ret::sample_unit(u, QR, KR, RV, RGS, args.ret_norm, args.state_ret, args.out, OCAT, F.lds);
        for (int s = F.bid; s < MS; s += F.G) dec::combine_unit(s, QB, QLAT, DPO, DML, args.out, args.w_kv_b, OCAT, (LAS float*)F.lds);
    }
    SEAM(6);
    if (IN(7)) { pg8::Gemm g{OCAT, (const bf16*)(ws + WS_WBC), MP, DM, DM}; pg8::StaticOrder S; S.init(MP, DM, F.G, F.bid);
        pg8::EpiMerge E{8, SGA, SGR, MRG}; pg8::gemm_phase<pg8::EpiMerge, pg8::StaticOrder, true, true>(F.lds, g, S, E);
        for (int u = F.bid; u < 128; u += F.G) sk::skinny_unit<DM, true, false>(u, OCAT, (const bf16*)(ws + WS_WBC), nullptr, (LAS float*)F.lds, sk::SkMerge{SGA, SGR, MRG}); }
    SEAM(7);
    if (IN(8)) { pg8::Gemm g{MRG, (const bf16*)(ws + WS_WOUT), MP, DM, DM}; pg8::StaticOrder S; S.init(MP, DM, F.G, F.bid);
        pg8::EpiResid<false> E{0, H1, H1, 1, H2, H2B, ssq_h2}; pg8::gemm_phase<pg8::EpiResid<false>, pg8::StaticOrder, true, true>(F.lds, g, S, E);
        for (int u = F.bid; u < 128; u += F.G) sk::skinny_unit<DM, false, true>(u, MRG, (const bf16*)(ws + WS_WOUT), ssq_h2, (LAS float*)F.lds, sk::SkResid{H1, 1.0f, H2, H2B}); }
    SEAM(8);
    if (IN(9)) { pg8::Gemm g{H2B, (const bf16*)(ws + WS_WGU2), MT, NGU, DM}; pg8::StaticOrder S; S.init(MT, NGU, F.G, F.bid);
        pg8::EpiSwiGLU E{0, ACT, ssq_h2}; pg8::gemm_phase<pg8::EpiSwiGLU, pg8::StaticOrder, true, true>(F.lds, g, S, E); }
    SEAM(9);
    if (IN(10)) { pg8::Gemm g{ACT, (const bf16*)(ws + WS_WD2), MP, DM, DFF}; pg8::StaticOrder S; S.init(MP, DM, F.G, F.bid);
        pg8::EpiResid<true> E{0, H2, H2, 1, H3, H3B, ssq_h3}; pg8::gemm_phase<pg8::EpiResid<true>, pg8::StaticOrder, true, true>(F.lds, g, S, E);
        for (int u = F.bid; u < 128; u += F.G) sk::skinny_unit<DFF, false, true>(u, ACT, (const bf16*)(ws + WS_WD2), ssq_h3, (LAS float*)F.lds, sk::SkResid{H2, 0.5f, H3, H3B}); }
    SEAM(10);
    if (IN(11)) { pg8::Gemm g{H3B, (const bf16*)(ws + WS_WPG), MP, DM, DM}; pg8::StaticOrder S; S.init(MP, DM, F.G, F.bid);
        pg8::EpiPle E{0, H3, PP, ssq_h3, H4, ssq_h4}; pg8::gemm_phase<pg8::EpiPle, pg8::StaticOrder, true, true>(F.lds, g, S, E);
        for (int u = F.bid; u < 128; u += F.G) sk::skinny_unit<DM, false, true>(u, H3B, (const bf16*)(ws + WS_WPG), ssq_h4, (LAS float*)F.lds, sk::SkPle{H3, PP, ssq_h3, H4}); }
    SEAM(11);
    if (IN(12)) {
        for (int m = gw; m < MP + MS; m += NGW) { const float rs = pg8::rstd_of<16>(ssq_h4, m, 1.0f / DM);
            const pg8::f32x4* hr = (const pg8::f32x4*)(H4 + (size_t)m * DM) + F.lane; pg8::f32x4* o = (pg8::f32x4*)(args.out + (m < MP ? O_YP + (size_t)m * DM : O_YS + (size_t)(m - MP) * DM)) + F.lane;
#pragma unroll
            for (int j = 0; j < 4; ++j) o[64 * j] = hr[64 * j] * rs * ((const pg8::f32x4*)args.final_norm)[F.lane + 64 * j]; }
    }
#undef IN
#undef SEAM
}

#ifdef DBG_LAST
__global__ void dbg_dump(const unsigned char* ws, float* out) {
    const size_t n = (size_t)MP * DM;
    for (size_t i = (size_t)blockIdx.x * blockDim.x + threadIdx.x; i < n; i += (size_t)gridDim.x * blockDim.x) { const size_t r = i >> 10, c = i & 1023; float v = 0.f;
        if (c < DBG_NCOLS) { if (DBG_F32) v = ((const float*)(ws + DBG_SRC))[r * DBG_PITCH + c]; else v = bf2f(((const bf16*)(ws + DBG_SRC))[r * DBG_PITCH + c]); }
#ifdef DBG_SRC2
        else v = bf2f(((const bf16*)(ws + DBG_SRC2))[r * DBG_PITCH + (c - DBG_NCOLS)]);
#endif
        out[i] = v; }
}
#endif
extern "C" void kernel_launch(void* const* d_in, const int* in_sizes, int n_in, void* d_out, int out_size, void* d_ws, size_t ws_size, hipStream_t stream) {
    static int grid = 0;
    if (grid == 0) {
        if (n_in != 30 || out_size != (int)O_END || ws_size < WS_END) { fprintf(stderr, "kernel_launch: built for 30 inputs, %zu outputs, >= %zu bytes of workspace; got n_in %d, out %d, ws %zu; nothing launched\n", (size_t)O_END, (size_t)WS_END, n_in, out_size, ws_size); grid = -1; return; }
        int dev = 0, cus = 0, per_cu = 0;
        if (hipGetDevice(&dev) != hipSuccess || hipDeviceGetAttribute(&cus, hipDeviceAttributeMultiprocessorCount, dev) != hipSuccess) { fprintf(stderr, "kernel_launch: device query failed\n"); grid = -1; return; }
        if (hipFuncSetAttribute((const void*)mk_fwd, hipFuncAttributeMaxDynamicSharedMemorySize, LDS_BYTES) != hipSuccess) { fprintf(stderr, "kernel_launch: hipFuncSetAttribute failed\n"); grid = -1; return; }
        if (hipOccupancyMaxActiveBlocksPerMultiprocessor(&per_cu, (const void*)mk_fwd, NWAVES * 64, LDS_BYTES) != hipSuccess || per_cu < 1)
            fprintf(stderr, "kernel_launch: note: occupancy query reports %d workgroups per CU\n", per_cu);
        (void)hipGetLastError();
        grid = cus;
    }
    if (grid < 0) return;
    if (hipMemsetAsync((char*)d_ws + WS_CTL, 0, CTL_ZERO_BYTES, stream) != hipSuccess) { fprintf(stderr, "kernel_launch: memset failed\n"); return; }
    Args a{};
    const float** fp = (const float**)&a;
    for (int i = 0; i < 30; ++i) fp[i] = (const float*)d_in[i];
    a.out = (float*)d_out; a.ws = (unsigned char*)d_ws;
#if MK_PER_PHASE
#ifdef DBG_LAST
    for (int k = 0; k <= DBG_LAST; ++k) { a.ph_lo = k; a.ph_hi = k + 1; hipLaunchKernelGGL(mk_fwd, dim3(grid), dim3(NWAVES * 64), LDS_BYTES, stream, a); }
    hipLaunchKernelGGL(dbg_dump, dim3(1024), dim3(256), 0, stream, (const unsigned char*)d_ws, (float*)d_out);
#else
    for (int k = 0; k < NPHASE; ++k) { a.ph_lo = k; a.ph_hi = k + 1; hipLaunchKernelGGL(mk_fwd, dim3(grid), dim3(NWAVES * 64), LDS_BYTES, stream, a); }
#endif
#else
    a.ph_lo = 0; a.ph_hi = NPHASE; hipLaunchKernelGGL(mk_fwd, dim3(grid), dim3(NWAVES * 64), LDS_BYTES, stream, a);
#endif
    const hipError_t le = hipPeekAtLastError();
    if (le != hipSuccess) fprintf(stderr, "kernel_launch: launch failed: %s\n", hipGetErrorName(le));
}
```

```cpp
#include <hip/hip_runtime.h>
#include <cstdio>
#include <cstdint>

#ifndef MK_PER_PHASE
#define MK_PER_PHASE 0
#endif

constexpr int DM = 1024, TSEQ = 8192, MP = 16384, MS = 128, MT = 16640, NPAN = MT / 256;
constexpr int DFF = 2816, NGU = 2 * DFF, NIN = 4608, PLE = 256;
constexpr int NH = 8, QKD = 96, KVL = 128, RPE = 32, QL = 256;
constexpr int RH = 4, RDK = 128, RDV = 128;
constexpr int NPAGES = 128, PAGE = 128;
constexpr float EPS = 1e-6f;
constexpr float C2 = 0.10206207261596575f * 1.4426950408889634f;
constexpr size_t O_YP = 0, O_YS = 16777216, O_CKVP = 16908288, O_KPEP = 19005440, O_RETP = 19529728, O_CKVS = 19660800, O_KPES = 19677184, O_RETS = 19681280, O_END = 28069888;

constexpr size_t MiB = 1u << 20;
constexpr size_t al1(size_t x) { return (x + MiB - 1) & ~(MiB - 1); }
constexpr size_t WS_CTL = 0, CTL_ZERO_BYTES = 1 * MiB;
constexpr size_t WS_WGU1 = 2 * MiB;
constexpr size_t WS_WD1  = WS_WGU1 + al1((size_t)NGU * DM * 2);
constexpr size_t WS_WIN  = WS_WD1 + al1((size_t)DM * DFF * 2);
constexpr size_t WS_WQB  = WS_WIN + al1((size_t)NIN * DM * 2);
constexpr size_t WS_WKVB = WS_WQB + al1((size_t)768 * 256 * 2);
constexpr size_t WS_WBC  = WS_WKVB + al1((size_t)1024 * 128 * 2);
constexpr size_t WS_WOUT = WS_WBC + al1((size_t)DM * DM * 2);
constexpr size_t WS_WGU2 = WS_WOUT + al1((size_t)DM * DM * 2);
constexpr size_t WS_WD2  = WS_WGU2 + al1((size_t)NGU * DM * 2);
constexpr size_t WS_WPG  = WS_WD2 + al1((size_t)DM * DFF * 2);
constexpr size_t WS_WPP  = WS_WPG + al1((size_t)DM * DM * 2);
constexpr size_t WS_ROPE = WS_WPP + al1((size_t)DM * PLE * 2);
constexpr size_t WS_XN1  = WS_ROPE + al1((size_t)8193 * 64 * 8);
constexpr size_t WS_ACT  = WS_XN1 + al1((size_t)MT * DM * 2);
constexpr size_t WS_H1   = WS_ACT + al1((size_t)MT * DFF * 2);
constexpr size_t WS_H1B  = WS_H1 + al1((size_t)MT * DM * 4);
constexpr size_t WS_CQB  = WS_H1B + al1((size_t)MT * DM * 2);
constexpr size_t WS_CKVF = WS_CQB + al1((size_t)MT * 256 * 2);
constexpr size_t WS_CKVB = WS_CKVF + al1((size_t)MT * 128 * 4);
constexpr size_t WS_KPEB = WS_CKVB + al1((size_t)MT * 128 * 2);
constexpr size_t WS_QR   = WS_KPEB + al1((size_t)MT * 32 * 2);
constexpr size_t WS_KR   = WS_QR + al1((size_t)MT * 512 * 2);
constexpr size_t WS_RV   = WS_KR + al1((size_t)MT * 512 * 2);
constexpr size_t WS_RGS  = WS_RV + al1((size_t)MT * 512 * 2);
constexpr size_t WS_SGA  = WS_RGS + al1((size_t)MT * 512 * 2);
constexpr size_t WS_SGR  = WS_SGA + al1((size_t)MT * DM * 2);
constexpr size_t WS_QB   = WS_SGR + al1((size_t)MT * DM * 2);
constexpr size_t WS_KN   = WS_QB + al1((size_t)MT * 768 * 2);
constexpr size_t WS_VB   = WS_KN + al1((size_t)MP * 512 * 2);
constexpr size_t WS_OCAT = WS_VB + al1((size_t)MP * 512 * 2);
constexpr size_t WS_KVC  = WS_OCAT + al1((size_t)MT * DM * 2);
constexpr size_t WS_SC   = WS_KVC + al1((size_t)512 * 16384 * 4);
constexpr size_t WS_MRG  = WS_SC + al1((size_t)512 * 16384 * 2);
constexpr size_t WS_H2   = WS_MRG + al1((size_t)MT * DM * 2);
constexpr size_t WS_H2B  = WS_H2 + al1((size_t)MT * DM * 4);
constexpr size_t WS_H3   = WS_H2B + al1((size_t)MT * DM * 2);
constexpr size_t WS_H3B  = WS_H3 + al1((size_t)MT * DM * 4);
constexpr size_t WS_PB   = WS_H3B + al1((size_t)MT * DM * 2);
constexpr size_t WS_PP   = WS_PB + al1((size_t)MT * PLE * 2);
constexpr size_t WS_H4   = WS_PP + al1((size_t)MT * DM * 2);
constexpr size_t WS_DPO  = WS_H4 + al1((size_t)MT * DM * 4);
constexpr size_t WS_DML  = WS_DPO + al1((size_t)128 * 16 * 8 * 128 * 4);
constexpr size_t WS_QLAT = WS_DML + MiB;
constexpr size_t WS_SSQ  = WS_QLAT + MiB;
constexpr size_t SSQ16_BYTES = (size_t)MT * 16 * 4, SSQ4_BYTES = (size_t)MT * 4 * 4;
constexpr size_t WS_END  = WS_SSQ + al1(4 * SSQ16_BYTES + 2 * SSQ4_BYTES);
constexpr int CW_TMO = 0, CW_BAR = 4096;

constexpr int RING_BYTES = 131072, PH5_BYTES = 157696, LDSCTL_OFF = PH5_BYTES, MISC_OFF = LDSCTL_OFF + 320, LDS_BYTES = 163840;

#define GAS __attribute__((address_space(1)))
#define LAS __attribute__((address_space(3)))
typedef unsigned short bf16;
typedef unsigned v4u __attribute__((ext_vector_type(4)));
typedef unsigned v2u __attribute__((ext_vector_type(2)));
typedef GAS unsigned gu32;
#define RLX_AGENT __ATOMIC_RELAXED, __HIP_MEMORY_SCOPE_AGENT
#define LDS_WAIT() asm volatile("s_waitcnt lgkmcnt(0)" ::: "memory")
#define VM_WAIT() asm volatile("s_waitcnt vmcnt(0)" ::: "memory")
__device__ __forceinline__ unsigned f2bf(float f) { unsigned u = __builtin_bit_cast(unsigned, f); return (u + 0x7fffu + ((u >> 16) & 1u)) >> 16; }
__device__ __forceinline__ unsigned pk2(float lo, float hi) { return f2bf(lo) | (f2bf(hi) << 16); }
__device__ __forceinline__ float bflo(unsigned w) { return __builtin_bit_cast(float, w << 16); }
__device__ __forceinline__ float bfhi(unsigned w) { return __builtin_bit_cast(float, w & 0xffff0000u); }
__device__ __forceinline__ float bf2f(bf16 h) { return __builtin_bit_cast(float, (unsigned)h << 16); }
__device__ __forceinline__ float sigm(float x) { return __builtin_amdgcn_rcpf(1.f + __builtin_amdgcn_exp2f(-1.4426950408889634f * x)); }
__device__ __forceinline__ float wave_sum(float v) {
#pragma unroll
    for (int o = 1; o < 64; o <<= 1) v += __shfl_xor(v, o);
    return v;
}
__device__ __forceinline__ float lg2gamma(int h) { return h == 0 ? -0.04580368961312479f : h == 1 ? -0.02272007650008353f : h == 2 ? -0.011315313227834146f : -0.005646563141142063f; }
namespace pg8 {
#define PG8_LAS __attribute__((address_space(3)))
typedef unsigned short bf16_t;
typedef short bf16x8 __attribute__((ext_vector_type(8)));
typedef float f32x4 __attribute__((ext_vector_type(4)));
typedef unsigned u32x4 __attribute__((ext_vector_type(4)));
constexpr int BM = 256, BK = 64, HALF = 128, HTB = HALF * BK * 2  , STAGE_BYTES = 8 * HTB, NXCD = 8, WGM = 8;

__host__ __device__ __forceinline__ int lds_byte(int r, int c) { const int st = (r >> 4) * 2 + (c >> 5), rr = r & 15, cc = c & 31, ob = rr * 64 + cc * 2; return st * 1024 + (ob ^ (((ob >> 9) & 1) << 5)); }
__host__ __device__ __forceinline__ void stage_rc(int b, int& R, int& C) { const int st = b / 1024, sb = b % 1024, swz = sb ^ (((sb >> 9) & 1) << 5); R = (st >> 1) * 16 + swz / 64; C = (st & 1) * 32 + (swz % 64) / 2; }
__host__ __device__ __forceinline__ int perm32(int rho) { const int n = rho >> 4, i = rho & 15; return 8 * (i >> 2) + 4 * n + (i & 3); }

struct Unit { int pm, pn; };
struct Gemm { const bf16_t* A; const bf16_t* Bt; int M, N, K; };

struct StaticOrder {
    int nM, nN, nwg, G, c;
    __host__ __device__ void init(int M, int N, int G_, int c_) { nM = M / BM; nN = N / BM; nwg = nM * nN; G = G_; c = c_; }
    __host__ __device__ bool next(int i, Unit& u) const {
        const long L = (long)i * G + c; if (L >= nwg) return false;
        int wgid = (int)L; { const int q = nwg / NXCD, r = nwg % NXCD, xcd = wgid % NXCD, off = wgid / NXCD; wgid = (xcd < r ? xcd * (q + 1) : r * (q + 1) + (xcd - r) * q) + off; }
        const int nig = WGM * nN, gid = wgid / nig, fm = gid * WGM, gsz = (nM - fm) < WGM ? (nM - fm) : WGM;
        u.pm = fm + ((wgid % nig) % gsz); u.pn = (wgid % nig) / gsz; return true;
    }
    __device__ __forceinline__ void a_ready(const Unit&) const {}
    __device__ __forceinline__ void done(const Unit&) const {}
};

typedef float cvt_f32x2_t __attribute__((ext_vector_type(2))); typedef __bf16 cvt_bf16x2_t __attribute__((ext_vector_type(2)));
__device__ __forceinline__ unsigned cvt_pk_bf16(float lo, float hi) { cvt_f32x2_t v = {lo, hi}; cvt_bf16x2_t b = __builtin_convertvector(v, cvt_bf16x2_t); return __builtin_bit_cast(unsigned, b); }
typedef float f32x2 __attribute__((ext_vector_type(2)));
template <class Epi, class Sched, bool ALIGN_EPI = false, bool SP2 = false>
__device__ __forceinline__ void gemm_phase(PG8_LAS unsigned char* lds, const Gemm g, const Sched S, const Epi E) {
    int tid_ = threadIdx.x; asm volatile("" : "+v"(tid_));
    const int tid = tid_, wid = __builtin_amdgcn_readfirstlane(tid >> 6), lane = tid & 63, wr = wid >> 2, wc = wid & 3, fr = lane & 15, fq = lane >> 4;
    const int K = g.K, nt = K / BK;
    unsigned voffA[2], voffB[2];
#pragma unroll
    for (int i = 0; i < 2; ++i) { int R, C; stage_rc(tid * 16 + i * 8192, R, C); const int Rb = Epi::PERM ? ((R & ~31) + perm32(R & 31)) : R;
        voffA[i] = (unsigned)(R * K + C) * 2u; voffB[i] = (unsigned)(Rb * K + C) * 2u; }
    const size_t kstep = (size_t)(BK * 2);
    const size_t hstep = (size_t)HALF * K * 2;
    const size_t tstep = 2 * hstep;
    const unsigned ldsw = (unsigned)wid * 1024u;
    const int aoff = lds_byte(wr * 64 + fr, fq * 8), boff = lds_byte(wc * 32 + fr, fq * 8);
#define PG8_SA(b, h) (((b) * 2 + (h)) * HTB)
#define PG8_SB(b, h) ((4 + (b) * 2 + (h)) * HTB)
#define PG8_STAGE(bufoff, gbase, voff) do { _Pragma("unroll") for (int _i = 0; _i < 2; ++_i) \
        __builtin_amdgcn_global_load_lds((const unsigned*)((const char*)(gbase) + (voff)[_i]), (PG8_LAS unsigned*)(lds + (bufoff) + ldsw + _i * 8192), 16, 0, 0); } while (0)
#define PG8_LDA(dst, b, h) do { _Pragma("unroll") for (int m = 0; m < 4; ++m) _Pragma("unroll") for (int k = 0; k < 2; ++k) dst[m][k] = *(const PG8_LAS bf16x8*)(lds + PG8_SA(b, h) + aoff + m * 2048 + k * 1024); } while (0)
#define PG8_LDB(dst, b, h) do { _Pragma("unroll") for (int n = 0; n < 2; ++n) _Pragma("unroll") for (int k = 0; k < 2; ++k) dst[n][k] = *(const PG8_LAS bf16x8*)(lds + PG8_SB(b, h) + boff + n * 2048 + k * 1024); } while (0)
#define PG8_MMA(ai, bj, At, Bt) do { __builtin_amdgcn_s_setprio(1); _Pragma("unroll") for (int m = 0; m < 4; ++m) _Pragma("unroll") for (int n = 0; n < 2; ++n) _Pragma("unroll") for (int k = 0; k < 2; ++k) \
        acc[ai][bj][m][n] = __builtin_amdgcn_mfma_f32_16x16x32_bf16(Bt[n][k], At[m][k], acc[ai][bj][m][n], 0, 0, 0); __builtin_amdgcn_s_setprio(0); } while (0)
#define PG8_WAIT_V(n) asm volatile("s_waitcnt vmcnt(" #n ")" ::: "memory")
#define PG8_WAIT_L(n) asm volatile("s_waitcnt lgkmcnt(" #n ")" ::: "memory")
#define PG8_BAR __builtin_amdgcn_s_barrier()
#define PG8_SCHED __builtin_amdgcn_sched_barrier(0)
    Unit cur, nxt; int ui = 0;
    if (!S.next(0, cur)) return;
    f32x4 acc[2][2][4][2];
#pragma unroll
    for (int a = 0; a < 2; ++a)
#pragma unroll
        for (int b = 0; b < 2; ++b)
#pragma unroll
            for (int m = 0; m < 4; ++m)
#pragma unroll
                for (int n = 0; n < 2; ++n) acc[a][b][m][n] = (f32x4){0.f, 0.f, 0.f, 0.f};
    bf16x8 At[4][2], B0[2][2], B1[2][2];
    const char* cA = (const char*)g.A + (size_t)cur.pm * tstep; const char* cB = (const char*)g.Bt + (size_t)cur.pn * tstep;
    S.a_ready(cur);
    if constexpr (SP2) {
        PG8_STAGE(PG8_SB(0, 0), cB, voffB); PG8_STAGE(PG8_SB(0, 1), cB + hstep, voffB); PG8_STAGE(PG8_SA(0, 0), cA, voffA); PG8_STAGE(PG8_SA(0, 1), cA + hstep, voffA);
        if (wr == 1) PG8_BAR;
        PG8_WAIT_V(2); PG8_BAR;
        PG8_STAGE(PG8_SB(1, 0), cB + kstep, voffB); PG8_STAGE(PG8_SA(1, 0), cA + kstep, voffA); PG8_STAGE(PG8_SB(1, 1), cB + hstep + kstep, voffB);
        PG8_WAIT_V(6); PG8_BAR;
    } else {
        PG8_STAGE(PG8_SB(0, 0), cB, voffB); PG8_STAGE(PG8_SA(0, 0), cA, voffA); PG8_STAGE(PG8_SB(0, 1), cB + hstep, voffB); PG8_STAGE(PG8_SA(0, 1), cA + hstep, voffA);
        if (wr == 1) PG8_BAR;
        PG8_WAIT_V(4); PG8_BAR;
        PG8_STAGE(PG8_SB(1, 0), cB + kstep, voffB); PG8_STAGE(PG8_SA(1, 0), cA + kstep, voffA); PG8_STAGE(PG8_SB(1, 1), cB + hstep + kstep, voffB);
        PG8_WAIT_V(6); PG8_BAR;
    }
    for (;;) {
        const bool has_next = S.next(ui + 1, nxt);
        const char* nA = has_next ? (const char*)g.A + (size_t)nxt.pm * tstep : cA; const char* nB = has_next ? (const char*)g.Bt + (size_t)nxt.pn * tstep : cB;
#pragma nounroll
        for (int t = 0; t < nt; t += 2) {
            if constexpr (Epi::HAS_MID) { if (t == E.mid_t) E.mid(acc, cur, wr, wc, fr, fq); }
            const bool last = (t == nt - 2);
            const char* a1 = cA + (size_t)(t + 1) * kstep;
            const char* a2 = last ? nA : cA + (size_t)(t + 2) * kstep; const char* b2 = last ? nB : cB + (size_t)(t + 2) * kstep;
            const char* a3 = a2 + kstep; const char* b3 = b2 + kstep;
            if (last && has_next) S.a_ready(nxt);
            if constexpr (SP2) {
            PG8_LDB(B0, 0, 0); PG8_LDB(B1, 0, 1); PG8_SCHED; PG8_LDA(At, 0, 0); PG8_STAGE(PG8_SA(1, 1), a1 + hstep, voffA);
            PG8_WAIT_V(8); PG8_WAIT_L(0); PG8_BAR; PG8_MMA(0, 0, At, B0); PG8_MMA(0, 1, At, B1); PG8_BAR; PG8_SCHED;
            PG8_LDA(At, 0, 1); PG8_STAGE(PG8_SB(0, 0), b2, voffB); PG8_STAGE(PG8_SB(0, 1), b2 + hstep, voffB); PG8_STAGE(PG8_SA(0, 0), a2, voffA);
            PG8_WAIT_V(8); PG8_WAIT_L(0); PG8_BAR; PG8_MMA(1, 0, At, B0); PG8_MMA(1, 1, At, B1); PG8_BAR; PG8_SCHED;
            PG8_LDB(B0, 1, 0); PG8_LDB(B1, 1, 1); PG8_SCHED; PG8_LDA(At, 1, 0); PG8_STAGE(PG8_SA(0, 1), a2 + hstep, voffA);
            PG8_WAIT_V(8); PG8_WAIT_L(0); PG8_BAR; PG8_MMA(0, 0, At, B0); PG8_MMA(0, 1, At, B1); PG8_BAR; PG8_SCHED;
            PG8_LDA(At, 1, 1); PG8_STAGE(PG8_SB(1, 0), b3, voffB); PG8_STAGE(PG8_SB(1, 1), b3 + hstep, voffB); PG8_STAGE(PG8_SA(1, 0), a3, voffA);
            PG8_WAIT_V(8); PG8_WAIT_L(0); PG8_BAR; PG8_MMA(1, 0, At, B0); PG8_MMA(1, 1, At, B1); PG8_BAR; PG8_SCHED;
            } else {
            PG8_LDB(B0, 0, 0); PG8_SCHED; PG8_LDA(At, 0, 0); PG8_STAGE(PG8_SA(1, 1), a1 + hstep, voffA);
            PG8_WAIT_L(8); PG8_BAR; PG8_WAIT_L(0); PG8_MMA(0, 0, At, B0); PG8_BAR; PG8_SCHED;
            PG8_LDB(B1, 0, 1); PG8_STAGE(PG8_SB(0, 0), b2, voffB);
            PG8_BAR; PG8_WAIT_L(0); PG8_MMA(0, 1, At, B1); PG8_BAR;
            PG8_LDA(At, 0, 1); PG8_STAGE(PG8_SA(0, 0), a2, voffA);
            PG8_BAR; PG8_WAIT_L(0); PG8_MMA(1, 0, At, B0); PG8_BAR; PG8_SCHED;
            PG8_STAGE(PG8_SB(0, 1), b2 + hstep, voffB);
            PG8_WAIT_V(6); PG8_BAR; PG8_MMA(1, 1, At, B1); PG8_BAR;
            PG8_LDB(B0, 1, 0); PG8_SCHED; PG8_LDA(At, 1, 0); PG8_STAGE(PG8_SA(0, 1), a2 + hstep, voffA);
            PG8_WAIT_L(8); PG8_BAR; PG8_WAIT_L(0); PG8_MMA(0, 0, At, B0); PG8_BAR; PG8_SCHED;
            PG8_LDB(B1, 1, 1); PG8_STAGE(PG8_SB(1, 0), b3, voffB);
            PG8_BAR; PG8_WAIT_L(0); PG8_MMA(0, 1, At, B1); PG8_BAR;
            PG8_LDA(At, 1, 1); PG8_STAGE(PG8_SA(1, 0), a3, voffA);
            PG8_BAR; PG8_WAIT_L(0); PG8_MMA(1, 0, At, B0); PG8_BAR; PG8_SCHED;
            PG8_STAGE(PG8_SB(1, 1), b3 + hstep, voffB);
            PG8_WAIT_V(6); PG8_BAR; PG8_MMA(1, 1, At, B1); PG8_BAR;
            }
        }
        if constexpr (ALIGN_EPI) { if (wr == 0) PG8_BAR; }
        if constexpr (!Epi::AFTER_DRAIN) { E(acc, cur, wr, wc, fr, fq); S.done(cur); }
        if (!has_next) break;
#pragma unroll
        for (int a = 0; a < 2; ++a)
#pragma unroll
            for (int b = 0; b < 2; ++b)
#pragma unroll
                for (int m = 0; m < 4; ++m)
#pragma unroll
                    for (int n = 0; n < 2; ++n) acc[a][b][m][n] = (f32x4){0.f, 0.f, 0.f, 0.f};
        cur = nxt; cA = nA; cB = nB; ++ui;
        if constexpr (ALIGN_EPI) { if (wr == 1) PG8_BAR; }
    }
    PG8_WAIT_V(0);
    if constexpr (!ALIGN_EPI) { if (wr == 0) PG8_BAR; }
    PG8_BAR;
    if constexpr (Epi::AFTER_DRAIN) { E.fused(acc, cur, wr, wc, fr, fq, lds, wid, lane); S.done(cur); }
#undef PG8_SA
#undef PG8_SB
#undef PG8_STAGE
#undef PG8_LDA
#undef PG8_LDB
#undef PG8_MMA
#undef PG8_WAIT_V
#undef PG8_WAIT_L
#undef PG8_BAR
#undef PG8_SCHED
}
}
namespace pg8 {
#define EPI_ROWS(ai, m) (u.pm * BM + (ai) * HALF + wr * 64 + (m) * 16 + fr)
#define EPI_OPAQUE int fr = fr_, fq = fq_; asm volatile("" : "+v"(fr), "+v"(fq))
__device__ __forceinline__ u32x4 pack8(f32x4 a, f32x4 b) { u32x4 w; w.x = cvt_pk_bf16(a[0], a[1]); w.y = cvt_pk_bf16(a[2], a[3]); w.z = cvt_pk_bf16(b[0], b[1]); w.w = cvt_pk_bf16(b[2], b[3]); return w; }
__device__ __forceinline__ float sq4(f32x4 a) { return (a[0] * a[0] + a[1] * a[1]) + (a[2] * a[2] + a[3] * a[3]); }
template <int NS> __device__ __forceinline__ float rstd_of(const float* part, int row, float invn) {
    float s = 0.f;
#pragma unroll
    for (int i = 0; i < NS; i += 4) { const f32x4 v = *(const f32x4*)(part + (size_t)row * NS + i); s += (v[0] + v[1]) + (v[2] + v[3]); }
    return 1.0f / sqrtf(s * invn + EPS);
}
template <int NS> __device__ __forceinline__ void ssq_put(float* part, int row, int slot, float s, int fq) { s += __shfl_xor(s, 16); s += __shfl_xor(s, 32); if (fq == 0) part[(size_t)row * NS + slot] = s; }
__device__ __forceinline__ float silu_f(float x) { return x * sigm(x); }
__device__ __forceinline__ int pos_of_row(int row) { return row < MP ? (row & (TSEQ - 1)) : TSEQ; }

struct EpiSwiGLU {
    static constexpr bool PERM = true, AFTER_DRAIN = false, HAS_MID = false; int mid_t;
    bf16_t* O; const float* ssq;
    __device__ __forceinline__ void mid(f32x4 (&)[2][2][4][2], const Unit&, int, int, int, int) const {}
    __device__ __forceinline__ void operator()(const f32x4 (&acc)[2][2][4][2], const Unit& u, int wr, int wc, int fr_, int fq_) const { EPI_OPAQUE;
        const int col0 = u.pn * HALF + wc * 32 + 8 * fq;
#pragma unroll
        for (int ai = 0; ai < 2; ++ai)
#pragma unroll
            for (int m = 0; m < 4; ++m) { const int row = EPI_ROWS(ai, m); const float rs = ssq ? rstd_of<16>(ssq, row, 1.0f / DM) : 1.0f;
                f32x4 o[2];
#pragma unroll
                for (int n = 0; n < 2; ++n)
#pragma unroll
                    for (int j = 0; j < 4; ++j) o[n][j] = silu_f(acc[ai][0][m][n][j] * rs) * (acc[ai][1][m][n][j] * rs);
                *(u32x4*)(O + (size_t)row * DFF + col0) = pack8(o[0], o[1]); }
    }
};

template <bool HALFA, bool XIN> struct EpiResid {
    static constexpr bool PERM = true, AFTER_DRAIN = false, HAS_MID = false; int mid_t; static constexpr float alpha = HALFA ? 0.5f : 1.0f;
    const void* R; bf16_t* Hb; float* ssq;
    __device__ __forceinline__ void mid(f32x4 (&)[2][2][4][2], const Unit&, int, int, int, int) const {}
    __device__ __forceinline__ void operator()(const f32x4 (&acc)[2][2][4][2], const Unit& u, int wr, int wc, int fr_, int fq_) const { EPI_OPAQUE;
        const int colb = u.pn * BM + wc * 32 + 8 * fq;
#pragma unroll
        for (int ai = 0; ai < 2; ++ai)
#pragma unroll
            for (int m = 0; m < 4; ++m) { const int row = EPI_ROWS(ai, m);
                float s = 0.f;
#pragma unroll
                for (int bj = 0; bj < 2; ++bj) { const int col = colb + bj * HALF; f32x4 r0, r1;
                    if (XIN) { const float* rp = (const float*)R + (size_t)row * DM + col; r0 = *(const f32x4*)rp; r1 = *(const f32x4*)(rp + 4); }
                    else { const u32x4 w = *(const u32x4*)((const bf16_t*)R + (size_t)row * DM + col); r0 = (f32x4){bflo(w[0]), bfhi(w[0]), bflo(w[1]), bfhi(w[1])}; r1 = (f32x4){bflo(w[2]), bfhi(w[2]), bflo(w[3]), bfhi(w[3])}; }
                    const f32x4 h0 = r0 + acc[ai][bj][m][0] * alpha, h1 = r1 + acc[ai][bj][m][1] * alpha;
                    *(u32x4*)(Hb + (size_t)row * DM + col) = pack8(h0, h1);
                    s += sq4(h0) + sq4(h1); }
                ssq_put<16>(ssq, row, u.pn * 4 + wc, s, fq); }
    }
};

__device__ __forceinline__ void rope4(const float2* tabrow, int i0, int istride, f32x4 x1, f32x4 x2, f32x4& y1, f32x4& y2) {
#pragma unroll
    for (int j = 0; j < 4; ++j) { const float2 cs = tabrow[(i0 + j) * istride]; y1[j] = x1[j] * cs.x - x2[j] * cs.y; y2[j] = x1[j] * cs.y + x2[j] * cs.x; }
}

struct EpiWin {
    static constexpr bool PERM = true, AFTER_DRAIN = false, HAS_MID = false; int mid_t;
    const float* ssq1; float* ssq_cq; float* ssq_kv; const float2* rope; float* dout;
    bf16_t *CQB, *CKVB, *KPEB, *QR, *KR, *RV, *RGS, *SGA, *SGR; float* CKVF;
    __device__ __forceinline__ void mid(f32x4 (&)[2][2][4][2], const Unit&, int, int, int, int) const {}
    __device__ __forceinline__ void operator()(const f32x4 (&acc)[2][2][4][2], const Unit& u, int wr, int wc, int fr_, int fq_) const { EPI_OPAQUE;
        const int pn = u.pn, c8 = wc * 32 + 8 * fq;
#pragma unroll
        for (int ai = 0; ai < 2; ++ai)
#pragma unroll
            for (int m = 0; m < 4; ++m) { const int row = EPI_ROWS(ai, m); const float rs = rstd_of<16>(ssq1, row, 1.0f / DM);
                if (pn == 0) {
                    float s = 0.f;
#pragma unroll
                    for (int bj = 0; bj < 2; ++bj) { const f32x4 a = acc[ai][bj][m][0] * rs, b = acc[ai][bj][m][1] * rs; s += sq4(a) + sq4(b);
                        *(u32x4*)(CQB + (size_t)row * QL + bj * HALF + c8) = pack8(a, b); }
                    ssq_put<4>(ssq_cq, row, wc, s, fq);
                } else if (pn == 1) {
                    { const f32x4 a = acc[ai][0][m][0] * rs, b = acc[ai][0][m][1] * rs;
                      *(f32x4*)(CKVF + (size_t)row * KVL + c8) = a; *(f32x4*)(CKVF + (size_t)row * KVL + c8 + 4) = b;
                      *(u32x4*)(CKVB + (size_t)row * KVL + c8) = pack8(a, b);
                      ssq_put<4>(ssq_kv, row, wc, sq4(a) + sq4(b), fq); }
                    if (wc == 0) { f32x4 y1, y2; rope4(rope + (size_t)pos_of_row(row) * 64, 4 * fq, 4, acc[ai][1][m][0] * rs, acc[ai][1][m][1] * rs, y1, y2);
                        float* o = row < MP ? dout + O_KPEP + (size_t)row * RPE : (row < MP + MS ? dout + O_KPES + (size_t)(row - MP) * RPE : nullptr);
                        if (o) { *(f32x4*)(o + 4 * fq) = y1; *(f32x4*)(o + 16 + 4 * fq) = y2; }
                        v2u w1, w2; w1.x = cvt_pk_bf16(y1[0], y1[1]); w1.y = cvt_pk_bf16(y1[2], y1[3]); w2.x = cvt_pk_bf16(y2[0], y2[1]); w2.y = cvt_pk_bf16(y2[2], y2[3]);
                        *(v2u*)(KPEB + (size_t)row * RPE + 4 * fq) = w1; *(v2u*)(KPEB + (size_t)row * RPE + 16 + 4 * fq) = w2; }
                } else if (pn < 6) {
                    const bool isk = pn >= 4; const int ic = row < MP ? (row & 127) : 0; const float2* tr = rope + (size_t)pos_of_row(row) * 64;
#pragma unroll
                    for (int bj = 0; bj < 2; ++bj) { const int hh = 2 * (pn - (isk ? 4 : 2)) + bj; const float lg = lg2gamma(hh) * (float)ic;
                        const float fs = rs * (isk ? __builtin_amdgcn_exp2f(-lg) * 0.08838834764831845f : __builtin_amdgcn_exp2f(lg));
                        f32x4 y1, y2; rope4(tr, 16 * wc + 4 * fq, 1, acc[ai][bj][m][0] * fs, acc[ai][bj][m][1] * fs, y1, y2);
                        bf16_t* o = (isk ? KR : QR) + (size_t)row * 512 + hh * 128 + 16 * wc + 4 * fq;
                        v2u w1, w2; w1.x = cvt_pk_bf16(y1[0], y1[1]); w1.y = cvt_pk_bf16(y1[2], y1[3]); w2.x = cvt_pk_bf16(y2[0], y2[1]); w2.y = cvt_pk_bf16(y2[2], y2[3]);
                        *(v2u*)o = w1; *(v2u*)(o + 64) = w2; }
                } else if (pn < 8) {
#pragma unroll
                    for (int bj = 0; bj < 2; ++bj) *(u32x4*)(RV + (size_t)row * 512 + (pn - 6) * BM + bj * HALF + c8) = pack8(acc[ai][bj][m][0] * rs, acc[ai][bj][m][1] * rs);
                } else if (pn < 10) {
#pragma unroll
                    for (int bj = 0; bj < 2; ++bj) { f32x4 a = acc[ai][bj][m][0] * rs, b = acc[ai][bj][m][1] * rs;
#pragma unroll
                        for (int j = 0; j < 4; ++j) { a[j] = silu_f(a[j]); b[j] = silu_f(b[j]); }
                        *(u32x4*)(RGS + (size_t)row * 512 + (pn - 8) * BM + bj * HALF + c8) = pack8(a, b); }
                } else {
                    bf16_t* base = pn < 14 ? SGA + (size_t)(pn - 10) * BM : SGR + (size_t)(pn - 14) * BM;
#pragma unroll
                    for (int bj = 0; bj < 2; ++bj) { f32x4 a = acc[ai][bj][m][0] * rs, b = acc[ai][bj][m][1] * rs;
#pragma unroll
                        for (int j = 0; j < 4; ++j) { a[j] = sigm(a[j]); b[j] = sigm(b[j]); }
                        *(u32x4*)(base + (size_t)row * DM + bj * HALF + c8) = pack8(a, b); }
                }
            }
    }
};

struct EpiQB {
    static constexpr bool PERM = true, AFTER_DRAIN = false, HAS_MID = false; int mid_t;
    const float* ssq_cq; const float2* rope; bf16_t* QB;
    __device__ __forceinline__ void mid(f32x4 (&)[2][2][4][2], const Unit&, int, int, int, int) const {}
    __device__ __forceinline__ void operator()(const f32x4 (&acc)[2][2][4][2], const Unit& u, int wr, int wc, int fr_, int fq_) const { EPI_OPAQUE;
#pragma unroll
        for (int ai = 0; ai < 2; ++ai)
#pragma unroll
            for (int m = 0; m < 4; ++m) { const int row = EPI_ROWS(ai, m); const float rs = rstd_of<4>(ssq_cq, row, 1.0f / QL);
                bf16_t* qrow = QB + (size_t)row * 768;
                if (u.pn < 2) {
#pragma unroll
                    for (int bj = 0; bj < 2; ++bj) { const int cidx = bj * HALF + wc * 32 + 8 * fq, hh = u.pn * 4 + (cidx >> 6), d = cidx & 63;
                        *(u32x4*)(qrow + hh * QKD + d) = pack8(acc[ai][bj][m][0] * rs, acc[ai][bj][m][1] * rs); }
                } else { const float2* tr = rope + (size_t)pos_of_row(row) * 64;
#pragma unroll
                    for (int bj = 0; bj < 2; ++bj) { const int hh = bj * 4 + wc; f32x4 y1, y2; rope4(tr, 4 * fq, 4, acc[ai][bj][m][0] * rs, acc[ai][bj][m][1] * rs, y1, y2);
                        v2u w1, w2; w1.x = cvt_pk_bf16(y1[0], y1[1]); w1.y = cvt_pk_bf16(y1[2], y1[3]); w2.x = cvt_pk_bf16(y2[0], y2[1]); w2.y = cvt_pk_bf16(y2[2], y2[3]);
                        *(v2u*)(qrow + hh * QKD + 64 + 4 * fq) = w1; *(v2u*)(qrow + hh * QKD + 80 + 4 * fq) = w2; }
                }
                asm volatile("" ::: "memory");
            }
    }
};

struct EpiPlain {
    static constexpr bool PERM = true, AFTER_DRAIN = false, HAS_MID = false; int mid_t;
    bf16_t* O0; bf16_t* O1; int ld; int split_tiles; const float* ssq; float invn;
    __device__ __forceinline__ void mid(f32x4 (&)[2][2][4][2], const Unit&, int, int, int, int) const {}
    __device__ __forceinline__ void operator()(const f32x4 (&acc)[2][2][4][2], const Unit& u, int wr, int wc, int fr_, int fq_) const { EPI_OPAQUE;
        bf16_t* base = u.pn < split_tiles ? O0 + (size_t)u.pn * BM : O1 + (size_t)(u.pn - split_tiles) * BM;
#pragma unroll
        for (int ai = 0; ai < 2; ++ai)
#pragma unroll
            for (int m = 0; m < 4; ++m) { const int row = EPI_ROWS(ai, m); const float rs = ssq ? rstd_of<4>(ssq, row, invn) : 1.0f;
#pragma unroll
                for (int bj = 0; bj < 2; ++bj) *(u32x4*)(base + (size_t)row * ld + bj * HALF + wc * 32 + 8 * fq) = pack8(acc[ai][bj][m][0] * rs, acc[ai][bj][m][1] * rs); }
    }
};

struct EpiMerge {
    static constexpr bool PERM = true, AFTER_DRAIN = false, HAS_MID = true; int mid_t;
    const bf16_t* SGA; const bf16_t* SGR; bf16_t* O;
    __device__ __forceinline__ void mid(f32x4 (&acc)[2][2][4][2], const Unit& u, int wr, int wc, int fr_, int fq) const {
        int fr = fr_; asm volatile("" : "+v"(fr));
#pragma unroll
        for (int ai = 0; ai < 2; ++ai) { u32x4 ga[4][2], gr[4][2];
#pragma unroll
            for (int m = 0; m < 4; ++m) { const int row = EPI_ROWS(ai, m);
#pragma unroll
                for (int bj = 0; bj < 2; ++bj) { const size_t off = (size_t)row * DM + u.pn * BM + bj * HALF + wc * 32 + 8 * fq; ga[m][bj] = *(const u32x4*)(SGA + off); gr[m][bj] = *(const u32x4*)(SGR + off); } }
#pragma unroll
            for (int m = 0; m < 4; ++m)
#pragma unroll
                for (int bj = 0; bj < 2; ++bj)
#pragma unroll
                    for (int q = 0; q < 4; ++q) { const float alo = bflo(ga[m][bj][q]), ahi = bfhi(ga[m][bj][q]), rlo = fmaxf(bflo(gr[m][bj][q]), 1e-30f), rhi = fmaxf(bfhi(gr[m][bj][q]), 1e-30f);
                        acc[ai][bj][m][q >> 1][(q & 1) * 2] *= alo * __builtin_amdgcn_rcpf(rlo); acc[ai][bj][m][q >> 1][(q & 1) * 2 + 1] *= ahi * __builtin_amdgcn_rcpf(rhi); }
            asm volatile("" ::: "memory"); }
    }
    __device__ __forceinline__ void operator()(const f32x4 (&acc)[2][2][4][2], const Unit& u, int wr, int wc, int fr_, int fq_) const { EPI_OPAQUE;
#pragma unroll
        for (int ai = 0; ai < 2; ++ai)
#pragma unroll
            for (int m = 0; m < 4; ++m) { const int row = EPI_ROWS(ai, m);
#pragma unroll
                for (int bj = 0; bj < 2; ++bj) { const size_t off = (size_t)row * DM + u.pn * BM + bj * HALF + wc * 32 + 8 * fq;
                    const u32x4 r = *(const u32x4*)(SGR + off); f32x4 o0, o1;
                    o0[0] = acc[ai][bj][m][0][0] * fmaxf(bflo(r[0]), 1e-30f); o0[1] = acc[ai][bj][m][0][1] * fmaxf(bfhi(r[0]), 1e-30f);
                    o0[2] = acc[ai][bj][m][0][2] * fmaxf(bflo(r[1]), 1e-30f); o0[3] = acc[ai][bj][m][0][3] * fmaxf(bfhi(r[1]), 1e-30f);
                    o1[0] = acc[ai][bj][m][1][0] * fmaxf(bflo(r[2]), 1e-30f); o1[1] = acc[ai][bj][m][1][1] * fmaxf(bfhi(r[2]), 1e-30f);
                    o1[2] = acc[ai][bj][m][1][2] * fmaxf(bflo(r[3]), 1e-30f); o1[3] = acc[ai][bj][m][1][3] * fmaxf(bfhi(r[3]), 1e-30f);
                    *(u32x4*)(O + off) = pack8(o0, o1); } }
    }
};

struct EpiPle {
    static constexpr bool PERM = true, AFTER_DRAIN = false, HAS_MID = false; int mid_t;
    const bf16_t* H3; const bf16_t* PP; const float* ssq3; bf16_t* H4; float* ssq4;
    __device__ __forceinline__ void mid(f32x4 (&)[2][2][4][2], const Unit&, int, int, int, int) const {}
    __device__ __forceinline__ void operator()(const f32x4 (&acc)[2][2][4][2], const Unit& u, int wr, int wc, int fr_, int fq_) const { EPI_OPAQUE;
#pragma unroll
        for (int ai = 0; ai < 2; ++ai)
#pragma unroll
            for (int m = 0; m < 4; ++m) { const int row = EPI_ROWS(ai, m); const float rs = rstd_of<16>(ssq3, row, 1.0f / DM); float s = 0.f;
#pragma unroll
                for (int bj = 0; bj < 2; ++bj) { const size_t off = (size_t)row * DM + u.pn * BM + bj * HALF + wc * 32 + 8 * fq;
                    const u32x4 p = *(const u32x4*)(PP + off), r = *(const u32x4*)(H3 + off);
                    f32x4 h0, h1;
                    h0[0] = bflo(r[0]) + sigm(acc[ai][bj][m][0][0] * rs) * bflo(p[0]); h0[1] = bfhi(r[0]) + sigm(acc[ai][bj][m][0][1] * rs) * bfhi(p[0]);
                    h0[2] = bflo(r[1]) + sigm(acc[ai][bj][m][0][2] * rs) * bflo(p[1]); h0[3] = bfhi(r[1]) + sigm(acc[ai][bj][m][0][3] * rs) * bfhi(p[1]);
                    h1[0] = bflo(r[2]) + sigm(acc[ai][bj][m][1][0] * rs) * bflo(p[2]); h1[1] = bfhi(r[2]) + sigm(acc[ai][bj][m][1][1] * rs) * bfhi(p[2]);
                    h1[2] = bflo(r[3]) + sigm(acc[ai][bj][m][1][2] * rs) * bflo(p[3]); h1[3] = bfhi(r[3]) + sigm(acc[ai][bj][m][1][3] * rs) * bfhi(p[3]);
                    *(u32x4*)(H4 + off) = pack8(h0, h1); s += sq4(h0) + sq4(h1); }
                ssq_put<16>(ssq4, row, u.pn * 4 + wc, s, fq); }
    }
};
#undef EPI_ROWS
#undef EPI_OPAQUE
}
namespace att {
using bf16x8 = __attribute__((ext_vector_type(8))) short;
using s16x4 = __attribute__((ext_vector_type(4))) short;
using f32x16 = __attribute__((ext_vector_type(16))) float;
using u32x4 = __attribute__((ext_vector_type(4))) unsigned;
typedef __attribute__((address_space(3))) const char* lds_cptr;
typedef __attribute__((address_space(3))) char* lds_ptr;
constexpr int KSLOT = 12288, VSLOT = 8192;
constexpr int L_K = 0, L_V = 3 * KSLOT, L_WS = L_V + 3 * VSLOT, L_OST = L_WS + 8 * 256, L_END = L_OST + 8 * 4096;
static_assert(L_END <= RING_BYTES, "attention LDS");
__device__ __forceinline__ int crow(int r, int hi) { return (r & 3) + 8 * (r >> 2) + 4 * hi; }
__device__ __forceinline__ void glds16(const void* gsrc, unsigned lds_dst) { unsigned keep;
    asm volatile("s_mov_b32 %0, m0\n\ts_mov_b32 m0, %2\n\ts_nop 0\n\tglobal_load_lds_dwordx4 %1, off\n\ts_mov_b32 m0, %0" : "=&s"(keep) : "v"(gsrc), "s"(lds_dst) : "memory"); }
typedef float f32x2_t __attribute__((ext_vector_type(2))); typedef __bf16 bf16x2_t __attribute__((ext_vector_type(2)));
__device__ __forceinline__ unsigned cvtpk_s(float lo, float hi) { f32x2_t v = {lo, hi}; bf16x2_t b = __builtin_convertvector(v, bf16x2_t); return __builtin_bit_cast(unsigned, b); }
__device__ __forceinline__ float swap32_max(float m) { auto rr = __builtin_amdgcn_permlane32_swap(__float_as_uint(m), __float_as_uint(m), false, false); return fmaxf(__uint_as_float(rr[0]), __uint_as_float(rr[1])); }
__device__ __forceinline__ float swap32_sum(float m) { auto rr = __builtin_amdgcn_permlane32_swap(__float_as_uint(m), __float_as_uint(m), false, false); return __uint_as_float(rr[0]) + __uint_as_float(rr[1]); }

__device__ __forceinline__ void pv(f32x16* o, int vb, bf16x8 pa0, bf16x8 pa1, bf16x8 pa2, bf16x8 pa3) {
#pragma unroll
    for (int d0 = 0; d0 < 2; ++d0) { s16x4 lo[4], hi[4];
#pragma unroll
        for (int ks = 0; ks < 4; ++ks) {
            asm volatile("ds_read_b64_tr_b16 %0,%1 offset:%c2" : "=&v"(lo[ks]) : "v"(vb), "i"(d0 * 4096 + ks * 1024) : "memory");
            asm volatile("ds_read_b64_tr_b16 %0,%1 offset:%c2" : "=&v"(hi[ks]) : "v"(vb), "i"(d0 * 4096 + ks * 1024 + 512) : "memory"); }
        asm volatile("s_waitcnt lgkmcnt(0)" ::: "memory"); __builtin_amdgcn_sched_barrier(0);
#define PK(k) (bf16x8){lo[k][0], lo[k][1], lo[k][2], lo[k][3], hi[k][0], hi[k][1], hi[k][2], hi[k][3]}
        o[d0] = __builtin_amdgcn_mfma_f32_32x32x16_bf16(pa0, PK(0), o[d0], 0, 0, 0);
        o[d0] = __builtin_amdgcn_mfma_f32_32x32x16_bf16(pa1, PK(1), o[d0], 0, 0, 0);
        o[d0] = __builtin_amdgcn_mfma_f32_32x32x16_bf16(pa2, PK(2), o[d0], 0, 0, 0);
        o[d0] = __builtin_amdgcn_mfma_f32_32x32x16_bf16(pa3, PK(3), o[d0], 0, 0, 0);
#undef PK
    }
}

__device__ __forceinline__ void k_load(bf16x8 (&kf)[12], lds_cptr kp) {
#pragma unroll
    for (int d0 = 0; d0 < 6; ++d0) { kf[2 * d0] = *(const __attribute__((address_space(3))) bf16x8*)(kp + d0 * 2048); kf[2 * d0 + 1] = *(const __attribute__((address_space(3))) bf16x8*)(kp + d0 * 2048 + 512); }
}
__device__ __forceinline__ void qk_mma(f32x16& p0, f32x16& p1, const bf16x8 (&kf)[12], const bf16x8 (&qr)[6]) {
    p0 = f32x16{}; p1 = f32x16{};
#pragma unroll
    for (int d0 = 0; d0 < 6; ++d0) { p0 = __builtin_amdgcn_mfma_f32_32x32x16_bf16(kf[2 * d0], qr[d0], p0, 0, 0, 0); p1 = __builtin_amdgcn_mfma_f32_32x32x16_bf16(kf[2 * d0 + 1], qr[d0], p1, 0, 0, 0); }
}
__device__ __forceinline__ void v_load(s16x4 (&lo)[8], s16x4 (&hi)[8], int vb) {
#pragma unroll
    for (int i = 0; i < 8; ++i) {
        asm volatile("ds_read_b64_tr_b16 %0,%1 offset:%c2" : "=&v"(lo[i]) : "v"(vb), "i"((i >> 2) * 4096 + (i & 3) * 1024) : "memory");
        asm volatile("ds_read_b64_tr_b16 %0,%1 offset:%c2" : "=&v"(hi[i]) : "v"(vb), "i"((i >> 2) * 4096 + (i & 3) * 1024 + 512) : "memory"); }
}
__device__ __forceinline__ void pv_mma(f32x16* o, const s16x4 (&lo)[8], const s16x4 (&hi)[8], bf16x8 pa0, bf16x8 pa1, bf16x8 pa2, bf16x8 pa3) {
#define PK(k) (bf16x8){lo[k][0], lo[k][1], lo[k][2], lo[k][3], hi[k][0], hi[k][1], hi[k][2], hi[k][3]}
    o[0] = __builtin_amdgcn_mfma_f32_32x32x16_bf16(pa0, PK(0), o[0], 0, 0, 0); o[1] = __builtin_amdgcn_mfma_f32_32x32x16_bf16(pa0, PK(4), o[1], 0, 0, 0);
    o[0] = __builtin_amdgcn_mfma_f32_32x32x16_bf16(pa1, PK(1), o[0], 0, 0, 0); o[1] = __builtin_amdgcn_mfma_f32_32x32x16_bf16(pa1, PK(5), o[1], 0, 0, 0);
    o[0] = __builtin_amdgcn_mfma_f32_32x32x16_bf16(pa2, PK(2), o[0], 0, 0, 0); o[1] = __builtin_amdgcn_mfma_f32_32x32x16_bf16(pa2, PK(6), o[1], 0, 0, 0);
    o[0] = __builtin_amdgcn_mfma_f32_32x32x16_bf16(pa3, PK(3), o[0], 0, 0, 0); o[1] = __builtin_amdgcn_mfma_f32_32x32x16_bf16(pa3, PK(7), o[1], 0, 0, 0);
#undef PK
}
__device__ __forceinline__ void qk_tile(f32x16& p0, f32x16& p1, lds_cptr kp, const bf16x8 (&qr)[6]) {
    p0 = f32x16{}; p1 = f32x16{};
#pragma unroll
    for (int d0 = 0; d0 < 6; ++d0) {
        const bf16x8 k0 = *(const __attribute__((address_space(3))) bf16x8*)(kp + d0 * 2048);
        const bf16x8 k1 = *(const __attribute__((address_space(3))) bf16x8*)(kp + d0 * 2048 + 512);
        p0 = __builtin_amdgcn_mfma_f32_32x32x16_bf16(k0, qr[d0], p0, 0, 0, 0);
        p1 = __builtin_amdgcn_mfma_f32_32x32x16_bf16(k1, qr[d0], p1, 0, 0, 0); }
}
__device__ __forceinline__ float max3f(float a, float b, float c) { return __builtin_fmaxf(__builtin_fmaxf(a, b), c); }
__device__ __forceinline__ void softmax_a(f32x16& p0, f32x16& p1, int jb, int qrel, int hi, int r32, float& m_run, float& l_run, f32x16 (&o)[2], LAS float* wsf) {
    if (jb >= 0) { const int kb = 64 * jb + 4 * hi;
#pragma unroll
        for (int r = 0; r < 16; ++r) { const int kv = kb + (r & 3) + 8 * (r >> 2); if (kv > qrel) p0[r] = -INFINITY; if (kv + 32 > qrel) p1[r] = -INFINITY; } }
    float a = max3f(p0[0], p0[1], p1[0]), b = max3f(p0[2], p0[3], p1[1]); a = max3f(a, p1[2], p1[3]);
#pragma unroll
    for (int r = 4; r < 16; r += 4) { a = max3f(a, p0[r], p0[r + 1]); b = max3f(b, p0[r + 2], p0[r + 3]); a = max3f(a, p1[r], p1[r + 1]); b = max3f(b, p1[r + 2], p1[r + 3]); }
    const float rm = swap32_max(fmaxf(a, b));
    const float mnew = (rm > m_run + 8.0f) ? rm : m_run;
    if (__any(mnew > m_run)) {
        const float alpha = __builtin_amdgcn_exp2f(m_run - mnew);
        l_run *= alpha; m_run = mnew;
        if (hi == 0) wsf[r32] = alpha;
        asm volatile("s_waitcnt lgkmcnt(0)" ::: "memory");
        f32x16 av;
#pragma unroll
        for (int r = 0; r < 16; ++r) av[r] = wsf[crow(r, hi)];
        o[0] *= av; o[1] *= av;
    }
}
__device__ __forceinline__ void softmax_b(f32x16& p0, f32x16& p1, float m_run, float& l_run, u32x4& pw0, u32x4& pw1, u32x4& pw2, u32x4& pw3) {
    p0 = p0 - m_run; p1 = p1 - m_run;
#pragma unroll
    for (int r = 0; r < 16; ++r) { p0[r] = __builtin_amdgcn_exp2f(p0[r]); p1[r] = __builtin_amdgcn_exp2f(p1[r]); }
    const f32x16 ps = p0 + p1;
    typedef float f32x8_t __attribute__((ext_vector_type(8))); typedef float f32x4_t __attribute__((ext_vector_type(4))); typedef float f32x2_t2 __attribute__((ext_vector_type(2)));
    const f32x8_t s8 = __builtin_shufflevector(ps, ps, 0, 1, 2, 3, 4, 5, 6, 7) + __builtin_shufflevector(ps, ps, 8, 9, 10, 11, 12, 13, 14, 15);
    const f32x4_t s4 = __builtin_shufflevector(s8, s8, 0, 1, 2, 3) + __builtin_shufflevector(s8, s8, 4, 5, 6, 7);
    const f32x2_t2 s2 = __builtin_shufflevector(s4, s4, 0, 1) + __builtin_shufflevector(s4, s4, 2, 3);
    l_run += s2[0] + s2[1];
#define PKW(P, B) cvtpk_s(P[B], P[B + 1])
    pw0 = (u32x4){PKW(p0, 0), PKW(p0, 2), PKW(p0, 4), PKW(p0, 6)}; pw1 = (u32x4){PKW(p0, 8), PKW(p0, 10), PKW(p0, 12), PKW(p0, 14)};
    pw2 = (u32x4){PKW(p1, 0), PKW(p1, 2), PKW(p1, 4), PKW(p1, 6)}; pw3 = (u32x4){PKW(p1, 8), PKW(p1, 10), PKW(p1, 12), PKW(p1, 14)};
#undef PKW
}
__device__ __forceinline__ void attn_unit(int b, int h, int qb, const bf16* Q, const bf16* KN, const bf16* KPE, const bf16* VB, bf16* O, char* shm) {
    int tid_ = threadIdx.x; asm volatile("" : "+v"(tid_)); const int tid = tid_, lane = tid & 63, r32 = lane & 31, hi = lane >> 5; const int wid = __builtin_amdgcn_readfirstlane(tid >> 6);
    const long rowbase = (long)b * TSEQ; const int q0 = qb * 256;
    const bf16* Qw = Q + (rowbase + q0 + wid * 32) * 768 + h * QKD;
    const unsigned lds0 = (unsigned)(uintptr_t)shm;
    const lds_ptr shm3 = (lds_ptr)shm;
    LAS float* wsf = (LAS float*)(shm3 + L_WS) + wid * 64;
    const bf16* ksrc0 = KN + (rowbase + lane) * 512 + h * 64 + wid * 8;
    const bf16* ksrc1 = KPE + (rowbase + lane) * RPE + (wid & 3) * 8;
    const bf16* vsrc = VB + (rowbase + 16 * (wid & 3) + (lane >> 2)) * 512 + h * 64 + (wid >> 2) * 32 + (lane & 3) * 8;
    const unsigned kdst0 = lds0 + L_K + wid * 1024, kdst1 = lds0 + L_K + (8 + (wid & 3)) * 1024, vdst = lds0 + L_V + wid * 1024;
#define ATT_DMAK(t, s) do { glds16(ksrc0 + (long)(t) * 64 * 512, (unsigned)__builtin_amdgcn_readfirstlane(kdst0 + (s) * KSLOT)); \
                            glds16(ksrc1 + (long)(t) * 64 * RPE, (unsigned)__builtin_amdgcn_readfirstlane(kdst1 + (s) * KSLOT)); } while (0)
#define ATT_DMAV(t, s) glds16(vsrc + (long)(t) * 64 * 512, (unsigned)__builtin_amdgcn_readfirstlane(vdst + (s) * VSLOT))
    const int vb0 = (int)(lds0 + L_V) + ((lane >> 4) & 1) * 32 + (lane & 3) * 8 + (4 * hi + ((lane & 15) >> 2)) * 64;
    const lds_cptr kp0 = (lds_cptr)shm3 + L_K + hi * 1024 + r32 * 16;
    const int NT = (q0 + 256) / 64;
    ATT_DMAK(0, 0); ATT_DMAV(0, 0); ATT_DMAK(1, 1); ATT_DMAV(1, 1); ATT_DMAK(2, 2);
    bf16x8 qr[6];
#pragma unroll
    for (int d0 = 0; d0 < 6; ++d0) qr[d0] = *reinterpret_cast<const bf16x8*>(&Qw[(long)r32 * 768 + d0 * 16 + hi * 8]);
    float m_run = -INFINITY, l_run = 0.f; f32x16 o[2]; o[0] = f32x16{}; o[1] = f32x16{};
    const int qrel = wid * 32 + r32;
    asm volatile("s_waitcnt vmcnt(0) lgkmcnt(0)\n\ts_barrier" ::: "memory");
    f32x16 sA0, sA1, sB0, sB1;
    qk_tile(sA0, sA1, kp0, qr);
    int t = 0, s0 = 0, s1 = 1, s2 = 2;
    for (; t + 1 < NT - 4; ++t) {
        asm volatile("s_waitcnt vmcnt(3) lgkmcnt(0)\n\ts_barrier" ::: "memory");
        ATT_DMAK(t + 3, s0); ATT_DMAV(t + 2, s2);
        bf16x8 kf[12]; s16x4 vlo[8], vhi[8];
        k_load(kf, kp0 + s1 * KSLOT); v_load(vlo, vhi, vb0 + s0 * VSLOT);
        softmax_a(sA0, sA1, -1, qrel, hi, r32, m_run, l_run, o, wsf);
        asm volatile("s_waitcnt lgkmcnt(0)" ::: "memory"); __builtin_amdgcn_sched_barrier(0);
        u32x4 pw0, pw1, pw2, pw3;
        qk_mma(sB0, sB1, kf, qr);
        softmax_b(sA0, sA1, m_run, l_run, pw0, pw1, pw2, pw3);
#pragma unroll
        for (int i = 0; i < 12; ++i) { __builtin_amdgcn_sched_group_barrier(0x008, 1, 0); __builtin_amdgcn_sched_group_barrier(0x002, 10, 0); }
        pv_mma(o, vlo, vhi, __builtin_bit_cast(bf16x8, pw0), __builtin_bit_cast(bf16x8, pw1), __builtin_bit_cast(bf16x8, pw2), __builtin_bit_cast(bf16x8, pw3));
        sA0 = sB0; sA1 = sB1;
        { const int r_ = s0; s0 = s1; s1 = s2; s2 = r_; }
    }
    for (; t < NT; ++t) {
        asm volatile("s_waitcnt vmcnt(0) lgkmcnt(0)\n\ts_barrier" ::: "memory");
        if (t + 3 < NT) ATT_DMAK(t + 3, s0);
        if (t + 2 < NT) ATT_DMAV(t + 2, s2);
        const int jb = t - (NT - 4), jbn = jb + 1;
        const bool pn = (t + 1 < NT) && (jbn < 0 || 2 * jbn <= wid);
        if (pn) qk_tile(sB0, sB1, kp0 + s1 * KSLOT, qr);
        if (jb < 0 || 2 * jb <= wid) { softmax_a(sA0, sA1, jb, qrel, hi, r32, m_run, l_run, o, wsf); u32x4 pw0, pw1, pw2, pw3; softmax_b(sA0, sA1, m_run, l_run, pw0, pw1, pw2, pw3);
            pv(o, vb0 + s0 * VSLOT, __builtin_bit_cast(bf16x8, pw0), __builtin_bit_cast(bf16x8, pw1), __builtin_bit_cast(bf16x8, pw2), __builtin_bit_cast(bf16x8, pw3)); }
        sA0 = sB0; sA1 = sB1;
        { const int r_ = s0; s0 = s1; s1 = s2; s2 = r_; }
    }
    l_run = swap32_sum(l_run);
    if (hi == 0) wsf[32 + r32] = l_run;
    asm volatile("s_waitcnt lgkmcnt(0)" ::: "memory");
    float rli[16];
#pragma unroll
    for (int r = 0; r < 16; ++r) rli[r] = 1.0f / wsf[32 + crow(r, hi)];
    bf16* Ow = O + (rowbase + q0 + wid * 32) * DM + h * 64;
    { LAS bf16* stg = (LAS bf16*)(shm3 + L_OST) + wid * 2048;
#pragma unroll
      for (int r = 0; r < 16; ++r) { const int orow = crow(r, hi);
#pragma unroll
          for (int d0 = 0; d0 < 2; ++d0) stg[orow * 64 + d0 * 32 + r32] = (bf16)f2bf(o[d0][r] * rli[r]); }
      asm volatile("s_waitcnt lgkmcnt(0)" ::: "memory");
#pragma unroll
      for (int i = 0; i < 4; ++i) { const int row = i * 8 + (lane >> 3), ch = lane & 7; const u32x4 v = *(const LAS u32x4*)(stg + row * 64 + ch * 8); *(u32x4*)(Ow + (long)row * DM + ch * 8) = v; } }
    asm volatile("s_waitcnt vmcnt(0) lgkmcnt(0)\n\ts_barrier" ::: "memory");
#undef ATT_DMAK
#undef ATT_DMAV
}
__device__ __forceinline__ void bar4(volatile LAS unsigned* cnt, unsigned& gen, int lane) {
    gen += 4u;
    if (lane == 0) { unsigned seen = __hip_atomic_fetch_add((LAS unsigned*)cnt, 1u, __ATOMIC_RELAXED, __HIP_MEMORY_SCOPE_WORKGROUP) + 1u;
        while (seen < gen) seen = __hip_atomic_load((LAS unsigned*)cnt, __ATOMIC_RELAXED, __HIP_MEMORY_SCOPE_WORKGROUP); }
    asm volatile("" ::: "memory");
}
__device__ __forceinline__ void bar4_arrive(volatile LAS unsigned* cnt, unsigned& gen, int lane) {
    gen += 4u;
    if (lane == 0) __hip_atomic_fetch_add((LAS unsigned*)cnt, 1u, __ATOMIC_RELAXED, __HIP_MEMORY_SCOPE_WORKGROUP);
    asm volatile("" ::: "memory");
}
__device__ __forceinline__ void bar4_wait(volatile LAS unsigned* cnt, unsigned gen, int lane) {
    if (lane == 0) { while (__hip_atomic_load((LAS unsigned*)cnt, __ATOMIC_RELAXED, __HIP_MEMORY_SCOPE_WORKGROUP) < gen) {} }
    asm volatile("" ::: "memory");
}
constexpr int H_K = 0, H_V = 3 * KSLOT, H_WS = H_V + 3 * VSLOT, H_OST = H_WS + 4 * 256, H_END = H_OST + 4 * 4096;
__device__ __forceinline__ void attn_half_unit(int b, int h, int qb, const bf16* Q, const bf16* KN, const bf16* KPE, const bf16* VB, bf16* O, char* shm, volatile LAS unsigned* cnt, unsigned& gen) {
    int tid_ = threadIdx.x; asm volatile("" : "+v"(tid_)); const int tid = tid_, lane = tid & 63, r32 = lane & 31, hi = lane >> 5; const int wid = __builtin_amdgcn_readfirstlane(tid >> 6) & 3;
    const long rowbase = (long)b * TSEQ; const int q0 = qb * 128;
    const bf16* Qw = Q + (rowbase + q0 + wid * 32) * 768 + h * QKD;
    const unsigned lds0 = (unsigned)(uintptr_t)shm;
    const lds_ptr shm3 = (lds_ptr)shm;
    LAS float* wsf = (LAS float*)(shm3 + H_WS) + wid * 64;
    const bf16* ksrcA = KN + (rowbase + lane) * 512 + h * 64 + wid * 8;
    const bf16* ksrcC = KPE + (rowbase + lane) * RPE + wid * 8;
    const bf16* vsrc = VB + (rowbase + 16 * wid + (lane >> 2)) * 512 + h * 64 + (lane & 3) * 8;
    const unsigned kdst = lds0 + H_K + wid * 1024, vdst = lds0 + H_V + wid * 1024;
#define HDMA(t, s) do { glds16(ksrcA + (long)(t) * 64 * 512, (unsigned)__builtin_amdgcn_readfirstlane(kdst + (s) * KSLOT)); \
                        glds16(ksrcA + (long)(t) * 64 * 512 + 32, (unsigned)__builtin_amdgcn_readfirstlane(kdst + (s) * KSLOT + 4096)); \
                        glds16(ksrcC + (long)(t) * 64 * RPE, (unsigned)__builtin_amdgcn_readfirstlane(kdst + (s) * KSLOT + 8192)); } while (0)
#define HDMAV(t, s) do { glds16(vsrc + (long)(t) * 64 * 512, (unsigned)__builtin_amdgcn_readfirstlane(vdst + (s) * VSLOT)); \
                         glds16(vsrc + (long)(t) * 64 * 512 + 32, (unsigned)__builtin_amdgcn_readfirstlane(vdst + (s) * VSLOT + 4096)); } while (0)
    const int vb0 = (int)(lds0 + H_V) + ((lane >> 4) & 1) * 32 + (lane & 3) * 8 + (4 * hi + ((lane & 15) >> 2)) * 64;
    const lds_cptr kp0 = (lds_cptr)shm3 + H_K + hi * 1024 + r32 * 16;
    const int NT = (q0 + 128) / 64;
    HDMA(0, 0); HDMAV(0, 0); HDMA(1, 1); HDMAV(1, 1); if (NT > 2) HDMA(2, 2);
    bf16x8 qr[6];
#pragma unroll
    for (int d0 = 0; d0 < 6; ++d0) qr[d0] = *reinterpret_cast<const bf16x8*>(&Qw[(long)r32 * 768 + d0 * 16 + hi * 8]);
    float m_run = -INFINITY, l_run = 0.f; f32x16 o[2]; o[0] = f32x16{}; o[1] = f32x16{};
    const int qrel = wid * 32 + r32;
    asm volatile("s_waitcnt vmcnt(0) lgkmcnt(0)" ::: "memory"); bar4(cnt, gen, lane);
    f32x16 sA0, sA1, sB0, sB1;
    qk_tile(sA0, sA1, kp0, qr);
    int t = 0, s0 = 0, s1 = 1, s2 = 2;
    for (; t + 1 < NT - 2; ++t) {
        asm volatile("s_waitcnt vmcnt(5) lgkmcnt(0)" ::: "memory"); bar4(cnt, gen, lane);
        HDMA(t + 3, s0); HDMAV(t + 2, s2);
        bf16x8 kf[12]; s16x4 vlo[8], vhi[8];
        k_load(kf, kp0 + s1 * KSLOT); v_load(vlo, vhi, vb0 + s0 * VSLOT);
        softmax_a(sA0, sA1, -1, qrel, hi, r32, m_run, l_run, o, wsf);
        asm volatile("s_waitcnt lgkmcnt(0)" ::: "memory"); __builtin_amdgcn_sched_barrier(0);
        u32x4 pw0, pw1, pw2, pw3;
        qk_mma(sB0, sB1, kf, qr);
        softmax_b(sA0, sA1, m_run, l_run, pw0, pw1, pw2, pw3);
#pragma unroll
        for (int i = 0; i < 12; ++i) { __builtin_amdgcn_sched_group_barrier(0x008, 1, 0); __builtin_amdgcn_sched_group_barrier(0x002, 10, 0); }
        pv_mma(o, vlo, vhi, __builtin_bit_cast(bf16x8, pw0), __builtin_bit_cast(bf16x8, pw1), __builtin_bit_cast(bf16x8, pw2), __builtin_bit_cast(bf16x8, pw3));
        sA0 = sB0; sA1 = sB1;
        { const int r_ = s0; s0 = s1; s1 = s2; s2 = r_; }
    }
    for (; t < NT; ++t) {
        asm volatile("s_waitcnt vmcnt(0) lgkmcnt(0)" ::: "memory"); bar4(cnt, gen, lane);
        if (t + 3 < NT) HDMA(t + 3, s0);
        if (t + 2 < NT) HDMAV(t + 2, s2);
        const int jb = t - (NT - 2), jbn = jb + 1;
        const bool pn = (t + 1 < NT) && (jbn < 0 || 2 * jbn <= wid);
        if (pn) qk_tile(sB0, sB1, kp0 + s1 * KSLOT, qr);
        if (jb < 0 || 2 * jb <= wid) { softmax_a(sA0, sA1, jb, qrel, hi, r32, m_run, l_run, o, wsf); u32x4 pw0, pw1, pw2, pw3; softmax_b(sA0, sA1, m_run, l_run, pw0, pw1, pw2, pw3);
            pv(o, vb0 + s0 * VSLOT, __builtin_bit_cast(bf16x8, pw0), __builtin_bit_cast(bf16x8, pw1), __builtin_bit_cast(bf16x8, pw2), __builtin_bit_cast(bf16x8, pw3)); }
        sA0 = sB0; sA1 = sB1;
        { const int r_ = s0; s0 = s1; s1 = s2; s2 = r_; }
    }
    l_run = swap32_sum(l_run);
    if (hi == 0) wsf[32 + r32] = l_run;
    asm volatile("s_waitcnt lgkmcnt(0)" ::: "memory");
    float rli[16];
#pragma unroll
    for (int r = 0; r < 16; ++r) rli[r] = 1.0f / wsf[32 + crow(r, hi)];
    bf16* Ow = O + (rowbase + q0 + wid * 32) * DM + h * 64;
    { LAS bf16* stg = (LAS bf16*)(shm3 + H_OST) + wid * 2048;
#pragma unroll
      for (int r = 0; r < 16; ++r) { const int orow = crow(r, hi);
#pragma unroll
          for (int d0 = 0; d0 < 2; ++d0) stg[orow * 64 + d0 * 32 + r32] = (bf16)f2bf(o[d0][r] * rli[r]); }
      asm volatile("s_waitcnt lgkmcnt(0)" ::: "memory");
#pragma unroll
      for (int i = 0; i < 4; ++i) { const int row = i * 8 + (lane >> 3), ch = lane & 7; const u32x4 v = *(const LAS u32x4*)(stg + row * 64 + ch * 8); *(u32x4*)(Ow + (long)row * DM + ch * 8) = v; } }
    asm volatile("s_waitcnt vmcnt(0) lgkmcnt(0)" ::: "memory"); bar4(cnt, gen, lane);
#undef HDMA
#undef HDMAV
}
}
namespace ret {
using bf16x8 = __attribute__((ext_vector_type(8))) short;
using s16x4 = __attribute__((ext_vector_type(4))) short;
using f32x16 = __attribute__((ext_vector_type(16))) float;
typedef short v4i16_t __attribute__((ext_vector_type(4)));
constexpr int TPB = 288, TB = 128 * TPB;
constexpr int OTP = 132;
static_assert(3 * TB <= RING_BYTES && 128 * OTP * 4 <= 2 * TB, "retention LDS");
__device__ __forceinline__ int crow(int r, int hi) { return (r & 3) + 8 * (r >> 2) + 4 * hi; }
__device__ __forceinline__ void stage_tile(LAS unsigned char* tile, const bf16* src, int pitch, int tid) {
#pragma unroll
    for (int i = 0; i < 4; ++i) { const int idx = tid + 512 * i, row = idx >> 4, ch = idx & 15;
        *(LAS v4u*)(tile + row * TPB + ch * 16) = *(const v4u*)(src + (size_t)row * pitch + ch * 8); }
}
__device__ __forceinline__ bf16x8 rowfrag(const LAS unsigned char* tile, int row0, int k0, int r32, int hi) { return *(const LAS bf16x8*)(tile + (row0 + r32) * TPB + (k0 + 8 * hi) * 2); }
__device__ __forceinline__ bf16x8 trfrag(const LAS unsigned char* tile, int k0, int c0, int lane) {
    const int h = lane >> 5, blk = (lane >> 4) & 1, q = (lane & 15) >> 2, p = lane & 3;
    const LAS unsigned char* a = tile + (k0 + 8 * h + q) * TPB + (c0 + 16 * blk + 4 * p) * 2;
    const s16x4 lo = __builtin_bit_cast(s16x4, __builtin_amdgcn_ds_read_tr16_b64_v4i16((LAS v4i16_t*)a));
    const s16x4 hi4 = __builtin_bit_cast(s16x4, __builtin_amdgcn_ds_read_tr16_b64_v4i16((LAS v4i16_t*)(a + 4 * TPB)));
    return (bf16x8){lo[0], lo[1], lo[2], lo[3], hi4[0], hi4[1], hi4[2], hi4[3]};
}

__device__ __forceinline__ void kv_unit(int u, const bf16* KR, const bf16* RV, float* KVC, LAS unsigned char* lds) {
    int tid_ = threadIdx.x; asm volatile("" : "+v"(tid_)); const int tid = tid_, lane = tid & 63, r32 = lane & 31, hi = lane >> 5, wid = __builtin_amdgcn_readfirstlane(tid >> 6), wi = wid >> 1, wj = wid & 1;
    const int bh = u >> 6, c = u & 63, b = bh >> 2, h = bh & 3; const size_t row0 = (size_t)b * TSEQ + c * 128;
    LAS unsigned char* T0 = lds; LAS unsigned char* T1 = lds + TB;
    stage_tile(T0, KR + row0 * 512 + h * 128, 512, tid); stage_tile(T1, RV + row0 * 512 + h * 128, 512, tid);
    __syncthreads();
    f32x16 acc[2]; acc[0] = f32x16{}; acc[1] = f32x16{};
#pragma unroll
    for (int ks = 0; ks < 8; ++ks) { const bf16x8 A = trfrag(T0, 16 * ks, 32 * wi, lane);
#pragma unroll
        for (int n = 0; n < 2; ++n) acc[n] = __builtin_amdgcn_mfma_f32_32x32x16_bf16(A, trfrag(T1, 16 * ks, 64 * wj + 32 * n, lane), acc[n], 0, 0, 0); }
    const float g127 = __builtin_amdgcn_exp2f(127.0f * lg2gamma(h));
    float* out = KVC + (size_t)u * 16384;
#pragma unroll
    for (int n = 0; n < 2; ++n)
#pragma unroll
        for (int r = 0; r < 16; ++r) out[(32 * wi + crow(r, hi)) * 128 + 64 * wj + 32 * n + r32] = acc[n][r] * g127;
    __syncthreads();
}

__device__ __forceinline__ void scan_items(int gtid, int gthreads, const float* KVC, bf16* SC, float* dout) {
    for (int e = gtid; e < 8 * 16384; e += gthreads) { const int bh = e >> 14, el = e & 16383; const float g128 = __builtin_amdgcn_exp2f(128.0f * lg2gamma(bh & 3));
        float s = 0.f;
        for (int c0 = 0; c0 < 64; c0 += 8) { float kv[8];
#pragma unroll
            for (int i = 0; i < 8; ++i) kv[i] = KVC[(size_t)(bh * 64 + c0 + i) * 16384 + el];
#pragma unroll
            for (int i = 0; i < 8; ++i) { SC[(size_t)(bh * 64 + c0 + i) * 16384 + el] = (bf16)f2bf(s); s = g128 * s + kv[i]; } }
        dout[O_RETP + e] = s; }
}

__device__ __forceinline__ void out_unit(int u, const bf16* QR, const bf16* KR, const bf16* RV, const bf16* SC, const bf16* RGS, const float* gnorm, bf16* OCAT, LAS unsigned char* lds) {
    int tid_ = threadIdx.x; asm volatile("" : "+v"(tid_)); const int tid = tid_, lane = tid & 63, r32 = lane & 31, hi = lane >> 5, wid = __builtin_amdgcn_readfirstlane(tid >> 6), wi = wid >> 1, wj = wid & 1;
    const int bh = u >> 6, c = u & 63, b = bh >> 2, h = bh & 3; const size_t row0 = (size_t)b * TSEQ + c * 128;
    LAS unsigned char* T0 = lds; LAS unsigned char* T1 = lds + TB; LAS unsigned char* T2 = lds + 2 * TB;
    stage_tile(T0, QR + row0 * 512 + h * 128, 512, tid); stage_tile(T1, KR + row0 * 512 + h * 128, 512, tid); stage_tile(T2, RV + row0 * 512 + h * 128, 512, tid);
    __syncthreads();
    f32x16 sr[2];
#pragma unroll
    for (int n = 0; n < 2; ++n) { const int jb = 2 * wj + n; sr[n] = f32x16{};
        if (jb <= wi) {
#pragma unroll
            for (int ks = 0; ks < 8; ++ks) sr[n] = __builtin_amdgcn_mfma_f32_32x32x16_bf16(rowfrag(T1, 32 * jb, 16 * ks, r32, hi), rowfrag(T0, 32 * wi, 16 * ks, r32, hi), sr[n], 0, 0, 0);
            if (jb == wi) {
#pragma unroll
                for (int r = 0; r < 16; ++r) if (crow(r, hi) > r32) sr[n][r] = 0.f; } } }
    __syncthreads();
#pragma unroll
    for (int n = 0; n < 2; ++n) { const int jb = 2 * wj + n;
        if (jb <= wi) {
#pragma unroll
            for (int r4 = 0; r4 < 4; ++r4) { v2u w; w.x = pg8::cvt_pk_bf16(sr[n][4 * r4], sr[n][4 * r4 + 1]); w.y = pg8::cvt_pk_bf16(sr[n][4 * r4 + 2], sr[n][4 * r4 + 3]);
                *(LAS v2u*)(T1 + (32 * wi + r32) * TPB + (32 * jb + 8 * r4 + 4 * hi) * 2) = w; } } }
    __syncthreads();
    f32x16 o1[2]; o1[0] = f32x16{}; o1[1] = f32x16{};
    for (int ks = 0; ks < 2 * (wi + 1); ++ks) { const bf16x8 A = rowfrag(T1, 32 * wi, 16 * ks, r32, hi);
#pragma unroll
        for (int n = 0; n < 2; ++n) o1[n] = __builtin_amdgcn_mfma_f32_32x32x16_bf16(A, trfrag(T2, 16 * ks, 64 * wj + 32 * n, lane), o1[n], 0, 0, 0); }
    __syncthreads();
    stage_tile(T2, SC + (size_t)u * 16384, 128, tid);
    __syncthreads();
    f32x16 o2[2]; o2[0] = f32x16{}; o2[1] = f32x16{};
#pragma unroll
    for (int ks = 0; ks < 8; ++ks) { const bf16x8 A = rowfrag(T0, 32 * wi, 16 * ks, r32, hi);
#pragma unroll
        for (int n = 0; n < 2; ++n) o2[n] = __builtin_amdgcn_mfma_f32_32x32x16_bf16(A, trfrag(T2, 16 * ks, 64 * wj + 32 * n, lane), o2[n], 0, 0, 0); }
    __syncthreads();
    const float gam = __builtin_amdgcn_exp2f(lg2gamma(h));
    LAS float* OT = (LAS float*)lds;
#pragma unroll
    for (int n = 0; n < 2; ++n)
#pragma unroll
        for (int r = 0; r < 16; ++r) OT[(32 * wi + crow(r, hi)) * OTP + 64 * wj + 32 * n + r32] = o1[n][r] + gam * o2[n][r];
    __syncthreads();
    { const int row = tid >> 2, part = tid & 3; const LAS float* orow = OT + row * OTP + part * 32; float v[32]; float s = 0.f;
#pragma unroll
      for (int k = 0; k < 32; ++k) { v[k] = orow[k]; s += v[k]; }
      s += __shfl_xor(s, 1); s += __shfl_xor(s, 2); const float mu = s * (1.0f / 128.0f); float q = 0.f;
#pragma unroll
      for (int k = 0; k < 32; ++k) { v[k] -= mu; q += v[k] * v[k]; }
      q += __shfl_xor(q, 1); q += __shfl_xor(q, 2); const float rstd = 1.0f / sqrtf(q * (1.0f / 128.0f) + EPS);
      const bf16* rg = RGS + (row0 + row) * 512 + h * 128 + part * 32; const float* gn = gnorm + h * 128 + part * 32; bf16* dst = OCAT + (row0 + row) * DM + 512 + h * 128 + part * 32;
#pragma unroll
      for (int k8 = 0; k8 < 4; ++k8) { const v4u g = *(const v4u*)(rg + 8 * k8); v4u w;
#pragma unroll
          for (int j = 0; j < 4; ++j) { const int k = 8 * k8 + 2 * j; w[j] = pk2(v[k] * rstd * gn[k] * bflo(g[j]), v[k + 1] * rstd * gn[k + 1] * bfhi(g[j])); }
          *(v4u*)(dst + 8 * k8) = w; } }
    __syncthreads();
}

__device__ __forceinline__ void sample_unit(int u, const bf16* QR, const bf16* KR, const bf16* RV, const bf16* RGS, const float* gnorm, const float* state, float* dout, bf16* OCAT, LAS unsigned char* lds) {
    int tid_ = threadIdx.x; asm volatile("" : "+v"(tid_)); const int tid = tid_, s = u >> 2, h = u & 3; const size_t row = (size_t)MP + s;
    LAS float* qf = (LAS float*)lds; LAS float* kf = qf + 128; LAS float* vf = kf + 128; LAS float* red = vf + 128; LAS float* ob = red + 512;
    if (tid < 128) { qf[tid] = bf2f(QR[row * 512 + h * 128 + tid]); kf[tid] = bf2f(KR[row * 512 + h * 128 + tid]); vf[tid] = bf2f(RV[row * 512 + h * 128 + tid]); }
    __syncthreads();
    const int dv = tid & 127, g = tid >> 7; const float gam = __builtin_amdgcn_exp2f(lg2gamma(h)); const float vv = vf[dv];
    const float* S0 = state + (size_t)u * 16384; float* Sn = dout + O_RETS + (size_t)u * 16384; float acc = 0.f;
#pragma unroll 8
    for (int i = 0; i < 32; ++i) { const int dk = 32 * g + i; const float s0 = S0[dk * 128 + dv]; acc += qf[dk] * s0; Sn[dk * 128 + dv] = gam * s0 + kf[dk] * vv; }
    red[tid] = acc;
    __syncthreads();
    if (tid < 128) { float qk = 0.f;
        for (int d = 0; d < 128; ++d) qk += qf[d] * kf[d];
        ob[tid] = qk * vv + gam * ((red[tid] + red[128 + tid]) + (red[256 + tid] + red[384 + tid])); }
    __syncthreads();
    if (tid < 128) { float sm = 0.f;
        for (int d = 0; d < 128; ++d) sm += ob[d];
        const float mu = sm * (1.0f / 128.0f); float q = 0.f;
        for (int d = 0; d < 128; ++d) { const float t = ob[d] - mu; q += t * t; }
        const float rstd = 1.0f / sqrtf(q * (1.0f / 128.0f) + EPS);
        OCAT[row * DM + 512 + h * 128 + tid] = (bf16)f2bf((ob[tid] - mu) * rstd * gnorm[h * 128 + tid] * bf2f(RGS[row * 512 + h * 128 + tid])); }
    __syncthreads();
}
__device__ __forceinline__ void sample_unit4(int u, int w4, int lane_, const bf16* QR, const bf16* KR, const bf16* RV, const bf16* RGS, const float* gnorm, const float* state, float* dout, bf16* OCAT, LAS float* tl, volatile LAS unsigned* cnt, unsigned& gen) {
    int lane = lane_; asm volatile("" : "+v"(lane));
    const int tid = w4 * 64 + lane, s = u >> 2, h = u & 3; const size_t row = (size_t)MP + s;
    LAS float* qf = tl; LAS float* kf = qf + 128; LAS float* vf = kf + 128; LAS float* red = vf + 128; LAS float* ob = red + 256;
    if (tid < 128) { qf[tid] = bf2f(QR[row * 512 + h * 128 + tid]); kf[tid] = bf2f(KR[row * 512 + h * 128 + tid]); vf[tid] = bf2f(RV[row * 512 + h * 128 + tid]); }
    asm volatile("s_waitcnt lgkmcnt(0)" ::: "memory"); att::bar4(cnt, gen, lane);
    const int dv = tid & 127, g = tid >> 7; const float gam = __builtin_amdgcn_exp2f(lg2gamma(h)); const float vv = vf[dv];
    const float* S0 = state + (size_t)u * 16384; float* Sn = dout + O_RETS + (size_t)u * 16384; float acc = 0.f;
#pragma unroll 16
    for (int i = 0; i < 64; ++i) { const int dk = 64 * g + i; const float s0 = S0[dk * 128 + dv]; acc += qf[dk] * s0; Sn[dk * 128 + dv] = gam * s0 + kf[dk] * vv; }
    red[tid] = acc;
    asm volatile("s_waitcnt lgkmcnt(0)" ::: "memory"); att::bar4(cnt, gen, lane);
    if (tid < 128) { float qk = 0.f;
        for (int d = 0; d < 128; ++d) qk += qf[d] * kf[d];
        ob[tid] = qk * vv + gam * (red[tid] + red[128 + tid]); }
    asm volatile("s_waitcnt lgkmcnt(0)" ::: "memory"); att::bar4(cnt, gen, lane);
    if (tid < 128) { float sm = 0.f;
        for (int d = 0; d < 128; ++d) sm += ob[d];
        const float mu = sm * (1.0f / 128.0f); float q = 0.f;
        for (int d = 0; d < 128; ++d) { const float t = ob[d] - mu; q += t * t; }
        const float rstd = 1.0f / sqrtf(q * (1.0f / 128.0f) + EPS);
        OCAT[row * DM + 512 + h * 128 + tid] = (bf16)f2bf((ob[tid] - mu) * rstd * gnorm[h * 128 + tid] * bf2f(RGS[row * 512 + h * 128 + tid])); }
    asm volatile("s_waitcnt lgkmcnt(0)" ::: "memory"); att::bar4(cnt, gen, lane);
}
}
namespace sk {
using bf16x8 = __attribute__((ext_vector_type(8))) short;
using f32x4 = __attribute__((ext_vector_type(4))) float;
using f32x2 = __attribute__((ext_vector_type(2))) float;
template <int K, bool DUAL, bool STAT, class Epi>
__device__ __forceinline__ void skinny_unit(int u, const bf16* A, const bf16* Bt, float* ssq, LAS float* lds, const Epi E) {
    int tid_ = threadIdx.x; asm volatile("" : "+v"(tid_)); const int tid = tid_, lane = tid & 63, wave = __builtin_amdgcn_readfirstlane(tid >> 6), fr = lane & 15, fq = lane >> 4;
    const int rb = u >> 4, cg = u & 15;
    constexpr int KW = K / 8, NS = KW / 32; static_assert(KW % 32 == 0, "K split");
    const bf16* ap = A + (size_t)(MP + 16 * rb + fr) * K + wave * KW + 8 * fq;
    const bf16* bp = Bt + (size_t)(64 * cg + fr) * K + wave * KW + 8 * fq;
    f32x4 acc[4];
#pragma unroll
    for (int n = 0; n < 4; ++n) acc[n] = (f32x4){0.f, 0.f, 0.f, 0.f};
#pragma unroll 4
    for (int s = 0; s < NS; ++s) { const bf16x8 a = *(const bf16x8*)(ap + 32 * s);
#pragma unroll
        for (int n = 0; n < 4; ++n) acc[n] = __builtin_amdgcn_mfma_f32_16x16x32_bf16(a, *(const bf16x8*)(bp + (size_t)16 * n * K + 32 * s), acc[n], 0, 0, 0); }
    LAS float* P = lds + wave * 1024;
#pragma unroll
    for (int n = 0; n < 4; ++n)
#pragma unroll
        for (int r = 0; r < 4; ++r) P[(4 * fq + r) * 64 + 16 * n + fr] = acc[n][r];
    __syncthreads();
    { const int row = tid >> 5, c2 = (tid & 31) * 2; float a0 = 0.f, a1 = 0.f, b0 = 0.f, b1 = 0.f;
#pragma unroll
      for (int w = 0; w < 8; ++w) { const f32x2 v = *(const LAS f32x2*)(lds + w * 1024 + row * 64 + c2); if (DUAL && w >= 4) { b0 += v[0]; b1 += v[1]; } else { a0 += v[0]; a1 += v[1]; } }
      const f32x2 h = E(MP + 16 * rb + row, 64 * cg + c2, a0, a1, b0, b1);
      if (STAT) { float s = h[0] * h[0] + h[1] * h[1];
#pragma unroll
          for (int o = 1; o < 32; o <<= 1) s += __shfl_xor(s, o);
          if ((tid & 31) == 0) ssq[(size_t)(MP + 16 * rb + row) * 16 + cg] = s; } }
    __syncthreads();
}
struct SkResid { const bf16* R; float alpha; bf16* Hb;
    __device__ __forceinline__ f32x2 operator()(int row, int col, float a0, float a1, float, float) const {
        const unsigned r = *(const unsigned*)(R + (size_t)row * DM + col); const f32x2 h = {bflo(r) + alpha * a0, bfhi(r) + alpha * a1};
        *(unsigned*)(Hb + (size_t)row * DM + col) = pg8::cvt_pk_bf16(h[0], h[1]); return h; } };
struct SkResidX { const float* xs; bf16* Hb;
    __device__ __forceinline__ f32x2 operator()(int row, int col, float a0, float a1, float, float) const {
        const f32x2 r = *(const f32x2*)(xs + (size_t)(row - MP) * DM + col); const f32x2 h = {r[0] + 0.5f * a0, r[1] + 0.5f * a1};
        *(unsigned*)(Hb + (size_t)row * DM + col) = pg8::cvt_pk_bf16(h[0], h[1]); return h; } };
struct SkMerge { const bf16* SGA; const bf16* SGR; bf16* O;
    __device__ __forceinline__ f32x2 operator()(int row, int col, float a0, float a1, float b0, float b1) const {
        const unsigned ga = *(const unsigned*)(SGA + (size_t)row * DM + col), gr = *(const unsigned*)(SGR + (size_t)row * DM + col);
        const f32x2 m = {bflo(ga) * a0 + bflo(gr) * b0, bfhi(ga) * a1 + bfhi(gr) * b1};
        *(unsigned*)(O + (size_t)row * DM + col) = pg8::cvt_pk_bf16(m[0], m[1]); return m; } };
struct SkPlain { bf16* O;
    __device__ __forceinline__ f32x2 operator()(int row, int col, float a0, float a1, float, float) const {
        *(unsigned*)(O + (size_t)row * DM + col) = pg8::cvt_pk_bf16(a0, a1); return (f32x2){a0, a1}; } };
struct SkPle { const bf16* H3; const bf16* PP; const float* ssq3; bf16* H4;
    __device__ __forceinline__ f32x2 operator()(int row, int col, float a0, float a1, float, float) const {
        const float rs = pg8::rstd_of<16>(ssq3, row, 1.0f / DM); const unsigned r = *(const unsigned*)(H3 + (size_t)row * DM + col); const unsigned p = *(const unsigned*)(PP + (size_t)row * DM + col);
        const f32x2 h = {bflo(r) + sigm(a0 * rs) * bflo(p), bfhi(r) + sigm(a1 * rs) * bfhi(p)};
        *(unsigned*)(H4 + (size_t)row * DM + col) = pg8::cvt_pk_bf16(h[0], h[1]); return h; } };
}
namespace dec {
using bf16x2 = __attribute__((ext_vector_type(2))) __bf16;
using u32x4 = __attribute__((ext_vector_type(4))) unsigned;
using f32x4 = __attribute__((ext_vector_type(4))) float;
using f32x2 = __attribute__((ext_vector_type(2))) float;
constexpr int NSPLIT = 16, PPS = NPAGES / NSPLIT;
constexpr int HPL = 2, GE = 8;
constexpr int L_QL = 0, L_P = 8 * 128, L_MRG = L_P + 8 * 64 * HPL, MRG_REC = 4 + 128, L_END = L_MRG + 8 * GE * MRG_REC;
static_assert(L_END * 4 <= RING_BYTES, "decode LDS");
__device__ __forceinline__ float dot2(unsigned k, unsigned q, float acc) { return __builtin_amdgcn_fdot2_f32_bf16(__builtin_bit_cast(bf16x2, k), __builtin_bit_cast(bf16x2, q), acc, false); }
__device__ __forceinline__ unsigned cvtpk(float lo, float hi) { return pg8::cvt_pk_bf16(lo, hi); }
template <int CTRL> __device__ __forceinline__ float dpp(float x) { return __builtin_bit_cast(float, __builtin_amdgcn_mov_dpp(__builtin_bit_cast(int, x), CTRL, 0xf, 0xf, true)); }
constexpr int XOR1 = 0xB1, XOR2 = 0x4E, XOR7 = 0x141, XOR8 = 0x128, ROR4 = 0x124;
__device__ __forceinline__ float xrow16_max(float x) {
    auto s = __builtin_amdgcn_permlane16_swap(__float_as_uint(x), __float_as_uint(x), false, false); x = fmaxf(__uint_as_float(s[0]), __uint_as_float(s[1]));
    auto t = __builtin_amdgcn_permlane32_swap(__float_as_uint(x), __float_as_uint(x), false, false); return fmaxf(__uint_as_float(t[0]), __uint_as_float(t[1])); }
__device__ __forceinline__ float xrow16_sum(float x) {
    auto s = __builtin_amdgcn_permlane16_swap(__float_as_uint(x), __float_as_uint(x), false, false); x = __uint_as_float(s[0]) + __uint_as_float(s[1]);
    auto t = __builtin_amdgcn_permlane32_swap(__float_as_uint(x), __float_as_uint(x), false, false); return __uint_as_float(t[0]) + __uint_as_float(t[1]); }

__device__ __forceinline__ void qlat_token(int s, const bf16* QB, const float* wkvb, LAS float* QLs, float* QLATg, bool store) {
    int tid_ = threadIdx.x; asm volatile("" : "+v"(tid_)); const int tid = tid_, lane = tid & 63, h = __builtin_amdgcn_readfirstlane(tid >> 6);
    const bf16* q = QB + (size_t)(MP + s) * 768 + h * QKD;
#pragma unroll
    for (int cc = 0; cc < 2; ++cc) { const int c = lane + 64 * cc; const float* w = wkvb + (size_t)c * 1024 + h * 128; float a = 0.f;
#pragma unroll 4
        for (int d = 0; d < 64; d += 4) { const f32x4 wv = *(const f32x4*)(w + d); a += bf2f(q[d]) * wv[0] + bf2f(q[d + 1]) * wv[1] + bf2f(q[d + 2]) * wv[2] + bf2f(q[d + 3]) * wv[3]; }
        QLs[h * 128 + c] = a; if (store) QLATg[(size_t)s * 1024 + h * 128 + c] = a; }
}

__device__ __forceinline__ void split_unit(int s, int sp, const bf16* QB, const float* cache_ckv, const float* cache_kpe, const int* page_table, float* DPO, float* DML, LAS float* lds) {
    int tid_ = threadIdx.x; asm volatile("" : "+v"(tid_)); const int tid = tid_, lane = tid & 63, wave = __builtin_amdgcn_readfirstlane(tid >> 6), r = lane >> 4, c = lane & 15;
    const LAS float* QL = lds + L_QL;
    u32x4 qpk[GE]; unsigned qpe[GE];
#pragma unroll
    for (int g = 0; g < GE; ++g) { const LAS float* ql = QL + g * 128 + 8 * c; qpk[g] = (u32x4){cvtpk(ql[0], ql[1]), cvtpk(ql[2], ql[3]), cvtpk(ql[4], ql[5]), cvtpk(ql[6], ql[7])};
        qpe[g] = *(const unsigned*)(QB + (size_t)(MP + s) * 768 + g * QKD + 64 + 2 * c); }
    float m[HPL], l[HPL], acc[GE * 8];
#pragma unroll
    for (int j = 0; j < HPL; ++j) { m[j] = -INFINITY; l[j] = 0.f; }
#pragma unroll
    for (int k = 0; k < GE * 8; ++k) acc[k] = 0.f;
    const int ph0 = page_table[s * NPAGES + PPS * sp + wave], ph1 = page_table[s * NPAGES + PPS * sp + wave + 8];
    f32x4 Kn[4][2]; f32x2 Pn[4];
#define DEC_ISSUE(i_) do { const int ph_ = ((i_) >> 3) ? ph1 : ph0; const size_t tok_ = (size_t)ph_ * PAGE + 16 * ((i_) & 7) + r; \
        _Pragma("unroll") for (int t_ = 0; t_ < 4; ++t_) { const float* kp_ = cache_ckv + (tok_ + 4 * t_) * KVL + 8 * c; \
            Kn[t_][0] = __builtin_nontemporal_load((const f32x4*)kp_); Kn[t_][1] = __builtin_nontemporal_load((const f32x4*)(kp_ + 4)); \
            Pn[t_] = __builtin_nontemporal_load((const f32x2*)(cache_kpe + (tok_ + 4 * t_) * RPE + 2 * c)); } } while (0)
    DEC_ISSUE(0);
#pragma nounroll
    for (int i = 0; i < 16; ++i) {
        u32x4 Kc[4]; unsigned Pc[4];
#pragma unroll
        for (int t = 0; t < 4; ++t) {
            Kc[t] = (u32x4){cvtpk(Kn[t][0][0], Kn[t][0][1]), cvtpk(Kn[t][0][2], Kn[t][0][3]), cvtpk(Kn[t][1][0], Kn[t][1][1]), cvtpk(Kn[t][1][2], Kn[t][1][3])}; Pc[t] = cvtpk(Pn[t][0], Pn[t][1]); }
        if (i + 1 < 16) DEC_ISSUE(i + 1);
        float x[4 * GE];
#pragma unroll
        for (int t = 0; t < 4; ++t)
#pragma unroll
            for (int g = 0; g < GE; ++g) { float d = dot2(Pc[t], qpe[g], 0.f);
#pragma unroll
                for (int k = 0; k < 4; ++k) d = dot2(Kc[t][k], qpk[g][k], d);
                x[t * GE + g] = d; }
#define TR_STEP(HALF, CTRL, BIT) _Pragma("unroll") for (int h = 0; h < (HALF); ++h) _Pragma("unroll") for (int j = 0; j < HPL; ++j) { \
        const float lo_ = x[h * HPL + j], hi_ = x[(h + (HALF)) * HPL + j]; const float t1_ = lo_ + dpp<CTRL>(lo_), t2_ = hi_ + dpp<CTRL>(hi_); \
        x[h * HPL + j] = (c & (BIT)) ? t2_ : t1_; }
        TR_STEP(8, XOR8, 8) TR_STEP(4, XOR7, 4) TR_STEP(2, XOR2, 2) TR_STEP(1, XOR1, 1)
#undef TR_STEP
        float p[HPL], alpha[HPL];
#pragma unroll
        for (int j = 0; j < HPL; ++j) { const float sc = x[j];
            float pm = sc; pm = fmaxf(pm, dpp<ROR4>(pm)); pm = fmaxf(pm, dpp<XOR8>(pm)); pm = xrow16_max(pm);
            const float mn = fmaxf(m[j], pm);
            alpha[j] = __builtin_amdgcn_exp2f(m[j] - mn); p[j] = __builtin_amdgcn_exp2f(sc - mn);
            l[j] = fmaf(l[j], alpha[j], p[j]); m[j] = mn; }
#pragma unroll
        for (int q4 = 0; q4 < 4; ++q4)
#pragma unroll
            for (int j = 0; j < HPL; ++j) { const float al = q4 == 0 ? dpp<0x00>(alpha[j]) : q4 == 1 ? dpp<0x55>(alpha[j]) : q4 == 2 ? dpp<0xAA>(alpha[j]) : dpp<0xFF>(alpha[j]);
#pragma unroll
                for (int k = 0; k < 8; ++k) acc[(q4 * HPL + j) * 8 + k] *= al; }
        LAS float* prow = lds + L_P + (wave * 4 + r) * 16 * HPL;
#pragma unroll
        for (int j = 0; j < HPL; ++j) prow[c * HPL + j] = p[j];
        asm volatile("s_waitcnt lgkmcnt(0)" ::: "memory");
#pragma unroll
        for (int t = 0; t < 4; ++t) { float vf[8]; f32x4 pr[2]; pr[0] = *(const LAS f32x4*)(prow + 8 * t); pr[1] = *(const LAS f32x4*)(prow + 8 * t + 4);
#pragma unroll
            for (int k = 0; k < 4; ++k) { vf[2 * k] = bflo(Kc[t][k]); vf[2 * k + 1] = bfhi(Kc[t][k]); }
#pragma unroll
            for (int g = 0; g < GE; ++g) { const float pg_ = pr[g >> 2][g & 3];
#pragma unroll
                for (int k = 0; k < 8; ++k) acc[g * 8 + k] = fmaf(pg_, vf[k], acc[g * 8 + k]); } }
        asm volatile("s_waitcnt lgkmcnt(0)" ::: "memory");
    }
#undef DEC_ISSUE
#pragma unroll
    for (int k = 0; k < GE * 8; ++k) acc[k] = xrow16_sum(acc[k]);
#pragma unroll
    for (int j = 0; j < HPL; ++j) { float t = l[j]; t += dpp<ROR4>(t); t += dpp<XOR8>(t); l[j] = xrow16_sum(t); }
    LAS float* mrg = lds + L_MRG;
    if (r == 0) {
#pragma unroll
        for (int g = 0; g < GE; ++g) { LAS float* rec = mrg + (wave * GE + g) * MRG_REC;
#pragma unroll
            for (int k = 0; k < 8; k += 4) *(LAS f32x4*)(rec + 4 + 8 * c + k) = (f32x4){acc[g * 8 + k], acc[g * 8 + k + 1], acc[g * 8 + k + 2], acc[g * 8 + k + 3]};
            if (c == g / HPL) { rec[0] = m[g % HPL]; rec[1] = l[g % HPL]; } } }
    __syncthreads();
    { const int g = wave, d0 = 2 * lane;
      float M = -INFINITY;
#pragma unroll
      for (int w = 0; w < 8; ++w) M = fmaxf(M, mrg[(w * GE + g) * MRG_REC]);
      float L = 0.f, o0 = 0.f, o1 = 0.f;
#pragma unroll
      for (int w = 0; w < 8; ++w) { const LAS float* rec = mrg + (w * GE + g) * MRG_REC; const float wt = __builtin_amdgcn_exp2f(rec[0] - M);
          L = fmaf(wt, rec[1], L); o0 = fmaf(wt, rec[4 + d0], o0); o1 = fmaf(wt, rec[4 + d0 + 1], o1); }
      const size_t slot = ((size_t)s * NSPLIT + sp) * GE + g;
      *(f32x2*)(DPO + slot * 128 + d0) = (f32x2){o0, o1};
      if (lane == 0) *(f32x2*)(DML + slot * 2) = (f32x2){M, L}; }
    __syncthreads();
}

constexpr int D_BASE = 78848;
constexpr int D4_QL = 0, D4_P = 8 * 128, D4_MRG = D4_P + 4 * 64 * HPL, D4_END = D4_MRG + 4 * GE * MRG_REC;
static_assert(D_BASE + D4_END * 4 <= PH5_BYTES, "decode-half LDS");
__device__ __forceinline__ void qlat_token4(int s, int w4, int lane_, const bf16* QB, const float* wkvb, LAS float* QLs, float* QLATg, bool store) {
    int lane = lane_; asm volatile("" : "+v"(lane));
#pragma unroll
    for (int hh = 0; hh < 2; ++hh) { const int h = w4 + 4 * hh; const bf16* q = QB + (size_t)(MP + s) * 768 + h * QKD;
#pragma unroll
        for (int cc = 0; cc < 2; ++cc) { const int c = lane + 64 * cc; const float* w = wkvb + (size_t)c * 1024 + h * 128; float a = 0.f;
#pragma unroll 4
            for (int d = 0; d < 64; d += 4) { const f32x4 wv = *(const f32x4*)(w + d); a += bf2f(q[d]) * wv[0] + bf2f(q[d + 1]) * wv[1] + bf2f(q[d + 2]) * wv[2] + bf2f(q[d + 3]) * wv[3]; }
            QLs[h * 128 + c] = a; if (store) QLATg[(size_t)s * 1024 + h * 128 + c] = a; } }
}
__device__ __forceinline__ void split_unit4(int s, int sp, int w4, int lane_, const bf16* QB, const float* cache_ckv, const float* cache_kpe, const int* page_table, float* DPO, float* DML, LAS float* lds, volatile LAS unsigned* cnt, unsigned& gen) {
    int lane = lane_; asm volatile("" : "+v"(lane));
    const int r = lane >> 4, c = lane & 15;
    const LAS float* QL = lds + D4_QL;
    u32x4 qpk[GE]; unsigned qpe[GE];
#pragma unroll
    for (int g = 0; g < GE; ++g) { const LAS float* ql = QL + g * 128 + 8 * c; qpk[g] = (u32x4){cvtpk(ql[0], ql[1]), cvtpk(ql[2], ql[3]), cvtpk(ql[4], ql[5]), cvtpk(ql[6], ql[7])};
        qpe[g] = *(const unsigned*)(QB + (size_t)(MP + s) * 768 + g * QKD + 64 + 2 * c); }
    float m[HPL], l[HPL], acc[GE * 8];
#pragma unroll
    for (int j = 0; j < HPL; ++j) { m[j] = -INFINITY; l[j] = 0.f; }
#pragma unroll
    for (int k = 0; k < GE * 8; ++k) acc[k] = 0.f;
    const int* pt = page_table + s * NPAGES + PPS * sp + w4;
    f32x4 Kn[4][2]; f32x2 Pn[4];
#define DEC_ISSUE(i_) do { const int ph_ = pt[4 * ((i_) >> 3)]; const size_t tok_ = (size_t)ph_ * PAGE + 16 * ((i_) & 7) + r; \
        _Pragma("unroll") for (int t_ = 0; t_ < 4; ++t_) { const float* kp_ = cache_ckv + (tok_ + 4 * t_) * KVL + 8 * c; \
            Kn[t_][0] = __builtin_nontemporal_load((const f32x4*)kp_); Kn[t_][1] = __builtin_nontemporal_load((const f32x4*)(kp_ + 4)); \
            Pn[t_] = __builtin_nontemporal_load((const f32x2*)(cache_kpe + (tok_ + 4 * t_) * RPE + 2 * c)); } } while (0)
    DEC_ISSUE(0);
#pragma nounroll
    for (int i = 0; i < 16; ++i) {
        u32x4 Kc[4]; unsigned Pc[4];
#pragma unroll
        for (int t = 0; t < 4; ++t) {
            Kc[t] = (u32x4){cvtpk(Kn[t][0][0], Kn[t][0][1]), cvtpk(Kn[t][0][2], Kn[t][0][3]), cvtpk(Kn[t][1][0], Kn[t][1][1]), cvtpk(Kn[t][1][2], Kn[t][1][3])}; Pc[t] = cvtpk(Pn[t][0], Pn[t][1]); }
        if (i + 1 < 16) DEC_ISSUE(i + 1);
        float x[4 * GE];
#pragma unroll
        for (int t = 0; t < 4; ++t)
#pragma unroll
            for (int g = 0; g < GE; ++g) { float d = dot2(Pc[t], qpe[g], 0.f);
#pragma unroll
                for (int k = 0; k < 4; ++k) d = dot2(Kc[t][k], qpk[g][k], d);
                x[t * GE + g] = d; }
#define TR_STEP(HALF, CTRL, BIT) _Pragma("unroll") for (int h = 0; h < (HALF); ++h) _Pragma("unroll") for (int j = 0; j < HPL; ++j) { \
        const float lo_ = x[h * HPL + j], hi_ = x[(h + (HALF)) * HPL + j]; const float t1_ = lo_ + dpp<CTRL>(lo_), t2_ = hi_ + dpp<CTRL>(hi_); \
        x[h * HPL + j] = (c & (BIT)) ? t2_ : t1_; }
        TR_STEP(8, XOR8, 8) TR_STEP(4, XOR7, 4) TR_STEP(2, XOR2, 2) TR_STEP(1, XOR1, 1)
#undef TR_STEP
        float p[HPL], alpha[HPL];
#pragma unroll
        for (int j = 0; j < HPL; ++j) { const float sc = x[j];
            float pm = sc; pm = fmaxf(pm, dpp<ROR4>(pm)); pm = fmaxf(pm, dpp<XOR8>(pm)); pm = xrow16_max(pm);
            const float mn = fmaxf(m[j], pm);
            alpha[j] = __builtin_amdgcn_exp2f(m[j] - mn); p[j] = __builtin_amdgcn_exp2f(sc - mn);
            l[j] = fmaf(l[j], alpha[j], p[j]); m[j] = mn; }
#pragma unroll
        for (int q4 = 0; q4 < 4; ++q4)
#pragma unroll
            for (int j = 0; j < HPL; ++j) { const float al = q4 == 0 ? dpp<0x00>(alpha[j]) : q4 == 1 ? dpp<0x55>(alpha[j]) : q4 == 2 ? dpp<0xAA>(alpha[j]) : dpp<0xFF>(alpha[j]);
#pragma unroll
                for (int k = 0; k < 8; ++k) acc[(q4 * HPL + j) * 8 + k] *= al; }
        LAS float* prow = lds + D4_P + (w4 * 4 + r) * 16 * HPL;
#pragma unroll
        for (int j = 0; j < HPL; ++j) prow[c * HPL + j] = p[j];
        asm volatile("s_waitcnt lgkmcnt(0)" ::: "memory");
#pragma unroll
        for (int t = 0; t < 4; ++t) { float vf[8]; f32x4 pr[2]; pr[0] = *(const LAS f32x4*)(prow + 8 * t); pr[1] = *(const LAS f32x4*)(prow + 8 * t + 4);
#pragma unroll
            for (int k = 0; k < 4; ++k) { vf[2 * k] = bflo(Kc[t][k]); vf[2 * k + 1] = bfhi(Kc[t][k]); }
#pragma unroll
            for (int g = 0; g < GE; ++g) { const float pg_ = pr[g >> 2][g & 3];
#pragma unroll
                for (int k = 0; k < 8; ++k) acc[g * 8 + k] = fmaf(pg_, vf[k], acc[g * 8 + k]); } }
        asm volatile("s_waitcnt lgkmcnt(0)" ::: "memory");
    }
#undef DEC_ISSUE
#pragma unroll
    for (int k = 0; k < GE * 8; ++k) acc[k] = xrow16_sum(acc[k]);
#pragma unroll
    for (int j = 0; j < HPL; ++j) { float t = l[j]; t += dpp<ROR4>(t); t += dpp<XOR8>(t); l[j] = xrow16_sum(t); }
    LAS float* mrg = lds + D4_MRG;
    if (r == 0) {
#pragma unroll
        for (int g = 0; g < GE; ++g) { LAS float* rec = mrg + (w4 * GE + g) * MRG_REC;
#pragma unroll
            for (int k = 0; k < 8; k += 4) *(LAS f32x4*)(rec + 4 + 8 * c + k) = (f32x4){acc[g * 8 + k], acc[g * 8 + k + 1], acc[g * 8 + k + 2], acc[g * 8 + k + 3]};
            if (c == g / HPL) { rec[0] = m[g % HPL]; rec[1] = l[g % HPL]; } } }
    asm volatile("s_waitcnt lgkmcnt(0)" ::: "memory"); att::bar4(cnt, gen, lane);
#pragma unroll
    for (int hh = 0; hh < 2; ++hh) { const int g = w4 + 4 * hh, d0 = 2 * lane;
      float M = -INFINITY;
#pragma unroll
      for (int w = 0; w < 4; ++w) M = fmaxf(M, mrg[(w * GE + g) * MRG_REC]);
      float L = 0.f, o0 = 0.f, o1 = 0.f;
#pragma unroll
      for (int w = 0; w < 4; ++w) { const LAS float* rec = mrg + (w * GE + g) * MRG_REC; const float wt = __builtin_amdgcn_exp2f(rec[0] - M);
          L = fmaf(wt, rec[1], L); o0 = fmaf(wt, rec[4 + d0], o0); o1 = fmaf(wt, rec[4 + d0 + 1], o1); }
      const size_t slot = ((size_t)s * NSPLIT + sp) * GE + g;
      *(f32x2*)(DPO + slot * 128 + d0) = (f32x2){o0, o1};
      if (lane == 0) *(f32x2*)(DML + slot * 2) = (f32x2){M, L}; }
    asm volatile("s_waitcnt lgkmcnt(0)" ::: "memory"); att::bar4(cnt, gen, lane);
}

using bf16x8 = __attribute__((ext_vector_type(8))) short;
typedef short dv4i16_t __attribute__((ext_vector_type(4)));
constexpr int VP = 272, VTILE = 32 * VP;
constexpr int M4_QL = 0, M4_VT = 4096, M4_END = M4_VT + 4 * VTILE;
static_assert(2 * D_BASE <= PH5_BYTES && M4_END <= D_BASE && 8 * MRG_REC * 4 <= VTILE, "P5 LDS (MFMA form)");
__device__ __forceinline__ bf16x8 pk8(f32x4 a, f32x4 b) { const u32x4 w = {pg8::cvt_pk_bf16(a[0], a[1]), pg8::cvt_pk_bf16(a[2], a[3]), pg8::cvt_pk_bf16(b[0], b[1]), pg8::cvt_pk_bf16(b[2], b[3])}; return __builtin_bit_cast(bf16x8, w); }
__device__ __forceinline__ void split_unit4m(int s, int sp, int w4, int lane_, const bf16* QB, const float* cache_ckv, const float* cache_kpe, const int* page_table, float* DPO, float* DML, LAS unsigned char* tl, volatile LAS unsigned* cnt, unsigned& gen) {
    int lane = lane_; asm volatile("" : "+v"(lane));
    const int t16 = lane & 15, kg = lane >> 4;
    const LAS float* QL = (const LAS float*)(tl + M4_QL);
    LAS unsigned char* vt = tl + M4_VT + w4 * VTILE;
    bf16x8 qf[5];
    if (t16 < 8) {
#pragma unroll
        for (int ks = 0; ks < 4; ++ks) { const LAS float* q = QL + t16 * 128 + 64 * (ks >> 1) + 32 * (ks & 1) + 4 * kg; qf[ks] = pk8(*(const LAS f32x4*)q, *(const LAS f32x4*)(q + 16)); }
        { const bf16* qp = QB + (size_t)(MP + s) * 768 + t16 * QKD + 64 + 4 * kg; const v2u a = *(const v2u*)qp, b = *(const v2u*)(qp + 16); const u32x4 w = {a.x, a.y, b.x, b.y}; qf[4] = __builtin_bit_cast(bf16x8, w); }
    } else {
#pragma unroll
        for (int ks = 0; ks < 5; ++ks) qf[ks] = (bf16x8){0, 0, 0, 0, 0, 0, 0, 0};
    }
    float m = -INFINITY, l = 0.f; f32x4 O[8];
#pragma unroll
    for (int c = 0; c < 8; ++c) O[c] = (f32x4){0.f, 0.f, 0.f, 0.f};
    const int* pt = page_table + s * NPAGES + PPS * sp + w4;
    const int ph0 = __builtin_amdgcn_readfirstlane(pt[0]), ph1 = __builtin_amdgcn_readfirstlane(pt[4]);
    f32x4 Cn[2][2][4], Pn[2][2];
#define DEC_ISSUE(i_) do { const int ph_ = ((i_) >> 2) ? ph1 : ph0; const size_t tok_ = (size_t)ph_ * PAGE + 32 * ((i_) & 3) + t16; \
        _Pragma("unroll") for (int g_ = 0; g_ < 2; ++g_) { const float* cp_ = cache_ckv + (tok_ + 16 * g_) * KVL + 4 * kg; const float* pp_ = cache_kpe + (tok_ + 16 * g_) * RPE + 4 * kg; \
            _Pragma("unroll") for (int b_ = 0; b_ < 2; ++b_) _Pragma("unroll") for (int j_ = 0; j_ < 4; ++j_) Cn[g_][b_][j_] = __builtin_nontemporal_load((const f32x4*)(cp_ + 64 * b_ + 16 * j_)); \
            Pn[g_][0] = __builtin_nontemporal_load((const f32x4*)pp_); Pn[g_][1] = __builtin_nontemporal_load((const f32x4*)(pp_ + 16)); } } while (0)
    DEC_ISSUE(0);
#pragma nounroll
    for (int i = 0; i < 8; ++i) {
        bf16x8 kf[2][5];
#pragma unroll
        for (int g = 0; g < 2; ++g) {
#pragma unroll
            for (int b = 0; b < 2; ++b) { kf[g][2 * b] = pk8(Cn[g][b][0], Cn[g][b][1]); kf[g][2 * b + 1] = pk8(Cn[g][b][2], Cn[g][b][3]); }
            kf[g][4] = pk8(Pn[g][0], Pn[g][1]); }
        if (i + 1 < 8) DEC_ISSUE(i + 1);
#pragma unroll
        for (int g = 0; g < 2; ++g)
#pragma unroll
            for (int ks = 0; ks < 4; ++ks) { const u32x4 w = __builtin_bit_cast(u32x4, kf[g][ks]); LAS unsigned char* d = vt + (16 * g + t16) * VP + 128 * (ks >> 1) + 64 * (ks & 1) + 8 * kg;
                *(LAS v2u*)d = (v2u){w[0], w[1]}; *(LAS v2u*)(d + 32) = (v2u){w[2], w[3]}; }
        f32x4 S[2];
#pragma unroll
        for (int g = 0; g < 2; ++g) { S[g] = (f32x4){0.f, 0.f, 0.f, 0.f};
#pragma unroll
            for (int ks = 0; ks < 5; ++ks) S[g] = __builtin_amdgcn_mfma_f32_16x16x32_bf16(kf[g][ks], qf[ks], S[g], 0, 0, 0); }
        float pm = fmaxf(fmaxf(fmaxf(S[0][0], S[0][1]), fmaxf(S[0][2], S[0][3])), fmaxf(fmaxf(S[1][0], S[1][1]), fmaxf(S[1][2], S[1][3])));
        pm = xrow16_max(pm);
        const float mn = (pm > m + 8.0f) ? pm : m;
        if (__any(mn > m)) {
            const float alpha = __builtin_amdgcn_exp2f(m - mn); l *= alpha; m = mn;
            float a4[4];
#pragma unroll
            for (int r = 0; r < 4; ++r) a4[r] = __shfl(alpha, 4 * kg + r);
#pragma unroll
            for (int c = 0; c < 8; ++c)
#pragma unroll
                for (int r = 0; r < 4; ++r) O[c][r] *= a4[r];
        }
        f32x4 p0, p1;
#pragma unroll
        for (int r = 0; r < 4; ++r) { p0[r] = __builtin_amdgcn_exp2f(S[0][r] - m); p1[r] = __builtin_amdgcn_exp2f(S[1][r] - m); }
        l += ((p0[0] + p0[1]) + (p0[2] + p0[3])) + ((p1[0] + p1[1]) + (p1[2] + p1[3]));
        const bf16x8 pa = pk8(p0, p1);
        const LAS unsigned char* vr = vt + (4 * kg + (t16 >> 2)) * VP + (t16 & 3) * 8;
#pragma unroll
        for (int c = 0; c < 8; ++c) {
            const dv4i16_t lo = __builtin_amdgcn_ds_read_tr16_b64_v4i16((LAS dv4i16_t*)(vr + 32 * c));
            const dv4i16_t hi = __builtin_amdgcn_ds_read_tr16_b64_v4i16((LAS dv4i16_t*)(vr + 16 * VP + 32 * c));
            const bf16x8 vb = {lo[0], lo[1], lo[2], lo[3], hi[0], hi[1], hi[2], hi[3]};
            O[c] = __builtin_amdgcn_mfma_f32_16x16x32_bf16(pa, vb, O[c], 0, 0, 0); }
    }
#undef DEC_ISSUE
    l = xrow16_sum(l);
    asm volatile("s_waitcnt lgkmcnt(0)" ::: "memory");
    LAS float* rec0 = (LAS float*)vt;
    if (kg < 2) {
#pragma unroll
        for (int c = 0; c < 8; ++c)
#pragma unroll
            for (int r = 0; r < 4; ++r) rec0[(4 * kg + r) * MRG_REC + 4 + 16 * c + t16] = O[c][r]; }
    if (kg == 0 && t16 < 8) { rec0[t16 * MRG_REC] = m; rec0[t16 * MRG_REC + 1] = l; }
    asm volatile("s_waitcnt lgkmcnt(0)" ::: "memory"); att::bar4(cnt, gen, lane);
#pragma unroll
    for (int hh = 0; hh < 2; ++hh) { const int g = w4 + 4 * hh, d0 = 2 * lane;
      float M = -INFINITY;
#pragma unroll
      for (int w = 0; w < 4; ++w) M = fmaxf(M, ((const LAS float*)(tl + M4_VT + w * VTILE))[g * MRG_REC]);
      float L = 0.f, o0 = 0.f, o1 = 0.f;
#pragma unroll
      for (int w = 0; w < 4; ++w) { const LAS float* rec = (const LAS float*)(tl + M4_VT + w * VTILE) + g * MRG_REC; const float wt = __builtin_amdgcn_exp2f(rec[0] - M);
          L = fmaf(wt, rec[1], L); o0 = fmaf(wt, rec[4 + d0], o0); o1 = fmaf(wt, rec[4 + d0 + 1], o1); }
      const size_t slot = ((size_t)s * NSPLIT + sp) * GE + g;
      *(f32x2*)(DPO + slot * 128 + d0) = (f32x2){o0, o1};
      if (lane == 0) *(f32x2*)(DML + slot * 2) = (f32x2){M, L}; }
    asm volatile("s_waitcnt lgkmcnt(0)" ::: "memory"); att::bar4(cnt, gen, lane);
}

__device__ __forceinline__ void combine_unit(int s, const bf16* QB, const float* QLATg, const float* DPO, const float* DML, const float* dout, const float* wkvb, bf16* OCAT, LAS float* lds) {
    int tid_ = threadIdx.x; asm volatile("" : "+v"(tid_)); const int tid = tid_, lane = tid & 63, g = __builtin_amdgcn_readfirstlane(tid >> 6), d0 = 2 * lane;
    const float* ck = dout + O_CKVS + (size_t)s * KVL; const float* kp = dout + O_KPES + (size_t)s * RPE;
    const f32x2 ckv = *(const f32x2*)(ck + d0); const f32x2 ql = *(const f32x2*)(QLATg + (size_t)s * 1024 + g * 128 + d0);
    float part = ql[0] * ckv[0] + ql[1] * ckv[1];
    if (lane < 16) { const unsigned qp = *(const unsigned*)(QB + (size_t)(MP + s) * 768 + g * QKD + 64 + d0); part += bflo(qp) * kp[d0] + bfhi(qp) * kp[d0 + 1]; }
    const float sself = wave_sum(part);
    float M = sself;
#pragma unroll
    for (int sp = 0; sp < NSPLIT; ++sp) M = fmaxf(M, DML[(((size_t)s * NSPLIT + sp) * GE + g) * 2]);
    float L = __builtin_amdgcn_exp2f(sself - M), o0 = L * ckv[0], o1 = L * ckv[1];
#pragma unroll
    for (int sp = 0; sp < NSPLIT; ++sp) { const size_t slot = ((size_t)s * NSPLIT + sp) * GE + g; const float wt = __builtin_amdgcn_exp2f(DML[slot * 2] - M);
        const f32x2 po = *(const f32x2*)(DPO + slot * 128 + d0); L = fmaf(wt, DML[slot * 2 + 1], L); o0 = fmaf(wt, po[0], o0); o1 = fmaf(wt, po[1], o1); }
    const float inv = 1.0f / L;
    LAS float* ol = lds + g * 128;
    ol[d0] = o0 * inv; ol[d0 + 1] = o1 * inv;
    asm volatile("s_waitcnt lgkmcnt(0)" ::: "memory");
    float a = 0.f;
#pragma unroll 8
    for (int cc = 0; cc < 128; ++cc) a = fmaf(ol[cc], wkvb[(size_t)cc * 1024 + g * 128 + 64 + lane], a);
    OCAT[(size_t)(MP + s) * DM + g * 64 + lane] = (bf16)f2bf(a);
    __syncthreads();
}
}
#define XB_TMO      128
#define XB_XCNT(j)  (256  + 64 * (j))
#define XB_XSUB(j)  (1280 + 64 * (j))
#define XB_XGEN(j)  (2304 + 64 * (j))
#define XB_TOP      3328
#define XB_TOPGEN   3392
#define XCD_BAR_WORDS 3456
#define XB_SPIN_CAP (1u << 18)

__device__ __forceinline__ unsigned xb_ld(unsigned* p)              { return __hip_atomic_load(p, __ATOMIC_RELAXED, __HIP_MEMORY_SCOPE_AGENT); }
__device__ __forceinline__ unsigned xb_add(unsigned* p, unsigned v) { return __hip_atomic_fetch_add(p, v, __ATOMIC_RELAXED, __HIP_MEMORY_SCOPE_AGENT); }
__device__ __forceinline__ unsigned xb_xcc_id() { return (unsigned)__builtin_amdgcn_s_getreg((3 << 11) | 20) & 0xFu; }
#define XB_SPIN(cond, bar) do { unsigned _sp = 0; while (cond) { __builtin_amdgcn_s_sleep(1); \
    if ((++_sp & 255u) == 0u) { if (xb_ld(&(bar)[XB_TMO])) break; if (_sp > XB_SPIN_CAP) { atomicAdd(&(bar)[XB_TMO], 1u); break; } } } } while (0)

struct XcdBarrier {
    unsigned* bar; unsigned x;
    volatile LAS unsigned* st;
};

__device__ __forceinline__ XcdBarrier xcd_barrier_post(unsigned* bar, volatile LAS unsigned* st) {
    XcdBarrier b; b.bar = bar; b.x = xb_xcc_id(); b.st = st;
    if (threadIdx.x == 0) (void)xb_add(&bar[XB_XCNT(b.x)], 1u);
    return b;
}
__device__ __forceinline__ void xcd_barrier_complete(unsigned* bar, unsigned x, unsigned& nloc, unsigned& nx) {
    const unsigned G = gridDim.x * gridDim.y * gridDim.z;
    unsigned sum, cnt, mine, sp = 0u;
    for (;;) {
        sum = 0u; cnt = 0u; mine = 0u;
#pragma unroll
        for (unsigned j = 0; j < 16; ++j) { const unsigned c = xb_ld(&bar[XB_XCNT(j)]); sum += c; cnt += (c > 0u) ? 1u : 0u; mine = (j == x) ? c : mine; }
        if (sum == G) break;
        __builtin_amdgcn_s_sleep(1);
        if ((++sp & 255u) == 0u) { if (xb_ld(&bar[XB_TMO])) break; if (sp > XB_SPIN_CAP) { atomicAdd(&bar[XB_TMO], 1u); break; } }
    }
    nloc = mine > 0u ? mine : 1u; nx = cnt > 0u ? cnt : 1u;
}

__device__ __forceinline__ void xcd_barrier(const XcdBarrier& b) {
    asm volatile("s_waitcnt vmcnt(0)" ::: "memory");
    __syncthreads();
    if (threadIdx.x == 0) {
        unsigned* bar = b.bar;
        __builtin_amdgcn_s_waitcnt(0);
        unsigned nloc = b.st[0], nx = b.st[1];
        if (nloc == 0u) { xcd_barrier_complete(bar, b.x, nloc, nx); b.st[0] = nloc; b.st[1] = nx; }
        const unsigned old = xb_add(&bar[XB_XSUB(b.x)], 1u);
        const unsigned gen = old / nloc;
        if (old + 1u == (gen + 1u) * nloc) {
            __builtin_amdgcn_fence(__ATOMIC_RELEASE, "agent");
            asm volatile("s_waitcnt vmcnt(0)" ::: "memory");
            const unsigned og = xb_add(&bar[XB_TOP], 1u);
            const unsigned tg = og / nx;
            if (og + 1u == (tg + 1u) * nx) xb_add(&bar[XB_TOPGEN], 1u);
            else XB_SPIN(xb_ld(&bar[XB_TOPGEN]) == tg, bar);
            __builtin_amdgcn_fence(__ATOMIC_ACQUIRE, "agent");
            xb_add(&bar[XB_XGEN(b.x)], 1u);
            asm volatile("s_waitcnt vmcnt(0)" ::: "memory");
        } else {
            XB_SPIN(xb_ld(&bar[XB_XGEN(b.x)]) == gen, bar);
            __builtin_amdgcn_fence(__ATOMIC_ACQUIRE, "agent");
            asm volatile("s_waitcnt vmcnt(0)" ::: "memory");
        }
    }
    __syncthreads();
}
constexpr int NWAVES = 8, NPHASE = 13;
struct Args {
    const float *x_prompt, *x_sample, *cache_ckv, *cache_kpe, *state_ret; const int* page_table; const float *p_prompt, *p_sample;
    const float *ffn1_norm, *ffn1_w_gate, *ffn1_w_up, *ffn1_w_down, *mix_norm, *w_in, *q_a_norm, *w_q_b, *kv_a_norm, *w_kv_b, *ret_norm, *w_branch_att, *w_branch_ret, *w_out;
    const float *ffn2_norm, *ffn2_w_gate, *ffn2_w_up, *ffn2_w_down, *ple_norm, *w_ple_gate, *w_ple_proj, *final_norm;
    float* out; unsigned char* ws; int ph_lo, ph_hi;
};
static_assert(sizeof(Args) == 32 * 8 + 8, "Args has no padding holes");

enum { RM_ID = 0, RM_GATE, RM_UP, RM_WIN, RM_QB, RM_KVB };
__device__ __forceinline__ int rowmap(int kind, int n) {
    switch (kind) {
    case RM_GATE: return (n >> 7) * 256 + (n & 127);
    case RM_UP:   return (n >> 7) * 256 + 128 + (n & 127);
    case RM_WIN: {
        if (n < 384) return n;
        if (n < 416) { const int j = n - 384, jj = j & 15; return 384 + 8 * (jj >> 2) + 4 * (j >> 4) + (jj & 3); }
        if (n < 1440) { const bool isk = n >= 928; const int j = n - (isk ? 928 : 416), hh = j >> 7, d = j & 127, i = d & 63, n_ = d >> 6;
            return (isk ? 1024 : 512) + hh * 128 + 32 * (i >> 4) + 8 * ((i >> 2) & 3) + 4 * n_ + (i & 3); }
        if (n < 1952) return 1536 + (n - 1440);
        if (n < 2464) return 2048 + (n - 1952);
        if (n < 3488) return 2560 + (n - 2464);
        return 3584 + (n - 3488); }
    case RM_QB: { const int hh = n / 96, d = n % 96; if (d < 64) return hh * 64 + d; const int j = d - 64, jj = j & 15; return 512 + hh * 32 + 8 * (jj >> 2) + 4 * (j >> 4) + (jj & 3); }
    case RM_KVB: { const int hh = n >> 7, d = n & 127; return d < 64 ? hh * 64 + d : 512 + hh * 64 + (d - 64); }
    default: return n; }
}
__device__ __forceinline__ void tr_item(const float* W, int N, bf16* WT, int Kd, int koff, const float* gain, float scale, int kind, LAS float* scr, int item, int lane) {
    const int nblk = N / 32, kb = item / nblk, nb = item % nblk, k0 = 64 * kb, n0 = 32 * nb;
#pragma unroll 8
    for (int i = 0; i < 32; ++i) { const int kk = 2 * i + (lane >> 5); const float g = gain ? gain[k0 + kk] * scale : scale; scr[kk * 33 + (lane & 31)] = W[(size_t)(k0 + kk) * N + n0 + (lane & 31)] * g; }
    LDS_WAIT(); asm volatile("" ::: "memory");
    const int c = lane & 7;
#pragma unroll
    for (int j = 0; j < 4; ++j) { const int n = (lane >> 3) + 8 * j; const LAS float* s = scr + (8 * c) * 33 + n;
        v4u o; o.x = pk2(s[0 * 33], s[1 * 33]); o.y = pk2(s[2 * 33], s[3 * 33]); o.z = pk2(s[4 * 33], s[5 * 33]); o.w = pk2(s[6 * 33], s[7 * 33]);
        *(GAS v4u*)(WT + (size_t)rowmap(kind, n0 + n) * Kd + koff + k0 + 8 * c) = o; }
    LDS_WAIT(); asm volatile("" ::: "memory");
}
__device__ __forceinline__ void sincos_d(double a, float& c, float& s) {
    const double k = __builtin_rint(a * 0.63661977236758134308);
    double r = __builtin_fma(-k, 1.5707963267948966, a); r = __builtin_fma(-k, 6.123233995736766e-17, r);
    const double r2 = r * r;
    const double sp = r * (1.0 + r2 * (-1.0 / 6 + r2 * (1.0 / 120 + r2 * (-1.0 / 5040 + r2 * (1.0 / 362880 + r2 * (-1.0 / 39916800 + r2 * (1.0 / 6227020800.0)))))));
    const double cp = 1.0 + r2 * (-0.5 + r2 * (1.0 / 24 + r2 * (-1.0 / 720 + r2 * (1.0 / 40320 + r2 * (-1.0 / 3628800 + r2 * (1.0 / 479001600.0 + r2 * (-1.0 / 87178291200.0)))))));
    const int q = (int)((long long)k & 3);
    const double cc = q == 0 ? cp : q == 1 ? -sp : q == 2 ? -cp : sp, ss = q == 0 ? sp : q == 1 ? cp : q == 2 ? -sp : -cp;
    c = (float)cc; s = (float)ss;
}

struct Frame {
    LAS unsigned char* lds; volatile LAS unsigned* MISC; gu32* ctl; int tid, lane, wave, G, bid;
};

__device__ __forceinline__ void p0_prologue(const Args& a, Frame& F) {
    unsigned char* ws = a.ws;
    LAS float* scr = (LAS float*)(F.lds + F.wave * 16384);
    const int gw = F.bid * NWAVES + F.wave, NGW = F.G * NWAVES;
    constexpr int I_FF = 16 * 88, I_DN = 44 * 32, I_IN = 16 * 141, I_QB = 4 * 24, I_KVB = 2 * 32;
    constexpr int NITEMS = 2 * I_FF + I_DN + I_IN + I_QB + I_KVB;
    for (int it = gw; it < NITEMS; it += NGW) {
        int r = it;
        if (r < I_FF) { tr_item(a.ffn1_w_gate, DFF, (bf16*)(ws + WS_WGU1), DM, 0, nullptr, 1.f, RM_GATE, scr, r, F.lane); continue; } r -= I_FF;
        if (r < I_FF) { tr_item(a.ffn1_w_up, DFF, (bf16*)(ws + WS_WGU1), DM, 0, nullptr, 1.f, RM_UP, scr, r, F.lane); continue; } r -= I_FF;
        if (r < I_DN) { tr_item(a.ffn1_w_down, DM, (bf16*)(ws + WS_WD1), DFF, 0, nullptr, 1.f, RM_ID, scr, r, F.lane); continue; } r -= I_DN;
        if (r < I_IN) { tr_item(a.w_in, 4512, (bf16*)(ws + WS_WIN), DM, 0, a.mix_norm, 1.f, RM_WIN, scr, r, F.lane); continue; } r -= I_IN;
        if (r < I_QB) { tr_item(a.w_q_b, 768, (bf16*)(ws + WS_WQB), QL, 0, a.q_a_norm, C2, RM_QB, scr, r, F.lane); continue; } r -= I_QB;
        tr_item(a.w_kv_b, 1024, (bf16*)(ws + WS_WKVB), KVL, 0, a.kv_a_norm, 1.f, RM_KVB, scr, r, F.lane);
    }
    const int gt = F.bid * (NWAVES * 64) + F.tid, NGT = F.G * NWAVES * 64;
    for (int i = gt; i < 96 * 128; i += NGT) *(v4u*)((bf16*)(ws + WS_WIN) + (size_t)416 * DM + (size_t)i * 8) = (v4u){0u, 0u, 0u, 0u};
    for (int i = gt; i < 8193 * 64; i += NGT) { const int pi = i >> 6, fi = i & 63; double inv = 1.0; for (int k = 0; k < fi; ++k) inv *= 0.8659643233600653;
        float c, s; sincos_d((double)(pi == 8192 ? 16384 : pi) * inv, c, s); ((float2*)(ws + WS_ROPE))[i] = make_float2(c, s); }
    for (int m = gw; m < MT; m += NGW) {
        bf16* orow = (bf16*)(ws + WS_XN1) + (size_t)m * DM; bf16* prow = (bf16*)(ws + WS_PB) + (size_t)m * PLE;
        if (m >= MP + MS) {
#pragma unroll
            for (int j = 0; j < 4; ++j) ((unsigned long long*)orow)[F.lane + 64 * j] = 0ull;
            ((unsigned long long*)prow)[F.lane] = 0ull; continue; }
        const float* xrow = m < MP ? a.x_prompt + (size_t)m * DM : a.x_sample + (size_t)(m - MP) * DM;
        const float* pr = m < MP ? a.p_prompt + (size_t)m * PLE : a.p_sample + (size_t)(m - MP) * PLE;
        const pg8::f32x4* xr = (const pg8::f32x4*)xrow + F.lane; pg8::f32x4 v[4]; float s = 0.f;
#pragma unroll
        for (int j = 0; j < 4; ++j) { v[j] = xr[64 * j]; s += (v[j].x * v[j].x + v[j].y * v[j].y) + (v[j].z * v[j].z + v[j].w * v[j].w); }
        const float rstd = 1.0f / sqrtf(wave_sum(s) * (1.f / DM) + EPS);
#pragma unroll
        for (int j = 0; j < 4; ++j) { const pg8::f32x4 g = ((const pg8::f32x4*)a.ffn1_norm)[F.lane + 64 * j];
            ((unsigned long long*)orow)[F.lane + 64 * j] = (unsigned long long)pk2(v[j].x * rstd * g.x, v[j].y * rstd * g.y) | ((unsigned long long)pk2(v[j].z * rstd * g.z, v[j].w * rstd * g.w) << 32); }
        const pg8::f32x4 pv = ((const pg8::f32x4*)pr)[F.lane];
        ((unsigned long long*)prow)[F.lane] = (unsigned long long)pk2(pv.x, pv.y) | ((unsigned long long)pk2(pv.z, pv.w) << 32);
    }
}

__device__ __forceinline__ void p0_deferred(const Args& a, Frame& F, int gw, int NGW) {
    unsigned char* ws = a.ws;
    LAS float* scr = (LAS float*)(F.lds + F.wave * 16384);
    constexpr int I_FF = 16 * 88, I_DN = 44 * 32, I_BR = 8 * 32, I_SQ = 16 * 32, I_PP = 4 * 32;
    constexpr int NITEMS = 2 * I_FF + I_DN + 2 * I_BR + 2 * I_SQ + I_PP;
    for (int it = gw; it < NITEMS; it += NGW) {
        int r = it;
        if (r < I_PP) { tr_item(a.w_ple_proj, DM, (bf16*)(ws + WS_WPP), PLE, 0, nullptr, 1.f, RM_ID, scr, r, F.lane); continue; } r -= I_PP;
        if (r < I_BR) { tr_item(a.w_branch_att, DM, (bf16*)(ws + WS_WBC), DM, 0, nullptr, 1.f, RM_ID, scr, r, F.lane); continue; } r -= I_BR;
        if (r < I_BR) { tr_item(a.w_branch_ret, DM, (bf16*)(ws + WS_WBC), DM, 512, nullptr, 1.f, RM_ID, scr, r, F.lane); continue; } r -= I_BR;
        if (r < I_SQ) { tr_item(a.w_out, DM, (bf16*)(ws + WS_WOUT), DM, 0, nullptr, 1.f, RM_ID, scr, r, F.lane); continue; } r -= I_SQ;
        if (r < I_FF) { tr_item(a.ffn2_w_gate, DFF, (bf16*)(ws + WS_WGU2), DM, 0, a.ffn2_norm, 1.f, RM_GATE, scr, r, F.lane); continue; } r -= I_FF;
        if (r < I_FF) { tr_item(a.ffn2_w_up, DFF, (bf16*)(ws + WS_WGU2), DM, 0, a.ffn2_norm, 1.f, RM_UP, scr, r, F.lane); continue; } r -= I_FF;
        if (r < I_DN) { tr_item(a.ffn2_w_down, DM, (bf16*)(ws + WS_WD2), DFF, 0, nullptr, 1.f, RM_ID, scr, r, F.lane); continue; } r -= I_DN;
        tr_item(a.w_ple_gate, DM, (bf16*)(ws + WS_WPG), DM, 0, a.ple_norm, 1.f, RM_ID, scr, r, F.lane);
    }
}

__global__ void __launch_bounds__(NWAVES * 64, 2) mk_fwd(Args args) {
    extern __shared__ __attribute__((aligned(16))) unsigned char lds[];
    Frame F;
    F.lds = (LAS unsigned char*)lds; F.MISC = (volatile LAS unsigned*)(F.lds + MISC_OFF);
    F.tid = threadIdx.x; F.lane = F.tid & 63; F.wave = __builtin_amdgcn_readfirstlane(F.tid >> 6); F.G = gridDim.x; F.bid = blockIdx.x;
    unsigned char* ws = args.ws;
    F.ctl = (gu32*)(ws + WS_CTL);
    for (int u = F.tid; u < (LDS_BYTES - LDSCTL_OFF) / 4; u += NWAVES * 64) ((LAS unsigned*)(F.lds + LDSCTL_OFF))[u] = 0u;
    __syncthreads();
    XcdBarrier bar; bar.bar = (unsigned*)(ws + WS_CTL) + CW_BAR; bar.x = 0; bar.st = nullptr;
    if (!MK_PER_PHASE) bar = xcd_barrier_post((unsigned*)(ws + WS_CTL) + CW_BAR, F.MISC + 8);
    const int lo = args.ph_lo, hi = args.ph_hi;
#ifndef PHASE_MASK
#define PHASE_MASK 0xFFFF
#endif
#define IN(k) (((PHASE_MASK >> (k)) & 1) && lo <= (k) && (k) < hi)
#ifndef REP_PHASE
#define REP_PHASE -1
#endif
#define REPK(k) ((k) == REP_PHASE ? 2 : 1)
#define SEAM(k) do { if (IN(k) && IN((k) + 1)) { if (MK_PER_PHASE) { if (F.tid == 0) __hip_atomic_store(F.ctl + CW_TMO, 0xBADBA0u, RLX_AGENT); } else xcd_barrier(bar); } } while (0)
    float* ssq_h1 = (float*)(ws + WS_SSQ); float* ssq_h2 = (float*)(ws + WS_SSQ + SSQ16_BYTES); float* ssq_h3 = (float*)(ws + WS_SSQ + 2 * SSQ16_BYTES); float* ssq_h4 = (float*)(ws + WS_SSQ + 3 * SSQ16_BYTES);
    float* ssq_cq = (float*)(ws + WS_SSQ + 4 * SSQ16_BYTES); float* ssq_kv = (float*)(ws + WS_SSQ + 4 * SSQ16_BYTES + SSQ4_BYTES);
    const float2* rope = (const float2*)(ws + WS_ROPE);
    bf16 *XN1 = (bf16*)(ws + WS_XN1), *ACT = (bf16*)(ws + WS_ACT), *H1B = (bf16*)(ws + WS_H1B), *CQB = (bf16*)(ws + WS_CQB), *CKVB = (bf16*)(ws + WS_CKVB), *KPEB = (bf16*)(ws + WS_KPEB);
    bf16 *QR = (bf16*)(ws + WS_QR), *KR = (bf16*)(ws + WS_KR), *RV = (bf16*)(ws + WS_RV), *RGS = (bf16*)(ws + WS_RGS), *SGA = (bf16*)(ws + WS_SGA), *SGR = (bf16*)(ws + WS_SGR);
    bf16 *QB = (bf16*)(ws + WS_QB), *KN = (bf16*)(ws + WS_KN), *VB = (bf16*)(ws + WS_VB), *OCAT = (bf16*)(ws + WS_OCAT), *SC = (bf16*)(ws + WS_SC), *MRG = (bf16*)(ws + WS_MRG);
    bf16 *H2B = (bf16*)(ws + WS_H2B), *H3B = (bf16*)(ws + WS_H3B), *PB = (bf16*)(ws + WS_PB), *PP = (bf16*)(ws + WS_PP);
    bf16* H4B = (bf16*)(ws + WS_H4); float *CKVF = (float*)(ws + WS_CKVF), *KVC = (float*)(ws + WS_KVC);
    float *DPO = (float*)(ws + WS_DPO), *DML = (float*)(ws + WS_DML), *QLAT = (float*)(ws + WS_QLAT);
    const int gt = F.bid * (NWAVES * 64) + F.tid, NGT = F.G * NWAVES * 64, gw = F.bid * NWAVES + F.wave, NGW = F.G * NWAVES;

    if (IN(0)) { p0_prologue(args, F); p0_deferred(args, F, gw, NGW); }
    SEAM(0);
    for (int rp_ = 0; rp_ < REPK(1); ++rp_) if (IN(1)) { pg8::Gemm g{XN1, (const bf16*)(ws + WS_WGU1), MT, NGU, DM}; pg8::StaticOrder S; S.init(MT, NGU, F.G, F.bid);
        pg8::EpiSwiGLU E{0, ACT, nullptr}; pg8::gemm_phase<pg8::EpiSwiGLU, pg8::StaticOrder, true, true>(F.lds, g, S, E);
        constexpr int NB6 = (MT / 256) * (NGU / 256) - 5 * 256;
        (void)NB6; }
    SEAM(1);
    for (int rp_ = 0; rp_ < REPK(2); ++rp_) if (IN(2)) { pg8::Gemm g{ACT, (const bf16*)(ws + WS_WD1), MP, DM, DFF}; pg8::StaticOrder S; S.init(MP, DM, F.G, F.bid);
        pg8::EpiResid<true, true> E{0, args.x_prompt, H1B, ssq_h1}; pg8::gemm_phase<pg8::EpiResid<true, true>, pg8::StaticOrder, true, true>(F.lds, g, S, E);
        for (int u = F.bid; u < 128; u += F.G) sk::skinny_unit<DFF, false, true>(u, ACT, (const bf16*)(ws + WS_WD1), ssq_h1, (LAS float*)F.lds, sk::SkResidX{args.x_sample, H1B}); }
    SEAM(2);
    for (int rp_ = 0; rp_ < REPK(3); ++rp_) if (IN(3)) { pg8::Gemm g{H1B, (const bf16*)(ws + WS_WIN), MT, NIN, DM}; pg8::StaticOrder S; S.init(MT, NIN, F.G, F.bid);
        pg8::EpiWin E{0, ssq_h1, ssq_cq, ssq_kv, rope, args.out, CQB, CKVB, KPEB, QR, KR, RV, RGS, SGA, SGR, CKVF};
        pg8::gemm_phase<pg8::EpiWin, pg8::StaticOrder, true, true>(F.lds, g, S, E);
        constexpr int NB5 = (MT / 256) * (NIN / 256) - 4 * 256; const int ng = (F.G == 256) ? 256 - NB5 : F.G, cg = (F.G == 256) ? F.bid - NB5 : F.bid;
        if (cg >= 0) { pg8::Gemm g2{PB, (const bf16*)(ws + WS_WPP), MP, DM, PLE}; pg8::StaticOrder S2; S2.init(MP, DM, ng, cg);
          pg8::EpiPlain E2{0, PP, PP, DM, 4, nullptr, 0.f}; pg8::gemm_phase<pg8::EpiPlain, pg8::StaticOrder, true, true>(F.lds, g2, S2, E2);
          for (int u = cg; u < 128; u += ng) sk::skinny_unit<PLE, false, false>(u, PB, (const bf16*)(ws + WS_WPP), nullptr, (LAS float*)F.lds, sk::SkPlain{PP}); } }
    SEAM(3);
    for (int rp_ = 0; rp_ < REPK(4); ++rp_) if (IN(4)) {
#ifndef P4_MASK
#define P4_MASK 31
#endif
        if (P4_MASK & 1) { pg8::Gemm g{CQB, (const bf16*)(ws + WS_WQB), MT, 768, QL}; pg8::StaticOrder S; S.init(MT, 768, F.G, F.bid);
          pg8::EpiQB E{0, ssq_cq, rope, QB}; pg8::gemm_phase<pg8::EpiQB, pg8::StaticOrder, true, true>(F.lds, g, S, E); }
        if (P4_MASK & 2) { pg8::Gemm g{CKVB, (const bf16*)(ws + WS_WKVB), MP, DM, KVL}; pg8::StaticOrder S; S.init(MP, DM, F.G, F.bid);
          pg8::EpiPlain E{0, KN, VB, 512, 2, ssq_kv, 1.0f / KVL}; pg8::gemm_phase<pg8::EpiPlain, pg8::StaticOrder, true, true>(F.lds, g, S, E); }
        if (P4_MASK & 8) for (int i = gt; i < (MP + MS) * 32; i += NGT) { const int row = i >> 5, c4 = (i & 31) * 4; const float rs = pg8::rstd_of<4>(ssq_kv, row, 1.0f / KVL);
            const pg8::f32x4 v = *(const pg8::f32x4*)(CKVF + (size_t)row * KVL + c4), g = *(const pg8::f32x4*)(args.kv_a_norm + c4);
            float* o = row < MP ? args.out + O_CKVP + (size_t)row * KVL : args.out + O_CKVS + (size_t)(row - MP) * KVL;
            *(pg8::f32x4*)(o + c4) = v * rs * g; }
        if (P4_MASK & 16) for (int u = F.bid; u < 512; u += F.G) ret::kv_unit(u, KR, RV, KVC, F.lds);
    }
    SEAM(4);
    for (int rp_ = 0; rp_ < REPK(5); ++rp_) if (IN(5)) {
#ifndef P5_MASK
#define P5_MASK 7
#endif
        { volatile LAS unsigned* cntA = F.MISC + 16; volatile LAS unsigned* cntD = F.MISC + 17; volatile LAS unsigned* nextw = F.MISC + 18; unsigned genA = cntA[0], genD = cntD[0];
          __syncthreads();
#ifdef PROBE_T
          unsigned long long t0_ = __builtin_amdgcn_s_memrealtime();
#endif
          for (int v = F.bid; v < 256; v += F.G) {
            const int s = v >> 1, sg = v & 1; const bool teamA = F.wave < 4; const int w4 = F.wave & 3;
            { const int bh = v >> 4, j = v & 15;
              if (teamA) {
                __builtin_amdgcn_s_setprio(3);
                att::attn_half_unit(bh >> 3, bh & 7, 63 - 2 * j, QB, KN, KPEB, VB, OCAT, (char*)lds, cntA, genA);
                att::attn_half_unit(bh >> 3, bh & 7, 2 * j + 1, QB, KN, KPEB, VB, OCAT, (char*)lds, cntA, genA);
                att::attn_half_unit(bh >> 3, bh & 7, 2 * j, QB, KN, KPEB, VB, OCAT, (char*)lds, cntA, genA);
                att::attn_half_unit(bh >> 3, bh & 7, 62 - 2 * j, QB, KN, KPEB, VB, OCAT, (char*)lds, cntA, genA);
                __builtin_amdgcn_s_setprio(0);
              } }
            { volatile LAS unsigned* cnt = teamA ? cntA : cntD; unsigned gen = teamA ? genA : genD; volatile LAS unsigned* bw = F.MISC + (teamA ? 20 : 21);
              LAS unsigned char* tl = F.lds + (teamA ? 0 : dec::D_BASE);
              if (!teamA) ret::scan_items(v * 256 + (F.tid - 256), F.G * 256, KVC, SC, args.out);
              if (!teamA) { for (int u = 2 * v; u < 2 * v + 2; ++u) ret::sample_unit4(u, w4, F.lane, QR, KR, RV, RGS, args.ret_norm, args.state_ret, args.out, OCAT, (LAS float*)tl, cnt, gen); }
              dec::qlat_token4(s, w4, F.lane, QB, args.w_kv_b, (LAS float*)(tl + dec::M4_QL), QLAT, sg == 0 && !teamA);
              for (;;) {
                  if (w4 == 0 && F.lane == 0) bw[0] = __hip_atomic_fetch_add((LAS unsigned*)nextw, 1u, __ATOMIC_RELAXED, __HIP_MEMORY_SCOPE_WORKGROUP);
                  asm volatile("s_waitcnt lgkmcnt(0)" ::: "memory"); att::bar4(cnt, gen, F.lane);
                  const int it = (int)bw[0];
                  if (it >= 8) break;
                  dec::split_unit4m(s, sg * 8 + it, w4, F.lane, QB, args.cache_ckv, args.cache_kpe, args.page_table, DPO, DML, tl, cnt, gen);
              }
              if (teamA) genA = gen; else genD = gen; }
          }
#ifdef PROBE_T
          { const unsigned long long t1_ = __builtin_amdgcn_s_memrealtime(); if (F.bid == PROBE_BLK && F.lane == 0 && F.wave == PROBE_T) ((volatile unsigned*)(ws + WS_CTL))[2] = (unsigned)(t1_ - t0_); }
#endif
          __syncthreads(); }
    }
    SEAM(5);
    for (int rp_ = 0; rp_ < REPK(6); ++rp_) if (IN(6)) {
        for (int u = F.bid; u < 512; u += F.G) ret::out_unit(u, QR, KR, RV, SC, RGS, args.ret_norm, OCAT, F.lds);
        for (int s = F.bid; s < MS; s += F.G) dec::combine_unit(s, QB, QLAT, DPO, DML, args.out, args.w_kv_b, OCAT, (LAS float*)F.lds);
    }
    SEAM(6);
    for (int rp_ = 0; rp_ < REPK(7); ++rp_) if (IN(7)) { pg8::Gemm g{OCAT, (const bf16*)(ws + WS_WBC), MP, DM, DM}; pg8::StaticOrder S; S.init(MP, DM, F.G, F.bid);
        pg8::EpiMerge E{8, SGA, SGR, MRG}; pg8::gemm_phase<pg8::EpiMerge, pg8::StaticOrder, true, true>(F.lds, g, S, E);
        for (int u = F.bid; u < 128; u += F.G) sk::skinny_unit<DM, true, false>(u, OCAT, (const bf16*)(ws + WS_WBC), nullptr, (LAS float*)F.lds, sk::SkMerge{SGA, SGR, MRG}); }
    SEAM(7);
    for (int rp_ = 0; rp_ < REPK(8); ++rp_) if (IN(8)) { pg8::Gemm g{MRG, (const bf16*)(ws + WS_WOUT), MP, DM, DM}; pg8::StaticOrder S; S.init(MP, DM, F.G, F.bid);
        pg8::EpiResid<false, false> E{0, H1B, H2B, ssq_h2}; pg8::gemm_phase<pg8::EpiResid<false, false>, pg8::StaticOrder, true, true>(F.lds, g, S, E);
        for (int u = F.bid; u < 128; u += F.G) sk::skinny_unit<DM, false, true>(u, MRG, (const bf16*)(ws + WS_WOUT), ssq_h2, (LAS float*)F.lds, sk::SkResid{H1B, 1.0f, H2B}); }
    SEAM(8);
    for (int rp_ = 0; rp_ < REPK(9); ++rp_) if (IN(9)) { pg8::Gemm g{H2B, (const bf16*)(ws + WS_WGU2), MT, NGU, DM}; pg8::StaticOrder S; S.init(MT, NGU, F.G, F.bid);
        pg8::EpiSwiGLU E{0, ACT, ssq_h2}; pg8::gemm_phase<pg8::EpiSwiGLU, pg8::StaticOrder, true, true>(F.lds, g, S, E); }
    SEAM(9);
    for (int rp_ = 0; rp_ < REPK(10); ++rp_) if (IN(10)) { pg8::Gemm g{ACT, (const bf16*)(ws + WS_WD2), MP, DM, DFF}; pg8::StaticOrder S; S.init(MP, DM, F.G, F.bid);
        pg8::EpiResid<true, false> E{0, H2B, H3B, ssq_h3}; pg8::gemm_phase<pg8::EpiResid<true, false>, pg8::StaticOrder, true, true>(F.lds, g, S, E);
        for (int u = F.bid; u < 128; u += F.G) sk::skinny_unit<DFF, false, true>(u, ACT, (const bf16*)(ws + WS_WD2), ssq_h3, (LAS float*)F.lds, sk::SkResid{H2B, 0.5f, H3B}); }
    SEAM(10);
    for (int rp_ = 0; rp_ < REPK(11); ++rp_) if (IN(11)) { pg8::Gemm g{H3B, (const bf16*)(ws + WS_WPG), MP, DM, DM}; pg8::StaticOrder S; S.init(MP, DM, F.G, F.bid);
        pg8::EpiPle E{0, H3B, PP, ssq_h3, H4B, ssq_h4}; pg8::gemm_phase<pg8::EpiPle, pg8::StaticOrder, true, true>(F.lds, g, S, E);
        for (int u = F.bid; u < 128; u += F.G) sk::skinny_unit<DM, false, true>(u, H3B, (const bf16*)(ws + WS_WPG), ssq_h4, (LAS float*)F.lds, sk::SkPle{H3B, PP, ssq_h3, H4B}); }
    SEAM(11);
    for (int rp_ = 0; rp_ < REPK(12); ++rp_) if (IN(12)) {
        for (int m = gw; m < MP + MS; m += NGW) { const float rs = pg8::rstd_of<16>(ssq_h4, m, 1.0f / DM);
            const unsigned long long* hr = (const unsigned long long*)(H4B + (size_t)m * DM) + F.lane; pg8::f32x4* o = (pg8::f32x4*)(args.out + (m < MP ? O_YP + (size_t)m * DM : O_YS + (size_t)(m - MP) * DM)) + F.lane;
#pragma unroll
            for (int j = 0; j < 4; ++j) { const unsigned long long w = hr[64 * j]; const unsigned lo = (unsigned)w, hi = (unsigned)(w >> 32);
                o[64 * j] = (pg8::f32x4){bflo(lo), bfhi(lo), bflo(hi), bfhi(hi)} * rs * ((const pg8::f32x4*)args.final_norm)[F.lane + 64 * j]; } }
#ifdef PROBE_T
        VM_WAIT(); if (F.bid == 0 && F.wave == 0 && F.lane == 0) args.out[O_YS + 5] = 2.0f * __builtin_rintf(0.01f * (float)((volatile unsigned*)(ws + WS_CTL))[2] * (1.0f / 20.0f));
#endif
    }
#undef IN
#undef SEAM
}

#ifdef DBG_LAST
__global__ void dbg_dump(const unsigned char* ws, float* out) {
    const size_t n = (size_t)MP * DM;
    for (size_t i = (size_t)blockIdx.x * blockDim.x + threadIdx.x; i < n; i += (size_t)gridDim.x * blockDim.x) { const size_t r = i >> 10, c = i & 1023; float v = 0.f;
        if (c < DBG_NCOLS) { if (DBG_F32) v = ((const float*)(ws + DBG_SRC))[r * DBG_PITCH + c]; else v = bf2f(((const bf16*)(ws + DBG_SRC))[r * DBG_PITCH + c]); }
#ifdef DBG_SRC2
        else v = bf2f(((const bf16*)(ws + DBG_SRC2))[r * DBG_PITCH + (c - DBG_NCOLS)]);
#endif
        out[i] = v; }
}
#endif
extern "C" void kernel_launch(void* const* d_in, const int* in_sizes, int n_in, void* d_out, int out_size, void* d_ws, size_t ws_size, hipStream_t stream) {
    static int grid = 0;
    if (grid == 0) {
        if (n_in != 30 || out_size != (int)O_END || ws_size < WS_END) { fprintf(stderr, "kernel_launch: built for 30 inputs, %zu outputs, >= %zu bytes of workspace; got n_in %d, out %d, ws %zu; nothing launched\n", (size_t)O_END, (size_t)WS_END, n_in, out_size, ws_size); grid = -1; return; }
        int dev = 0, cus = 0, per_cu = 0;
        if (hipGetDevice(&dev) != hipSuccess || hipDeviceGetAttribute(&cus, hipDeviceAttributeMultiprocessorCount, dev) != hipSuccess) { fprintf(stderr, "kernel_launch: device query failed\n"); grid = -1; return; }
        if (hipFuncSetAttribute((const void*)mk_fwd, hipFuncAttributeMaxDynamicSharedMemorySize, LDS_BYTES) != hipSuccess) { fprintf(stderr, "kernel_launch: hipFuncSetAttribute failed\n"); grid = -1; return; }
        if (hipOccupancyMaxActiveBlocksPerMultiprocessor(&per_cu, (const void*)mk_fwd, NWAVES * 64, LDS_BYTES) != hipSuccess || per_cu < 1)
            fprintf(stderr, "kernel_launch: note: occupancy query reports %d workgroups per CU\n", per_cu);
        (void)hipGetLastError();
        grid = cus;
    }
    if (grid < 0) return;
    if (hipMemsetAsync((char*)d_ws + WS_CTL, 0, CTL_ZERO_BYTES, stream) != hipSuccess) { fprintf(stderr, "kernel_launch: memset failed\n"); return; }
    Args a{};
    const float** fp = (const float**)&a;
    for (int i = 0; i < 30; ++i) fp[i] = (const float*)d_in[i];
    a.out = (float*)d_out; a.ws = (unsigned char*)d_ws;
#if MK_PER_PHASE
#ifdef DBG_LAST
    for (int k = 0; k <= DBG_LAST; ++k) { a.ph_lo = k; a.ph_hi = k + 1; hipLaunchKernelGGL(mk_fwd, dim3(grid), dim3(NWAVES * 64), LDS_BYTES, stream, a); }
    hipLaunchKernelGGL(dbg_dump, dim3(1024), dim3(256), 0, stream, (const unsigned char*)d_ws, (float*)d_out);
#else
    for (int k = 0; k < NPHASE; ++k) { a.ph_lo = k; a.ph_hi = k + 1; hipLaunchKernelGGL(mk_fwd, dim3(grid), dim3(NWAVES * 64), LDS_BYTES, stream, a); }
#endif
#else
    a.ph_lo = 0; a.ph_hi = NPHASE; hipLaunchKernelGGL(mk_fwd, dim3(grid), dim3(NWAVES * 64), LDS_BYTES, stream, a);
#endif
    const hipError_t le = hipPeekAtLastError();
    if (le != hipSuccess) fprintf(stderr, "kernel_launch: launch failed: %s\n", hipGetErrorName(le));
}
```

```cpp
#include <hip/hip_runtime.h>
#include <cstdio>
#include <cstdint>

#ifndef MK_PER_PHASE
#define MK_PER_PHASE 0
#endif

constexpr int DM = 1024, TSEQ = 8192, MP = 16384, MS = 128, MT = 16640, NPAN = MT / 256;
constexpr int DFF = 2816, NGU = 2 * DFF, NIN = 4608, PLE = 256;
constexpr int NH = 8, QKD = 96, KVL = 128, RPE = 32, QL = 256;
constexpr int RH = 4, RDK = 128, RDV = 128;
constexpr int NPAGES = 128, PAGE = 128;
constexpr float EPS = 1e-6f;
constexpr float C2 = 0.10206207261596575f * 1.4426950408889634f;
constexpr size_t O_YP = 0, O_YS = 16777216, O_CKVP = 16908288, O_KPEP = 19005440, O_RETP = 19529728, O_CKVS = 19660800, O_KPES = 19677184, O_RETS = 19681280, O_END = 28069888;

constexpr size_t MiB = 1u << 20;
constexpr size_t al1(size_t x) { return (x + MiB - 1) & ~(MiB - 1); }
constexpr size_t WS_CTL = 0, CTL_ZERO_BYTES = 1 * MiB;
constexpr size_t WS_WGU1 = 2 * MiB;
constexpr size_t WS_WD1  = WS_WGU1 + al1((size_t)NGU * DM * 2);
constexpr size_t WS_WIN  = WS_WD1 + al1((size_t)DM * DFF * 2);
constexpr size_t WS_WQB  = WS_WIN + al1((size_t)NIN * DM * 2);
constexpr size_t WS_WKVB = WS_WQB + al1((size_t)768 * 256 * 2);
constexpr size_t WS_WBC  = WS_WKVB + al1((size_t)1024 * 128 * 2);
constexpr size_t WS_WOUT = WS_WBC + al1((size_t)DM * DM * 2);
constexpr size_t WS_WGU2 = WS_WOUT + al1((size_t)DM * DM * 2);
constexpr size_t WS_WD2  = WS_WGU2 + al1((size_t)NGU * DM * 2);
constexpr size_t WS_WPG  = WS_WD2 + al1((size_t)DM * DFF * 2);
constexpr size_t WS_WPP  = WS_WPG + al1((size_t)DM * DM * 2);
constexpr size_t WS_ROPE = WS_WPP + al1((size_t)DM * PLE * 2);
constexpr size_t WS_XN1  = WS_ROPE + al1((size_t)8193 * 64 * 8);
constexpr size_t WS_ACT  = WS_XN1 + al1((size_t)MT * DM * 2);
constexpr size_t WS_H1   = WS_ACT + al1((size_t)MT * DFF * 2);
constexpr size_t WS_H1B  = WS_H1 + al1((size_t)MT * DM * 4);
constexpr size_t WS_CQB  = WS_H1B + al1((size_t)MT * DM * 2);
constexpr size_t WS_CKVF = WS_CQB + al1((size_t)MT * 256 * 2);
constexpr size_t WS_CKVB = WS_CKVF + al1((size_t)MT * 128 * 4);
constexpr size_t WS_KPEB = WS_CKVB + al1((size_t)MT * 128 * 2);
constexpr size_t WS_QR   = WS_KPEB + al1((size_t)MT * 32 * 2);
constexpr size_t WS_KR   = WS_QR + al1((size_t)MT * 512 * 2);
constexpr size_t WS_RV   = WS_KR + al1((size_t)MT * 512 * 2);
constexpr size_t WS_RGS  = WS_RV + al1((size_t)MT * 512 * 2);
constexpr size_t WS_SGA  = WS_RGS + al1((size_t)MT * 512 * 2);
constexpr size_t WS_SGR  = WS_SGA + al1((size_t)MT * DM * 2);
constexpr size_t WS_QB   = WS_SGR + al1((size_t)MT * DM * 2);
constexpr size_t WS_KN   = WS_QB + al1((size_t)MT * 768 * 2);
constexpr size_t WS_VB   = WS_KN + al1((size_t)MP * 512 * 2);
constexpr size_t WS_OCAT = WS_VB + al1((size_t)MP * 512 * 2);
constexpr size_t WS_KVC  = WS_OCAT + al1((size_t)MT * DM * 2);
constexpr size_t WS_SC   = WS_KVC + al1((size_t)512 * 16384 * 4);
constexpr size_t WS_MRG  = WS_SC + al1((size_t)512 * 16384 * 2);
constexpr size_t WS_H2   = WS_MRG + al1((size_t)MT * DM * 2);
constexpr size_t WS_H2B  = WS_H2 + al1((size_t)MT * DM * 4);
constexpr size_t WS_H3   = WS_H2B + al1((size_t)MT * DM * 2);
constexpr size_t WS_H3B  = WS_H3 + al1((size_t)MT * DM * 4);
constexpr size_t WS_PB   = WS_H3B + al1((size_t)MT * DM * 2);
constexpr size_t WS_PP   = WS_PB + al1((size_t)MT * PLE * 2);
constexpr size_t WS_H4   = WS_PP + al1((size_t)MT * DM * 2);
constexpr size_t WS_DPO  = WS_H4 + al1((size_t)MT * DM * 4);
constexpr size_t WS_DML  = WS_DPO + al1((size_t)128 * 16 * 8 * 128 * 4);
constexpr size_t WS_QLAT = WS_DML + MiB;
constexpr size_t WS_SSQ  = WS_QLAT + MiB;
constexpr size_t SSQ16_BYTES = (size_t)MT * 16 * 4, SSQ4_BYTES = (size_t)MT * 4 * 4;
constexpr size_t WS_END  = WS_SSQ + al1(4 * SSQ16_BYTES + 2 * SSQ4_BYTES);
constexpr int CW_TMO = 0, CW_BAR = 4096;

constexpr int RING_BYTES = 131072, PH5_BYTES = 157696, LDSCTL_OFF = PH5_BYTES, MISC_OFF = LDSCTL_OFF + 320, LDS_BYTES = 163840;

#define GAS __attribute__((address_space(1)))
#define LAS __attribute__((address_space(3)))
typedef unsigned short bf16;
typedef unsigned v4u __attribute__((ext_vector_type(4)));
typedef unsigned v2u __attribute__((ext_vector_type(2)));
typedef GAS unsigned gu32;
#define RLX_AGENT __ATOMIC_RELAXED, __HIP_MEMORY_SCOPE_AGENT
#define LDS_WAIT() asm volatile("s_waitcnt lgkmcnt(0)" ::: "memory")
#define VM_WAIT() asm volatile("s_waitcnt vmcnt(0)" ::: "memory")
__device__ __forceinline__ unsigned f2bf(float f) { unsigned u = __builtin_bit_cast(unsigned, f); return (u + 0x7fffu + ((u >> 16) & 1u)) >> 16; }
__device__ __forceinline__ unsigned pk2(float lo, float hi) { return f2bf(lo) | (f2bf(hi) << 16); }
__device__ __forceinline__ float bflo(unsigned w) { return __builtin_bit_cast(float, w << 16); }
__device__ __forceinline__ float bfhi(unsigned w) { return __builtin_bit_cast(float, w & 0xffff0000u); }
__device__ __forceinline__ float bf2f(bf16 h) { return __builtin_bit_cast(float, (unsigned)h << 16); }
__device__ __forceinline__ float sigm(float x) { return __builtin_amdgcn_rcpf(1.f + __builtin_amdgcn_exp2f(-1.4426950408889634f * x)); }
__device__ __forceinline__ float wave_sum(float v) {
#pragma unroll
    for (int o = 1; o < 64; o <<= 1) v += __shfl_xor(v, o);
    return v;
}
__device__ __forceinline__ float lg2gamma(int h) { return h == 0 ? -0.04580368961312479f : h == 1 ? -0.02272007650008353f : h == 2 ? -0.011315313227834146f : -0.005646563141142063f; }
namespace pg8 {
#define PG8_LAS __attribute__((address_space(3)))
typedef unsigned short bf16_t;
typedef short bf16x8 __attribute__((ext_vector_type(8)));
typedef float f32x4 __attribute__((ext_vector_type(4)));
typedef unsigned u32x4 __attribute__((ext_vector_type(4)));
constexpr int BM = 256, BK = 64, HALF = 128, HTB = HALF * BK * 2  , STAGE_BYTES = 8 * HTB, NXCD = 8, WGM = 8;

__host__ __device__ __forceinline__ int lds_byte(int r, int c) { const int st = (r >> 4) * 2 + (c >> 5), rr = r & 15, cc = c & 31, ob = rr * 64 + cc * 2; return st * 1024 + (ob ^ (((ob >> 9) & 1) << 5)); }
__host__ __device__ __forceinline__ void stage_rc(int b, int& R, int& C) { const int st = b / 1024, sb = b % 1024, swz = sb ^ (((sb >> 9) & 1) << 5); R = (st >> 1) * 16 + swz / 64; C = (st & 1) * 32 + (swz % 64) / 2; }
__host__ __device__ __forceinline__ int perm32(int rho) { const int n = rho >> 4, i = rho & 15; return 8 * (i >> 2) + 4 * n + (i & 3); }

struct Unit { int pm, pn; };
struct Gemm { const bf16_t* A; const bf16_t* Bt; int M, N, K; };

struct StaticOrder {
    int nM, nN, nwg, G, c;
    __host__ __device__ void init(int M, int N, int G_, int c_) { nM = M / BM; nN = N / BM; nwg = nM * nN; G = G_; c = c_; }
    __host__ __device__ bool next(int i, Unit& u) const {
        const long L = (long)i * G + c; if (L >= nwg) return false;
        int wgid = (int)L; { const int q = nwg / NXCD, r = nwg % NXCD, xcd = wgid % NXCD, off = wgid / NXCD; wgid = (xcd < r ? xcd * (q + 1) : r * (q + 1) + (xcd - r) * q) + off; }
        const int nig = WGM * nN, gid = wgid / nig, fm = gid * WGM, gsz = (nM - fm) < WGM ? (nM - fm) : WGM;
        u.pm = fm + ((wgid % nig) % gsz); u.pn = (wgid % nig) / gsz; return true;
    }
    __device__ __forceinline__ void a_ready(const Unit&) const {}
    __device__ __forceinline__ void done(const Unit&) const {}
};

typedef float cvt_f32x2_t __attribute__((ext_vector_type(2))); typedef __bf16 cvt_bf16x2_t __attribute__((ext_vector_type(2)));
__device__ __forceinline__ unsigned cvt_pk_bf16(float lo, float hi) { cvt_f32x2_t v = {lo, hi}; cvt_bf16x2_t b = __builtin_convertvector(v, cvt_bf16x2_t); return __builtin_bit_cast(unsigned, b); }
typedef float f32x2 __attribute__((ext_vector_type(2)));
template <class Epi, class Sched, bool ALIGN_EPI = false, bool SP2 = false>
__device__ __forceinline__ void gemm_phase(PG8_LAS unsigned char* lds, const Gemm g, const Sched S, const Epi E) {
    int tid_ = threadIdx.x; asm volatile("" : "+v"(tid_));
    const int tid = tid_, wid = __builtin_amdgcn_readfirstlane(tid >> 6), lane = tid & 63, wr = wid >> 2, wc = wid & 3, fr = lane & 15, fq = lane >> 4;
    const int K = g.K, nt = K / BK;
    unsigned voffA[2], voffB[2];
#pragma unroll
    for (int i = 0; i < 2; ++i) { int R, C; stage_rc(tid * 16 + i * 8192, R, C); const int Rb = Epi::PERM ? ((R & ~31) + perm32(R & 31)) : R;
        voffA[i] = (unsigned)(R * K + C) * 2u; voffB[i] = (unsigned)(Rb * K + C) * 2u; }
    const size_t kstep = (size_t)(BK * 2);
    const size_t hstep = (size_t)HALF * K * 2;
    const size_t tstep = 2 * hstep;
    const unsigned ldsw = (unsigned)wid * 1024u;
    const int aoff = lds_byte(wr * 64 + fr, fq * 8), boff = lds_byte(wc * 32 + fr, fq * 8);
#define PG8_SA(b, h) (((b) * 2 + (h)) * HTB)
#define PG8_SB(b, h) ((4 + (b) * 2 + (h)) * HTB)
#define PG8_STAGE(bufoff, gbase, voff) do { _Pragma("unroll") for (int _i = 0; _i < 2; ++_i) \
        __builtin_amdgcn_global_load_lds((const unsigned*)((const char*)(gbase) + (voff)[_i]), (PG8_LAS unsigned*)(lds + (bufoff) + ldsw + _i * 8192), 16, 0, 0); } while (0)
#define PG8_LDA(dst, b, h) do { _Pragma("unroll") for (int m = 0; m < 4; ++m) _Pragma("unroll") for (int k = 0; k < 2; ++k) dst[m][k] = *(const PG8_LAS bf16x8*)(lds + PG8_SA(b, h) + aoff + m * 2048 + k * 1024); } while (0)
#define PG8_LDB(dst, b, h) do { _Pragma("unroll") for (int n = 0; n < 2; ++n) _Pragma("unroll") for (int k = 0; k < 2; ++k) dst[n][k] = *(const PG8_LAS bf16x8*)(lds + PG8_SB(b, h) + boff + n * 2048 + k * 1024); } while (0)
#define PG8_MMA(ai, bj, At, Bt) do { __builtin_amdgcn_s_setprio(1); _Pragma("unroll") for (int m = 0; m < 4; ++m) _Pragma("unroll") for (int n = 0; n < 2; ++n) _Pragma("unroll") for (int k = 0; k < 2; ++k) \
        acc[ai][bj][m][n] = __builtin_amdgcn_mfma_f32_16x16x32_bf16(Bt[n][k], At[m][k], acc[ai][bj][m][n], 0, 0, 0); __builtin_amdgcn_s_setprio(0); } while (0)
#define PG8_WAIT_V(n) asm volatile("s_waitcnt vmcnt(" #n ")" ::: "memory")
#define PG8_WAIT_L(n) asm volatile("s_waitcnt lgkmcnt(" #n ")" ::: "memory")
#define PG8_BAR __builtin_amdgcn_s_barrier()
#define PG8_SCHED __builtin_amdgcn_sched_barrier(0)
    Unit cur, nxt; int ui = 0;
    if (!S.next(0, cur)) return;
    f32x4 acc[2][2][4][2];
#pragma unroll
    for (int a = 0; a < 2; ++a)
#pragma unroll
        for (int b = 0; b < 2; ++b)
#pragma unroll
            for (int m = 0; m < 4; ++m)
#pragma unroll
                for (int n = 0; n < 2; ++n) acc[a][b][m][n] = (f32x4){0.f, 0.f, 0.f, 0.f};
    bf16x8 At[4][2], B0[2][2], B1[2][2];
    const char* cA = (const char*)g.A + (size_t)cur.pm * tstep; const char* cB = (const char*)g.Bt + (size_t)cur.pn * tstep;
    S.a_ready(cur);
    if constexpr (SP2) {
        PG8_STAGE(PG8_SB(0, 0), cB, voffB); PG8_STAGE(PG8_SB(0, 1), cB + hstep, voffB); PG8_STAGE(PG8_SA(0, 0), cA, voffA); PG8_STAGE(PG8_SA(0, 1), cA + hstep, voffA);
        if (wr == 1) PG8_BAR;
        PG8_WAIT_V(2); PG8_BAR;
        PG8_STAGE(PG8_SB(1, 0), cB + kstep, voffB); PG8_STAGE(PG8_SA(1, 0), cA + kstep, voffA); PG8_STAGE(PG8_SB(1, 1), cB + hstep + kstep, voffB);
        PG8_WAIT_V(6); PG8_BAR;
    } else {
        PG8_STAGE(PG8_SB(0, 0), cB, voffB); PG8_STAGE(PG8_SA(0, 0), cA, voffA); PG8_STAGE(PG8_SB(0, 1), cB + hstep, voffB); PG8_STAGE(PG8_SA(0, 1), cA + hstep, voffA);
        if (wr == 1) PG8_BAR;
        PG8_WAIT_V(4); PG8_BAR;
        PG8_STAGE(PG8_SB(1, 0), cB + kstep, voffB); PG8_STAGE(PG8_SA(1, 0), cA + kstep, voffA); PG8_STAGE(PG8_SB(1, 1), cB + hstep + kstep, voffB);
        PG8_WAIT_V(6); PG8_BAR;
    }
    for (;;) {
        const bool has_next = S.next(ui + 1, nxt);
        const char* nA = has_next ? (const char*)g.A + (size_t)nxt.pm * tstep : cA; const char* nB = has_next ? (const char*)g.Bt + (size_t)nxt.pn * tstep : cB;
#pragma nounroll
        for (int t = 0; t < nt; t += 2) {
            if constexpr (Epi::HAS_MID) { if (t == E.mid_t) E.mid(acc, cur, wr, wc, fr, fq); }
            const bool last = (t == nt - 2);
            const char* a1 = cA + (size_t)(t + 1) * kstep;
            const char* a2 = last ? nA : cA + (size_t)(t + 2) * kstep; const char* b2 = last ? nB : cB + (size_t)(t + 2) * kstep;
            const char* a3 = a2 + kstep; const char* b3 = b2 + kstep;
            if (last && has_next) S.a_ready(nxt);
            if constexpr (SP2) {
            PG8_LDB(B0, 0, 0); PG8_LDB(B1, 0, 1); PG8_SCHED; PG8_LDA(At, 0, 0); PG8_STAGE(PG8_SA(1, 1), a1 + hstep, voffA);
            PG8_WAIT_V(8); PG8_WAIT_L(0); PG8_BAR; PG8_MMA(0, 0, At, B0); PG8_MMA(0, 1, At, B1); PG8_BAR; PG8_SCHED;
            PG8_LDA(At, 0, 1); PG8_STAGE(PG8_SB(0, 0), b2, voffB); PG8_STAGE(PG8_SB(0, 1), b2 + hstep, voffB); PG8_STAGE(PG8_SA(0, 0), a2, voffA);
            PG8_WAIT_V(8); PG8_WAIT_L(0); PG8_BAR; PG8_MMA(1, 0, At, B0); PG8_MMA(1, 1, At, B1); PG8_BAR; PG8_SCHED;
            PG8_LDB(B0, 1, 0); PG8_LDB(B1, 1, 1); PG8_SCHED; PG8_LDA(At, 1, 0); PG8_STAGE(PG8_SA(0, 1), a2 + hstep, voffA);
            PG8_WAIT_V(8); PG8_WAIT_L(0); PG8_BAR; PG8_MMA(0, 0, At, B0); PG8_MMA(0, 1, At, B1); PG8_BAR; PG8_SCHED;
            PG8_LDA(At, 1, 1); PG8_STAGE(PG8_SB(1, 0), b3, voffB); PG8_STAGE(PG8_SB(1, 1), b3 + hstep, voffB); PG8_STAGE(PG8_SA(1, 0), a3, voffA);
            PG8_WAIT_V(8); PG8_WAIT_L(0); PG8_BAR; PG8_MMA(1, 0, At, B0); PG8_MMA(1, 1, At, B1); PG8_BAR; PG8_SCHED;
            } else {
            PG8_LDB(B0, 0, 0); PG8_SCHED; PG8_LDA(At, 0, 0); PG8_STAGE(PG8_SA(1, 1), a1 + hstep, voffA);
            PG8_WAIT_L(8); PG8_BAR; PG8_WAIT_L(0); PG8_MMA(0, 0, At, B0); PG8_BAR; PG8_SCHED;
            PG8_LDB(B1, 0, 1); PG8_STAGE(PG8_SB(0, 0), b2, voffB);
            PG8_BAR; PG8_WAIT_L(0); PG8_MMA(0, 1, At, B1); PG8_BAR;
            PG8_LDA(At, 0, 1); PG8_STAGE(PG8_SA(0, 0), a2, voffA);
            PG8_BAR; PG8_WAIT_L(0); PG8_MMA(1, 0, At, B0); PG8_BAR; PG8_SCHED;
            PG8_STAGE(PG8_SB(0, 1), b2 + hstep, voffB);
            PG8_WAIT_V(6); PG8_BAR; PG8_MMA(1, 1, At, B1); PG8_BAR;
            PG8_LDB(B0, 1, 0); PG8_SCHED; PG8_LDA(At, 1, 0); PG8_STAGE(PG8_SA(0, 1), a2 + hstep, voffA);
            PG8_WAIT_L(8); PG8_BAR; PG8_WAIT_L(0); PG8_MMA(0, 0, At, B0); PG8_BAR; PG8_SCHED;
            PG8_LDB(B1, 1, 1); PG8_STAGE(PG8_SB(1, 0), b3, voffB);
            PG8_BAR; PG8_WAIT_L(0); PG8_MMA(0, 1, At, B1); PG8_BAR;
            PG8_LDA(At, 1, 1); PG8_STAGE(PG8_SA(1, 0), a3, voffA);
            PG8_BAR; PG8_WAIT_L(0); PG8_MMA(1, 0, At, B0); PG8_BAR; PG8_SCHED;
            PG8_STAGE(PG8_SB(1, 1), b3 + hstep, voffB);
            PG8_WAIT_V(6); PG8_BAR; PG8_MMA(1, 1, At, B1); PG8_BAR;
            }
        }
        if constexpr (ALIGN_EPI) { if (wr == 0) PG8_BAR; }
        if constexpr (!Epi::AFTER_DRAIN) { E(acc, cur, wr, wc, fr, fq); S.done(cur); }
        if (!has_next) break;
#pragma unroll
        for (int a = 0; a < 2; ++a)
#pragma unroll
            for (int b = 0; b < 2; ++b)
#pragma unroll
                for (int m = 0; m < 4; ++m)
#pragma unroll
                    for (int n = 0; n < 2; ++n) acc[a][b][m][n] = (f32x4){0.f, 0.f, 0.f, 0.f};
        cur = nxt; cA = nA; cB = nB; ++ui;
        if constexpr (ALIGN_EPI) { if (wr == 1) PG8_BAR; }
    }
    PG8_WAIT_V(0);
    if constexpr (!ALIGN_EPI) { if (wr == 0) PG8_BAR; }
    PG8_BAR;
    if constexpr (Epi::AFTER_DRAIN) { E.fused(acc, cur, wr, wc, fr, fq, lds, wid, lane); S.done(cur); }
#undef PG8_SA
#undef PG8_SB
#undef PG8_STAGE
#undef PG8_LDA
#undef PG8_LDB
#undef PG8_MMA
#undef PG8_WAIT_V
#undef PG8_WAIT_L
#undef PG8_BAR
#undef PG8_SCHED
}
}
namespace pg8 {
#define EPI_ROWS(ai, m) (u.pm * BM + (ai) * HALF + wr * 64 + (m) * 16 + fr)
#define EPI_OPAQUE int fr = fr_, fq = fq_; asm volatile("" : "+v"(fr), "+v"(fq))
__device__ __forceinline__ u32x4 pack8(f32x4 a, f32x4 b) { u32x4 w; w.x = cvt_pk_bf16(a[0], a[1]); w.y = cvt_pk_bf16(a[2], a[3]); w.z = cvt_pk_bf16(b[0], b[1]); w.w = cvt_pk_bf16(b[2], b[3]); return w; }
__device__ __forceinline__ float sq4(f32x4 a) { return (a[0] * a[0] + a[1] * a[1]) + (a[2] * a[2] + a[3] * a[3]); }
template <int NS> __device__ __forceinline__ float rstd_of(const float* part, int row, float invn) {
    float s = 0.f;
#pragma unroll
    for (int i = 0; i < NS; i += 4) { const f32x4 v = *(const f32x4*)(part + (size_t)row * NS + i); s += (v[0] + v[1]) + (v[2] + v[3]); }
    return 1.0f / sqrtf(s * invn + EPS);
}
template <int NS> __device__ __forceinline__ void ssq_put(float* part, int row, int slot, float s, int fq) { s += __shfl_xor(s, 16); s += __shfl_xor(s, 32); if (fq == 0) part[(size_t)row * NS + slot] = s; }
__device__ __forceinline__ float silu_f(float x) { return x * sigm(x); }
__device__ __forceinline__ int pos_of_row(int row) { return row < MP ? (row & (TSEQ - 1)) : TSEQ; }

struct EpiSwiGLU {
    static constexpr bool PERM = true, AFTER_DRAIN = false, HAS_MID = false; int mid_t;
    bf16_t* O; const float* ssq;
    __device__ __forceinline__ void mid(f32x4 (&)[2][2][4][2], const Unit&, int, int, int, int) const {}
    __device__ __forceinline__ void operator()(const f32x4 (&acc)[2][2][4][2], const Unit& u, int wr, int wc, int fr_, int fq_) const { EPI_OPAQUE;
        const int col0 = u.pn * HALF + wc * 32 + 8 * fq;
#pragma unroll
        for (int ai = 0; ai < 2; ++ai)
#pragma unroll
            for (int m = 0; m < 4; ++m) { const int row = EPI_ROWS(ai, m); const float rs = ssq ? rstd_of<16>(ssq, row, 1.0f / DM) : 1.0f;
                f32x4 o[2];
#pragma unroll
                for (int n = 0; n < 2; ++n)
#pragma unroll
                    for (int j = 0; j < 4; ++j) o[n][j] = silu_f(acc[ai][0][m][n][j] * rs) * (acc[ai][1][m][n][j] * rs);
                *(u32x4*)(O + (size_t)row * DFF + col0) = pack8(o[0], o[1]); }
    }
};

template <bool HALFA, bool XIN> struct EpiResid {
    static constexpr bool PERM = true, AFTER_DRAIN = false, HAS_MID = false; int mid_t; static constexpr float alpha = HALFA ? 0.5f : 1.0f;
    const void* R; bf16_t* Hb; float* ssq;
    __device__ __forceinline__ void mid(f32x4 (&)[2][2][4][2], const Unit&, int, int, int, int) const {}
    __device__ __forceinline__ void operator()(const f32x4 (&acc)[2][2][4][2], const Unit& u, int wr, int wc, int fr_, int fq_) const { EPI_OPAQUE;
        const int colb = u.pn * BM + wc * 32 + 8 * fq;
#pragma unroll
        for (int ai = 0; ai < 2; ++ai)
#pragma unroll
            for (int m = 0; m < 4; ++m) { const int row = EPI_ROWS(ai, m);
                float s = 0.f;
#pragma unroll
                for (int bj = 0; bj < 2; ++bj) { const int col = colb + bj * HALF; f32x4 r0, r1;
                    if (XIN) { const float* rp = (const float*)R + (size_t)row * DM + col; r0 = *(const f32x4*)rp; r1 = *(const f32x4*)(rp + 4); }
                    else { const u32x4 w = *(const u32x4*)((const bf16_t*)R + (size_t)row * DM + col); r0 = (f32x4){bflo(w[0]), bfhi(w[0]), bflo(w[1]), bfhi(w[1])}; r1 = (f32x4){bflo(w[2]), bfhi(w[2]), bflo(w[3]), bfhi(w[3])}; }
                    const f32x4 h0 = r0 + acc[ai][bj][m][0] * alpha, h1 = r1 + acc[ai][bj][m][1] * alpha;
                    *(u32x4*)(Hb + (size_t)row * DM + col) = pack8(h0, h1);
                    s += sq4(h0) + sq4(h1); }
                ssq_put<16>(ssq, row, u.pn * 4 + wc, s, fq); }
    }
};

__device__ __forceinline__ void rope4(const float2* tabrow, int i0, int istride, f32x4 x1, f32x4 x2, f32x4& y1, f32x4& y2) {
#pragma unroll
    for (int j = 0; j < 4; ++j) { const float2 cs = tabrow[(i0 + j) * istride]; y1[j] = x1[j] * cs.x - x2[j] * cs.y; y2[j] = x1[j] * cs.y + x2[j] * cs.x; }
}

struct EpiWin {
    static constexpr bool PERM = true, AFTER_DRAIN = false, HAS_MID = false; int mid_t;
    const float* ssq1; float* ssq_cq; float* ssq_kv; const float2* rope; float* dout;
    bf16_t *CQB, *CKVB, *KPEB, *QR, *KR, *RV, *RGS, *SGA, *SGR; float* CKVF;
    __device__ __forceinline__ void mid(f32x4 (&)[2][2][4][2], const Unit&, int, int, int, int) const {}
    __device__ __forceinline__ void operator()(const f32x4 (&acc)[2][2][4][2], const Unit& u, int wr, int wc, int fr_, int fq_) const { EPI_OPAQUE;
        const int pn = u.pn, c8 = wc * 32 + 8 * fq;
#pragma unroll
        for (int ai = 0; ai < 2; ++ai)
#pragma unroll
            for (int m = 0; m < 4; ++m) { const int row = EPI_ROWS(ai, m); const float rs = rstd_of<16>(ssq1, row, 1.0f / DM);
                if (pn == 0) {
                    float s = 0.f;
#pragma unroll
                    for (int bj = 0; bj < 2; ++bj) { const f32x4 a = acc[ai][bj][m][0] * rs, b = acc[ai][bj][m][1] * rs; s += sq4(a) + sq4(b);
                        *(u32x4*)(CQB + (size_t)row * QL + bj * HALF + c8) = pack8(a, b); }
                    ssq_put<4>(ssq_cq, row, wc, s, fq);
                } else if (pn == 1) {
                    { const f32x4 a = acc[ai][0][m][0] * rs, b = acc[ai][0][m][1] * rs;
                      *(f32x4*)(CKVF + (size_t)row * KVL + c8) = a; *(f32x4*)(CKVF + (size_t)row * KVL + c8 + 4) = b;
                      *(u32x4*)(CKVB + (size_t)row * KVL + c8) = pack8(a, b);
                      ssq_put<4>(ssq_kv, row, wc, sq4(a) + sq4(b), fq); }
                    if (wc == 0) { f32x4 y1, y2; rope4(rope + (size_t)pos_of_row(row) * 64, 4 * fq, 4, acc[ai][1][m][0] * rs, acc[ai][1][m][1] * rs, y1, y2);
                        float* o = row < MP ? dout + O_KPEP + (size_t)row * RPE : (row < MP + MS ? dout + O_KPES + (size_t)(row - MP) * RPE : nullptr);
                        if (o) { *(f32x4*)(o + 4 * fq) = y1; *(f32x4*)(o + 16 + 4 * fq) = y2; }
                        v2u w1, w2; w1.x = cvt_pk_bf16(y1[0], y1[1]); w1.y = cvt_pk_bf16(y1[2], y1[3]); w2.x = cvt_pk_bf16(y2[0], y2[1]); w2.y = cvt_pk_bf16(y2[2], y2[3]);
                        *(v2u*)(KPEB + (size_t)row * RPE + 4 * fq) = w1; *(v2u*)(KPEB + (size_t)row * RPE + 16 + 4 * fq) = w2; }
                } else if (pn < 6) {
                    const bool isk = pn >= 4; const int ic = row < MP ? (row & 127) : 0; const float2* tr = rope + (size_t)pos_of_row(row) * 64;
#pragma unroll
                    for (int bj = 0; bj < 2; ++bj) { const int hh = 2 * (pn - (isk ? 4 : 2)) + bj; const float lg = lg2gamma(hh) * (float)ic;
                        const float fs = rs * (isk ? __builtin_amdgcn_exp2f(-lg) * 0.08838834764831845f : __builtin_amdgcn_exp2f(lg));
                        f32x4 y1, y2; rope4(tr, 16 * wc + 4 * fq, 1, acc[ai][bj][m][0] * fs, acc[ai][bj][m][1] * fs, y1, y2);
                        bf16_t* o = (isk ? KR : QR) + (size_t)row * 512 + hh * 128 + 16 * wc + 4 * fq;
                        v2u w1, w2; w1.x = cvt_pk_bf16(y1[0], y1[1]); w1.y = cvt_pk_bf16(y1[2], y1[3]); w2.x = cvt_pk_bf16(y2[0], y2[1]); w2.y = cvt_pk_bf16(y2[2], y2[3]);
                        *(v2u*)o = w1; *(v2u*)(o + 64) = w2; }
                } else if (pn < 8) {
#pragma unroll
                    for (int bj = 0; bj < 2; ++bj) *(u32x4*)(RV + (size_t)row * 512 + (pn - 6) * BM + bj * HALF + c8) = pack8(acc[ai][bj][m][0] * rs, acc[ai][bj][m][1] * rs);
                } else if (pn < 10) {
#pragma unroll
                    for (int bj = 0; bj < 2; ++bj) { f32x4 a = acc[ai][bj][m][0] * rs, b = acc[ai][bj][m][1] * rs;
#pragma unroll
                        for (int j = 0; j < 4; ++j) { a[j] = silu_f(a[j]); b[j] = silu_f(b[j]); }
                        *(u32x4*)(RGS + (size_t)row * 512 + (pn - 8) * BM + bj * HALF + c8) = pack8(a, b); }
                } else {
                    bf16_t* base = pn < 14 ? SGA + (size_t)(pn - 10) * BM : SGR + (size_t)(pn - 14) * BM;
#pragma unroll
                    for (int bj = 0; bj < 2; ++bj) { f32x4 a = acc[ai][bj][m][0] * rs, b = acc[ai][bj][m][1] * rs;
#pragma unroll
                        for (int j = 0; j < 4; ++j) { a[j] = sigm(a[j]); b[j] = sigm(b[j]); }
                        *(u32x4*)(base + (size_t)row * DM + bj * HALF + c8) = pack8(a, b); }
                }
            }
    }
};

struct EpiQB {
    static constexpr bool PERM = true, AFTER_DRAIN = false, HAS_MID = false; int mid_t;
    const float* ssq_cq; const float2* rope; bf16_t* QB;
    __device__ __forceinline__ void mid(f32x4 (&)[2][2][4][2], const Unit&, int, int, int, int) const {}
    __device__ __forceinline__ void operator()(const f32x4 (&acc)[2][2][4][2], const Unit& u, int wr, int wc, int fr_, int fq_) const { EPI_OPAQUE;
#pragma unroll
        for (int ai = 0; ai < 2; ++ai)
#pragma unroll
            for (int m = 0; m < 4; ++m) { const int row = EPI_ROWS(ai, m); const float rs = rstd_of<4>(ssq_cq, row, 1.0f / QL);
                bf16_t* qrow = QB + (size_t)row * 768;
                if (u.pn < 2) {
#pragma unroll
                    for (int bj = 0; bj < 2; ++bj) { const int cidx = bj * HALF + wc * 32 + 8 * fq, hh = u.pn * 4 + (cidx >> 6), d = cidx & 63;
                        *(u32x4*)(qrow + hh * QKD + d) = pack8(acc[ai][bj][m][0] * rs, acc[ai][bj][m][1] * rs); }
                } else { const float2* tr = rope + (size_t)pos_of_row(row) * 64;
#pragma unroll
                    for (int bj = 0; bj < 2; ++bj) { const int hh = bj * 4 + wc; f32x4 y1, y2; rope4(tr, 4 * fq, 4, acc[ai][bj][m][0] * rs, acc[ai][bj][m][1] * rs, y1, y2);
                        v2u w1, w2; w1.x = cvt_pk_bf16(y1[0], y1[1]); w1.y = cvt_pk_bf16(y1[2], y1[3]); w2.x = cvt_pk_bf16(y2[0], y2[1]); w2.y = cvt_pk_bf16(y2[2], y2[3]);
                        *(v2u*)(qrow + hh * QKD + 64 + 4 * fq) = w1; *(v2u*)(qrow + hh * QKD + 80 + 4 * fq) = w2; }
                }
                asm volatile("" ::: "memory");
            }
    }
};

struct EpiPlain {
    static constexpr bool PERM = true, AFTER_DRAIN = false, HAS_MID = false; int mid_t;
    bf16_t* O0; bf16_t* O1; int ld; int split_tiles; const float* ssq; float invn;
    __device__ __forceinline__ void mid(f32x4 (&)[2][2][4][2], const Unit&, int, int, int, int) const {}
    __device__ __forceinline__ void operator()(const f32x4 (&acc)[2][2][4][2], const Unit& u, int wr, int wc, int fr_, int fq_) const { EPI_OPAQUE;
        bf16_t* base = u.pn < split_tiles ? O0 + (size_t)u.pn * BM : O1 + (size_t)(u.pn - split_tiles) * BM;
#pragma unroll
        for (int ai = 0; ai < 2; ++ai)
#pragma unroll
            for (int m = 0; m < 4; ++m) { const int row = EPI_ROWS(ai, m); const float rs = ssq ? rstd_of<4>(ssq, row, invn) : 1.0f;
#pragma unroll
                for (int bj = 0; bj < 2; ++bj) *(u32x4*)(base + (size_t)row * ld + bj * HALF + wc * 32 + 8 * fq) = pack8(acc[ai][bj][m][0] * rs, acc[ai][bj][m][1] * rs); }
    }
};

struct EpiMerge {
    static constexpr bool PERM = true, AFTER_DRAIN = false, HAS_MID = true; int mid_t;
    const bf16_t* SGA; const bf16_t* SGR; bf16_t* O;
    __device__ __forceinline__ void mid(f32x4 (&acc)[2][2][4][2], const Unit& u, int wr, int wc, int fr_, int fq) const {
        int fr = fr_; asm volatile("" : "+v"(fr));
#pragma unroll
        for (int ai = 0; ai < 2; ++ai) { u32x4 ga[4][2], gr[4][2];
#pragma unroll
            for (int m = 0; m < 4; ++m) { const int row = EPI_ROWS(ai, m);
#pragma unroll
                for (int bj = 0; bj < 2; ++bj) { const size_t off = (size_t)row * DM + u.pn * BM + bj * HALF + wc * 32 + 8 * fq; ga[m][bj] = *(const u32x4*)(SGA + off); gr[m][bj] = *(const u32x4*)(SGR + off); } }
#pragma unroll
            for (int m = 0; m < 4; ++m)
#pragma unroll
                for (int bj = 0; bj < 2; ++bj)
#pragma unroll
                    for (int q = 0; q < 4; ++q) { const float alo = bflo(ga[m][bj][q]), ahi = bfhi(ga[m][bj][q]), rlo = fmaxf(bflo(gr[m][bj][q]), 1e-30f), rhi = fmaxf(bfhi(gr[m][bj][q]), 1e-30f);
                        acc[ai][bj][m][q >> 1][(q & 1) * 2] *= alo * __builtin_amdgcn_rcpf(rlo); acc[ai][bj][m][q >> 1][(q & 1) * 2 + 1] *= ahi * __builtin_amdgcn_rcpf(rhi); }
            asm volatile("" ::: "memory"); }
    }
    __device__ __forceinline__ void operator()(const f32x4 (&acc)[2][2][4][2], const Unit& u, int wr, int wc, int fr_, int fq_) const { EPI_OPAQUE;
#pragma unroll
        for (int ai = 0; ai < 2; ++ai)
#pragma unroll
            for (int m = 0; m < 4; ++m) { const int row = EPI_ROWS(ai, m);
#pragma unroll
                for (int bj = 0; bj < 2; ++bj) { const size_t off = (size_t)row * DM + u.pn * BM + bj * HALF + wc * 32 + 8 * fq;
                    const u32x4 r = *(const u32x4*)(SGR + off); f32x4 o0, o1;
                    o0[0] = acc[ai][bj][m][0][0] * fmaxf(bflo(r[0]), 1e-30f); o0[1] = acc[ai][bj][m][0][1] * fmaxf(bfhi(r[0]), 1e-30f);
                    o0[2] = acc[ai][bj][m][0][2] * fmaxf(bflo(r[1]), 1e-30f); o0[3] = acc[ai][bj][m][0][3] * fmaxf(bfhi(r[1]), 1e-30f);
                    o1[0] = acc[ai][bj][m][1][0] * fmaxf(bflo(r[2]), 1e-30f); o1[1] = acc[ai][bj][m][1][1] * fmaxf(bfhi(r[2]), 1e-30f);
                    o1[2] = acc[ai][bj][m][1][2] * fmaxf(bflo(r[3]), 1e-30f); o1[3] = acc[ai][bj][m][1][3] * fmaxf(bfhi(r[3]), 1e-30f);
                    *(u32x4*)(O + off) = pack8(o0, o1); } }
    }
};

struct EpiPle {
    static constexpr bool PERM = true, AFTER_DRAIN = false, HAS_MID = false; int mid_t;
    const bf16_t* H3; const bf16_t* PP; const float* ssq3; bf16_t* H4; float* ssq4;
    __device__ __forceinline__ void mid(f32x4 (&)[2][2][4][2], const Unit&, int, int, int, int) const {}
    __device__ __forceinline__ void operator()(const f32x4 (&acc)[2][2][4][2], const Unit& u, int wr, int wc, int fr_, int fq_) const { EPI_OPAQUE;
#pragma unroll
        for (int ai = 0; ai < 2; ++ai)
#pragma unroll
            for (int m = 0; m < 4; ++m) { const int row = EPI_ROWS(ai, m); const float rs = rstd_of<16>(ssq3, row, 1.0f / DM); float s = 0.f;
#pragma unroll
                for (int bj = 0; bj < 2; ++bj) { const size_t off = (size_t)row * DM + u.pn * BM + bj * HALF + wc * 32 + 8 * fq;
                    const u32x4 p = *(const u32x4*)(PP + off), r = *(const u32x4*)(H3 + off);
                    f32x4 h0, h1;
                    h0[0] = bflo(r[0]) + sigm(acc[ai][bj][m][0][0] * rs) * bflo(p[0]); h0[1] = bfhi(r[0]) + sigm(acc[ai][bj][m][0][1] * rs) * bfhi(p[0]);
                    h0[2] = bflo(r[1]) + sigm(acc[ai][bj][m][0][2] * rs) * bflo(p[1]); h0[3] = bfhi(r[1]) + sigm(acc[ai][bj][m][0][3] * rs) * bfhi(p[1]);
                    h1[0] = bflo(r[2]) + sigm(acc[ai][bj][m][1][0] * rs) * bflo(p[2]); h1[1] = bfhi(r[2]) + sigm(acc[ai][bj][m][1][1] * rs) * bfhi(p[2]);
                    h1[2] = bflo(r[3]) + sigm(acc[ai][bj][m][1][2] * rs) * bflo(p[3]); h1[3] = bfhi(r[3]) + sigm(acc[ai][bj][m][1][3] * rs) * bfhi(p[3]);
                    *(u32x4*)(H4 + off) = pack8(h0, h1); s += sq4(h0) + sq4(h1); }
                ssq_put<16>(ssq4, row, u.pn * 4 + wc, s, fq); }
    }
};
#undef EPI_ROWS
#undef EPI_OPAQUE
}
namespace att {
using bf16x8 = __attribute__((ext_vector_type(8))) short;
using s16x4 = __attribute__((ext_vector_type(4))) short;
using f32x16 = __attribute__((ext_vector_type(16))) float;
using u32x4 = __attribute__((ext_vector_type(4))) unsigned;
typedef __attribute__((address_space(3))) const char* lds_cptr;
typedef __attribute__((address_space(3))) char* lds_ptr;
constexpr int KSLOT = 12288, VSLOT = 8192;
constexpr int L_K = 0, L_V = 3 * KSLOT, L_WS = L_V + 3 * VSLOT, L_OST = L_WS + 8 * 256, L_END = L_OST + 8 * 4096;
static_assert(L_END <= RING_BYTES, "attention LDS");
__device__ __forceinline__ int crow(int r, int hi) { return (r & 3) + 8 * (r >> 2) + 4 * hi; }
__device__ __forceinline__ void glds16(const void* gsrc, unsigned lds_dst) { unsigned keep;
    asm volatile("s_mov_b32 %0, m0\n\ts_mov_b32 m0, %2\n\ts_nop 0\n\tglobal_load_lds_dwordx4 %1, off\n\ts_mov_b32 m0, %0" : "=&s"(keep) : "v"(gsrc), "s"(lds_dst) : "memory"); }
typedef float f32x2_t __attribute__((ext_vector_type(2))); typedef __bf16 bf16x2_t __attribute__((ext_vector_type(2)));
__device__ __forceinline__ unsigned cvtpk_s(float lo, float hi) { f32x2_t v = {lo, hi}; bf16x2_t b = __builtin_convertvector(v, bf16x2_t); return __builtin_bit_cast(unsigned, b); }
__device__ __forceinline__ float swap32_max(float m) { auto rr = __builtin_amdgcn_permlane32_swap(__float_as_uint(m), __float_as_uint(m), false, false); return fmaxf(__uint_as_float(rr[0]), __uint_as_float(rr[1])); }
__device__ __forceinline__ float swap32_sum(float m) { auto rr = __builtin_amdgcn_permlane32_swap(__float_as_uint(m), __float_as_uint(m), false, false); return __uint_as_float(rr[0]) + __uint_as_float(rr[1]); }

__device__ __forceinline__ void pv(f32x16* o, int vb, bf16x8 pa0, bf16x8 pa1, bf16x8 pa2, bf16x8 pa3) {
#pragma unroll
    for (int d0 = 0; d0 < 2; ++d0) { s16x4 lo[4], hi[4];
#pragma unroll
        for (int ks = 0; ks < 4; ++ks) {
            asm volatile("ds_read_b64_tr_b16 %0,%1 offset:%c2" : "=&v"(lo[ks]) : "v"(vb), "i"(d0 * 4096 + ks * 1024) : "memory");
            asm volatile("ds_read_b64_tr_b16 %0,%1 offset:%c2" : "=&v"(hi[ks]) : "v"(vb), "i"(d0 * 4096 + ks * 1024 + 512) : "memory"); }
        asm volatile("s_waitcnt lgkmcnt(0)" ::: "memory"); __builtin_amdgcn_sched_barrier(0);
#define PK(k) (bf16x8){lo[k][0], lo[k][1], lo[k][2], lo[k][3], hi[k][0], hi[k][1], hi[k][2], hi[k][3]}
        o[d0] = __builtin_amdgcn_mfma_f32_32x32x16_bf16(pa0, PK(0), o[d0], 0, 0, 0);
        o[d0] = __builtin_amdgcn_mfma_f32_32x32x16_bf16(pa1, PK(1), o[d0], 0, 0, 0);
        o[d0] = __builtin_amdgcn_mfma_f32_32x32x16_bf16(pa2, PK(2), o[d0], 0, 0, 0);
        o[d0] = __builtin_amdgcn_mfma_f32_32x32x16_bf16(pa3, PK(3), o[d0], 0, 0, 0);
#undef PK
    }
}

__device__ __forceinline__ void k_load(bf16x8 (&kf)[12], lds_cptr kp) {
#pragma unroll
    for (int d0 = 0; d0 < 6; ++d0) { kf[2 * d0] = *(const __attribute__((address_space(3))) bf16x8*)(kp + d0 * 2048); kf[2 * d0 + 1] = *(const __attribute__((address_space(3))) bf16x8*)(kp + d0 * 2048 + 512); }
}
__device__ __forceinline__ void qk_mma(f32x16& p0, f32x16& p1, const bf16x8 (&kf)[12], const bf16x8 (&qr)[6]) {
    p0 = f32x16{}; p1 = f32x16{};
#pragma unroll
    for (int d0 = 0; d0 < 6; ++d0) { p0 = __builtin_amdgcn_mfma_f32_32x32x16_bf16(kf[2 * d0], qr[d0], p0, 0, 0, 0); p1 = __builtin_amdgcn_mfma_f32_32x32x16_bf16(kf[2 * d0 + 1], qr[d0], p1, 0, 0, 0); }
}
__device__ __forceinline__ void v_load(s16x4 (&lo)[8], s16x4 (&hi)[8], int vb) {
#pragma unroll
    for (int i = 0; i < 8; ++i) {
        asm volatile("ds_read_b64_tr_b16 %0,%1 offset:%c2" : "=&v"(lo[i]) : "v"(vb), "i"((i >> 2) * 4096 + (i & 3) * 1024) : "memory");
        asm volatile("ds_read_b64_tr_b16 %0,%1 offset:%c2" : "=&v"(hi[i]) : "v"(vb), "i"((i >> 2) * 4096 + (i & 3) * 1024 + 512) : "memory"); }
}
__device__ __forceinline__ void pv_mma(f32x16* o, const s16x4 (&lo)[8], const s16x4 (&hi)[8], bf16x8 pa0, bf16x8 pa1, bf16x8 pa2, bf16x8 pa3) {
#define PK(k) (bf16x8){lo[k][0], lo[k][1], lo[k][2], lo[k][3], hi[k][0], hi[k][1], hi[k][2], hi[k][3]}
    o[0] = __builtin_amdgcn_mfma_f32_32x32x16_bf16(pa0, PK(0), o[0], 0, 0, 0); o[1] = __builtin_amdgcn_mfma_f32_32x32x16_bf16(pa0, PK(4), o[1], 0, 0, 0);
    o[0] = __builtin_amdgcn_mfma_f32_32x32x16_bf16(pa1, PK(1), o[0], 0, 0, 0); o[1] = __builtin_amdgcn_mfma_f32_32x32x16_bf16(pa1, PK(5), o[1], 0, 0, 0);
    o[0] = __builtin_amdgcn_mfma_f32_32x32x16_bf16(pa2, PK(2), o[0], 0, 0, 0); o[1] = __builtin_amdgcn_mfma_f32_32x32x16_bf16(pa2, PK(6), o[1], 0, 0, 0);
    o[0] = __builtin_amdgcn_mfma_f32_32x32x16_bf16(pa3, PK(3), o[0], 0, 0, 0); o[1] = __builtin_amdgcn_mfma_f32_32x32x16_bf16(pa3, PK(7), o[1], 0, 0, 0);
#undef PK
}
__device__ __forceinline__ void qk_tile(f32x16& p0, f32x16& p1, lds_cptr kp, const bf16x8 (&qr)[6]) {
    p0 = f32x16{}; p1 = f32x16{};
#pragma unroll
    for (int d0 = 0; d0 < 6; ++d0) {
        const bf16x8 k0 = *(const __attribute__((address_space(3))) bf16x8*)(kp + d0 * 2048);
        const bf16x8 k1 = *(const __attribute__((address_space(3))) bf16x8*)(kp + d0 * 2048 + 512);
        p0 = __builtin_amdgcn_mfma_f32_32x32x16_bf16(k0, qr[d0], p0, 0, 0, 0);
        p1 = __builtin_amdgcn_mfma_f32_32x32x16_bf16(k1, qr[d0], p1, 0, 0, 0); }
}
__device__ __forceinline__ float max3f(float a, float b, float c) { return __builtin_fmaxf(__builtin_fmaxf(a, b), c); }
__device__ __forceinline__ void softmax_a(f32x16& p0, f32x16& p1, int jb, int qrel, int hi, int r32, float& m_run, float& l_run, f32x16 (&o)[2], LAS float* wsf) {
    if (jb >= 0) { const int kb = 64 * jb + 4 * hi;
#pragma unroll
        for (int r = 0; r < 16; ++r) { const int kv = kb + (r & 3) + 8 * (r >> 2); if (kv > qrel) p0[r] = -INFINITY; if (kv + 32 > qrel) p1[r] = -INFINITY; } }
    float a = max3f(p0[0], p0[1], p1[0]), b = max3f(p0[2], p0[3], p1[1]); a = max3f(a, p1[2], p1[3]);
#pragma unroll
    for (int r = 4; r < 16; r += 4) { a = max3f(a, p0[r], p0[r + 1]); b = max3f(b, p0[r + 2], p0[r + 3]); a = max3f(a, p1[r], p1[r + 1]); b = max3f(b, p1[r + 2], p1[r + 3]); }
    const float rm = swap32_max(fmaxf(a, b));
    const float mnew = (rm > m_run + 8.0f) ? rm : m_run;
    if (__any(mnew > m_run)) {
        const float alpha = __builtin_amdgcn_exp2f(m_run - mnew);
        l_run *= alpha; m_run = mnew;
        if (hi == 0) wsf[r32] = alpha;
        asm volatile("s_waitcnt lgkmcnt(0)" ::: "memory");
        f32x16 av;
#pragma unroll
        for (int r = 0; r < 16; ++r) av[r] = wsf[crow(r, hi)];
        o[0] *= av; o[1] *= av;
    }
}
__device__ __forceinline__ void softmax_b(f32x16& p0, f32x16& p1, float m_run, float& l_run, u32x4& pw0, u32x4& pw1, u32x4& pw2, u32x4& pw3) {
    p0 = p0 - m_run; p1 = p1 - m_run;
#pragma unroll
    for (int r = 0; r < 16; ++r) { p0[r] = __builtin_amdgcn_exp2f(p0[r]); p1[r] = __builtin_amdgcn_exp2f(p1[r]); }
    const f32x16 ps = p0 + p1;
    typedef float f32x8_t __attribute__((ext_vector_type(8))); typedef float f32x4_t __attribute__((ext_vector_type(4))); typedef float f32x2_t2 __attribute__((ext_vector_type(2)));
    const f32x8_t s8 = __builtin_shufflevector(ps, ps, 0, 1, 2, 3, 4, 5, 6, 7) + __builtin_shufflevector(ps, ps, 8, 9, 10, 11, 12, 13, 14, 15);
    const f32x4_t s4 = __builtin_shufflevector(s8, s8, 0, 1, 2, 3) + __builtin_shufflevector(s8, s8, 4, 5, 6, 7);
    const f32x2_t2 s2 = __builtin_shufflevector(s4, s4, 0, 1) + __builtin_shufflevector(s4, s4, 2, 3);
    l_run += s2[0] + s2[1];
#define PKW(P, B) cvtpk_s(P[B], P[B + 1])
    pw0 = (u32x4){PKW(p0, 0), PKW(p0, 2), PKW(p0, 4), PKW(p0, 6)}; pw1 = (u32x4){PKW(p0, 8), PKW(p0, 10), PKW(p0, 12), PKW(p0, 14)};
    pw2 = (u32x4){PKW(p1, 0), PKW(p1, 2), PKW(p1, 4), PKW(p1, 6)}; pw3 = (u32x4){PKW(p1, 8), PKW(p1, 10), PKW(p1, 12), PKW(p1, 14)};
#undef PKW
}
__device__ __forceinline__ void attn_unit(int b, int h, int qb, const bf16* Q, const bf16* KN, const bf16* KPE, const bf16* VB, bf16* O, char* shm) {
    int tid_ = threadIdx.x; asm volatile("" : "+v"(tid_)); const int tid = tid_, lane = tid & 63, r32 = lane & 31, hi = lane >> 5; const int wid = __builtin_amdgcn_readfirstlane(tid >> 6);
    const long rowbase = (long)b * TSEQ; const int q0 = qb * 256;
    const bf16* Qw = Q + (rowbase + q0 + wid * 32) * 768 + h * QKD;
    const unsigned lds0 = (unsigned)(uintptr_t)shm;
    const lds_ptr shm3 = (lds_ptr)shm;
    LAS float* wsf = (LAS float*)(shm3 + L_WS) + wid * 64;
    const bf16* ksrc0 = KN + (rowbase + lane) * 512 + h * 64 + wid * 8;
    const bf16* ksrc1 = KPE + (rowbase + lane) * RPE + (wid & 3) * 8;
    const bf16* vsrc = VB + (rowbase + 16 * (wid & 3) + (lane >> 2)) * 512 + h * 64 + (wid >> 2) * 32 + (lane & 3) * 8;
    const unsigned kdst0 = lds0 + L_K + wid * 1024, kdst1 = lds0 + L_K + (8 + (wid & 3)) * 1024, vdst = lds0 + L_V + wid * 1024;
#define ATT_DMAK(t, s) do { glds16(ksrc0 + (long)(t) * 64 * 512, (unsigned)__builtin_amdgcn_readfirstlane(kdst0 + (s) * KSLOT)); \
                            glds16(ksrc1 + (long)(t) * 64 * RPE, (unsigned)__builtin_amdgcn_readfirstlane(kdst1 + (s) * KSLOT)); } while (0)
#define ATT_DMAV(t, s) glds16(vsrc + (long)(t) * 64 * 512, (unsigned)__builtin_amdgcn_readfirstlane(vdst + (s) * VSLOT))
    const int vb0 = (int)(lds0 + L_V) + ((lane >> 4) & 1) * 32 + (lane & 3) * 8 + (4 * hi + ((lane & 15) >> 2)) * 64;
    const lds_cptr kp0 = (lds_cptr)shm3 + L_K + hi * 1024 + r32 * 16;
    const int NT = (q0 + 256) / 64;
    ATT_DMAK(0, 0); ATT_DMAV(0, 0); ATT_DMAK(1, 1); ATT_DMAV(1, 1); ATT_DMAK(2, 2);
    bf16x8 qr[6];
#pragma unroll
    for (int d0 = 0; d0 < 6; ++d0) qr[d0] = *reinterpret_cast<const bf16x8*>(&Qw[(long)r32 * 768 + d0 * 16 + hi * 8]);
    float m_run = -INFINITY, l_run = 0.f; f32x16 o[2]; o[0] = f32x16{}; o[1] = f32x16{};
    const int qrel = wid * 32 + r32;
    asm volatile("s_waitcnt vmcnt(0) lgkmcnt(0)\n\ts_barrier" ::: "memory");
    f32x16 sA0, sA1, sB0, sB1;
    qk_tile(sA0, sA1, kp0, qr);
    int t = 0, s0 = 0, s1 = 1, s2 = 2;
    for (; t + 1 < NT - 4; ++t) {
        asm volatile("s_waitcnt vmcnt(3) lgkmcnt(0)\n\ts_barrier" ::: "memory");
        ATT_DMAK(t + 3, s0); ATT_DMAV(t + 2, s2);
        bf16x8 kf[12]; s16x4 vlo[8], vhi[8];
        k_load(kf, kp0 + s1 * KSLOT); v_load(vlo, vhi, vb0 + s0 * VSLOT);
        softmax_a(sA0, sA1, -1, qrel, hi, r32, m_run, l_run, o, wsf);
        asm volatile("s_waitcnt lgkmcnt(0)" ::: "memory"); __builtin_amdgcn_sched_barrier(0);
        u32x4 pw0, pw1, pw2, pw3;
        qk_mma(sB0, sB1, kf, qr);
        softmax_b(sA0, sA1, m_run, l_run, pw0, pw1, pw2, pw3);
#pragma unroll
        for (int i = 0; i < 12; ++i) { __builtin_amdgcn_sched_group_barrier(0x008, 1, 0); __builtin_amdgcn_sched_group_barrier(0x002, 10, 0); }
        pv_mma(o, vlo, vhi, __builtin_bit_cast(bf16x8, pw0), __builtin_bit_cast(bf16x8, pw1), __builtin_bit_cast(bf16x8, pw2), __builtin_bit_cast(bf16x8, pw3));
        sA0 = sB0; sA1 = sB1;
        { const int r_ = s0; s0 = s1; s1 = s2; s2 = r_; }
    }
    for (; t < NT; ++t) {
        asm volatile("s_waitcnt vmcnt(0) lgkmcnt(0)\n\ts_barrier" ::: "memory");
        if (t + 3 < NT) ATT_DMAK(t + 3, s0);
        if (t + 2 < NT) ATT_DMAV(t + 2, s2);
        const int jb = t - (NT - 4), jbn = jb + 1;
        const bool pn = (t + 1 < NT) && (jbn < 0 || 2 * jbn <= wid);
        if (pn) qk_tile(sB0, sB1, kp0 + s1 * KSLOT, qr);
        if (jb < 0 || 2 * jb <= wid) { softmax_a(sA0, sA1, jb, qrel, hi, r32, m_run, l_run, o, wsf); u32x4 pw0, pw1, pw2, pw3; softmax_b(sA0, sA1, m_run, l_run, pw0, pw1, pw2, pw3);
            pv(o, vb0 + s0 * VSLOT, __builtin_bit_cast(bf16x8, pw0), __builtin_bit_cast(bf16x8, pw1), __builtin_bit_cast(bf16x8, pw2), __builtin_bit_cast(bf16x8, pw3)); }
        sA0 = sB0; sA1 = sB1;
        { const int r_ = s0; s0 = s1; s1 = s2; s2 = r_; }
    }
    l_run = swap32_sum(l_run);
    if (hi == 0) wsf[32 + r32] = l_run;
    asm volatile("s_waitcnt lgkmcnt(0)" ::: "memory");
    float rli[16];
#pragma unroll
    for (int r = 0; r < 16; ++r) rli[r] = 1.0f / wsf[32 + crow(r, hi)];
    bf16* Ow = O + (rowbase + q0 + wid * 32) * DM + h * 64;
    { LAS bf16* stg = (LAS bf16*)(shm3 + L_OST) + wid * 2048;
#pragma unroll
      for (int r = 0; r < 16; ++r) { const int orow = crow(r, hi);
#pragma unroll
          for (int d0 = 0; d0 < 2; ++d0) stg[orow * 64 + d0 * 32 + r32] = (bf16)f2bf(o[d0][r] * rli[r]); }
      asm volatile("s_waitcnt lgkmcnt(0)" ::: "memory");
#pragma unroll
      for (int i = 0; i < 4; ++i) { const int row = i * 8 + (lane >> 3), ch = lane & 7; const u32x4 v = *(const LAS u32x4*)(stg + row * 64 + ch * 8); *(u32x4*)(Ow + (long)row * DM + ch * 8) = v; } }
    asm volatile("s_waitcnt vmcnt(0) lgkmcnt(0)\n\ts_barrier" ::: "memory");
#undef ATT_DMAK
#undef ATT_DMAV
}
__device__ __forceinline__ void bar4(volatile LAS unsigned* cnt, unsigned& gen, int lane) {
    gen += 4u;
    if (lane == 0) { unsigned seen = __hip_atomic_fetch_add((LAS unsigned*)cnt, 1u, __ATOMIC_RELAXED, __HIP_MEMORY_SCOPE_WORKGROUP) + 1u;
        while (seen < gen) seen = __hip_atomic_load((LAS unsigned*)cnt, __ATOMIC_RELAXED, __HIP_MEMORY_SCOPE_WORKGROUP); }
    asm volatile("" ::: "memory");
}
__device__ __forceinline__ void bar4_arrive(volatile LAS unsigned* cnt, unsigned& gen, int lane) {
    gen += 4u;
    if (lane == 0) __hip_atomic_fetch_add((LAS unsigned*)cnt, 1u, __ATOMIC_RELAXED, __HIP_MEMORY_SCOPE_WORKGROUP);
    asm volatile("" ::: "memory");
}
__device__ __forceinline__ void bar4_wait(volatile LAS unsigned* cnt, unsigned gen, int lane) {
    if (lane == 0) { while (__hip_atomic_load((LAS unsigned*)cnt, __ATOMIC_RELAXED, __HIP_MEMORY_SCOPE_WORKGROUP) < gen) {} }
    asm volatile("" ::: "memory");
}
constexpr int H_K = 0, H_V = 3 * KSLOT, H_WS = H_V + 3 * VSLOT, H_OST = H_WS + 4 * 256, H_END = H_OST + 4 * 4096;
__device__ __forceinline__ void attn_half_unit(int b, int h, int qb, const bf16* Q, const bf16* KN, const bf16* KPE, const bf16* VB, bf16* O, char* shm, volatile LAS unsigned* cnt, unsigned& gen) {
    int tid_ = threadIdx.x; asm volatile("" : "+v"(tid_)); const int tid = tid_, lane = tid & 63, r32 = lane & 31, hi = lane >> 5; const int wid = __builtin_amdgcn_readfirstlane(tid >> 6) & 3;
    const long rowbase = (long)b * TSEQ; const int q0 = qb * 128;
    const bf16* Qw = Q + (rowbase + q0 + wid * 32) * 768 + h * QKD;
    const unsigned lds0 = (unsigned)(uintptr_t)shm;
    const lds_ptr shm3 = (lds_ptr)shm;
    LAS float* wsf = (LAS float*)(shm3 + H_WS) + wid * 64;
    const bf16* ksrcA = KN + (rowbase + lane) * 512 + h * 64 + wid * 8;
    const bf16* ksrcC = KPE + (rowbase + lane) * RPE + wid * 8;
    const bf16* vsrc = VB + (rowbase + 16 * wid + (lane >> 2)) * 512 + h * 64 + (lane & 3) * 8;
    const unsigned kdst = lds0 + H_K + wid * 1024, vdst = lds0 + H_V + wid * 1024;
#define HDMA(t, s) do { glds16(ksrcA + (long)(t) * 64 * 512, (unsigned)__builtin_amdgcn_readfirstlane(kdst + (s) * KSLOT)); \
                        glds16(ksrcA + (long)(t) * 64 * 512 + 32, (unsigned)__builtin_amdgcn_readfirstlane(kdst + (s) * KSLOT + 4096)); \
                        glds16(ksrcC + (long)(t) * 64 * RPE, (unsigned)__builtin_amdgcn_readfirstlane(kdst + (s) * KSLOT + 8192)); } while (0)
#define HDMAV(t, s) do { glds16(vsrc + (long)(t) * 64 * 512, (unsigned)__builtin_amdgcn_readfirstlane(vdst + (s) * VSLOT)); \
                         glds16(vsrc + (long)(t) * 64 * 512 + 32, (unsigned)__builtin_amdgcn_readfirstlane(vdst + (s) * VSLOT + 4096)); } while (0)
    const int vb0 = (int)(lds0 + H_V) + ((lane >> 4) & 1) * 32 + (lane & 3) * 8 + (4 * hi + ((lane & 15) >> 2)) * 64;
    const lds_cptr kp0 = (lds_cptr)shm3 + H_K + hi * 1024 + r32 * 16;
    const int NT = (q0 + 128) / 64;
    HDMA(0, 0); HDMAV(0, 0); HDMA(1, 1); HDMAV(1, 1); if (NT > 2) HDMA(2, 2);
    bf16x8 qr[6];
#pragma unroll
    for (int d0 = 0; d0 < 6; ++d0) qr[d0] = *reinterpret_cast<const bf16x8*>(&Qw[(long)r32 * 768 + d0 * 16 + hi * 8]);
    float m_run = -INFINITY, l_run = 0.f; f32x16 o[2]; o[0] = f32x16{}; o[1] = f32x16{};
    const int qrel = wid * 32 + r32;
    asm volatile("s_waitcnt vmcnt(0) lgkmcnt(0)" ::: "memory"); bar4(cnt, gen, lane);
    f32x16 sA0, sA1, sB0, sB1;
    qk_tile(sA0, sA1, kp0, qr);
    int t = 0, s0 = 0, s1 = 1, s2 = 2;
    for (; t + 1 < NT - 2; ++t) {
        asm volatile("s_waitcnt vmcnt(5) lgkmcnt(0)" ::: "memory"); bar4(cnt, gen, lane);
        HDMA(t + 3, s0); HDMAV(t + 2, s2);
        bf16x8 kf[12]; s16x4 vlo[8], vhi[8];
        k_load(kf, kp0 + s1 * KSLOT); v_load(vlo, vhi, vb0 + s0 * VSLOT);
        softmax_a(sA0, sA1, -1, qrel, hi, r32, m_run, l_run, o, wsf);
        asm volatile("s_waitcnt lgkmcnt(0)" ::: "memory"); __builtin_amdgcn_sched_barrier(0);
        u32x4 pw0, pw1, pw2, pw3;
        qk_mma(sB0, sB1, kf, qr);
        softmax_b(sA0, sA1, m_run, l_run, pw0, pw1, pw2, pw3);
#pragma unroll
        for (int i = 0; i < 12; ++i) { __builtin_amdgcn_sched_group_barrier(0x008, 1, 0); __builtin_amdgcn_sched_group_barrier(0x002, 10, 0); }
        pv_mma(o, vlo, vhi, __builtin_bit_cast(bf16x8, pw0), __builtin_bit_cast(bf16x8, pw1), __builtin_bit_cast(bf16x8, pw2), __builtin_bit_cast(bf16x8, pw3));
        sA0 = sB0; sA1 = sB1;
        { const int r_ = s0; s0 = s1; s1 = s2; s2 = r_; }
    }
    for (; t < NT; ++t) {
        asm volatile("s_waitcnt vmcnt(0) lgkmcnt(0)" ::: "memory"); bar4(cnt, gen, lane);
        if (t + 3 < NT) HDMA(t + 3, s0);
        if (t + 2 < NT) HDMAV(t + 2, s2);
        const int jb = t - (NT - 2), jbn = jb + 1;
        const bool pn = (t + 1 < NT) && (jbn < 0 || 2 * jbn <= wid);
        if (pn) qk_tile(sB0, sB1, kp0 + s1 * KSLOT, qr);
        if (jb < 0 || 2 * jb <= wid) { softmax_a(sA0, sA1, jb, qrel, hi, r32, m_run, l_run, o, wsf); u32x4 pw0, pw1, pw2, pw3; softmax_b(sA0, sA1, m_run, l_run, pw0, pw1, pw2, pw3);
            pv(o, vb0 + s0 * VSLOT, __builtin_bit_cast(bf16x8, pw0), __builtin_bit_cast(bf16x8, pw1), __builtin_bit_cast(bf16x8, pw2), __builtin_bit_cast(bf16x8, pw3)); }
        sA0 = sB0; sA1 = sB1;
        { const int r_ = s0; s0 = s1; s1 = s2; s2 = r_; }
    }
    l_run = swap32_sum(l_run);
    if (hi == 0) wsf[32 + r32] = l_run;
    asm volatile("s_waitcnt lgkmcnt(0)" ::: "memory");
    float rli[16];
#pragma unroll
    for (int r = 0; r < 16; ++r) rli[r] = 1.0f / wsf[32 + crow(r, hi)];
    bf16* Ow = O + (rowbase + q0 + wid * 32) * DM + h * 64;
    { LAS bf16* stg = (LAS bf16*)(shm3 + H_OST) + wid * 2048;
#pragma unroll
      for (int r = 0; r < 16; ++r) { const int orow = crow(r, hi);
#pragma unroll
          for (int d0 = 0; d0 < 2; ++d0) stg[orow * 64 + d0 * 32 + r32] = (bf16)f2bf(o[d0][r] * rli[r]); }
      asm volatile("s_waitcnt lgkmcnt(0)" ::: "memory");
#pragma unroll
      for (int i = 0; i < 4; ++i) { const int row = i * 8 + (lane >> 3), ch = lane & 7; const u32x4 v = *(const LAS u32x4*)(stg + row * 64 + ch * 8); *(u32x4*)(Ow + (long)row * DM + ch * 8) = v; } }
    asm volatile("s_waitcnt vmcnt(0) lgkmcnt(0)" ::: "memory"); bar4(cnt, gen, lane);
#undef HDMA
#undef HDMAV
}
}
namespace ret {
using bf16x8 = __attribute__((ext_vector_type(8))) short;
using s16x4 = __attribute__((ext_vector_type(4))) short;
using f32x16 = __attribute__((ext_vector_type(16))) float;
typedef short v4i16_t __attribute__((ext_vector_type(4)));
constexpr int TPB = 288, TB = 128 * TPB;
constexpr int OTP = 132;
static_assert(3 * TB <= RING_BYTES && 128 * OTP * 4 <= 2 * TB, "retention LDS");
__device__ __forceinline__ int crow(int r, int hi) { return (r & 3) + 8 * (r >> 2) + 4 * hi; }
__device__ __forceinline__ void stage_tile(LAS unsigned char* tile, const bf16* src, int pitch, int tid) {
#pragma unroll
    for (int i = 0; i < 4; ++i) { const int idx = tid + 512 * i, row = idx >> 4, ch = idx & 15;
        *(LAS v4u*)(tile + row * TPB + ch * 16) = *(const v4u*)(src + (size_t)row * pitch + ch * 8); }
}
__device__ __forceinline__ bf16x8 rowfrag(const LAS unsigned char* tile, int row0, int k0, int r32, int hi) { return *(const LAS bf16x8*)(tile + (row0 + r32) * TPB + (k0 + 8 * hi) * 2); }
__device__ __forceinline__ bf16x8 trfrag(const LAS unsigned char* tile, int k0, int c0, int lane) {
    const int h = lane >> 5, blk = (lane >> 4) & 1, q = (lane & 15) >> 2, p = lane & 3;
    const LAS unsigned char* a = tile + (k0 + 8 * h + q) * TPB + (c0 + 16 * blk + 4 * p) * 2;
    const s16x4 lo = __builtin_bit_cast(s16x4, __builtin_amdgcn_ds_read_tr16_b64_v4i16((LAS v4i16_t*)a));
    const s16x4 hi4 = __builtin_bit_cast(s16x4, __builtin_amdgcn_ds_read_tr16_b64_v4i16((LAS v4i16_t*)(a + 4 * TPB)));
    return (bf16x8){lo[0], lo[1], lo[2], lo[3], hi4[0], hi4[1], hi4[2], hi4[3]};
}

__device__ __forceinline__ void kv_unit(int u, const bf16* KR, const bf16* RV, float* KVC, LAS unsigned char* lds) {
    int tid_ = threadIdx.x; asm volatile("" : "+v"(tid_)); const int tid = tid_, lane = tid & 63, r32 = lane & 31, hi = lane >> 5, wid = __builtin_amdgcn_readfirstlane(tid >> 6), wi = wid >> 1, wj = wid & 1;
    const int bh = u >> 6, c = u & 63, b = bh >> 2, h = bh & 3; const size_t row0 = (size_t)b * TSEQ + c * 128;
    LAS unsigned char* T0 = lds; LAS unsigned char* T1 = lds + TB;
    stage_tile(T0, KR + row0 * 512 + h * 128, 512, tid); stage_tile(T1, RV + row0 * 512 + h * 128, 512, tid);
    __syncthreads();
    f32x16 acc[2]; acc[0] = f32x16{}; acc[1] = f32x16{};
#pragma unroll
    for (int ks = 0; ks < 8; ++ks) { const bf16x8 A = trfrag(T0, 16 * ks, 32 * wi, lane);
#pragma unroll
        for (int n = 0; n < 2; ++n) acc[n] = __builtin_amdgcn_mfma_f32_32x32x16_bf16(A, trfrag(T1, 16 * ks, 64 * wj + 32 * n, lane), acc[n], 0, 0, 0); }
    const float g127 = __builtin_amdgcn_exp2f(127.0f * lg2gamma(h));
    float* out = KVC + (size_t)u * 16384;
#pragma unroll
    for (int n = 0; n < 2; ++n)
#pragma unroll
        for (int r = 0; r < 16; ++r) out[(32 * wi + crow(r, hi)) * 128 + 64 * wj + 32 * n + r32] = acc[n][r] * g127;
    __syncthreads();
}

__device__ __forceinline__ void scan_items(int gtid, int gthreads, const float* KVC, bf16* SC, float* dout) {
    for (int e = gtid; e < 8 * 16384; e += gthreads) { const int bh = e >> 14, el = e & 16383; const float g128 = __builtin_amdgcn_exp2f(128.0f * lg2gamma(bh & 3));
        float s = 0.f;
        for (int c0 = 0; c0 < 64; c0 += 8) { float kv[8];
#pragma unroll
            for (int i = 0; i < 8; ++i) kv[i] = KVC[(size_t)(bh * 64 + c0 + i) * 16384 + el];
#pragma unroll
            for (int i = 0; i < 8; ++i) { SC[(size_t)(bh * 64 + c0 + i) * 16384 + el] = (bf16)f2bf(s); s = g128 * s + kv[i]; } }
        dout[O_RETP + e] = s; }
}

__device__ __forceinline__ void out_unit(int u, const bf16* QR, const bf16* KR, const bf16* RV, const bf16* SC, const bf16* RGS, const float* gnorm, bf16* OCAT, LAS unsigned char* lds) {
    int tid_ = threadIdx.x; asm volatile("" : "+v"(tid_)); const int tid = tid_, lane = tid & 63, r32 = lane & 31, hi = lane >> 5, wid = __builtin_amdgcn_readfirstlane(tid >> 6), wi = wid >> 1, wj = wid & 1;
    const int bh = u >> 6, c = u & 63, b = bh >> 2, h = bh & 3; const size_t row0 = (size_t)b * TSEQ + c * 128;
    LAS unsigned char* T0 = lds; LAS unsigned char* T1 = lds + TB; LAS unsigned char* T2 = lds + 2 * TB;
    stage_tile(T0, QR + row0 * 512 + h * 128, 512, tid); stage_tile(T1, KR + row0 * 512 + h * 128, 512, tid); stage_tile(T2, RV + row0 * 512 + h * 128, 512, tid);
    __syncthreads();
    f32x16 sr[2];
#pragma unroll
    for (int n = 0; n < 2; ++n) { const int jb = 2 * wj + n; sr[n] = f32x16{};
        if (jb <= wi) {
#pragma unroll
            for (int ks = 0; ks < 8; ++ks) sr[n] = __builtin_amdgcn_mfma_f32_32x32x16_bf16(rowfrag(T1, 32 * jb, 16 * ks, r32, hi), rowfrag(T0, 32 * wi, 16 * ks, r32, hi), sr[n], 0, 0, 0);
            if (jb == wi) {
#pragma unroll
                for (int r = 0; r < 16; ++r) if (crow(r, hi) > r32) sr[n][r] = 0.f; } } }
    __syncthreads();
#pragma unroll
    for (int n = 0; n < 2; ++n) { const int jb = 2 * wj + n;
        if (jb <= wi) {
#pragma unroll
            for (int r4 = 0; r4 < 4; ++r4) { v2u w; w.x = pg8::cvt_pk_bf16(sr[n][4 * r4], sr[n][4 * r4 + 1]); w.y = pg8::cvt_pk_bf16(sr[n][4 * r4 + 2], sr[n][4 * r4 + 3]);
                *(LAS v2u*)(T1 + (32 * wi + r32) * TPB + (32 * jb + 8 * r4 + 4 * hi) * 2) = w; } } }
    __syncthreads();
    f32x16 o1[2]; o1[0] = f32x16{}; o1[1] = f32x16{};
    for (int ks = 0; ks < 2 * (wi + 1); ++ks) { const bf16x8 A = rowfrag(T1, 32 * wi, 16 * ks, r32, hi);
#pragma unroll
        for (int n = 0; n < 2; ++n) o1[n] = __builtin_amdgcn_mfma_f32_32x32x16_bf16(A, trfrag(T2, 16 * ks, 64 * wj + 32 * n, lane), o1[n], 0, 0, 0); }
    __syncthreads();
    stage_tile(T2, SC + (size_t)u * 16384, 128, tid);
    __syncthreads();
    f32x16 o2[2]; o2[0] = f32x16{}; o2[1] = f32x16{};
#pragma unroll
    for (int ks = 0; ks < 8; ++ks) { const bf16x8 A = rowfrag(T0, 32 * wi, 16 * ks, r32, hi);
#pragma unroll
        for (int n = 0; n < 2; ++n) o2[n] = __builtin_amdgcn_mfma_f32_32x32x16_bf16(A, trfrag(T2, 16 * ks, 64 * wj + 32 * n, lane), o2[n], 0, 0, 0); }
    __syncthreads();
    const float gam = __builtin_amdgcn_exp2f(lg2gamma(h));
    LAS float* OT = (LAS float*)lds;
#pragma unroll
    for (int n = 0; n < 2; ++n)
#pragma unroll
        for (int r = 0; r < 16; ++r) OT[(32 * wi + crow(r, hi)) * OTP + 64 * wj + 32 * n + r32] = o1[n][r] + gam * o2[n][r];
    __syncthreads();
    { const int row = tid >> 2, part = tid & 3; const LAS float* orow = OT + row * OTP + part * 32; float v[32]; float s = 0.f;
#pragma unroll
      for (int k = 0; k < 32; ++k) { v[k] = orow[k]; s += v[k]; }
      s += __shfl_xor(s, 1); s += __shfl_xor(s, 2); const float mu = s * (1.0f / 128.0f); float q = 0.f;
#pragma unroll
      for (int k = 0; k < 32; ++k) { v[k] -= mu; q += v[k] * v[k]; }
      q += __shfl_xor(q, 1); q += __shfl_xor(q, 2); const float rstd = 1.0f / sqrtf(q * (1.0f / 128.0f) + EPS);
      const bf16* rg = RGS + (row0 + row) * 512 + h * 128 + part * 32; const float* gn = gnorm + h * 128 + part * 32; bf16* dst = OCAT + (row0 + row) * DM + 512 + h * 128 + part * 32;
#pragma unroll
      for (int k8 = 0; k8 < 4; ++k8) { const v4u g = *(const v4u*)(rg + 8 * k8); v4u w;
#pragma unroll
          for (int j = 0; j < 4; ++j) { const int k = 8 * k8 + 2 * j; w[j] = pk2(v[k] * rstd * gn[k] * bflo(g[j]), v[k + 1] * rstd * gn[k + 1] * bfhi(g[j])); }
          *(v4u*)(dst + 8 * k8) = w; } }
    __syncthreads();
}

__device__ __forceinline__ void sample_unit(int u, const bf16* QR, const bf16* KR, const bf16* RV, const bf16* RGS, const float* gnorm, const float* state, float* dout, bf16* OCAT, LAS unsigned char* lds) {
    int tid_ = threadIdx.x; asm volatile("" : "+v"(tid_)); const int tid = tid_, s = u >> 2, h = u & 3; const size_t row = (size_t)MP + s;
    LAS float* qf = (LAS float*)lds; LAS float* kf = qf + 128; LAS float* vf = kf + 128; LAS float* red = vf + 128; LAS float* ob = red + 512;
    if (tid < 128) { qf[tid] = bf2f(QR[row * 512 + h * 128 + tid]); kf[tid] = bf2f(KR[row * 512 + h * 128 + tid]); vf[tid] = bf2f(RV[row * 512 + h * 128 + tid]); }
    __syncthreads();
    const int dv = tid & 127, g = tid >> 7; const float gam = __builtin_amdgcn_exp2f(lg2gamma(h)); const float vv = vf[dv];
    const float* S0 = state + (size_t)u * 16384; float* Sn = dout + O_RETS + (size_t)u * 16384; float acc = 0.f;
#pragma unroll 8
    for (int i = 0; i < 32; ++i) { const int dk = 32 * g + i; const float s0 = S0[dk * 128 + dv]; acc += qf[dk] * s0; Sn[dk * 128 + dv] = gam * s0 + kf[dk] * vv; }
    red[tid] = acc;
    __syncthreads();
    if (tid < 128) { float qk = 0.f;
        for (int d = 0; d < 128; ++d) qk += qf[d] * kf[d];
        ob[tid] = qk * vv + gam * ((red[tid] + red[128 + tid]) + (red[256 + tid] + red[384 + tid])); }
    __syncthreads();
    if (tid < 128) { float sm = 0.f;
        for (int d = 0; d < 128; ++d) sm += ob[d];
        const float mu = sm * (1.0f / 128.0f); float q = 0.f;
        for (int d = 0; d < 128; ++d) { const float t = ob[d] - mu; q += t * t; }
        const float rstd = 1.0f / sqrtf(q * (1.0f / 128.0f) + EPS);
        OCAT[row * DM + 512 + h * 128 + tid] = (bf16)f2bf((ob[tid] - mu) * rstd * gnorm[h * 128 + tid] * bf2f(RGS[row * 512 + h * 128 + tid])); }
    __syncthreads();
}
__device__ __forceinline__ void sample_unit4(int u, int w4, int lane_, const bf16* QR, const bf16* KR, const bf16* RV, const bf16* RGS, const float* gnorm, const float* state, float* dout, bf16* OCAT, LAS float* tl, volatile LAS unsigned* cnt, unsigned& gen) {
    int lane = lane_; asm volatile("" : "+v"(lane));
    const int tid = w4 * 64 + lane, s = u >> 2, h = u & 3; const size_t row = (size_t)MP + s;
    LAS float* qf = tl; LAS float* kf = qf + 128; LAS float* vf = kf + 128; LAS float* red = vf + 128; LAS float* ob = red + 256;
    if (tid < 128) { qf[tid] = bf2f(QR[row * 512 + h * 128 + tid]); kf[tid] = bf2f(KR[row * 512 + h * 128 + tid]); vf[tid] = bf2f(RV[row * 512 + h * 128 + tid]); }
    asm volatile("s_waitcnt lgkmcnt(0)" ::: "memory"); att::bar4(cnt, gen, lane);
    const int dv = tid & 127, g = tid >> 7; const float gam = __builtin_amdgcn_exp2f(lg2gamma(h)); const float vv = vf[dv];
    const float* S0 = state + (size_t)u * 16384; float* Sn = dout + O_RETS + (size_t)u * 16384; float acc = 0.f;
#pragma unroll 16
    for (int i = 0; i < 64; ++i) { const int dk = 64 * g + i; const float s0 = S0[dk * 128 + dv]; acc += qf[dk] * s0; Sn[dk * 128 + dv] = gam * s0 + kf[dk] * vv; }
    red[tid] = acc;
    asm volatile("s_waitcnt lgkmcnt(0)" ::: "memory"); att::bar4(cnt, gen, lane);
    if (tid < 128) { float qk = 0.f;
        for (int d = 0; d < 128; ++d) qk += qf[d] * kf[d];
        ob[tid] = qk * vv + gam * (red[tid] + red[128 + tid]); }
    asm volatile("s_waitcnt lgkmcnt(0)" ::: "memory"); att::bar4(cnt, gen, lane);
    if (tid < 128) { float sm = 0.f;
        for (int d = 0; d < 128; ++d) sm += ob[d];
        const float mu = sm * (1.0f / 128.0f); float q = 0.f;
        for (int d = 0; d < 128; ++d) { const float t = ob[d] - mu; q += t * t; }
        const float rstd = 1.0f / sqrtf(q * (1.0f / 128.0f) + EPS);
        OCAT[row * DM + 512 + h * 128 + tid] = (bf16)f2bf((ob[tid] - mu) * rstd * gnorm[h * 128 + tid] * bf2f(RGS[row * 512 + h * 128 + tid])); }
    asm volatile("s_waitcnt lgkmcnt(0)" ::: "memory"); att::bar4(cnt, gen, lane);
}
}
namespace sk {
using bf16x8 = __attribute__((ext_vector_type(8))) short;
using f32x4 = __attribute__((ext_vector_type(4))) float;
using f32x2 = __attribute__((ext_vector_type(2))) float;
template <int K, bool DUAL, bool STAT, class Epi>
__device__ __forceinline__ void skinny_unit(int u, const bf16* A, const bf16* Bt, float* ssq, LAS float* lds, const Epi E) {
    int tid_ = threadIdx.x; asm volatile("" : "+v"(tid_)); const int tid = tid_, lane = tid & 63, wave = __builtin_amdgcn_readfirstlane(tid >> 6), fr = lane & 15, fq = lane >> 4;
    const int rb = u >> 4, cg = u & 15;
    constexpr int KW = K / 8, NS = KW / 32; static_assert(KW % 32 == 0, "K split");
    const bf16* ap = A + (size_t)(MP + 16 * rb + fr) * K + wave * KW + 8 * fq;
    const bf16* bp = Bt + (size_t)(64 * cg + fr) * K + wave * KW + 8 * fq;
    f32x4 acc[4];
#pragma unroll
    for (int n = 0; n < 4; ++n) acc[n] = (f32x4){0.f, 0.f, 0.f, 0.f};
#pragma unroll 4
    for (int s = 0; s < NS; ++s) { const bf16x8 a = *(const bf16x8*)(ap + 32 * s);
#pragma unroll
        for (int n = 0; n < 4; ++n) acc[n] = __builtin_amdgcn_mfma_f32_16x16x32_bf16(a, *(const bf16x8*)(bp + (size_t)16 * n * K + 32 * s), acc[n], 0, 0, 0); }
    LAS float* P = lds + wave * 1024;
#pragma unroll
    for (int n = 0; n < 4; ++n)
#pragma unroll
        for (int r = 0; r < 4; ++r) P[(4 * fq + r) * 64 + 16 * n + fr] = acc[n][r];
    __syncthreads();
    { const int row = tid >> 5, c2 = (tid & 31) * 2; float a0 = 0.f, a1 = 0.f, b0 = 0.f, b1 = 0.f;
#pragma unroll
      for (int w = 0; w < 8; ++w) { const f32x2 v = *(const LAS f32x2*)(lds + w * 1024 + row * 64 + c2); if (DUAL && w >= 4) { b0 += v[0]; b1 += v[1]; } else { a0 += v[0]; a1 += v[1]; } }
      const f32x2 h = E(MP + 16 * rb + row, 64 * cg + c2, a0, a1, b0, b1);
      if (STAT) { float s = h[0] * h[0] + h[1] * h[1];
#pragma unroll
          for (int o = 1; o < 32; o <<= 1) s += __shfl_xor(s, o);
          if ((tid & 31) == 0) ssq[(size_t)(MP + 16 * rb + row) * 16 + cg] = s; } }
    __syncthreads();
}
struct SkResid { const bf16* R; float alpha; bf16* Hb;
    __device__ __forceinline__ f32x2 operator()(int row, int col, float a0, float a1, float, float) const {
        const unsigned r = *(const unsigned*)(R + (size_t)row * DM + col); const f32x2 h = {bflo(r) + alpha * a0, bfhi(r) + alpha * a1};
        *(unsigned*)(Hb + (size_t)row * DM + col) = pg8::cvt_pk_bf16(h[0], h[1]); return h; } };
struct SkResidX { const float* xs; bf16* Hb;
    __device__ __forceinline__ f32x2 operator()(int row, int col, float a0, float a1, float, float) const {
        const f32x2 r = *(const f32x2*)(xs + (size_t)(row - MP) * DM + col); const f32x2 h = {r[0] + 0.5f * a0, r[1] + 0.5f * a1};
        *(unsigned*)(Hb + (size_t)row * DM + col) = pg8::cvt_pk_bf16(h[0], h[1]); return h; } };
struct SkMerge { const bf16* SGA; const bf16* SGR; bf16* O;
    __device__ __forceinline__ f32x2 operator()(int row, int col, float a0, float a1, float b0, float b1) const {
        const unsigned ga = *(const unsigned*)(SGA + (size_t)row * DM + col), gr = *(const unsigned*)(SGR + (size_t)row * DM + col);
        const f32x2 m = {bflo(ga) * a0 + bflo(gr) * b0, bfhi(ga) * a1 + bfhi(gr) * b1};
        *(unsigned*)(O + (size_t)row * DM + col) = pg8::cvt_pk_bf16(m[0], m[1]); return m; } };
struct SkPlain { bf16* O;
    __device__ __forceinline__ f32x2 operator()(int row, int col, float a0, float a1, float, float) const {
        *(unsigned*)(O + (size_t)row * DM + col) = pg8::cvt_pk_bf16(a0, a1); return (f32x2){a0, a1}; } };
struct SkPle { const bf16* H3; const bf16* PP; const float* ssq3; bf16* H4;
    __device__ __forceinline__ f32x2 operator()(int row, int col, float a0, float a1, float, float) const {
        const float rs = pg8::rstd_of<16>(ssq3, row, 1.0f / DM); const unsigned r = *(const unsigned*)(H3 + (size_t)row * DM + col); const unsigned p = *(const unsigned*)(PP + (size_t)row * DM + col);
        const f32x2 h = {bflo(r) + sigm(a0 * rs) * bflo(p), bfhi(r) + sigm(a1 * rs) * bfhi(p)};
        *(unsigned*)(H4 + (size_t)row * DM + col) = pg8::cvt_pk_bf16(h[0], h[1]); return h; } };
}
namespace dec {
using bf16x2 = __attribute__((ext_vector_type(2))) __bf16;
using u32x4 = __attribute__((ext_vector_type(4))) unsigned;
using f32x4 = __attribute__((ext_vector_type(4))) float;
using f32x2 = __attribute__((ext_vector_type(2))) float;
constexpr int NSPLIT = 16, PPS = NPAGES / NSPLIT;
constexpr int HPL = 2, GE = 8;
constexpr int L_QL = 0, L_P = 8 * 128, L_MRG = L_P + 8 * 64 * HPL, MRG_REC = 4 + 128, L_END = L_MRG + 8 * GE * MRG_REC;
static_assert(L_END * 4 <= RING_BYTES, "decode LDS");
__device__ __forceinline__ float dot2(unsigned k, unsigned q, float acc) { return __builtin_amdgcn_fdot2_f32_bf16(__builtin_bit_cast(bf16x2, k), __builtin_bit_cast(bf16x2, q), acc, false); }
__device__ __forceinline__ unsigned cvtpk(float lo, float hi) { return pg8::cvt_pk_bf16(lo, hi); }
template <int CTRL> __device__ __forceinline__ float dpp(float x) { return __builtin_bit_cast(float, __builtin_amdgcn_mov_dpp(__builtin_bit_cast(int, x), CTRL, 0xf, 0xf, true)); }
constexpr int XOR1 = 0xB1, XOR2 = 0x4E, XOR7 = 0x141, XOR8 = 0x128, ROR4 = 0x124;
__device__ __forceinline__ float xrow16_max(float x) {
    auto s = __builtin_amdgcn_permlane16_swap(__float_as_uint(x), __float_as_uint(x), false, false); x = fmaxf(__uint_as_float(s[0]), __uint_as_float(s[1]));
    auto t = __builtin_amdgcn_permlane32_swap(__float_as_uint(x), __float_as_uint(x), false, false); return fmaxf(__uint_as_float(t[0]), __uint_as_float(t[1])); }
__device__ __forceinline__ float xrow16_sum(float x) {
    auto s = __builtin_amdgcn_permlane16_swap(__float_as_uint(x), __float_as_uint(x), false, false); x = __uint_as_float(s[0]) + __uint_as_float(s[1]);
    auto t = __builtin_amdgcn_permlane32_swap(__float_as_uint(x), __float_as_uint(x), false, false); return __uint_as_float(t[0]) + __uint_as_float(t[1]); }

__device__ __forceinline__ void qlat_token(int s, const bf16* QB, const float* wkvb, LAS float* QLs, float* QLATg, bool store) {
    int tid_ = threadIdx.x; asm volatile("" : "+v"(tid_)); const int tid = tid_, lane = tid & 63, h = __builtin_amdgcn_readfirstlane(tid >> 6);
    const bf16* q = QB + (size_t)(MP + s) * 768 + h * QKD;
#pragma unroll
    for (int cc = 0; cc < 2; ++cc) { const int c = lane + 64 * cc; const float* w = wkvb + (size_t)c * 1024 + h * 128; float a = 0.f;
#pragma unroll 4
        for (int d = 0; d < 64; d += 4) { const f32x4 wv = *(const f32x4*)(w + d); a += bf2f(q[d]) * wv[0] + bf2f(q[d + 1]) * wv[1] + bf2f(q[d + 2]) * wv[2] + bf2f(q[d + 3]) * wv[3]; }
        QLs[h * 128 + c] = a; if (store) QLATg[(size_t)s * 1024 + h * 128 + c] = a; }
}

__device__ __forceinline__ void split_unit(int s, int sp, const bf16* QB, const float* cache_ckv, const float* cache_kpe, const int* page_table, float* DPO, float* DML, LAS float* lds) {
    int tid_ = threadIdx.x; asm volatile("" : "+v"(tid_)); const int tid = tid_, lane = tid & 63, wave = __builtin_amdgcn_readfirstlane(tid >> 6), r = lane >> 4, c = lane & 15;
    const LAS float* QL = lds + L_QL;
    u32x4 qpk[GE]; unsigned qpe[GE];
#pragma unroll
    for (int g = 0; g < GE; ++g) { const LAS float* ql = QL + g * 128 + 8 * c; qpk[g] = (u32x4){cvtpk(ql[0], ql[1]), cvtpk(ql[2], ql[3]), cvtpk(ql[4], ql[5]), cvtpk(ql[6], ql[7])};
        qpe[g] = *(const unsigned*)(QB + (size_t)(MP + s) * 768 + g * QKD + 64 + 2 * c); }
    float m[HPL], l[HPL], acc[GE * 8];
#pragma unroll
    for (int j = 0; j < HPL; ++j) { m[j] = -INFINITY; l[j] = 0.f; }
#pragma unroll
    for (int k = 0; k < GE * 8; ++k) acc[k] = 0.f;
    const int ph0 = page_table[s * NPAGES + PPS * sp + wave], ph1 = page_table[s * NPAGES + PPS * sp + wave + 8];
    f32x4 Kn[4][2]; f32x2 Pn[4];
#define DEC_ISSUE(i_) do { const int ph_ = ((i_) >> 3) ? ph1 : ph0; const size_t tok_ = (size_t)ph_ * PAGE + 16 * ((i_) & 7) + r; \
        _Pragma("unroll") for (int t_ = 0; t_ < 4; ++t_) { const float* kp_ = cache_ckv + (tok_ + 4 * t_) * KVL + 8 * c; \
            Kn[t_][0] = __builtin_nontemporal_load((const f32x4*)kp_); Kn[t_][1] = __builtin_nontemporal_load((const f32x4*)(kp_ + 4)); \
            Pn[t_] = __builtin_nontemporal_load((const f32x2*)(cache_kpe + (tok_ + 4 * t_) * RPE + 2 * c)); } } while (0)
    DEC_ISSUE(0);
#pragma nounroll
    for (int i = 0; i < 16; ++i) {
        u32x4 Kc[4]; unsigned Pc[4];
#pragma unroll
        for (int t = 0; t < 4; ++t) {
            Kc[t] = (u32x4){cvtpk(Kn[t][0][0], Kn[t][0][1]), cvtpk(Kn[t][0][2], Kn[t][0][3]), cvtpk(Kn[t][1][0], Kn[t][1][1]), cvtpk(Kn[t][1][2], Kn[t][1][3])}; Pc[t] = cvtpk(Pn[t][0], Pn[t][1]); }
        if (i + 1 < 16) DEC_ISSUE(i + 1);
        float x[4 * GE];
#pragma unroll
        for (int t = 0; t < 4; ++t)
#pragma unroll
            for (int g = 0; g < GE; ++g) { float d = dot2(Pc[t], qpe[g], 0.f);
#pragma unroll
                for (int k = 0; k < 4; ++k) d = dot2(Kc[t][k], qpk[g][k], d);
                x[t * GE + g] = d; }
#define TR_STEP(HALF, CTRL, BIT) _Pragma("unroll") for (int h = 0; h < (HALF); ++h) _Pragma("unroll") for (int j = 0; j < HPL; ++j) { \
        const float lo_ = x[h * HPL + j], hi_ = x[(h + (HALF)) * HPL + j]; const float t1_ = lo_ + dpp<CTRL>(lo_), t2_ = hi_ + dpp<CTRL>(hi_); \
        x[h * HPL + j] = (c & (BIT)) ? t2_ : t1_; }
        TR_STEP(8, XOR8, 8) TR_STEP(4, XOR7, 4) TR_STEP(2, XOR2, 2) TR_STEP(1, XOR1, 1)
#undef TR_STEP
        float p[HPL], alpha[HPL];
#pragma unroll
        for (int j = 0; j < HPL; ++j) { const float sc = x[j];
            float pm = sc; pm = fmaxf(pm, dpp<ROR4>(pm)); pm = fmaxf(pm, dpp<XOR8>(pm)); pm = xrow16_max(pm);
            const float mn = fmaxf(m[j], pm);
            alpha[j] = __builtin_amdgcn_exp2f(m[j] - mn); p[j] = __builtin_amdgcn_exp2f(sc - mn);
            l[j] = fmaf(l[j], alpha[j], p[j]); m[j] = mn; }
#pragma unroll
        for (int q4 = 0; q4 < 4; ++q4)
#pragma unroll
            for (int j = 0; j < HPL; ++j) { const float al = q4 == 0 ? dpp<0x00>(alpha[j]) : q4 == 1 ? dpp<0x55>(alpha[j]) : q4 == 2 ? dpp<0xAA>(alpha[j]) : dpp<0xFF>(alpha[j]);
#pragma unroll
                for (int k = 0; k < 8; ++k) acc[(q4 * HPL + j) * 8 + k] *= al; }
        LAS float* prow = lds + L_P + (wave * 4 + r) * 16 * HPL;
#pragma unroll
        for (int j = 0; j < HPL; ++j) prow[c * HPL + j] = p[j];
        asm volatile("s_waitcnt lgkmcnt(0)" ::: "memory");
#pragma unroll
        for (int t = 0; t < 4; ++t) { float vf[8]; f32x4 pr[2]; pr[0] = *(const LAS f32x4*)(prow + 8 * t); pr[1] = *(const LAS f32x4*)(prow + 8 * t + 4);
#pragma unroll
            for (int k = 0; k < 4; ++k) { vf[2 * k] = bflo(Kc[t][k]); vf[2 * k + 1] = bfhi(Kc[t][k]); }
#pragma unroll
            for (int g = 0; g < GE; ++g) { const float pg_ = pr[g >> 2][g & 3];
#pragma unroll
                for (int k = 0; k < 8; ++k) acc[g * 8 + k] = fmaf(pg_, vf[k], acc[g * 8 + k]); } }
        asm volatile("s_waitcnt lgkmcnt(0)" ::: "memory");
    }
#undef DEC_ISSUE
#pragma unroll
    for (int k = 0; k < GE * 8; ++k) acc[k] = xrow16_sum(acc[k]);
#pragma unroll
    for (int j = 0; j < HPL; ++j) { float t = l[j]; t += dpp<ROR4>(t); t += dpp<XOR8>(t); l[j] = xrow16_sum(t); }
    LAS float* mrg = lds + L_MRG;
    if (r == 0) {
#pragma unroll
        for (int g = 0; g < GE; ++g) { LAS float* rec = mrg + (wave * GE + g) * MRG_REC;
#pragma unroll
            for (int k = 0; k < 8; k += 4) *(LAS f32x4*)(rec + 4 + 8 * c + k) = (f32x4){acc[g * 8 + k], acc[g * 8 + k + 1], acc[g * 8 + k + 2], acc[g * 8 + k + 3]};
            if (c == g / HPL) { rec[0] = m[g % HPL]; rec[1] = l[g % HPL]; } } }
    __syncthreads();
    { const int g = wave, d0 = 2 * lane;
      float M = -INFINITY;
#pragma unroll
      for (int w = 0; w < 8; ++w) M = fmaxf(M, mrg[(w * GE + g) * MRG_REC]);
      float L = 0.f, o0 = 0.f, o1 = 0.f;
#pragma unroll
      for (int w = 0; w < 8; ++w) { const LAS float* rec = mrg + (w * GE + g) * MRG_REC; const float wt = __builtin_amdgcn_exp2f(rec[0] - M);
          L = fmaf(wt, rec[1], L); o0 = fmaf(wt, rec[4 + d0], o0); o1 = fmaf(wt, rec[4 + d0 + 1], o1); }
      const size_t slot = ((size_t)s * NSPLIT + sp) * GE + g;
      *(f32x2*)(DPO + slot * 128 + d0) = (f32x2){o0, o1};
      if (lane == 0) *(f32x2*)(DML + slot * 2) = (f32x2){M, L}; }
    __syncthreads();
}

constexpr int D_BASE = 78848;
constexpr int D4_QL = 0, D4_P = 8 * 128, D4_MRG = D4_P + 4 * 64 * HPL, D4_END = D4_MRG + 4 * GE * MRG_REC;
static_assert(D_BASE + D4_END * 4 <= PH5_BYTES, "decode-half LDS");
__device__ __forceinline__ void qlat_token4(int s, int w4, int lane_, const bf16* QB, const float* wkvb, LAS float* QLs, float* QLATg, bool store) {
    int lane = lane_; asm volatile("" : "+v"(lane));
#pragma unroll
    for (int hh = 0; hh < 2; ++hh) { const int h = w4 + 4 * hh; const bf16* q = QB + (size_t)(MP + s) * 768 + h * QKD;
#pragma unroll
        for (int cc = 0; cc < 2; ++cc) { const int c = lane + 64 * cc; const float* w = wkvb + (size_t)c * 1024 + h * 128; float a = 0.f;
#pragma unroll 4
            for (int d = 0; d < 64; d += 4) { const f32x4 wv = *(const f32x4*)(w + d); a += bf2f(q[d]) * wv[0] + bf2f(q[d + 1]) * wv[1] + bf2f(q[d + 2]) * wv[2] + bf2f(q[d + 3]) * wv[3]; }
            QLs[h * 128 + c] = a; if (store) QLATg[(size_t)s * 1024 + h * 128 + c] = a; } }
}
__device__ __forceinline__ void split_unit4(int s, int sp, int w4, int lane_, const bf16* QB, const float* cache_ckv, const float* cache_kpe, const int* page_table, float* DPO, float* DML, LAS float* lds, volatile LAS unsigned* cnt, unsigned& gen) {
    int lane = lane_; asm volatile("" : "+v"(lane));
    const int r = lane >> 4, c = lane & 15;
    const LAS float* QL = lds + D4_QL;
    u32x4 qpk[GE]; unsigned qpe[GE];
#pragma unroll
    for (int g = 0; g < GE; ++g) { const LAS float* ql = QL + g * 128 + 8 * c; qpk[g] = (u32x4){cvtpk(ql[0], ql[1]), cvtpk(ql[2], ql[3]), cvtpk(ql[4], ql[5]), cvtpk(ql[6], ql[7])};
        qpe[g] = *(const unsigned*)(QB + (size_t)(MP + s) * 768 + g * QKD + 64 + 2 * c); }
    float m[HPL], l[HPL], acc[GE * 8];
#pragma unroll
    for (int j = 0; j < HPL; ++j) { m[j] = -INFINITY; l[j] = 0.f; }
#pragma unroll
    for (int k = 0; k < GE * 8; ++k) acc[k] = 0.f;
    const int* pt = page_table + s * NPAGES + PPS * sp + w4;
    f32x4 Kn[4][2]; f32x2 Pn[4];
#define DEC_ISSUE(i_) do { const int ph_ = pt[4 * ((i_) >> 3)]; const size_t tok_ = (size_t)ph_ * PAGE + 16 * ((i_) & 7) + r; \
        _Pragma("unroll") for (int t_ = 0; t_ < 4; ++t_) { const float* kp_ = cache_ckv + (tok_ + 4 * t_) * KVL + 8 * c; \
            Kn[t_][0] = __builtin_nontemporal_load((const f32x4*)kp_); Kn[t_][1] = __builtin_nontemporal_load((const f32x4*)(kp_ + 4)); \
            Pn[t_] = __builtin_nontemporal_load((const f32x2*)(cache_kpe + (tok_ + 4 * t_) * RPE + 2 * c)); } } while (0)
    DEC_ISSUE(0);
#pragma nounroll
    for (int i = 0; i < 16; ++i) {
        u32x4 Kc[4]; unsigned Pc[4];
#pragma unroll
        for (int t = 0; t < 4; ++t) {
            Kc[t] = (u32x4){cvtpk(Kn[t][0][0], Kn[t][0][1]), cvtpk(Kn[t][0][2], Kn[t][0][3]), cvtpk(Kn[t][1][0], Kn[t][1][1]), cvtpk(Kn[t][1][2], Kn[t][1][3])}; Pc[t] = cvtpk(Pn[t][0], Pn[t][1]); }
        if (i + 1 < 16) DEC_ISSUE(i + 1);
        float x[4 * GE];
#pragma unroll
        for (int t = 0; t < 4; ++t)
#pragma unroll
            for (int g = 0; g < GE; ++g) { float d = dot2(Pc[t], qpe[g], 0.f);
#pragma unroll
                for (int k = 0; k < 4; ++k) d = dot2(Kc[t][k], qpk[g][k], d);
                x[t * GE + g] = d; }
#define TR_STEP(HALF, CTRL, BIT) _Pragma("unroll") for (int h = 0; h < (HALF); ++h) _Pragma("unroll") for (int j = 0; j < HPL; ++j) { \
        const float lo_ = x[h * HPL + j], hi_ = x[(h + (HALF)) * HPL + j]; const float t1_ = lo_ + dpp<CTRL>(lo_), t2_ = hi_ + dpp<CTRL>(hi_); \
        x[h * HPL + j] = (c & (BIT)) ? t2_ : t1_; }
        TR_STEP(8, XOR8, 8) TR_STEP(4, XOR7, 4) TR_STEP(2, XOR2, 2) TR_STEP(1, XOR1, 1)
#undef TR_STEP
        float p[HPL], alpha[HPL];
#pragma unroll
        for (int j = 0; j < HPL; ++j) { const float sc = x[j];
            float pm = sc; pm = fmaxf(pm, dpp<ROR4>(pm)); pm = fmaxf(pm, dpp<XOR8>(pm)); pm = xrow16_max(pm);
            const float mn = fmaxf(m[j], pm);
            alpha[j] = __builtin_amdgcn_exp2f(m[j] - mn); p[j] = __builtin_amdgcn_exp2f(sc - mn);
            l[j] = fmaf(l[j], alpha[j], p[j]); m[j] = mn; }
#pragma unroll
        for (int q4 = 0; q4 < 4; ++q4)
#pragma unroll
            for (int j = 0; j < HPL; ++j) { const float al = q4 == 0 ? dpp<0x00>(alpha[j]) : q4 == 1 ? dpp<0x55>(alpha[j]) : q4 == 2 ? dpp<0xAA>(alpha[j]) : dpp<0xFF>(alpha[j]);
#pragma unroll
                for (int k = 0; k < 8; ++k) acc[(q4 * HPL + j) * 8 + k] *= al; }
        LAS float* prow = lds + D4_P + (w4 * 4 + r) * 16 * HPL;
#pragma unroll
        for (int j = 0; j < HPL; ++j) prow[c * HPL + j] = p[j];
        asm volatile("s_waitcnt lgkmcnt(0)" ::: "memory");
#pragma unroll
        for (int t = 0; t < 4; ++t) { float vf[8]; f32x4 pr[2]; pr[0] = *(const LAS f32x4*)(prow + 8 * t); pr[1] = *(const LAS f32x4*)(prow + 8 * t + 4);
#pragma unroll
            for (int k = 0; k < 4; ++k) { vf[2 * k] = bflo(Kc[t][k]); vf[2 * k + 1] = bfhi(Kc[t][k]); }
#pragma unroll
            for (int g = 0; g < GE; ++g) { const float pg_ = pr[g >> 2][g & 3];
#pragma unroll
                for (int k = 0; k < 8; ++k) acc[g * 8 + k] = fmaf(pg_, vf[k], acc[g * 8 + k]); } }
        asm volatile("s_waitcnt lgkmcnt(0)" ::: "memory");
    }
#undef DEC_ISSUE
#pragma unroll
    for (int k = 0; k < GE * 8; ++k) acc[k] = xrow16_sum(acc[k]);
#pragma unroll
    for (int j = 0; j < HPL; ++j) { float t = l[j]; t += dpp<ROR4>(t); t += dpp<XOR8>(t); l[j] = xrow16_sum(t); }
    LAS float* mrg = lds + D4_MRG;
    if (r == 0) {
#pragma unroll
        for (int g = 0; g < GE; ++g) { LAS float* rec = mrg + (w4 * GE + g) * MRG_REC;
#pragma unroll
            for (int k = 0; k < 8; k += 4) *(LAS f32x4*)(rec + 4 + 8 * c + k) = (f32x4){acc[g * 8 + k], acc[g * 8 + k + 1], acc[g * 8 + k + 2], acc[g * 8 + k + 3]};
            if (c == g / HPL) { rec[0] = m[g % HPL]; rec[1] = l[g % HPL]; } } }
    asm volatile("s_waitcnt lgkmcnt(0)" ::: "memory"); att::bar4(cnt, gen, lane);
#pragma unroll
    for (int hh = 0; hh < 2; ++hh) { const int g = w4 + 4 * hh, d0 = 2 * lane;
      float M = -INFINITY;
#pragma unroll
      for (int w = 0; w < 4; ++w) M = fmaxf(M, mrg[(w * GE + g) * MRG_REC]);
      float L = 0.f, o0 = 0.f, o1 = 0.f;
#pragma unroll
      for (int w = 0; w < 4; ++w) { const LAS float* rec = mrg + (w * GE + g) * MRG_REC; const float wt = __builtin_amdgcn_exp2f(rec[0] - M);
          L = fmaf(wt, rec[1], L); o0 = fmaf(wt, rec[4 + d0], o0); o1 = fmaf(wt, rec[4 + d0 + 1], o1); }
      const size_t slot = ((size_t)s * NSPLIT + sp) * GE + g;
      *(f32x2*)(DPO + slot * 128 + d0) = (f32x2){o0, o1};
      if (lane == 0) *(f32x2*)(DML + slot * 2) = (f32x2){M, L}; }
    asm volatile("s_waitcnt lgkmcnt(0)" ::: "memory"); att::bar4(cnt, gen, lane);
}

using bf16x8 = __attribute__((ext_vector_type(8))) short;
typedef short dv4i16_t __attribute__((ext_vector_type(4)));
constexpr int VP = 272, VTILE = 32 * VP;
constexpr int M4_QL = 0, M4_VT = 4096, M4_END = M4_VT + 4 * VTILE;
static_assert(2 * D_BASE <= PH5_BYTES && M4_END <= D_BASE && 8 * MRG_REC * 4 <= VTILE, "P5 LDS (MFMA form)");
__device__ __forceinline__ bf16x8 pk8(f32x4 a, f32x4 b) { const u32x4 w = {pg8::cvt_pk_bf16(a[0], a[1]), pg8::cvt_pk_bf16(a[2], a[3]), pg8::cvt_pk_bf16(b[0], b[1]), pg8::cvt_pk_bf16(b[2], b[3])}; return __builtin_bit_cast(bf16x8, w); }
__device__ __forceinline__ void split_unit4m(int s, int sp, int w4, int lane_, const bf16* QB, const float* cache_ckv, const float* cache_kpe, const int* page_table, float* DPO, float* DML, LAS unsigned char* tl, volatile LAS unsigned* cnt, unsigned& gen) {
    int lane = lane_; asm volatile("" : "+v"(lane));
    const int t16 = lane & 15, kg = lane >> 4;
    const LAS float* QL = (const LAS float*)(tl + M4_QL);
    LAS unsigned char* vt = tl + M4_VT + w4 * VTILE;
    bf16x8 qf[5];
    if (t16 < 8) {
#pragma unroll
        for (int ks = 0; ks < 4; ++ks) { const LAS float* q = QL + t16 * 128 + 64 * (ks >> 1) + 32 * (ks & 1) + 4 * kg; qf[ks] = pk8(*(const LAS f32x4*)q, *(const LAS f32x4*)(q + 16)); }
        { const bf16* qp = QB + (size_t)(MP + s) * 768 + t16 * QKD + 64 + 4 * kg; const v2u a = *(const v2u*)qp, b = *(const v2u*)(qp + 16); const u32x4 w = {a.x, a.y, b.x, b.y}; qf[4] = __builtin_bit_cast(bf16x8, w); }
    } else {
#pragma unroll
        for (int ks = 0; ks < 5; ++ks) qf[ks] = (bf16x8){0, 0, 0, 0, 0, 0, 0, 0};
    }
    float m = -INFINITY, l = 0.f; f32x4 O[8];
#pragma unroll
    for (int c = 0; c < 8; ++c) O[c] = (f32x4){0.f, 0.f, 0.f, 0.f};
    const int* pt = page_table + s * NPAGES + PPS * sp + w4;
    const int ph0 = __builtin_amdgcn_readfirstlane(pt[0]), ph1 = __builtin_amdgcn_readfirstlane(pt[4]);
    f32x4 Cn[2][2][4], Pn[2][2];
#define DEC_ISSUE(i_) do { const int ph_ = ((i_) >> 2) ? ph1 : ph0; const size_t tok_ = (size_t)ph_ * PAGE + 32 * ((i_) & 3) + t16; \
        _Pragma("unroll") for (int g_ = 0; g_ < 2; ++g_) { const float* cp_ = cache_ckv + (tok_ + 16 * g_) * KVL + 4 * kg; const float* pp_ = cache_kpe + (tok_ + 16 * g_) * RPE + 4 * kg; \
            _Pragma("unroll") for (int b_ = 0; b_ < 2; ++b_) _Pragma("unroll") for (int j_ = 0; j_ < 4; ++j_) Cn[g_][b_][j_] = __builtin_nontemporal_load((const f32x4*)(cp_ + 64 * b_ + 16 * j_)); \
            Pn[g_][0] = __builtin_nontemporal_load((const f32x4*)pp_); Pn[g_][1] = __builtin_nontemporal_load((const f32x4*)(pp_ + 16)); } } while (0)
    DEC_ISSUE(0);
#pragma nounroll
    for (int i = 0; i < 8; ++i) {
        bf16x8 kf[2][5];
#pragma unroll
        for (int g = 0; g < 2; ++g) {
#pragma unroll
            for (int b = 0; b < 2; ++b) { kf[g][2 * b] = pk8(Cn[g][b][0], Cn[g][b][1]); kf[g][2 * b + 1] = pk8(Cn[g][b][2], Cn[g][b][3]); }
            kf[g][4] = pk8(Pn[g][0], Pn[g][1]); }
        if (i + 1 < 8) DEC_ISSUE(i + 1);
#pragma unroll
        for (int g = 0; g < 2; ++g)
#pragma unroll
            for (int ks = 0; ks < 4; ++ks) { const u32x4 w = __builtin_bit_cast(u32x4, kf[g][ks]); LAS unsigned char* d = vt + (16 * g + t16) * VP + 128 * (ks >> 1) + 64 * (ks & 1) + 8 * kg;
                *(LAS v2u*)d = (v2u){w[0], w[1]}; *(LAS v2u*)(d + 32) = (v2u){w[2], w[3]}; }
        f32x4 S[2];
#pragma unroll
        for (int g = 0; g < 2; ++g) { S[g] = (f32x4){0.f, 0.f, 0.f, 0.f};
#pragma unroll
            for (int ks = 0; ks < 5; ++ks) S[g] = __builtin_amdgcn_mfma_f32_16x16x32_bf16(kf[g][ks], qf[ks], S[g], 0, 0, 0); }
        float pm = fmaxf(fmaxf(fmaxf(S[0][0], S[0][1]), fmaxf(S[0][2], S[0][3])), fmaxf(fmaxf(S[1][0], S[1][1]), fmaxf(S[1][2], S[1][3])));
        pm = xrow16_max(pm);
        const float mn = (pm > m + 8.0f) ? pm : m;
        if (__any(mn > m)) {
            const float alpha = __builtin_amdgcn_exp2f(m - mn); l *= alpha; m = mn;
            float a4[4];
#pragma unroll
            for (int r = 0; r < 4; ++r) a4[r] = __shfl(alpha, 4 * kg + r);
#pragma unroll
            for (int c = 0; c < 8; ++c)
#pragma unroll
                for (int r = 0; r < 4; ++r) O[c][r] *= a4[r];
        }
        f32x4 p0, p1;
#pragma unroll
        for (int r = 0; r < 4; ++r) { p0[r] = __builtin_amdgcn_exp2f(S[0][r] - m); p1[r] = __builtin_amdgcn_exp2f(S[1][r] - m); }
        l += ((p0[0] + p0[1]) + (p0[2] + p0[3])) + ((p1[0] + p1[1]) + (p1[2] + p1[3]));
        const bf16x8 pa = pk8(p0, p1);
        const LAS unsigned char* vr = vt + (4 * kg + (t16 >> 2)) * VP + (t16 & 3) * 8;
#pragma unroll
        for (int c = 0; c < 8; ++c) {
            const dv4i16_t lo = __builtin_amdgcn_ds_read_tr16_b64_v4i16((LAS dv4i16_t*)(vr + 32 * c));
            const dv4i16_t hi = __builtin_amdgcn_ds_read_tr16_b64_v4i16((LAS dv4i16_t*)(vr + 16 * VP + 32 * c));
            const bf16x8 vb = {lo[0], lo[1], lo[2], lo[3], hi[0], hi[1], hi[2], hi[3]};
            O[c] = __builtin_amdgcn_mfma_f32_16x16x32_bf16(pa, vb, O[c], 0, 0, 0); }
    }
#undef DEC_ISSUE
    l = xrow16_sum(l);
    asm volatile("s_waitcnt lgkmcnt(0)" ::: "memory");
    LAS float* rec0 = (LAS float*)vt;
    if (kg < 2) {
#pragma unroll
        for (int c = 0; c < 8; ++c)
#pragma unroll
            for (int r = 0; r < 4; ++r) rec0[(4 * kg + r) * MRG_REC + 4 + 16 * c + t16] = O[c][r]; }
    if (kg == 0 && t16 < 8) { rec0[t16 * MRG_REC] = m; rec0[t16 * MRG_REC + 1] = l; }
    asm volatile("s_waitcnt lgkmcnt(0)" ::: "memory"); att::bar4(cnt, gen, lane);
#pragma unroll
    for (int hh = 0; hh < 2; ++hh) { const int g = w4 + 4 * hh, d0 = 2 * lane;
      float M = -INFINITY;
#pragma unroll
      for (int w = 0; w < 4; ++w) M = fmaxf(M, ((const LAS float*)(tl + M4_VT + w * VTILE))[g * MRG_REC]);
      float L = 0.f, o0 = 0.f, o1 = 0.f;
#pragma unroll
      for (int w = 0; w < 4; ++w) { const LAS float* rec = (const LAS float*)(tl + M4_VT + w * VTILE) + g * MRG_REC; const float wt = __builtin_amdgcn_exp2f(rec[0] - M);
          L = fmaf(wt, rec[1], L); o0 = fmaf(wt, rec[4 + d0], o0); o1 = fmaf(wt, rec[4 + d0 + 1], o1); }
      const size_t slot = ((size_t)s * NSPLIT + sp) * GE + g;
      *(f32x2*)(DPO + slot * 128 + d0) = (f32x2){o0, o1};
      if (lane == 0) *(f32x2*)(DML + slot * 2) = (f32x2){M, L}; }
    asm volatile("s_waitcnt lgkmcnt(0)" ::: "memory"); att::bar4(cnt, gen, lane);
}

__device__ __forceinline__ void combine_unit(int s, const bf16* QB, const float* QLATg, const float* DPO, const float* DML, const float* dout, const float* wkvb, bf16* OCAT, LAS float* lds) {
    int tid_ = threadIdx.x; asm volatile("" : "+v"(tid_)); const int tid = tid_, lane = tid & 63, g = __builtin_amdgcn_readfirstlane(tid >> 6), d0 = 2 * lane;
    const float* ck = dout + O_CKVS + (size_t)s * KVL; const float* kp = dout + O_KPES + (size_t)s * RPE;
    const f32x2 ckv = *(const f32x2*)(ck + d0); const f32x2 ql = *(const f32x2*)(QLATg + (size_t)s * 1024 + g * 128 + d0);
    float part = ql[0] * ckv[0] + ql[1] * ckv[1];
    if (lane < 16) { const unsigned qp = *(const unsigned*)(QB + (size_t)(MP + s) * 768 + g * QKD + 64 + d0); part += bflo(qp) * kp[d0] + bfhi(qp) * kp[d0 + 1]; }
    const float sself = wave_sum(part);
    float M = sself;
#pragma unroll
    for (int sp = 0; sp < NSPLIT; ++sp) M = fmaxf(M, DML[(((size_t)s * NSPLIT + sp) * GE + g) * 2]);
    float L = __builtin_amdgcn_exp2f(sself - M), o0 = L * ckv[0], o1 = L * ckv[1];
#pragma unroll
    for (int sp = 0; sp < NSPLIT; ++sp) { const size_t slot = ((size_t)s * NSPLIT + sp) * GE + g; const float wt = __builtin_amdgcn_exp2f(DML[slot * 2] - M);
        const f32x2 po = *(const f32x2*)(DPO + slot * 128 + d0); L = fmaf(wt, DML[slot * 2 + 1], L); o0 = fmaf(wt, po[0], o0); o1 = fmaf(wt, po[1], o1); }
    const float inv = 1.0f / L;
    LAS float* ol = lds + g * 128;
    ol[d0] = o0 * inv; ol[d0 + 1] = o1 * inv;
    asm volatile("s_waitcnt lgkmcnt(0)" ::: "memory");
    float a = 0.f;
#pragma unroll 8
    for (int cc = 0; cc < 128; ++cc) a = fmaf(ol[cc], wkvb[(size_t)cc * 1024 + g * 128 + 64 + lane], a);
    OCAT[(size_t)(MP + s) * DM + g * 64 + lane] = (bf16)f2bf(a);
    __syncthreads();
}
}
#define XB_TMO      128
#define XB_XCNT(j)  (256  + 64 * (j))
#define XB_XSUB(j)  (1280 + 64 * (j))
#define XB_XGEN(j)  (2304 + 64 * (j))
#define XB_TOP      3328
#define XB_TOPGEN   3392
#define XCD_BAR_WORDS 3456
#define XB_SPIN_CAP (1u << 18)

__device__ __forceinline__ unsigned xb_ld(unsigned* p)              { return __hip_atomic_load(p, __ATOMIC_RELAXED, __HIP_MEMORY_SCOPE_AGENT); }
__device__ __forceinline__ unsigned xb_add(unsigned* p, unsigned v) { return __hip_atomic_fetch_add(p, v, __ATOMIC_RELAXED, __HIP_MEMORY_SCOPE_AGENT); }
__device__ __forceinline__ unsigned xb_xcc_id() { return (unsigned)__builtin_amdgcn_s_getreg((3 << 11) | 20) & 0xFu; }
#define XB_SPIN(cond, bar) do { unsigned _sp = 0; while (cond) { __builtin_amdgcn_s_sleep(1); \
    if ((++_sp & 255u) == 0u) { if (xb_ld(&(bar)[XB_TMO])) break; if (_sp > XB_SPIN_CAP) { atomicAdd(&(bar)[XB_TMO], 1u); break; } } } } while (0)

struct XcdBarrier {
    unsigned* bar; unsigned x;
    volatile LAS unsigned* st;
};

__device__ __forceinline__ XcdBarrier xcd_barrier_post(unsigned* bar, volatile LAS unsigned* st) {
    XcdBarrier b; b.bar = bar; b.x = xb_xcc_id(); b.st = st;
    if (threadIdx.x == 0) (void)xb_add(&bar[XB_XCNT(b.x)], 1u);
    return b;
}
__device__ __forceinline__ void xcd_barrier_complete(unsigned* bar, unsigned x, unsigned& nloc, unsigned& nx) {
    const unsigned G = gridDim.x * gridDim.y * gridDim.z;
    unsigned sum, cnt, mine, sp = 0u;
    for (;;) {
        sum = 0u; cnt = 0u; mine = 0u;
#pragma unroll
        for (unsigned j = 0; j < 16; ++j) { const unsigned c = xb_ld(&bar[XB_XCNT(j)]); sum += c; cnt += (c > 0u) ? 1u : 0u; mine = (j == x) ? c : mine; }
        if (sum == G) break;
        __builtin_amdgcn_s_sleep(1);
        if ((++sp & 255u) == 0u) { if (xb_ld(&bar[XB_TMO])) break; if (sp > XB_SPIN_CAP) { atomicAdd(&bar[XB_TMO], 1u); break; } }
    }
    nloc = mine > 0u ? mine : 1u; nx = cnt > 0u ? cnt : 1u;
}

__device__ __forceinline__ void xcd_barrier(const XcdBarrier& b) {
    asm volatile("s_waitcnt vmcnt(0)" ::: "memory");
    __syncthreads();
    if (threadIdx.x == 0) {
        unsigned* bar = b.bar;
        __builtin_amdgcn_s_waitcnt(0);
        unsigned nloc = b.st[0], nx = b.st[1];
        if (nloc == 0u) { xcd_barrier_complete(bar, b.x, nloc, nx); b.st[0] = nloc; b.st[1] = nx; }
        const unsigned old = xb_add(&bar[XB_XSUB(b.x)], 1u);
        const unsigned gen = old / nloc;
        if (old + 1u == (gen + 1u) * nloc) {
            __builtin_amdgcn_fence(__ATOMIC_RELEASE, "agent");
            asm volatile("s_waitcnt vmcnt(0)" ::: "memory");
            const unsigned og = xb_add(&bar[XB_TOP], 1u);
            const unsigned tg = og / nx;
            if (og + 1u == (tg + 1u) * nx) xb_add(&bar[XB_TOPGEN], 1u);
            else XB_SPIN(xb_ld(&bar[XB_TOPGEN]) == tg, bar);
            __builtin_amdgcn_fence(__ATOMIC_ACQUIRE, "agent");
            xb_add(&bar[XB_XGEN(b.x)], 1u);
            asm volatile("s_waitcnt vmcnt(0)" ::: "memory");
        } else {
            XB_SPIN(xb_ld(&bar[XB_XGEN(b.x)]) == gen, bar);
            __builtin_amdgcn_fence(__ATOMIC_ACQUIRE, "agent");
            asm volatile("s_waitcnt vmcnt(0)" ::: "memory");
        }
    }
    __syncthreads();
}
constexpr int NWAVES = 8, NPHASE = 13;
struct Args {
    const float *x_prompt, *x_sample, *cache_ckv, *cache_kpe, *state_ret; const int* page_table; const float *p_prompt, *p_sample;
    const float *ffn1_norm, *ffn1_w_gate, *ffn1_w_up, *ffn1_w_down, *mix_norm, *w_in, *q_a_norm, *w_q_b, *kv_a_norm, *w_kv_b, *ret_norm, *w_branch_att, *w_branch_ret, *w_out;
    const float *ffn2_norm, *ffn2_w_gate, *ffn2_w_up, *ffn2_w_down, *ple_norm, *w_ple_gate, *w_ple_proj, *final_norm;
    float* out; unsigned char* ws; int ph_lo, ph_hi;
};
static_assert(sizeof(Args) == 32 * 8 + 8, "Args has no padding holes");

enum { RM_ID = 0, RM_GATE, RM_UP, RM_WIN, RM_QB, RM_KVB };
__device__ __forceinline__ int rowmap(int kind, int n) {
    switch (kind) {
    case RM_GATE: return (n >> 7) * 256 + (n & 127);
    case RM_UP:   return (n >> 7) * 256 + 128 + (n & 127);
    case RM_WIN: {
        if (n < 384) return n;
        if (n < 416) { const int j = n - 384, jj = j & 15; return 384 + 8 * (jj >> 2) + 4 * (j >> 4) + (jj & 3); }
        if (n < 1440) { const bool isk = n >= 928; const int j = n - (isk ? 928 : 416), hh = j >> 7, d = j & 127, i = d & 63, n_ = d >> 6;
            return (isk ? 1024 : 512) + hh * 128 + 32 * (i >> 4) + 8 * ((i >> 2) & 3) + 4 * n_ + (i & 3); }
        if (n < 1952) return 1536 + (n - 1440);
        if (n < 2464) return 2048 + (n - 1952);
        if (n < 3488) return 2560 + (n - 2464);
        return 3584 + (n - 3488); }
    case RM_QB: { const int hh = n / 96, d = n % 96; if (d < 64) return hh * 64 + d; const int j = d - 64, jj = j & 15; return 512 + hh * 32 + 8 * (jj >> 2) + 4 * (j >> 4) + (jj & 3); }
    case RM_KVB: { const int hh = n >> 7, d = n & 127; return d < 64 ? hh * 64 + d : 512 + hh * 64 + (d - 64); }
    default: return n; }
}
__device__ __forceinline__ void tr_item2(const float* W, int N, bf16* WT, int Kd, int koff, const float* gain, float scale, int kind, LAS float* scr, int item, int lane) {
    const int nblk = N / 32, kb = item / nblk, nb = item % nblk, k0 = 128 * kb, n0 = 32 * nb, kr = lane >> 3, n4 = (lane & 7) * 4, c = lane & 7;
    pg8::f32x4 v[16];
#pragma unroll
    for (int i = 0; i < 16; ++i) v[i] = *(const pg8::f32x4*)(W + (size_t)(k0 + 8 * i + kr) * N + n0 + n4);
#pragma unroll
    for (int h = 0; h < 2; ++h) {
#pragma unroll
        for (int i = 0; i < 8; ++i) { const int kk = 8 * i + kr; const float g = gain ? gain[k0 + 64 * h + kk] * scale : scale; LAS float* d = scr + kk * 33 + n4;
            d[0] = v[8 * h + i][0] * g; d[1] = v[8 * h + i][1] * g; d[2] = v[8 * h + i][2] * g; d[3] = v[8 * h + i][3] * g; }
        LDS_WAIT(); asm volatile("" ::: "memory");
#pragma unroll
        for (int q = 0; q < 4; ++q) { const int n = (lane >> 3) + 8 * q; const LAS float* s = scr + (8 * c) * 33 + n;
            v4u o; o.x = pk2(s[0 * 33], s[1 * 33]); o.y = pk2(s[2 * 33], s[3 * 33]); o.z = pk2(s[4 * 33], s[5 * 33]); o.w = pk2(s[6 * 33], s[7 * 33]);
            *(GAS v4u*)(WT + (size_t)rowmap(kind, n0 + n) * Kd + koff + k0 + 64 * h + 8 * c) = o; }
        LDS_WAIT(); asm volatile("" ::: "memory"); }
}
__device__ __forceinline__ void sincos_d(double a, float& c, float& s) {
    const double k = __builtin_rint(a * 0.63661977236758134308);
    double r = __builtin_fma(-k, 1.5707963267948966, a); r = __builtin_fma(-k, 6.123233995736766e-17, r);
    const double r2 = r * r;
    const double sp = r * (1.0 + r2 * (-1.0 / 6 + r2 * (1.0 / 120 + r2 * (-1.0 / 5040 + r2 * (1.0 / 362880 + r2 * (-1.0 / 39916800 + r2 * (1.0 / 6227020800.0)))))));
    const double cp = 1.0 + r2 * (-0.5 + r2 * (1.0 / 24 + r2 * (-1.0 / 720 + r2 * (1.0 / 40320 + r2 * (-1.0 / 3628800 + r2 * (1.0 / 479001600.0 + r2 * (-1.0 / 87178291200.0)))))));
    const int q = (int)((long long)k & 3);
    const double cc = q == 0 ? cp : q == 1 ? -sp : q == 2 ? -cp : sp, ss = q == 0 ? sp : q == 1 ? cp : q == 2 ? -sp : -cp;
    c = (float)cc; s = (float)ss;
}

struct Frame {
    LAS unsigned char* lds; volatile LAS unsigned* MISC; gu32* ctl; int tid, lane, wave, G, bid;
};

__device__ __forceinline__ void p0_prologue(const Args& a, Frame& F) {
    unsigned char* ws = a.ws;
    LAS float* scr = (LAS float*)(F.lds + F.wave * 16384);
    const int gw = F.bid * NWAVES + F.wave, NGW = F.G * NWAVES;
    constexpr int I_FF = 8 * 88, I_DN = 22 * 32, I_IN = 8 * 141, I_QB = 2 * 24, I_KVB = 1 * 32, I_BR = 4 * 32, I_SQ = 8 * 32, I_PP = 2 * 32;
    constexpr int NITEMS = 4 * I_FF + 2 * I_DN + I_IN + I_QB + I_KVB + 2 * I_BR + 2 * I_SQ + I_PP;
#ifndef REP_P0A
#define REP_P0A 1
#define REP_P0B 1
#endif
    for (int rpa_ = 0; rpa_ < REP_P0A; ++rpa_)
    for (int it = gw; it < NITEMS; it += NGW) {
        int r = it;
        if (r < I_FF) { tr_item2(a.ffn1_w_gate, DFF, (bf16*)(ws + WS_WGU1), DM, 0, nullptr, 1.f, RM_GATE, scr, r, F.lane); continue; } r -= I_FF;
        if (r < I_FF) { tr_item2(a.ffn1_w_up, DFF, (bf16*)(ws + WS_WGU1), DM, 0, nullptr, 1.f, RM_UP, scr, r, F.lane); continue; } r -= I_FF;
        if (r < I_FF) { tr_item2(a.ffn2_w_gate, DFF, (bf16*)(ws + WS_WGU2), DM, 0, a.ffn2_norm, 1.f, RM_GATE, scr, r, F.lane); continue; } r -= I_FF;
        if (r < I_FF) { tr_item2(a.ffn2_w_up, DFF, (bf16*)(ws + WS_WGU2), DM, 0, a.ffn2_norm, 1.f, RM_UP, scr, r, F.lane); continue; } r -= I_FF;
        if (r < I_DN) { tr_item2(a.ffn1_w_down, DM, (bf16*)(ws + WS_WD1), DFF, 0, nullptr, 1.f, RM_ID, scr, r, F.lane); continue; } r -= I_DN;
        if (r < I_DN) { tr_item2(a.ffn2_w_down, DM, (bf16*)(ws + WS_WD2), DFF, 0, nullptr, 1.f, RM_ID, scr, r, F.lane); continue; } r -= I_DN;
        if (r < I_IN) { tr_item2(a.w_in, 4512, (bf16*)(ws + WS_WIN), DM, 0, a.mix_norm, 1.f, RM_WIN, scr, r, F.lane); continue; } r -= I_IN;
        if (r < I_QB) { tr_item2(a.w_q_b, 768, (bf16*)(ws + WS_WQB), QL, 0, a.q_a_norm, C2, RM_QB, scr, r, F.lane); continue; } r -= I_QB;
        if (r < I_KVB) { tr_item2(a.w_kv_b, 1024, (bf16*)(ws + WS_WKVB), KVL, 0, a.kv_a_norm, 1.f, RM_KVB, scr, r, F.lane); continue; } r -= I_KVB;
        if (r < I_BR) { tr_item2(a.w_branch_att, DM, (bf16*)(ws + WS_WBC), DM, 0, nullptr, 1.f, RM_ID, scr, r, F.lane); continue; } r -= I_BR;
        if (r < I_BR) { tr_item2(a.w_branch_ret, DM, (bf16*)(ws + WS_WBC), DM, 512, nullptr, 1.f, RM_ID, scr, r, F.lane); continue; } r -= I_BR;
        if (r < I_SQ) { tr_item2(a.w_out, DM, (bf16*)(ws + WS_WOUT), DM, 0, nullptr, 1.f, RM_ID, scr, r, F.lane); continue; } r -= I_SQ;
        if (r < I_SQ) { tr_item2(a.w_ple_gate, DM, (bf16*)(ws + WS_WPG), DM, 0, a.ple_norm, 1.f, RM_ID, scr, r, F.lane); continue; } r -= I_SQ;
        tr_item2(a.w_ple_proj, DM, (bf16*)(ws + WS_WPP), PLE, 0, nullptr, 1.f, RM_ID, scr, r, F.lane);
    }
    const int gt = F.bid * (NWAVES * 64) + F.tid, NGT = F.G * NWAVES * 64;
    for (int i = gt; i < 96 * 128; i += NGT) *(v4u*)((bf16*)(ws + WS_WIN) + (size_t)416 * DM + (size_t)i * 8) = (v4u){0u, 0u, 0u, 0u};
    for (int i = gt; i < 8193 * 64; i += NGT) { const int pi = i >> 6, fi = i & 63; double inv = 1.0; for (int k = 0; k < fi; ++k) inv *= 0.8659643233600653;
        float c, s; sincos_d((double)(pi == 8192 ? 16384 : pi) * inv, c, s); ((float2*)(ws + WS_ROPE))[i] = make_float2(c, s); }
    for (int rpb_ = 0; rpb_ < REP_P0B; ++rpb_)
    for (int m = gw; m < MT; m += NGW) {
        bf16* orow = (bf16*)(ws + WS_XN1) + (size_t)m * DM; bf16* prow = (bf16*)(ws + WS_PB) + (size_t)m * PLE;
        if (m >= MP + MS) {
#pragma unroll
            for (int j = 0; j < 4; ++j) ((unsigned long long*)orow)[F.lane + 64 * j] = 0ull;
            ((unsigned long long*)prow)[F.lane] = 0ull; continue; }
        const float* xrow = m < MP ? a.x_prompt + (size_t)m * DM : a.x_sample + (size_t)(m - MP) * DM;
        const float* pr = m < MP ? a.p_prompt + (size_t)m * PLE : a.p_sample + (size_t)(m - MP) * PLE;
        const pg8::f32x4* xr = (const pg8::f32x4*)xrow + F.lane; pg8::f32x4 v[4]; float s = 0.f;
#pragma unroll
        for (int j = 0; j < 4; ++j) { v[j] = xr[64 * j]; s += (v[j].x * v[j].x + v[j].y * v[j].y) + (v[j].z * v[j].z + v[j].w * v[j].w); }
        const float rstd = 1.0f / sqrtf(wave_sum(s) * (1.f / DM) + EPS);
#pragma unroll
        for (int j = 0; j < 4; ++j) { const pg8::f32x4 g = ((const pg8::f32x4*)a.ffn1_norm)[F.lane + 64 * j];
            ((unsigned long long*)orow)[F.lane + 64 * j] = (unsigned long long)pk2(v[j].x * rstd * g.x, v[j].y * rstd * g.y) | ((unsigned long long)pk2(v[j].z * rstd * g.z, v[j].w * rstd * g.w) << 32); }
        const pg8::f32x4 pv = ((const pg8::f32x4*)pr)[F.lane];
        ((unsigned long long*)prow)[F.lane] = (unsigned long long)pk2(pv.x, pv.y) | ((unsigned long long)pk2(pv.z, pv.w) << 32);
    }
}

__global__ void __launch_bounds__(NWAVES * 64, 2) mk_fwd(Args args) {
    extern __shared__ __attribute__((aligned(16))) unsigned char lds[];
    Frame F;
    F.lds = (LAS unsigned char*)lds; F.MISC = (volatile LAS unsigned*)(F.lds + MISC_OFF);
    F.tid = threadIdx.x; F.lane = F.tid & 63; F.wave = __builtin_amdgcn_readfirstlane(F.tid >> 6); F.G = gridDim.x; F.bid = blockIdx.x;
    unsigned char* ws = args.ws;
    F.ctl = (gu32*)(ws + WS_CTL);
    for (int u = F.tid; u < (LDS_BYTES - LDSCTL_OFF) / 4; u += NWAVES * 64) ((LAS unsigned*)(F.lds + LDSCTL_OFF))[u] = 0u;
    __syncthreads();
    XcdBarrier bar; bar.bar = (unsigned*)(ws + WS_CTL) + CW_BAR; bar.x = 0; bar.st = nullptr;
    if (!MK_PER_PHASE) bar = xcd_barrier_post((unsigned*)(ws + WS_CTL) + CW_BAR, F.MISC + 8);
    const int lo = args.ph_lo, hi = args.ph_hi;
#ifndef PHASE_MASK
#define PHASE_MASK 0xFFFF
#endif
#define IN(k) (((PHASE_MASK >> (k)) & 1) && lo <= (k) && (k) < hi)
#ifndef REP_PHASE
#define REP_PHASE -1
#endif
#define REPK(k) ((k) == REP_PHASE ? 2 : 1)
#define SEAM(k) do { if (IN(k) && IN((k) + 1)) { if (MK_PER_PHASE) { if (F.tid == 0) __hip_atomic_store(F.ctl + CW_TMO, 0xBADBA0u, RLX_AGENT); } else xcd_barrier(bar); } } while (0)
    float* ssq_h1 = (float*)(ws + WS_SSQ); float* ssq_h2 = (float*)(ws + WS_SSQ + SSQ16_BYTES); float* ssq_h3 = (float*)(ws + WS_SSQ + 2 * SSQ16_BYTES); float* ssq_h4 = (float*)(ws + WS_SSQ + 3 * SSQ16_BYTES);
    float* ssq_cq = (float*)(ws + WS_SSQ + 4 * SSQ16_BYTES); float* ssq_kv = (float*)(ws + WS_SSQ + 4 * SSQ16_BYTES + SSQ4_BYTES);
    const float2* rope = (const float2*)(ws + WS_ROPE);
    bf16 *XN1 = (bf16*)(ws + WS_XN1), *ACT = (bf16*)(ws + WS_ACT), *H1B = (bf16*)(ws + WS_H1B), *CQB = (bf16*)(ws + WS_CQB), *CKVB = (bf16*)(ws + WS_CKVB), *KPEB = (bf16*)(ws + WS_KPEB);
    bf16 *QR = (bf16*)(ws + WS_QR), *KR = (bf16*)(ws + WS_KR), *RV = (bf16*)(ws + WS_RV), *RGS = (bf16*)(ws + WS_RGS), *SGA = (bf16*)(ws + WS_SGA), *SGR = (bf16*)(ws + WS_SGR);
    bf16 *QB = (bf16*)(ws + WS_QB), *KN = (bf16*)(ws + WS_KN), *VB = (bf16*)(ws + WS_VB), *OCAT = (bf16*)(ws + WS_OCAT), *SC = (bf16*)(ws + WS_SC), *MRG = (bf16*)(ws + WS_MRG);
    bf16 *H2B = (bf16*)(ws + WS_H2B), *H3B = (bf16*)(ws + WS_H3B), *PB = (bf16*)(ws + WS_PB), *PP = (bf16*)(ws + WS_PP);
    bf16* H4B = (bf16*)(ws + WS_H4); float *CKVF = (float*)(ws + WS_CKVF), *KVC = (float*)(ws + WS_KVC);
    float *DPO = (float*)(ws + WS_DPO), *DML = (float*)(ws + WS_DML), *QLAT = (float*)(ws + WS_QLAT);
    const int gt = F.bid * (NWAVES * 64) + F.tid, NGT = F.G * NWAVES * 64, gw = F.bid * NWAVES + F.wave, NGW = F.G * NWAVES;

    for (int rp_ = 0; rp_ < REPK(0); ++rp_) if (IN(0)) { p0_prologue(args, F); }
    SEAM(0);
    for (int rp_ = 0; rp_ < REPK(1); ++rp_) if (IN(1)) { pg8::Gemm g{XN1, (const bf16*)(ws + WS_WGU1), MT, NGU, DM}; pg8::StaticOrder S; S.init(MT, NGU, F.G, F.bid);
        pg8::EpiSwiGLU E{0, ACT, nullptr}; pg8::gemm_phase<pg8::EpiSwiGLU, pg8::StaticOrder, true, true>(F.lds, g, S, E);
        constexpr int NB6 = (MT / 256) * (NGU / 256) - 5 * 256;
        (void)NB6; }
    SEAM(1);
    for (int rp_ = 0; rp_ < REPK(2); ++rp_) if (IN(2)) { pg8::Gemm g{ACT, (const bf16*)(ws + WS_WD1), MP, DM, DFF}; pg8::StaticOrder S; S.init(MP, DM, F.G, F.bid);
        pg8::EpiResid<true, true> E{0, args.x_prompt, H1B, ssq_h1}; pg8::gemm_phase<pg8::EpiResid<true, true>, pg8::StaticOrder, true, true>(F.lds, g, S, E);
        for (int u = F.bid; u < 128; u += F.G) sk::skinny_unit<DFF, false, true>(u, ACT, (const bf16*)(ws + WS_WD1), ssq_h1, (LAS float*)F.lds, sk::SkResidX{args.x_sample, H1B}); }
    SEAM(2);
    for (int rp_ = 0; rp_ < REPK(3); ++rp_) if (IN(3)) { pg8::Gemm g{H1B, (const bf16*)(ws + WS_WIN), MT, NIN, DM}; pg8::StaticOrder S; S.init(MT, NIN, F.G, F.bid);
        pg8::EpiWin E{0, ssq_h1, ssq_cq, ssq_kv, rope, args.out, CQB, CKVB, KPEB, QR, KR, RV, RGS, SGA, SGR, CKVF};
        pg8::gemm_phase<pg8::EpiWin, pg8::StaticOrder, true, true>(F.lds, g, S, E);
        constexpr int NB5 = (MT / 256) * (NIN / 256) - 4 * 256; const int ng = (F.G == 256) ? 256 - NB5 : F.G, cg = (F.G == 256) ? F.bid - NB5 : F.bid;
        if (cg >= 0) { pg8::Gemm g2{PB, (const bf16*)(ws + WS_WPP), MP, DM, PLE}; pg8::StaticOrder S2; S2.init(MP, DM, ng, cg);
          pg8::EpiPlain E2{0, PP, PP, DM, 4, nullptr, 0.f}; pg8::gemm_phase<pg8::EpiPlain, pg8::StaticOrder, true, true>(F.lds, g2, S2, E2);
          for (int u = cg; u < 128; u += ng) sk::skinny_unit<PLE, false, false>(u, PB, (const bf16*)(ws + WS_WPP), nullptr, (LAS float*)F.lds, sk::SkPlain{PP}); } }
    SEAM(3);
    for (int rp_ = 0; rp_ < REPK(4); ++rp_) if (IN(4)) {
#ifndef P4_MASK
#define P4_MASK 31
#endif
        if (P4_MASK & 1) { pg8::Gemm g{CQB, (const bf16*)(ws + WS_WQB), MT, 768, QL}; pg8::StaticOrder S; S.init(MT, 768, F.G, F.bid);
          pg8::EpiQB E{0, ssq_cq, rope, QB}; pg8::gemm_phase<pg8::EpiQB, pg8::StaticOrder, true, true>(F.lds, g, S, E); }
        if (P4_MASK & 2) { pg8::Gemm g{CKVB, (const bf16*)(ws + WS_WKVB), MP, DM, KVL}; pg8::StaticOrder S; S.init(MP, DM, F.G, F.bid);
          pg8::EpiPlain E{0, KN, VB, 512, 2, ssq_kv, 1.0f / KVL}; pg8::gemm_phase<pg8::EpiPlain, pg8::StaticOrder, true, true>(F.lds, g, S, E); }
        if (P4_MASK & 8) for (int i = gt; i < (MP + MS) * 32; i += NGT) { const int row = i >> 5, c4 = (i & 31) * 4; const float rs = pg8::rstd_of<4>(ssq_kv, row, 1.0f / KVL);
            const pg8::f32x4 v = *(const pg8::f32x4*)(CKVF + (size_t)row * KVL + c4), g = *(const pg8::f32x4*)(args.kv_a_norm + c4);
            float* o = row < MP ? args.out + O_CKVP + (size_t)row * KVL : args.out + O_CKVS + (size_t)(row - MP) * KVL;
            *(pg8::f32x4*)(o + c4) = v * rs * g; }
        if (P4_MASK & 16) for (int u = F.bid; u < 512; u += F.G) ret::kv_unit(u, KR, RV, KVC, F.lds);
    }
    SEAM(4);
    for (int rp_ = 0; rp_ < REPK(5); ++rp_) if (IN(5)) {
#ifndef P5_MASK
#define P5_MASK 7
#endif
        { volatile LAS unsigned* cntA = F.MISC + 16; volatile LAS unsigned* cntD = F.MISC + 17; volatile LAS unsigned* nextw = F.MISC + 18; unsigned genA = cntA[0], genD = cntD[0];
          __syncthreads();
#ifdef PROBE_T
          unsigned long long t0_ = __builtin_amdgcn_s_memrealtime();
#endif
          for (int v = F.bid; v < 256; v += F.G) {
            const int s = v >> 1, sg = v & 1; const bool teamA = F.wave < 4; const int w4 = F.wave & 3;
            { const int bh = v >> 4, j = v & 15;
              if (teamA) {
                __builtin_amdgcn_s_setprio(3);
                att::attn_half_unit(bh >> 3, bh & 7, 63 - 2 * j, QB, KN, KPEB, VB, OCAT, (char*)lds, cntA, genA);
                att::attn_half_unit(bh >> 3, bh & 7, 2 * j + 1, QB, KN, KPEB, VB, OCAT, (char*)lds, cntA, genA);
                att::attn_half_unit(bh >> 3, bh & 7, 2 * j, QB, KN, KPEB, VB, OCAT, (char*)lds, cntA, genA);
                att::attn_half_unit(bh >> 3, bh & 7, 62 - 2 * j, QB, KN, KPEB, VB, OCAT, (char*)lds, cntA, genA);
                __builtin_amdgcn_s_setprio(0);
              } }
            { volatile LAS unsigned* cnt = teamA ? cntA : cntD; unsigned gen = teamA ? genA : genD; volatile LAS unsigned* bw = F.MISC + (teamA ? 20 : 21);
              LAS unsigned char* tl = F.lds + (teamA ? 0 : dec::D_BASE);
              if (!teamA) ret::scan_items(v * 256 + (F.tid - 256), F.G * 256, KVC, SC, args.out);
              if (!teamA) { for (int u = 2 * v; u < 2 * v + 2; ++u) ret::sample_unit4(u, w4, F.lane, QR, KR, RV, RGS, args.ret_norm, args.state_ret, args.out, OCAT, (LAS float*)tl, cnt, gen); }
              dec::qlat_token4(s, w4, F.lane, QB, args.w_kv_b, (LAS float*)(tl + dec::M4_QL), QLAT, sg == 0 && !teamA);
              for (;;) {
                  if (w4 == 0 && F.lane == 0) bw[0] = __hip_atomic_fetch_add((LAS unsigned*)nextw, 1u, __ATOMIC_RELAXED, __HIP_MEMORY_SCOPE_WORKGROUP);
                  asm volatile("s_waitcnt lgkmcnt(0)" ::: "memory"); att::bar4(cnt, gen, F.lane);
                  const int it = (int)bw[0];
                  if (it >= 8) break;
                  dec::split_unit4m(s, sg * 8 + it, w4, F.lane, QB, args.cache_ckv, args.cache_kpe, args.page_table, DPO, DML, tl, cnt, gen);
              }
              if (teamA) genA = gen; else genD = gen; }
          }
#ifdef PROBE_T
          { const unsigned long long t1_ = __builtin_amdgcn_s_memrealtime(); if (F.bid == PROBE_BLK && F.lane == 0 && F.wave == PROBE_T) ((volatile unsigned*)(ws + WS_CTL))[2] = (unsigned)(t1_ - t0_); }
#endif
          __syncthreads(); }
    }
    SEAM(5);
    for (int rp_ = 0; rp_ < REPK(6); ++rp_) if (IN(6)) {
        for (int u = F.bid; u < 512; u += F.G) ret::out_unit(u, QR, KR, RV, SC, RGS, args.ret_norm, OCAT, F.lds);
        for (int s = F.bid; s < MS; s += F.G) dec::combine_unit(s, QB, QLAT, DPO, DML, args.out, args.w_kv_b, OCAT, (LAS float*)F.lds);
    }
    SEAM(6);
    for (int rp_ = 0; rp_ < REPK(7); ++rp_) if (IN(7)) { pg8::Gemm g{OCAT, (const bf16*)(ws + WS_WBC), MP, DM, DM}; pg8::StaticOrder S; S.init(MP, DM, F.G, F.bid);
        pg8::EpiMerge E{8, SGA, SGR, MRG}; pg8::gemm_phase<pg8::EpiMerge, pg8::StaticOrder, true, true>(F.lds, g, S, E);
        for (int u = F.bid; u < 128; u += F.G) sk::skinny_unit<DM, true, false>(u, OCAT, (const bf16*)(ws + WS_WBC), nullptr, (LAS float*)F.lds, sk::SkMerge{SGA, SGR, MRG}); }
    SEAM(7);
    for (int rp_ = 0; rp_ < REPK(8); ++rp_) if (IN(8)) { pg8::Gemm g{MRG, (const bf16*)(ws + WS_WOUT), MP, DM, DM}; pg8::StaticOrder S; S.init(MP, DM, F.G, F.bid);
        pg8::EpiResid<false, false> E{0, H1B, H2B, ssq_h2}; pg8::gemm_phase<pg8::EpiResid<false, false>, pg8::StaticOrder, true, true>(F.lds, g, S, E);
        for (int u = F.bid; u < 128; u += F.G) sk::skinny_unit<DM, false, true>(u, MRG, (const bf16*)(ws + WS_WOUT), ssq_h2, (LAS float*)F.lds, sk::SkResid{H1B, 1.0f, H2B}); }
    SEAM(8);
    for (int rp_ = 0; rp_ < REPK(9); ++rp_) if (IN(9)) { pg8::Gemm g{H2B, (const bf16*)(ws + WS_WGU2), MT, NGU, DM}; pg8::StaticOrder S; S.init(MT, NGU, F.G, F.bid);
        pg8::EpiSwiGLU E{0, ACT, ssq_h2}; pg8::gemm_phase<pg8::EpiSwiGLU, pg8::StaticOrder, true, true>(F.lds, g, S, E); }
    SEAM(9);
    for (int rp_ = 0; rp_ < REPK(10); ++rp_) if (IN(10)) { pg8::Gemm g{ACT, (const bf16*)(ws + WS_WD2), MP, DM, DFF}; pg8::StaticOrder S; S.init(MP, DM, F.G, F.bid);
        pg8::EpiResid<true, false> E{0, H2B, H3B, ssq_h3}; pg8::gemm_phase<pg8::EpiResid<true, false>, pg8::StaticOrder, true, true>(F.lds, g, S, E);
        for (int u = F.bid; u < 128; u += F.G) sk::skinny_unit<DFF, false, true>(u, ACT, (const bf16*)(ws + WS_WD2), ssq_h3, (LAS float*)F.lds, sk::SkResid{H2B, 0.5f, H3B}); }
    SEAM(10);
    for (int rp_ = 0; rp_ < REPK(11); ++rp_) if (IN(11)) { pg8::Gemm g{H3B, (const bf16*)(ws + WS_WPG), MP, DM, DM}; pg8::StaticOrder S; S.init(MP, DM, F.G, F.bid);
        pg8::EpiPle E{0, H3B, PP, ssq_h3, H4B, ssq_h4}; pg8::gemm_phase<pg8::EpiPle, pg8::StaticOrder, true, true>(F.lds, g, S, E);
        for (int u = F.bid; u < 128; u += F.G) sk::skinny_unit<DM, false, true>(u, H3B, (const bf16*)(ws + WS_WPG), ssq_h4, (LAS float*)F.lds, sk::SkPle{H3B, PP, ssq_h3, H4B}); }
    SEAM(11);
    for (int rp_ = 0; rp_ < REPK(12); ++rp_) if (IN(12)) {
        for (int m = gw; m < MP + MS; m += NGW) { const float rs = pg8::rstd_of<16>(ssq_h4, m, 1.0f / DM);
            const unsigned long long* hr = (const unsigned long long*)(H4B + (size_t)m * DM) + F.lane; pg8::f32x4* o = (pg8::f32x4*)(args.out + (m < MP ? O_YP + (size_t)m * DM : O_YS + (size_t)(m - MP) * DM)) + F.lane;
#pragma unroll
            for (int j = 0; j < 4; ++j) { const unsigned long long w = hr[64 * j]; const unsigned lo = (unsigned)w, hi = (unsigned)(w >> 32);
                o[64 * j] = (pg8::f32x4){bflo(lo), bfhi(lo), bflo(hi), bfhi(hi)} * rs * ((const pg8::f32x4*)args.final_norm)[F.lane + 64 * j]; } }
#ifdef PROBE_T
        VM_WAIT(); if (F.bid == 0 && F.wave == 0 && F.lane == 0) args.out[O_YS + 5] = 2.0f * __builtin_rintf(0.01f * (float)((volatile unsigned*)(ws + WS_CTL))[2] * (1.0f / 20.0f));
#endif
    }
#undef IN
#undef SEAM
}

#ifdef DBG_LAST
__global__ void dbg_dump(const unsigned char* ws, float* out) {
    const size_t n = (size_t)MP * DM;
    for (size_t i = (size_t)blockIdx.x * blockDim.x + threadIdx.x; i < n; i += (size_t)gridDim.x * blockDim.x) { const size_t r = i >> 10, c = i & 1023; float v = 0.f;
        if (c < DBG_NCOLS) { if (DBG_F32) v = ((const float*)(ws + DBG_SRC))[r * DBG_PITCH + c]; else v = bf2f(((const bf16*)(ws + DBG_SRC))[r * DBG_PITCH + c]); }
#ifdef DBG_SRC2
        else v = bf2f(((const bf16*)(ws + DBG_SRC2))[r * DBG_PITCH + (c - DBG_NCOLS)]);
#endif
        out[i] = v; }
}
#endif
extern "C" void kernel_launch(void* const* d_in, const int* in_sizes, int n_in, void* d_out, int out_size, void* d_ws, size_t ws_size, hipStream_t stream) {
    static int grid = 0;
    if (grid == 0) {
        if (n_in != 30 || out_size != (int)O_END || ws_size < WS_END) { fprintf(stderr, "kernel_launch: built for 30 inputs, %zu outputs, >= %zu bytes of workspace; got n_in %d, out %d, ws %zu; nothing launched\n", (size_t)O_END, (size_t)WS_END, n_in, out_size, ws_size); grid = -1; return; }
        int dev = 0, cus = 0, per_cu = 0;
        if (hipGetDevice(&dev) != hipSuccess || hipDeviceGetAttribute(&cus, hipDeviceAttributeMultiprocessorCount, dev) != hipSuccess) { fprintf(stderr, "kernel_launch: device query failed\n"); grid = -1; return; }
        if (hipFuncSetAttribute((const void*)mk_fwd, hipFuncAttributeMaxDynamicSharedMemorySize, LDS_BYTES) != hipSuccess) { fprintf(stderr, "kernel_launch: hipFuncSetAttribute failed\n"); grid = -1; return; }
        if (hipOccupancyMaxActiveBlocksPerMultiprocessor(&per_cu, (const void*)mk_fwd, NWAVES * 64, LDS_BYTES) != hipSuccess || per_cu < 1)
            fprintf(stderr, "kernel_launch: note: occupancy query reports %d workgroups per CU\n", per_cu);
        (void)hipGetLastError();
        grid = cus;
    }
    if (grid < 0) return;
    if (hipMemsetAsync((char*)d_ws + WS_CTL, 0, CTL_ZERO_BYTES, stream) != hipSuccess) { fprintf(stderr, "kernel_launch: memset failed\n"); return; }
    Args a{};
    const float** fp = (const float**)&a;
    for (int i = 0; i < 30; ++i) fp[i] = (const float*)d_in[i];
    a.out = (float*)d_out; a.ws = (unsigned char*)d_ws;
#if MK_PER_PHASE
#ifdef DBG_LAST
    for (int k = 0; k <= DBG_LAST; ++k) { a.ph_lo = k; a.ph_hi = k + 1; hipLaunchKernelGGL(mk_fwd, dim3(grid), dim3(NWAVES * 64), LDS_BYTES, stream, a); }
    hipLaunchKernelGGL(dbg_dump, dim3(1024), dim3(256), 0, stream, (const unsigned char*)d_ws, (float*)d_out);
#else
    for (int k = 0; k < NPHASE; ++k) { a.ph_lo = k; a.ph_hi = k + 1; hipLaunchKernelGGL(mk_fwd, dim3(grid), dim3(NWAVES * 64), LDS_BYTES, stream, a); }
#endif
#else
    a.ph_lo = 0; a.ph_hi = NPHASE; hipLaunchKernelGGL(mk_fwd, dim3(grid), dim3(NWAVES * 64), LDS_BYTES, stream, a);
#endif
    const hipError_t le = hipPeekAtLastError();
    if (le != hipSuccess) fprintf(stderr, "kernel_launch: launch failed: %s\n", hipGetErrorName(le));
}
```

```cpp
#include <hip/hip_runtime.h>
#include <cstdio>
#include <cstdint>

#ifndef MK_PER_PHASE
#define MK_PER_PHASE 0
#endif

constexpr int DM = 1024, TSEQ = 8192, MP = 16384, MS = 128, MT = 16640, NPAN = MT / 256;
constexpr int DFF = 2816, NGU = 2 * DFF, NIN = 4608, PLE = 256;
constexpr int NH = 8, QKD = 96, KVL = 128, RPE = 32, QL = 256;
constexpr int RH = 4, RDK = 128, RDV = 128;
constexpr int NPAGES = 128, PAGE = 128;
constexpr float EPS = 1e-6f;
constexpr float C2 = 0.10206207261596575f * 1.4426950408889634f;
constexpr size_t O_YP = 0, O_YS = 16777216, O_CKVP = 16908288, O_KPEP = 19005440, O_RETP = 19529728, O_CKVS = 19660800, O_KPES = 19677184, O_RETS = 19681280, O_END = 28069888;

constexpr size_t MiB = 1u << 20;
constexpr size_t al1(size_t x) { return (x + MiB - 1) & ~(MiB - 1); }
constexpr size_t WS_CTL = 0, CTL_ZERO_BYTES = 1 * MiB;
constexpr size_t WS_WGU1 = 2 * MiB;
constexpr size_t WS_WD1  = WS_WGU1 + al1((size_t)NGU * DM * 2);
constexpr size_t WS_WIN  = WS_WD1 + al1((size_t)DM * DFF * 2);
constexpr size_t WS_WQB  = WS_WIN + al1((size_t)NIN * DM * 2);
constexpr size_t WS_WKVB = WS_WQB + al1((size_t)768 * 256 * 2);
constexpr size_t WS_WBC  = WS_WKVB + al1((size_t)1024 * 128 * 2);
constexpr size_t WS_WOUT = WS_WBC + al1((size_t)DM * DM * 2);
constexpr size_t WS_WGU2 = WS_WOUT + al1((size_t)DM * DM * 2);
constexpr size_t WS_WD2  = WS_WGU2 + al1((size_t)NGU * DM * 2);
constexpr size_t WS_WPG  = WS_WD2 + al1((size_t)DM * DFF * 2);
constexpr size_t WS_WPP  = WS_WPG + al1((size_t)DM * DM * 2);
constexpr size_t WS_ROPE = WS_WPP + al1((size_t)DM * PLE * 2);
constexpr size_t WS_XN1  = WS_ROPE + al1((size_t)8193 * 64 * 8);
constexpr size_t WS_ACT  = WS_XN1 + al1((size_t)MT * DM * 2);
constexpr size_t WS_H1   = WS_ACT + al1((size_t)MT * DFF * 2);
constexpr size_t WS_H1B  = WS_H1 + al1((size_t)MT * DM * 4);
constexpr size_t WS_CQB  = WS_H1B + al1((size_t)MT * DM * 2);
constexpr size_t WS_CKVF = WS_CQB + al1((size_t)MT * 256 * 2);
constexpr size_t WS_CKVB = WS_CKVF + al1((size_t)MT * 128 * 4);
constexpr size_t WS_KPEB = WS_CKVB + al1((size_t)MT * 128 * 2);
constexpr size_t WS_QR   = WS_KPEB + al1((size_t)MT * 32 * 2);
constexpr size_t WS_KR   = WS_QR + al1((size_t)MT * 512 * 2);
constexpr size_t WS_RV   = WS_KR + al1((size_t)MT * 512 * 2);
constexpr size_t WS_RGS  = WS_RV + al1((size_t)MT * 512 * 2);
constexpr size_t WS_SGA  = WS_RGS + al1((size_t)MT * 512 * 2);
constexpr size_t WS_SGR  = WS_SGA + al1((size_t)MT * DM * 2);
constexpr size_t WS_QB   = WS_SGR + al1((size_t)MT * DM * 2);
constexpr size_t WS_KN   = WS_QB + al1((size_t)MT * 768 * 2);
constexpr size_t WS_VB   = WS_KN + al1((size_t)MP * 512 * 2);
constexpr size_t WS_OCAT = WS_VB + al1((size_t)MP * 512 * 2);
constexpr size_t WS_KVC  = WS_OCAT + al1((size_t)MT * DM * 2);
constexpr size_t WS_SC   = WS_KVC + al1((size_t)512 * 16384 * 4);
constexpr size_t WS_MRG  = WS_SC + al1((size_t)512 * 16384 * 2);
constexpr size_t WS_H2   = WS_MRG + al1((size_t)MT * DM * 2);
constexpr size_t WS_H2B  = WS_H2 + al1((size_t)MT * DM * 4);
constexpr size_t WS_H3   = WS_H2B + al1((size_t)MT * DM * 2);
constexpr size_t WS_H3B  = WS_H3 + al1((size_t)MT * DM * 4);
constexpr size_t WS_PB   = WS_H3B + al1((size_t)MT * DM * 2);
constexpr size_t WS_PP   = WS_PB + al1((size_t)MT * PLE * 2);
constexpr size_t WS_H4   = WS_PP + al1((size_t)MT * DM * 2);
constexpr size_t WS_DPO  = WS_H4 + al1((size_t)MT * DM * 4);
constexpr size_t WS_DML  = WS_DPO + al1((size_t)128 * 16 * 8 * 128 * 4);
constexpr size_t WS_QLAT = WS_DML + MiB;
constexpr size_t WS_SSQ  = WS_QLAT + MiB;
constexpr size_t SSQ16_BYTES = (size_t)MT * 16 * 4, SSQ4_BYTES = (size_t)MT * 4 * 4;
constexpr size_t WS_END  = WS_SSQ + al1(4 * SSQ16_BYTES + 2 * SSQ4_BYTES);
constexpr int CW_TMO = 0, CW_BAR = 4096;

constexpr int RING_BYTES = 131072, PH5_BYTES = 157696, LDSCTL_OFF = PH5_BYTES, MISC_OFF = LDSCTL_OFF + 320, LDS_BYTES = 163840;

#define GAS __attribute__((address_space(1)))
#define LAS __attribute__((address_space(3)))
typedef unsigned short bf16;
typedef unsigned v4u __attribute__((ext_vector_type(4)));
typedef unsigned v2u __attribute__((ext_vector_type(2)));
typedef GAS unsigned gu32;
#define RLX_AGENT __ATOMIC_RELAXED, __HIP_MEMORY_SCOPE_AGENT
#define LDS_WAIT() asm volatile("s_waitcnt lgkmcnt(0)" ::: "memory")
#define VM_WAIT() asm volatile("s_waitcnt vmcnt(0)" ::: "memory")
__device__ __forceinline__ unsigned f2bf(float f) { unsigned u = __builtin_bit_cast(unsigned, f); return (u + 0x7fffu + ((u >> 16) & 1u)) >> 16; }
__device__ __forceinline__ unsigned pk2(float lo, float hi) { return f2bf(lo) | (f2bf(hi) << 16); }
__device__ __forceinline__ float bflo(unsigned w) { return __builtin_bit_cast(float, w << 16); }
__device__ __forceinline__ float bfhi(unsigned w) { return __builtin_bit_cast(float, w & 0xffff0000u); }
__device__ __forceinline__ float bf2f(bf16 h) { return __builtin_bit_cast(float, (unsigned)h << 16); }
__device__ __forceinline__ float sigm(float x) { return __builtin_amdgcn_rcpf(1.f + __builtin_amdgcn_exp2f(-1.4426950408889634f * x)); }
__device__ __forceinline__ float wave_sum(float v) {
#pragma unroll
    for (int o = 1; o < 64; o <<= 1) v += __shfl_xor(v, o);
    return v;
}
__device__ __forceinline__ float lg2gamma(int h) { return h == 0 ? -0.04580368961312479f : h == 1 ? -0.02272007650008353f : h == 2 ? -0.011315313227834146f : -0.005646563141142063f; }
namespace pg8 {
#define PG8_LAS __attribute__((address_space(3)))
typedef unsigned short bf16_t;
typedef short bf16x8 __attribute__((ext_vector_type(8)));
typedef float f32x4 __attribute__((ext_vector_type(4)));
typedef unsigned u32x4 __attribute__((ext_vector_type(4)));
constexpr int BM = 256, BK = 64, HALF = 128, HTB = HALF * BK * 2  , STAGE_BYTES = 8 * HTB, NXCD = 8, WGM = 8;

__host__ __device__ __forceinline__ int lds_byte(int r, int c) { const int st = (r >> 4) * 2 + (c >> 5), rr = r & 15, cc = c & 31, ob = rr * 64 + cc * 2; return st * 1024 + (ob ^ (((ob >> 9) & 1) << 5)); }
__host__ __device__ __forceinline__ void stage_rc(int b, int& R, int& C) { const int st = b / 1024, sb = b % 1024, swz = sb ^ (((sb >> 9) & 1) << 5); R = (st >> 1) * 16 + swz / 64; C = (st & 1) * 32 + (swz % 64) / 2; }
__host__ __device__ __forceinline__ int perm32(int rho) { const int n = rho >> 4, i = rho & 15; return 8 * (i >> 2) + 4 * n + (i & 3); }

struct Unit { int pm, pn, idx; };
struct Gemm { const bf16_t* A; const bf16_t* Bt; int M, N, K; };

struct StaticOrder {
    int nM, nN, nwg, G, c;
    __host__ __device__ void init(int M, int N, int G_, int c_) { nM = M / BM; nN = N / BM; nwg = nM * nN; G = G_; c = c_; }
    __host__ __device__ bool next(int i, Unit& u) const {
        const long L = (long)i * G + c; if (L >= nwg) return false;
        int wgid = (int)L; { const int q = nwg / NXCD, r = nwg % NXCD, xcd = wgid % NXCD, off = wgid / NXCD; wgid = (xcd < r ? xcd * (q + 1) : r * (q + 1) + (xcd - r) * q) + off; }
        const int nig = WGM * nN, gid = wgid / nig, fm = gid * WGM, gsz = (nM - fm) < WGM ? (nM - fm) : WGM;
        u.pm = fm + ((wgid % nig) % gsz); u.pn = (wgid % nig) / gsz; u.idx = i; return true;
    }
    __device__ __forceinline__ void a_ready(const Unit&) const {}
    __device__ __forceinline__ void done(const Unit&) const {}
};

typedef float cvt_f32x2_t __attribute__((ext_vector_type(2))); typedef __bf16 cvt_bf16x2_t __attribute__((ext_vector_type(2)));
__device__ __forceinline__ unsigned cvt_pk_bf16(float lo, float hi) { cvt_f32x2_t v = {lo, hi}; cvt_bf16x2_t b = __builtin_convertvector(v, cvt_bf16x2_t); return __builtin_bit_cast(unsigned, b); }
typedef float f32x2 __attribute__((ext_vector_type(2)));
template <class Epi, class Sched, bool ALIGN_EPI = false, bool SP2 = false>
__device__ __forceinline__ void gemm_phase(PG8_LAS unsigned char* lds, const Gemm g, const Sched S, const Epi E) {
    int tid_ = threadIdx.x; asm volatile("" : "+v"(tid_));
    const int tid = tid_, wid = __builtin_amdgcn_readfirstlane(tid >> 6), lane = tid & 63, wr = wid >> 2, wc = wid & 3, fr = lane & 15, fq = lane >> 4;
    const int K = g.K, nt = K / BK;
    unsigned voffA[2], voffB[2];
#pragma unroll
    for (int i = 0; i < 2; ++i) { int R, C; stage_rc(tid * 16 + i * 8192, R, C); const int Rb = Epi::PERM ? ((R & ~31) + perm32(R & 31)) : R;
        voffA[i] = (unsigned)(R * K + C) * 2u; voffB[i] = (unsigned)(Rb * K + C) * 2u; }
    const size_t kstep = (size_t)(BK * 2);
    const size_t hstep = (size_t)HALF * K * 2;
    const size_t tstep = 2 * hstep;
    const unsigned ldsw = (unsigned)wid * 1024u;
    const int aoff = lds_byte(wr * 64 + fr, fq * 8), boff = lds_byte(wc * 32 + fr, fq * 8);
#define PG8_SA(b, h) (((b) * 2 + (h)) * HTB)
#define PG8_SB(b, h) ((4 + (b) * 2 + (h)) * HTB)
#define PG8_STAGE(bufoff, gbase, voff) do { _Pragma("unroll") for (int _i = 0; _i < 2; ++_i) \
        __builtin_amdgcn_global_load_lds((const unsigned*)((const char*)(gbase) + (voff)[_i]), (PG8_LAS unsigned*)(lds + (bufoff) + ldsw + _i * 8192), 16, 0, 0); } while (0)
#define PG8_LDA(dst, b, h) do { _Pragma("unroll") for (int m = 0; m < 4; ++m) _Pragma("unroll") for (int k = 0; k < 2; ++k) dst[m][k] = *(const PG8_LAS bf16x8*)(lds + PG8_SA(b, h) + aoff + m * 2048 + k * 1024); } while (0)
#define PG8_LDB(dst, b, h) do { _Pragma("unroll") for (int n = 0; n < 2; ++n) _Pragma("unroll") for (int k = 0; k < 2; ++k) dst[n][k] = *(const PG8_LAS bf16x8*)(lds + PG8_SB(b, h) + boff + n * 2048 + k * 1024); } while (0)
#define PG8_MMA(ai, bj, At, Bt) do { __builtin_amdgcn_s_setprio(1); _Pragma("unroll") for (int m = 0; m < 4; ++m) _Pragma("unroll") for (int n = 0; n < 2; ++n) _Pragma("unroll") for (int k = 0; k < 2; ++k) \
        acc[ai][bj][m][n] = __builtin_amdgcn_mfma_f32_16x16x32_bf16(Bt[n][k], At[m][k], acc[ai][bj][m][n], 0, 0, 0); __builtin_amdgcn_s_setprio(0); } while (0)
#define PG8_WAIT_V(n) asm volatile("s_waitcnt vmcnt(" #n ")" ::: "memory")
#define PG8_WAIT_L(n) asm volatile("s_waitcnt lgkmcnt(" #n ")" ::: "memory")
#define PG8_BAR __builtin_amdgcn_s_barrier()
#define PG8_SCHED __builtin_amdgcn_sched_barrier(0)
    Unit cur, nxt; int ui = 0;
    if (!S.next(0, cur)) return;
    f32x4 acc[2][2][4][2];
#pragma unroll
    for (int a = 0; a < 2; ++a)
#pragma unroll
        for (int b = 0; b < 2; ++b)
#pragma unroll
            for (int m = 0; m < 4; ++m)
#pragma unroll
                for (int n = 0; n < 2; ++n) acc[a][b][m][n] = (f32x4){0.f, 0.f, 0.f, 0.f};
    bf16x8 At[4][2], B0[2][2], B1[2][2];
    const char* cA = (const char*)g.A + (size_t)cur.pm * tstep; const char* cB = (const char*)g.Bt + (size_t)cur.pn * tstep;
    S.a_ready(cur);
    if constexpr (SP2) {
        PG8_STAGE(PG8_SB(0, 0), cB, voffB); PG8_STAGE(PG8_SB(0, 1), cB + hstep, voffB); PG8_STAGE(PG8_SA(0, 0), cA, voffA); PG8_STAGE(PG8_SA(0, 1), cA + hstep, voffA);
        if (wr == 1) PG8_BAR;
        PG8_WAIT_V(2); PG8_BAR;
        PG8_STAGE(PG8_SB(1, 0), cB + kstep, voffB); PG8_STAGE(PG8_SA(1, 0), cA + kstep, voffA); PG8_STAGE(PG8_SB(1, 1), cB + hstep + kstep, voffB);
        PG8_WAIT_V(6); PG8_BAR;
    } else {
        PG8_STAGE(PG8_SB(0, 0), cB, voffB); PG8_STAGE(PG8_SA(0, 0), cA, voffA); PG8_STAGE(PG8_SB(0, 1), cB + hstep, voffB); PG8_STAGE(PG8_SA(0, 1), cA + hstep, voffA);
        if (wr == 1) PG8_BAR;
        PG8_WAIT_V(4); PG8_BAR;
        PG8_STAGE(PG8_SB(1, 0), cB + kstep, voffB); PG8_STAGE(PG8_SA(1, 0), cA + kstep, voffA); PG8_STAGE(PG8_SB(1, 1), cB + hstep + kstep, voffB);
        PG8_WAIT_V(6); PG8_BAR;
    }
    for (;;) {
        const bool has_next = S.next(ui + 1, nxt);
        const char* nA = has_next ? (const char*)g.A + (size_t)nxt.pm * tstep : cA; const char* nB = has_next ? (const char*)g.Bt + (size_t)nxt.pn * tstep : cB;
#pragma nounroll
        for (int t = 0; t < nt; t += 2) {
            if constexpr (Epi::HAS_MID) { if (t == E.mid_t) E.mid(acc, cur, wr, wc, fr, fq); }
            const bool last = (t == nt - 2);
            const char* a1 = cA + (size_t)(t + 1) * kstep;
            const char* a2 = last ? nA : cA + (size_t)(t + 2) * kstep; const char* b2 = last ? nB : cB + (size_t)(t + 2) * kstep;
            const char* a3 = a2 + kstep; const char* b3 = b2 + kstep;
            if (last && has_next) S.a_ready(nxt);
            if constexpr (SP2) {
            PG8_LDB(B0, 0, 0); PG8_LDB(B1, 0, 1); PG8_SCHED; PG8_LDA(At, 0, 0); PG8_STAGE(PG8_SA(1, 1), a1 + hstep, voffA);
            PG8_WAIT_V(8); PG8_WAIT_L(0); PG8_BAR; PG8_MMA(0, 0, At, B0); PG8_MMA(0, 1, At, B1); PG8_BAR; PG8_SCHED;
            PG8_LDA(At, 0, 1); PG8_STAGE(PG8_SB(0, 0), b2, voffB); PG8_STAGE(PG8_SB(0, 1), b2 + hstep, voffB); PG8_STAGE(PG8_SA(0, 0), a2, voffA);
            PG8_WAIT_V(8); PG8_WAIT_L(0); PG8_BAR; PG8_MMA(1, 0, At, B0); PG8_MMA(1, 1, At, B1); PG8_BAR; PG8_SCHED;
            PG8_LDB(B0, 1, 0); PG8_LDB(B1, 1, 1); PG8_SCHED; PG8_LDA(At, 1, 0); PG8_STAGE(PG8_SA(0, 1), a2 + hstep, voffA);
            PG8_WAIT_V(8); PG8_WAIT_L(0); PG8_BAR; PG8_MMA(0, 0, At, B0); PG8_MMA(0, 1, At, B1); PG8_BAR; PG8_SCHED;
            PG8_LDA(At, 1, 1); PG8_STAGE(PG8_SB(1, 0), b3, voffB); PG8_STAGE(PG8_SB(1, 1), b3 + hstep, voffB); PG8_STAGE(PG8_SA(1, 0), a3, voffA);
            PG8_WAIT_V(8); PG8_WAIT_L(0); PG8_BAR; PG8_MMA(1, 0, At, B0); PG8_MMA(1, 1, At, B1); PG8_BAR; PG8_SCHED;
            } else {
            PG8_LDB(B0, 0, 0); PG8_SCHED; PG8_LDA(At, 0, 0); PG8_STAGE(PG8_SA(1, 1), a1 + hstep, voffA);
            PG8_WAIT_L(8); PG8_BAR; PG8_WAIT_L(0); PG8_MMA(0, 0, At, B0); PG8_BAR; PG8_SCHED;
            PG8_LDB(B1, 0, 1); PG8_STAGE(PG8_SB(0, 0), b2, voffB);
            PG8_BAR; PG8_WAIT_L(0); PG8_MMA(0, 1, At, B1); PG8_BAR;
            PG8_LDA(At, 0, 1); PG8_STAGE(PG8_SA(0, 0), a2, voffA);
            PG8_BAR; PG8_WAIT_L(0); PG8_MMA(1, 0, At, B0); PG8_BAR; PG8_SCHED;
            PG8_STAGE(PG8_SB(0, 1), b2 + hstep, voffB);
            PG8_WAIT_V(6); PG8_BAR; PG8_MMA(1, 1, At, B1); PG8_BAR;
            PG8_LDB(B0, 1, 0); PG8_SCHED; PG8_LDA(At, 1, 0); PG8_STAGE(PG8_SA(0, 1), a2 + hstep, voffA);
            PG8_WAIT_L(8); PG8_BAR; PG8_WAIT_L(0); PG8_MMA(0, 0, At, B0); PG8_BAR; PG8_SCHED;
            PG8_LDB(B1, 1, 1); PG8_STAGE(PG8_SB(1, 0), b3, voffB);
            PG8_BAR; PG8_WAIT_L(0); PG8_MMA(0, 1, At, B1); PG8_BAR;
            PG8_LDA(At, 1, 1); PG8_STAGE(PG8_SA(1, 0), a3, voffA);
            PG8_BAR; PG8_WAIT_L(0); PG8_MMA(1, 0, At, B0); PG8_BAR; PG8_SCHED;
            PG8_STAGE(PG8_SB(1, 1), b3 + hstep, voffB);
            PG8_WAIT_V(6); PG8_BAR; PG8_MMA(1, 1, At, B1); PG8_BAR;
            }
        }
        if constexpr (ALIGN_EPI) { if (wr == 0) PG8_BAR; }
        if constexpr (!Epi::AFTER_DRAIN) { E(acc, cur, wr, wc, fr, fq); S.done(cur); }
        if (!has_next) break;
#pragma unroll
        for (int a = 0; a < 2; ++a)
#pragma unroll
            for (int b = 0; b < 2; ++b)
#pragma unroll
                for (int m = 0; m < 4; ++m)
#pragma unroll
                    for (int n = 0; n < 2; ++n) acc[a][b][m][n] = (f32x4){0.f, 0.f, 0.f, 0.f};
        cur = nxt; cA = nA; cB = nB; ++ui;
        if constexpr (ALIGN_EPI) { if (wr == 1) PG8_BAR; }
    }
    PG8_WAIT_V(0);
    if constexpr (!ALIGN_EPI) { if (wr == 0) PG8_BAR; }
    PG8_BAR;
    if constexpr (Epi::AFTER_DRAIN) { E.fused(acc, cur, wr, wc, fr, fq, lds, wid, lane); S.done(cur); }
#undef PG8_SA
#undef PG8_SB
#undef PG8_STAGE
#undef PG8_LDA
#undef PG8_LDB
#undef PG8_MMA
#undef PG8_WAIT_V
#undef PG8_WAIT_L
#undef PG8_BAR
#undef PG8_SCHED
}
}
namespace pg8 {
#define EPI_ROWS(ai, m) (u.pm * BM + (ai) * HALF + wr * 64 + (m) * 16 + fr)
#define EPI_OPAQUE int fr = fr_, fq = fq_; asm volatile("" : "+v"(fr), "+v"(fq))
__device__ __forceinline__ u32x4 pack8(f32x4 a, f32x4 b) { u32x4 w; w.x = cvt_pk_bf16(a[0], a[1]); w.y = cvt_pk_bf16(a[2], a[3]); w.z = cvt_pk_bf16(b[0], b[1]); w.w = cvt_pk_bf16(b[2], b[3]); return w; }
__device__ __forceinline__ float sq4(f32x4 a) { return (a[0] * a[0] + a[1] * a[1]) + (a[2] * a[2] + a[3] * a[3]); }
template <int NS> __device__ __forceinline__ float rstd_of(const float* part, int row, float invn) {
    float s = 0.f;
#pragma unroll
    for (int i = 0; i < NS; i += 4) { const f32x4 v = *(const f32x4*)(part + (size_t)row * NS + i); s += (v[0] + v[1]) + (v[2] + v[3]); }
    return 1.0f / sqrtf(s * invn + EPS);
}
constexpr int RST_OFF = 131072;
template <int NS, class Sched> __device__ __forceinline__ void rst_fill(PG8_LAS unsigned char* lds, const Sched& S, const float* part, float invn, int) {
    int tid = threadIdx.x; asm volatile("" : "+v"(tid));
    PG8_LAS float* tab = (PG8_LAS float*)(lds + RST_OFF);
    for (int idx = tid; idx < 6 * 256; idx += 512) { Unit u; if (!S.next(idx >> 8, u)) break; tab[idx] = rstd_of<NS>(part, u.pm * BM + (idx & 255), invn); }
    __syncthreads();
}
#define EPI_RS(ai, m) (rst[u.idx * 256 + (ai) * HALF + wr * 64 + (m) * 16 + fr])
template <int NS> __device__ __forceinline__ void ssq_put(float* part, int row, int slot, float s, int fq) { s += __shfl_xor(s, 16); s += __shfl_xor(s, 32); if (fq == 0) part[(size_t)row * NS + slot] = s; }
__device__ __forceinline__ float silu_f(float x) { return x * sigm(x); }
__device__ __forceinline__ int pos_of_row(int row) { return row < MP ? (row & (TSEQ - 1)) : TSEQ; }

struct EpiSwiGLU {
    static constexpr bool PERM = true, AFTER_DRAIN = false, HAS_MID = false; int mid_t;
    bf16_t* O; const PG8_LAS float* rst;
    __device__ __forceinline__ void mid(f32x4 (&)[2][2][4][2], const Unit&, int, int, int, int) const {}
    __device__ __forceinline__ void operator()(const f32x4 (&acc)[2][2][4][2], const Unit& u, int wr, int wc, int fr_, int fq_) const { EPI_OPAQUE;
        const int col0 = u.pn * HALF + wc * 32 + 8 * fq;
#pragma unroll
        for (int ai = 0; ai < 2; ++ai)
#pragma unroll
            for (int m = 0; m < 4; ++m) { const int row = EPI_ROWS(ai, m); const float rs = rst ? EPI_RS(ai, m) : 1.0f;
                f32x4 o[2];
#pragma unroll
                for (int n = 0; n < 2; ++n)
#pragma unroll
                    for (int j = 0; j < 4; ++j) o[n][j] = silu_f(acc[ai][0][m][n][j] * rs) * (acc[ai][1][m][n][j] * rs);
                *(u32x4*)(O + (size_t)row * DFF + col0) = pack8(o[0], o[1]); }
    }
};

template <bool HALFA, bool XIN> struct EpiResid {
    static constexpr bool PERM = true, AFTER_DRAIN = false, HAS_MID = false; int mid_t; static constexpr float alpha = HALFA ? 0.5f : 1.0f;
    const void* R; bf16_t* Hb; float* ssq;
    __device__ __forceinline__ void mid(f32x4 (&)[2][2][4][2], const Unit&, int, int, int, int) const {}
    __device__ __forceinline__ void operator()(const f32x4 (&acc)[2][2][4][2], const Unit& u, int wr, int wc, int fr_, int fq_) const { EPI_OPAQUE;
        const int colb = u.pn * BM + wc * 32 + 8 * fq;
#pragma unroll
        for (int ai = 0; ai < 2; ++ai)
#pragma unroll
            for (int m = 0; m < 4; ++m) { const int row = EPI_ROWS(ai, m);
                float s = 0.f;
#pragma unroll
                for (int bj = 0; bj < 2; ++bj) { const int col = colb + bj * HALF; f32x4 r0, r1;
                    if (XIN) { const float* rp = (const float*)R + (size_t)row * DM + col; r0 = *(const f32x4*)rp; r1 = *(const f32x4*)(rp + 4); }
                    else { const u32x4 w = *(const u32x4*)((const bf16_t*)R + (size_t)row * DM + col); r0 = (f32x4){bflo(w[0]), bfhi(w[0]), bflo(w[1]), bfhi(w[1])}; r1 = (f32x4){bflo(w[2]), bfhi(w[2]), bflo(w[3]), bfhi(w[3])}; }
                    const f32x4 h0 = r0 + acc[ai][bj][m][0] * alpha, h1 = r1 + acc[ai][bj][m][1] * alpha;
                    *(u32x4*)(Hb + (size_t)row * DM + col) = pack8(h0, h1);
                    s += sq4(h0) + sq4(h1); }
                ssq_put<16>(ssq, row, u.pn * 4 + wc, s, fq); }
    }
};

__device__ __forceinline__ void rope4(const float2* tabrow, int i0, int istride, f32x4 x1, f32x4 x2, f32x4& y1, f32x4& y2) {
#pragma unroll
    for (int j = 0; j < 4; ++j) { const float2 cs = tabrow[(i0 + j) * istride]; y1[j] = x1[j] * cs.x - x2[j] * cs.y; y2[j] = x1[j] * cs.y + x2[j] * cs.x; }
}

struct EpiWin {
    static constexpr bool PERM = true, AFTER_DRAIN = false, HAS_MID = false; int mid_t;
    const PG8_LAS float* rst; float* ssq_cq; float* ssq_kv; const float2* rope; float* dout;
    bf16_t *CQB, *CKVB, *KPEB, *QR, *KR, *RV, *RGS, *SGA, *SGR; float* CKVF;
    __device__ __forceinline__ void mid(f32x4 (&)[2][2][4][2], const Unit&, int, int, int, int) const {}
    __device__ __forceinline__ void operator()(const f32x4 (&acc)[2][2][4][2], const Unit& u, int wr, int wc, int fr_, int fq_) const { EPI_OPAQUE;
        const int pn = u.pn, c8 = wc * 32 + 8 * fq;
#pragma unroll
        for (int ai = 0; ai < 2; ++ai)
#pragma unroll
            for (int m = 0; m < 4; ++m) { const int row = EPI_ROWS(ai, m); const float rs = EPI_RS(ai, m);
                if (pn == 0) {
                    float s = 0.f;
#pragma unroll
                    for (int bj = 0; bj < 2; ++bj) { const f32x4 a = acc[ai][bj][m][0] * rs, b = acc[ai][bj][m][1] * rs; s += sq4(a) + sq4(b);
                        *(u32x4*)(CQB + (size_t)row * QL + bj * HALF + c8) = pack8(a, b); }
                    ssq_put<4>(ssq_cq, row, wc, s, fq);
                } else if (pn == 1) {
                    { const f32x4 a = acc[ai][0][m][0] * rs, b = acc[ai][0][m][1] * rs;
                      *(f32x4*)(CKVF + (size_t)row * KVL + c8) = a; *(f32x4*)(CKVF + (size_t)row * KVL + c8 + 4) = b;
                      *(u32x4*)(CKVB + (size_t)row * KVL + c8) = pack8(a, b);
                      ssq_put<4>(ssq_kv, row, wc, sq4(a) + sq4(b), fq); }
                    if (wc == 0) { f32x4 y1, y2; rope4(rope + (size_t)pos_of_row(row) * 64, 4 * fq, 4, acc[ai][1][m][0] * rs, acc[ai][1][m][1] * rs, y1, y2);
                        float* o = row < MP ? dout + O_KPEP + (size_t)row * RPE : (row < MP + MS ? dout + O_KPES + (size_t)(row - MP) * RPE : nullptr);
                        if (o) { *(f32x4*)(o + 4 * fq) = y1; *(f32x4*)(o + 16 + 4 * fq) = y2; }
                        v2u w1, w2; w1.x = cvt_pk_bf16(y1[0], y1[1]); w1.y = cvt_pk_bf16(y1[2], y1[3]); w2.x = cvt_pk_bf16(y2[0], y2[1]); w2.y = cvt_pk_bf16(y2[2], y2[3]);
                        *(v2u*)(KPEB + (size_t)row * RPE + 4 * fq) = w1; *(v2u*)(KPEB + (size_t)row * RPE + 16 + 4 * fq) = w2; }
                } else if (pn < 6) {
                    const bool isk = pn >= 4; const int ic = row < MP ? (row & 127) : 0; const float2* tr = rope + (size_t)pos_of_row(row) * 64;
#pragma unroll
                    for (int bj = 0; bj < 2; ++bj) { const int hh = 2 * (pn - (isk ? 4 : 2)) + bj; const float lg = lg2gamma(hh) * (float)ic;
                        const float fs = rs * (isk ? __builtin_amdgcn_exp2f(-lg) * 0.08838834764831845f : __builtin_amdgcn_exp2f(lg));
                        f32x4 y1, y2; rope4(tr, 16 * wc + 4 * fq, 1, acc[ai][bj][m][0] * fs, acc[ai][bj][m][1] * fs, y1, y2);
                        bf16_t* o = (isk ? KR : QR) + (size_t)row * 512 + hh * 128 + 16 * wc + 4 * fq;
                        v2u w1, w2; w1.x = cvt_pk_bf16(y1[0], y1[1]); w1.y = cvt_pk_bf16(y1[2], y1[3]); w2.x = cvt_pk_bf16(y2[0], y2[1]); w2.y = cvt_pk_bf16(y2[2], y2[3]);
                        *(v2u*)o = w1; *(v2u*)(o + 64) = w2; }
                } else if (pn < 8) {
#pragma unroll
                    for (int bj = 0; bj < 2; ++bj) *(u32x4*)(RV + (size_t)row * 512 + (pn - 6) * BM + bj * HALF + c8) = pack8(acc[ai][bj][m][0] * rs, acc[ai][bj][m][1] * rs);
                } else if (pn < 10) {
#pragma unroll
                    for (int bj = 0; bj < 2; ++bj) { f32x4 a = acc[ai][bj][m][0] * rs, b = acc[ai][bj][m][1] * rs;
#pragma unroll
                        for (int j = 0; j < 4; ++j) { a[j] = silu_f(a[j]); b[j] = silu_f(b[j]); }
                        *(u32x4*)(RGS + (size_t)row * 512 + (pn - 8) * BM + bj * HALF + c8) = pack8(a, b); }
                } else {
                    bf16_t* base = pn < 14 ? SGA + (size_t)(pn - 10) * BM : SGR + (size_t)(pn - 14) * BM;
#pragma unroll
                    for (int bj = 0; bj < 2; ++bj) { f32x4 a = acc[ai][bj][m][0] * rs, b = acc[ai][bj][m][1] * rs;
#pragma unroll
                        for (int j = 0; j < 4; ++j) { a[j] = sigm(a[j]); b[j] = sigm(b[j]); }
                        *(u32x4*)(base + (size_t)row * DM + bj * HALF + c8) = pack8(a, b); }
                }
            }
    }
};

struct EpiQB {
    static constexpr bool PERM = true, AFTER_DRAIN = false, HAS_MID = false; int mid_t;
    const PG8_LAS float* rst; const float2* rope; bf16_t* QB;
    __device__ __forceinline__ void mid(f32x4 (&)[2][2][4][2], const Unit&, int, int, int, int) const {}
    __device__ __forceinline__ void operator()(const f32x4 (&acc)[2][2][4][2], const Unit& u, int wr, int wc, int fr_, int fq_) const { EPI_OPAQUE;
#pragma unroll
        for (int ai = 0; ai < 2; ++ai)
#pragma unroll
            for (int m = 0; m < 4; ++m) { const int row = EPI_ROWS(ai, m); const float rs = EPI_RS(ai, m);
                bf16_t* qrow = QB + (size_t)row * 768;
                if (u.pn < 2) {
#pragma unroll
                    for (int bj = 0; bj < 2; ++bj) { const int cidx = bj * HALF + wc * 32 + 8 * fq, hh = u.pn * 4 + (cidx >> 6), d = cidx & 63;
                        *(u32x4*)(qrow + hh * QKD + d) = pack8(acc[ai][bj][m][0] * rs, acc[ai][bj][m][1] * rs); }
                } else { const float2* tr = rope + (size_t)pos_of_row(row) * 64;
#pragma unroll
                    for (int bj = 0; bj < 2; ++bj) { const int hh = bj * 4 + wc; f32x4 y1, y2; rope4(tr, 4 * fq, 4, acc[ai][bj][m][0] * rs, acc[ai][bj][m][1] * rs, y1, y2);
                        v2u w1, w2; w1.x = cvt_pk_bf16(y1[0], y1[1]); w1.y = cvt_pk_bf16(y1[2], y1[3]); w2.x = cvt_pk_bf16(y2[0], y2[1]); w2.y = cvt_pk_bf16(y2[2], y2[3]);
                        *(v2u*)(qrow + hh * QKD + 64 + 4 * fq) = w1; *(v2u*)(qrow + hh * QKD + 80 + 4 * fq) = w2; }
                }
                asm volatile("" ::: "memory");
            }
    }
};

struct EpiPlain {
    static constexpr bool PERM = true, AFTER_DRAIN = false, HAS_MID = false; int mid_t;
    bf16_t* O0; bf16_t* O1; int ld; int split_tiles; const PG8_LAS float* rst;
    __device__ __forceinline__ void mid(f32x4 (&)[2][2][4][2], const Unit&, int, int, int, int) const {}
    __device__ __forceinline__ void operator()(const f32x4 (&acc)[2][2][4][2], const Unit& u, int wr, int wc, int fr_, int fq_) const { EPI_OPAQUE;
        bf16_t* base = u.pn < split_tiles ? O0 + (size_t)u.pn * BM : O1 + (size_t)(u.pn - split_tiles) * BM;
#pragma unroll
        for (int ai = 0; ai < 2; ++ai)
#pragma unroll
            for (int m = 0; m < 4; ++m) { const int row = EPI_ROWS(ai, m); const float rs = rst ? EPI_RS(ai, m) : 1.0f;
#pragma unroll
                for (int bj = 0; bj < 2; ++bj) *(u32x4*)(base + (size_t)row * ld + bj * HALF + wc * 32 + 8 * fq) = pack8(acc[ai][bj][m][0] * rs, acc[ai][bj][m][1] * rs); }
    }
};

struct EpiMerge {
    static constexpr bool PERM = true, AFTER_DRAIN = false, HAS_MID = true; int mid_t;
    const bf16_t* SGA; const bf16_t* SGR; bf16_t* O;
    __device__ __forceinline__ void mid(f32x4 (&acc)[2][2][4][2], const Unit& u, int wr, int wc, int fr_, int fq) const {
        int fr = fr_; asm volatile("" : "+v"(fr));
#pragma unroll
        for (int ai = 0; ai < 2; ++ai) { u32x4 ga[4][2], gr[4][2];
#pragma unroll
            for (int m = 0; m < 4; ++m) { const int row = EPI_ROWS(ai, m);
#pragma unroll
                for (int bj = 0; bj < 2; ++bj) { const size_t off = (size_t)row * DM + u.pn * BM + bj * HALF + wc * 32 + 8 * fq; ga[m][bj] = *(const u32x4*)(SGA + off); gr[m][bj] = *(const u32x4*)(SGR + off); } }
#pragma unroll
            for (int m = 0; m < 4; ++m)
#pragma unroll
                for (int bj = 0; bj < 2; ++bj)
#pragma unroll
                    for (int q = 0; q < 4; ++q) { const float alo = bflo(ga[m][bj][q]), ahi = bfhi(ga[m][bj][q]), rlo = fmaxf(bflo(gr[m][bj][q]), 1e-30f), rhi = fmaxf(bfhi(gr[m][bj][q]), 1e-30f);
                        acc[ai][bj][m][q >> 1][(q & 1) * 2] *= alo * __builtin_amdgcn_rcpf(rlo); acc[ai][bj][m][q >> 1][(q & 1) * 2 + 1] *= ahi * __builtin_amdgcn_rcpf(rhi); }
            asm volatile("" ::: "memory"); }
    }
    __device__ __forceinline__ void operator()(const f32x4 (&acc)[2][2][4][2], const Unit& u, int wr, int wc, int fr_, int fq_) const { EPI_OPAQUE;
#pragma unroll
        for (int ai = 0; ai < 2; ++ai)
#pragma unroll
            for (int m = 0; m < 4; ++m) { const int row = EPI_ROWS(ai, m);
#pragma unroll
                for (int bj = 0; bj < 2; ++bj) { const size_t off = (size_t)row * DM + u.pn * BM + bj * HALF + wc * 32 + 8 * fq;
                    const u32x4 r = *(const u32x4*)(SGR + off); f32x4 o0, o1;
                    o0[0] = acc[ai][bj][m][0][0] * fmaxf(bflo(r[0]), 1e-30f); o0[1] = acc[ai][bj][m][0][1] * fmaxf(bfhi(r[0]), 1e-30f);
                    o0[2] = acc[ai][bj][m][0][2] * fmaxf(bflo(r[1]), 1e-30f); o0[3] = acc[ai][bj][m][0][3] * fmaxf(bfhi(r[1]), 1e-30f);
                    o1[0] = acc[ai][bj][m][1][0] * fmaxf(bflo(r[2]), 1e-30f); o1[1] = acc[ai][bj][m][1][1] * fmaxf(bfhi(r[2]), 1e-30f);
                    o1[2] = acc[ai][bj][m][1][2] * fmaxf(bflo(r[3]), 1e-30f); o1[3] = acc[ai][bj][m][1][3] * fmaxf(bfhi(r[3]), 1e-30f);
                    *(u32x4*)(O + off) = pack8(o0, o1); } }
    }
};

struct EpiPle {
    static constexpr bool PERM = true, AFTER_DRAIN = false, HAS_MID = false; int mid_t;
    const bf16_t* H3; const bf16_t* PP; const PG8_LAS float* rst; bf16_t* H4; float* ssq4;
    __device__ __forceinline__ void mid(f32x4 (&)[2][2][4][2], const Unit&, int, int, int, int) const {}
    __device__ __forceinline__ void operator()(const f32x4 (&acc)[2][2][4][2], const Unit& u, int wr, int wc, int fr_, int fq_) const { EPI_OPAQUE;
#pragma unroll
        for (int ai = 0; ai < 2; ++ai)
#pragma unroll
            for (int m = 0; m < 4; ++m) { const int row = EPI_ROWS(ai, m); const float rs = EPI_RS(ai, m); float s = 0.f;
#pragma unroll
                for (int bj = 0; bj < 2; ++bj) { const size_t off = (size_t)row * DM + u.pn * BM + bj * HALF + wc * 32 + 8 * fq;
                    const u32x4 p = *(const u32x4*)(PP + off), r = *(const u32x4*)(H3 + off);
                    f32x4 h0, h1;
                    h0[0] = bflo(r[0]) + sigm(acc[ai][bj][m][0][0] * rs) * bflo(p[0]); h0[1] = bfhi(r[0]) + sigm(acc[ai][bj][m][0][1] * rs) * bfhi(p[0]);
                    h0[2] = bflo(r[1]) + sigm(acc[ai][bj][m][0][2] * rs) * bflo(p[1]); h0[3] = bfhi(r[1]) + sigm(acc[ai][bj][m][0][3] * rs) * bfhi(p[1]);
                    h1[0] = bflo(r[2]) + sigm(acc[ai][bj][m][1][0] * rs) * bflo(p[2]); h1[1] = bfhi(r[2]) + sigm(acc[ai][bj][m][1][1] * rs) * bfhi(p[2]);
                    h1[2] = bflo(r[3]) + sigm(acc[ai][bj][m][1][2] * rs) * bflo(p[3]); h1[3] = bfhi(r[3]) + sigm(acc[ai][bj][m][1][3] * rs) * bfhi(p[3]);
                    *(u32x4*)(H4 + off) = pack8(h0, h1); s += sq4(h0) + sq4(h1); }
                ssq_put<16>(ssq4, row, u.pn * 4 + wc, s, fq); }
    }
};
#undef EPI_ROWS
#undef EPI_OPAQUE
#undef EPI_RS
}
namespace att {
using bf16x8 = __attribute__((ext_vector_type(8))) short;
using s16x4 = __attribute__((ext_vector_type(4))) short;
using f32x16 = __attribute__((ext_vector_type(16))) float;
using u32x4 = __attribute__((ext_vector_type(4))) unsigned;
typedef __attribute__((address_space(3))) const char* lds_cptr;
typedef __attribute__((address_space(3))) char* lds_ptr;
constexpr int KSLOT = 12288, VSLOT = 8192;
constexpr int L_K = 0, L_V = 3 * KSLOT, L_WS = L_V + 3 * VSLOT, L_OST = L_WS + 8 * 256, L_END = L_OST + 8 * 4096;
static_assert(L_END <= RING_BYTES, "attention LDS");
__device__ __forceinline__ int crow(int r, int hi) { return (r & 3) + 8 * (r >> 2) + 4 * hi; }
__device__ __forceinline__ void glds16(const void* gsrc, unsigned lds_dst) { unsigned keep;
    asm volatile("s_mov_b32 %0, m0\n\ts_mov_b32 m0, %2\n\ts_nop 0\n\tglobal_load_lds_dwordx4 %1, off\n\ts_mov_b32 m0, %0" : "=&s"(keep) : "v"(gsrc), "s"(lds_dst) : "memory"); }
typedef float f32x2_t __attribute__((ext_vector_type(2))); typedef __bf16 bf16x2_t __attribute__((ext_vector_type(2)));
__device__ __forceinline__ unsigned cvtpk_s(float lo, float hi) { f32x2_t v = {lo, hi}; bf16x2_t b = __builtin_convertvector(v, bf16x2_t); return __builtin_bit_cast(unsigned, b); }
__device__ __forceinline__ float swap32_max(float m) { auto rr = __builtin_amdgcn_permlane32_swap(__float_as_uint(m), __float_as_uint(m), false, false); return fmaxf(__uint_as_float(rr[0]), __uint_as_float(rr[1])); }
__device__ __forceinline__ float swap32_sum(float m) { auto rr = __builtin_amdgcn_permlane32_swap(__float_as_uint(m), __float_as_uint(m), false, false); return __uint_as_float(rr[0]) + __uint_as_float(rr[1]); }

__device__ __forceinline__ void pv(f32x16* o, int vb, bf16x8 pa0, bf16x8 pa1, bf16x8 pa2, bf16x8 pa3) {
#pragma unroll
    for (int d0 = 0; d0 < 2; ++d0) { s16x4 lo[4], hi[4];
#pragma unroll
        for (int ks = 0; ks < 4; ++ks) {
            asm volatile("ds_read_b64_tr_b16 %0,%1 offset:%c2" : "=&v"(lo[ks]) : "v"(vb), "i"(d0 * 4096 + ks * 1024) : "memory");
            asm volatile("ds_read_b64_tr_b16 %0,%1 offset:%c2" : "=&v"(hi[ks]) : "v"(vb), "i"(d0 * 4096 + ks * 1024 + 512) : "memory"); }
        asm volatile("s_waitcnt lgkmcnt(0)" ::: "memory"); __builtin_amdgcn_sched_barrier(0);
#define PK(k) (bf16x8){lo[k][0], lo[k][1], lo[k][2], lo[k][3], hi[k][0], hi[k][1], hi[k][2], hi[k][3]}
        o[d0] = __builtin_amdgcn_mfma_f32_32x32x16_bf16(pa0, PK(0), o[d0], 0, 0, 0);
        o[d0] = __builtin_amdgcn_mfma_f32_32x32x16_bf16(pa1, PK(1), o[d0], 0, 0, 0);
        o[d0] = __builtin_amdgcn_mfma_f32_32x32x16_bf16(pa2, PK(2), o[d0], 0, 0, 0);
        o[d0] = __builtin_amdgcn_mfma_f32_32x32x16_bf16(pa3, PK(3), o[d0], 0, 0, 0);
#undef PK
    }
}

__device__ __forceinline__ void k_load(bf16x8 (&kf)[12], lds_cptr kp) {
#pragma unroll
    for (int d0 = 0; d0 < 6; ++d0) { kf[2 * d0] = *(const __attribute__((address_space(3))) bf16x8*)(kp + d0 * 2048); kf[2 * d0 + 1] = *(const __attribute__((address_space(3))) bf16x8*)(kp + d0 * 2048 + 512); }
}
__device__ __forceinline__ void qk_mma(f32x16& p0, f32x16& p1, const bf16x8 (&kf)[12], const bf16x8 (&qr)[6]) {
    p0 = f32x16{}; p1 = f32x16{};
#pragma unroll
    for (int d0 = 0; d0 < 6; ++d0) { p0 = __builtin_amdgcn_mfma_f32_32x32x16_bf16(kf[2 * d0], qr[d0], p0, 0, 0, 0); p1 = __builtin_amdgcn_mfma_f32_32x32x16_bf16(kf[2 * d0 + 1], qr[d0], p1, 0, 0, 0); }
}
__device__ __forceinline__ void v_load(s16x4 (&lo)[8], s16x4 (&hi)[8], int vb) {
#pragma unroll
    for (int i = 0; i < 8; ++i) {
        asm volatile("ds_read_b64_tr_b16 %0,%1 offset:%c2" : "=&v"(lo[i]) : "v"(vb), "i"((i >> 2) * 4096 + (i & 3) * 1024) : "memory");
        asm volatile("ds_read_b64_tr_b16 %0,%1 offset:%c2" : "=&v"(hi[i]) : "v"(vb), "i"((i >> 2) * 4096 + (i & 3) * 1024 + 512) : "memory"); }
}
__device__ __forceinline__ void pv_mma(f32x16* o, const s16x4 (&lo)[8], const s16x4 (&hi)[8], bf16x8 pa0, bf16x8 pa1, bf16x8 pa2, bf16x8 pa3) {
#define PK(k) (bf16x8){lo[k][0], lo[k][1], lo[k][2], lo[k][3], hi[k][0], hi[k][1], hi[k][2], hi[k][3]}
    o[0] = __builtin_amdgcn_mfma_f32_32x32x16_bf16(pa0, PK(0), o[0], 0, 0, 0); o[1] = __builtin_amdgcn_mfma_f32_32x32x16_bf16(pa0, PK(4), o[1], 0, 0, 0);
    o[0] = __builtin_amdgcn_mfma_f32_32x32x16_bf16(pa1, PK(1), o[0], 0, 0, 0); o[1] = __builtin_amdgcn_mfma_f32_32x32x16_bf16(pa1, PK(5), o[1], 0, 0, 0);
    o[0] = __builtin_amdgcn_mfma_f32_32x32x16_bf16(pa2, PK(2), o[0], 0, 0, 0); o[1] = __builtin_amdgcn_mfma_f32_32x32x16_bf16(pa2, PK(6), o[1], 0, 0, 0);
    o[0] = __builtin_amdgcn_mfma_f32_32x32x16_bf16(pa3, PK(3), o[0], 0, 0, 0); o[1] = __builtin_amdgcn_mfma_f32_32x32x16_bf16(pa3, PK(7), o[1], 0, 0, 0);
#undef PK
}
__device__ __forceinline__ void qk_tile(f32x16& p0, f32x16& p1, lds_cptr kp, const bf16x8 (&qr)[6]) {
    p0 = f32x16{}; p1 = f32x16{};
#pragma unroll
    for (int d0 = 0; d0 < 6; ++d0) {
        const bf16x8 k0 = *(const __attribute__((address_space(3))) bf16x8*)(kp + d0 * 2048);
        const bf16x8 k1 = *(const __attribute__((address_space(3))) bf16x8*)(kp + d0 * 2048 + 512);
        p0 = __builtin_amdgcn_mfma_f32_32x32x16_bf16(k0, qr[d0], p0, 0, 0, 0);
        p1 = __builtin_amdgcn_mfma_f32_32x32x16_bf16(k1, qr[d0], p1, 0, 0, 0); }
}
__device__ __forceinline__ float max3f(float a, float b, float c) { return __builtin_fmaxf(__builtin_fmaxf(a, b), c); }
__device__ __forceinline__ void softmax_a(f32x16& p0, f32x16& p1, int jb, int qrel, int hi, int r32, float& m_run, float& l_run, f32x16 (&o)[2], LAS float* wsf) {
    if (jb >= 0) { const int kb = 64 * jb + 4 * hi;
#pragma unroll
        for (int r = 0; r < 16; ++r) { const int kv = kb + (r & 3) + 8 * (r >> 2); if (kv > qrel) p0[r] = -INFINITY; if (kv + 32 > qrel) p1[r] = -INFINITY; } }
    float a = max3f(p0[0], p0[1], p1[0]), b = max3f(p0[2], p0[3], p1[1]); a = max3f(a, p1[2], p1[3]);
#pragma unroll
    for (int r = 4; r < 16; r += 4) { a = max3f(a, p0[r], p0[r + 1]); b = max3f(b, p0[r + 2], p0[r + 3]); a = max3f(a, p1[r], p1[r + 1]); b = max3f(b, p1[r + 2], p1[r + 3]); }
    const float rm = swap32_max(fmaxf(a, b));
    const float mnew = (rm > m_run + 8.0f) ? rm : m_run;
    if (__any(mnew > m_run)) {
        const float alpha = __builtin_amdgcn_exp2f(m_run - mnew);
        l_run *= alpha; m_run = mnew;
        if (hi == 0) wsf[r32] = alpha;
        asm volatile("s_waitcnt lgkmcnt(0)" ::: "memory");
        f32x16 av;
#pragma unroll
        for (int r = 0; r < 16; ++r) av[r] = wsf[crow(r, hi)];
        o[0] *= av; o[1] *= av;
    }
}
__device__ __forceinline__ void softmax_b(f32x16& p0, f32x16& p1, float m_run, float& l_run, u32x4& pw0, u32x4& pw1, u32x4& pw2, u32x4& pw3) {
    p0 = p0 - m_run; p1 = p1 - m_run;
#pragma unroll
    for (int r = 0; r < 16; ++r) { p0[r] = __builtin_amdgcn_exp2f(p0[r]); p1[r] = __builtin_amdgcn_exp2f(p1[r]); }
    const f32x16 ps = p0 + p1;
    typedef float f32x8_t __attribute__((ext_vector_type(8))); typedef float f32x4_t __attribute__((ext_vector_type(4))); typedef float f32x2_t2 __attribute__((ext_vector_type(2)));
    const f32x8_t s8 = __builtin_shufflevector(ps, ps, 0, 1, 2, 3, 4, 5, 6, 7) + __builtin_shufflevector(ps, ps, 8, 9, 10, 11, 12, 13, 14, 15);
    const f32x4_t s4 = __builtin_shufflevector(s8, s8, 0, 1, 2, 3) + __builtin_shufflevector(s8, s8, 4, 5, 6, 7);
    const f32x2_t2 s2 = __builtin_shufflevector(s4, s4, 0, 1) + __builtin_shufflevector(s4, s4, 2, 3);
    l_run += s2[0] + s2[1];
#define PKW(P, B) cvtpk_s(P[B], P[B + 1])
    pw0 = (u32x4){PKW(p0, 0), PKW(p0, 2), PKW(p0, 4), PKW(p0, 6)}; pw1 = (u32x4){PKW(p0, 8), PKW(p0, 10), PKW(p0, 12), PKW(p0, 14)};
    pw2 = (u32x4){PKW(p1, 0), PKW(p1, 2), PKW(p1, 4), PKW(p1, 6)}; pw3 = (u32x4){PKW(p1, 8), PKW(p1, 10), PKW(p1, 12), PKW(p1, 14)};
#undef PKW
}
__device__ __forceinline__ void attn_unit(int b, int h, int qb, const bf16* Q, const bf16* KN, const bf16* KPE, const bf16* VB, bf16* O, char* shm) {
    int tid_ = threadIdx.x; asm volatile("" : "+v"(tid_)); const int tid = tid_, lane = tid & 63, r32 = lane & 31, hi = lane >> 5; const int wid = __builtin_amdgcn_readfirstlane(tid >> 6);
    const long rowbase = (long)b * TSEQ; const int q0 = qb * 256;
    const bf16* Qw = Q + (rowbase + q0 + wid * 32) * 768 + h * QKD;
    const unsigned lds0 = (unsigned)(uintptr_t)shm;
    const lds_ptr shm3 = (lds_ptr)shm;
    LAS float* wsf = (LAS float*)(shm3 + L_WS) + wid * 64;
    const bf16* ksrc0 = KN + (rowbase + lane) * 512 + h * 64 + wid * 8;
    const bf16* ksrc1 = KPE + (rowbase + lane) * RPE + (wid & 3) * 8;
    const bf16* vsrc = VB + (rowbase + 16 * (wid & 3) + (lane >> 2)) * 512 + h * 64 + (wid >> 2) * 32 + (lane & 3) * 8;
    const unsigned kdst0 = lds0 + L_K + wid * 1024, kdst1 = lds0 + L_K + (8 + (wid & 3)) * 1024, vdst = lds0 + L_V + wid * 1024;
#define ATT_DMAK(t, s) do { glds16(ksrc0 + (long)(t) * 64 * 512, (unsigned)__builtin_amdgcn_readfirstlane(kdst0 + (s) * KSLOT)); \
                            glds16(ksrc1 + (long)(t) * 64 * RPE, (unsigned)__builtin_amdgcn_readfirstlane(kdst1 + (s) * KSLOT)); } while (0)
#define ATT_DMAV(t, s) glds16(vsrc + (long)(t) * 64 * 512, (unsigned)__builtin_amdgcn_readfirstlane(vdst + (s) * VSLOT))
    const int vb0 = (int)(lds0 + L_V) + ((lane >> 4) & 1) * 32 + (lane & 3) * 8 + (4 * hi + ((lane & 15) >> 2)) * 64;
    const lds_cptr kp0 = (lds_cptr)shm3 + L_K + hi * 1024 + r32 * 16;
    const int NT = (q0 + 256) / 64;
    ATT_DMAK(0, 0); ATT_DMAV(0, 0); ATT_DMAK(1, 1); ATT_DMAV(1, 1); ATT_DMAK(2, 2);
    bf16x8 qr[6];
#pragma unroll
    for (int d0 = 0; d0 < 6; ++d0) qr[d0] = *reinterpret_cast<const bf16x8*>(&Qw[(long)r32 * 768 + d0 * 16 + hi * 8]);
    float m_run = -INFINITY, l_run = 0.f; f32x16 o[2]; o[0] = f32x16{}; o[1] = f32x16{};
    const int qrel = wid * 32 + r32;
    asm volatile("s_waitcnt vmcnt(0) lgkmcnt(0)\n\ts_barrier" ::: "memory");
    f32x16 sA0, sA1, sB0, sB1;
    qk_tile(sA0, sA1, kp0, qr);
    int t = 0, s0 = 0, s1 = 1, s2 = 2;
    for (; t + 1 < NT - 4; ++t) {
        asm volatile("s_waitcnt vmcnt(3) lgkmcnt(0)\n\ts_barrier" ::: "memory");
        ATT_DMAK(t + 3, s0); ATT_DMAV(t + 2, s2);
        bf16x8 kf[12]; s16x4 vlo[8], vhi[8];
        k_load(kf, kp0 + s1 * KSLOT); v_load(vlo, vhi, vb0 + s0 * VSLOT);
        softmax_a(sA0, sA1, -1, qrel, hi, r32, m_run, l_run, o, wsf);
        asm volatile("s_waitcnt lgkmcnt(0)" ::: "memory"); __builtin_amdgcn_sched_barrier(0);
        u32x4 pw0, pw1, pw2, pw3;
        qk_mma(sB0, sB1, kf, qr);
        softmax_b(sA0, sA1, m_run, l_run, pw0, pw1, pw2, pw3);
#pragma unroll
        for (int i = 0; i < 12; ++i) { __builtin_amdgcn_sched_group_barrier(0x008, 1, 0); __builtin_amdgcn_sched_group_barrier(0x002, 10, 0); }
        pv_mma(o, vlo, vhi, __builtin_bit_cast(bf16x8, pw0), __builtin_bit_cast(bf16x8, pw1), __builtin_bit_cast(bf16x8, pw2), __builtin_bit_cast(bf16x8, pw3));
        sA0 = sB0; sA1 = sB1;
        { const int r_ = s0; s0 = s1; s1 = s2; s2 = r_; }
    }
    for (; t < NT; ++t) {
        asm volatile("s_waitcnt vmcnt(0) lgkmcnt(0)\n\ts_barrier" ::: "memory");
        if (t + 3 < NT) ATT_DMAK(t + 3, s0);
        if (t + 2 < NT) ATT_DMAV(t + 2, s2);
        const int jb = t - (NT - 4), jbn = jb + 1;
        const bool pn = (t + 1 < NT) && (jbn < 0 || 2 * jbn <= wid);
        if (pn) qk_tile(sB0, sB1, kp0 + s1 * KSLOT, qr);
        if (jb < 0 || 2 * jb <= wid) { softmax_a(sA0, sA1, jb, qrel, hi, r32, m_run, l_run, o, wsf); u32x4 pw0, pw1, pw2, pw3; softmax_b(sA0, sA1, m_run, l_run, pw0, pw1, pw2, pw3);
            pv(o, vb0 + s0 * VSLOT, __builtin_bit_cast(bf16x8, pw0), __builtin_bit_cast(bf16x8, pw1), __builtin_bit_cast(bf16x8, pw2), __builtin_bit_cast(bf16x8, pw3)); }
        sA0 = sB0; sA1 = sB1;
        { const int r_ = s0; s0 = s1; s1 = s2; s2 = r_; }
    }
    l_run = swap32_sum(l_run);
    if (hi == 0) wsf[32 + r32] = l_run;
    asm volatile("s_waitcnt lgkmcnt(0)" ::: "memory");
    float rli[16];
#pragma unroll
    for (int r = 0; r < 16; ++r) rli[r] = 1.0f / wsf[32 + crow(r, hi)];
    bf16* Ow = O + (rowbase + q0 + wid * 32) * DM + h * 64;
    { LAS bf16* stg = (LAS bf16*)(shm3 + L_OST) + wid * 2048;
#pragma unroll
      for (int r = 0; r < 16; ++r) { const int orow = crow(r, hi);
#pragma unroll
          for (int d0 = 0; d0 < 2; ++d0) stg[orow * 64 + d0 * 32 + r32] = (bf16)f2bf(o[d0][r] * rli[r]); }
      asm volatile("s_waitcnt lgkmcnt(0)" ::: "memory");
#pragma unroll
      for (int i = 0; i < 4; ++i) { const int row = i * 8 + (lane >> 3), ch = lane & 7; const u32x4 v = *(const LAS u32x4*)(stg + row * 64 + ch * 8); *(u32x4*)(Ow + (long)row * DM + ch * 8) = v; } }
    asm volatile("s_waitcnt vmcnt(0) lgkmcnt(0)\n\ts_barrier" ::: "memory");
#undef ATT_DMAK
#undef ATT_DMAV
}
__device__ __forceinline__ void bar4(volatile LAS unsigned* cnt, unsigned& gen, int lane) {
    gen += 4u;
    if (lane == 0) { unsigned seen = __hip_atomic_fetch_add((LAS unsigned*)cnt, 1u, __ATOMIC_RELAXED, __HIP_MEMORY_SCOPE_WORKGROUP) + 1u;
        while (seen < gen) seen = __hip_atomic_load((LAS unsigned*)cnt, __ATOMIC_RELAXED, __HIP_MEMORY_SCOPE_WORKGROUP); }
    asm volatile("" ::: "memory");
}
__device__ __forceinline__ void bar4_arrive(volatile LAS unsigned* cnt, unsigned& gen, int lane) {
    gen += 4u;
    if (lane == 0) __hip_atomic_fetch_add((LAS unsigned*)cnt, 1u, __ATOMIC_RELAXED, __HIP_MEMORY_SCOPE_WORKGROUP);
    asm volatile("" ::: "memory");
}
__device__ __forceinline__ void bar4_wait(volatile LAS unsigned* cnt, unsigned gen, int lane) {
    if (lane == 0) { while (__hip_atomic_load((LAS unsigned*)cnt, __ATOMIC_RELAXED, __HIP_MEMORY_SCOPE_WORKGROUP) < gen) {} }
    asm volatile("" ::: "memory");
}
constexpr int H_K = 0, H_V = 3 * KSLOT, H_WS = H_V + 3 * VSLOT, H_OST = H_WS + 4 * 256, H_END = H_OST + 4 * 4096;
__device__ __forceinline__ void attn_half_unit(int b, int h, int qb, const bf16* Q, const bf16* KN, const bf16* KPE, const bf16* VB, bf16* O, char* shm, volatile LAS unsigned* cnt, unsigned& gen) {
    int tid_ = threadIdx.x; asm volatile("" : "+v"(tid_)); const int tid = tid_, lane = tid & 63, r32 = lane & 31, hi = lane >> 5; const int wid = __builtin_amdgcn_readfirstlane(tid >> 6) & 3;
    const long rowbase = (long)b * TSEQ; const int q0 = qb * 128;
    const bf16* Qw = Q + (rowbase + q0 + wid * 32) * 768 + h * QKD;
    const unsigned lds0 = (unsigned)(uintptr_t)shm;
    const lds_ptr shm3 = (lds_ptr)shm;
    LAS float* wsf = (LAS float*)(shm3 + H_WS) + wid * 64;
    const bf16* ksrcA = KN + (rowbase + lane) * 512 + h * 64 + wid * 8;
    const bf16* ksrcC = KPE + (rowbase + lane) * RPE + wid * 8;
    const bf16* vsrc = VB + (rowbase + 16 * wid + (lane >> 2)) * 512 + h * 64 + (lane & 3) * 8;
    const unsigned kdst = lds0 + H_K + wid * 1024, vdst = lds0 + H_V + wid * 1024;
#define HDMA(t, s) do { glds16(ksrcA + (long)(t) * 64 * 512, (unsigned)__builtin_amdgcn_readfirstlane(kdst + (s) * KSLOT)); \
                        glds16(ksrcA + (long)(t) * 64 * 512 + 32, (unsigned)__builtin_amdgcn_readfirstlane(kdst + (s) * KSLOT + 4096)); \
                        glds16(ksrcC + (long)(t) * 64 * RPE, (unsigned)__builtin_amdgcn_readfirstlane(kdst + (s) * KSLOT + 8192)); } while (0)
#define HDMAV(t, s) do { glds16(vsrc + (long)(t) * 64 * 512, (unsigned)__builtin_amdgcn_readfirstlane(vdst + (s) * VSLOT)); \
                         glds16(vsrc + (long)(t) * 64 * 512 + 32, (unsigned)__builtin_amdgcn_readfirstlane(vdst + (s) * VSLOT + 4096)); } while (0)
    const int vb0 = (int)(lds0 + H_V) + ((lane >> 4) & 1) * 32 + (lane & 3) * 8 + (4 * hi + ((lane & 15) >> 2)) * 64;
    const lds_cptr kp0 = (lds_cptr)shm3 + H_K + hi * 1024 + r32 * 16;
    const int NT = (q0 + 128) / 64;
    HDMA(0, 0); HDMAV(0, 0); HDMA(1, 1); HDMAV(1, 1); if (NT > 2) HDMA(2, 2);
    bf16x8 qr[6];
#pragma unroll
    for (int d0 = 0; d0 < 6; ++d0) qr[d0] = *reinterpret_cast<const bf16x8*>(&Qw[(long)r32 * 768 + d0 * 16 + hi * 8]);
    float m_run = -INFINITY, l_run = 0.f; f32x16 o[2]; o[0] = f32x16{}; o[1] = f32x16{};
    const int qrel = wid * 32 + r32;
    asm volatile("s_waitcnt vmcnt(0) lgkmcnt(0)" ::: "memory"); bar4(cnt, gen, lane);
    f32x16 sA0, sA1, sB0, sB1;
    qk_tile(sA0, sA1, kp0, qr);
    int t = 0, s0 = 0, s1 = 1, s2 = 2;
    for (; t + 1 < NT - 2; ++t) {
        asm volatile("s_waitcnt vmcnt(5) lgkmcnt(0)" ::: "memory"); bar4(cnt, gen, lane);
        HDMA(t + 3, s0); HDMAV(t + 2, s2);
        bf16x8 kf[12]; s16x4 vlo[8], vhi[8];
        k_load(kf, kp0 + s1 * KSLOT); v_load(vlo, vhi, vb0 + s0 * VSLOT);
        softmax_a(sA0, sA1, -1, qrel, hi, r32, m_run, l_run, o, wsf);
        asm volatile("s_waitcnt lgkmcnt(0)" ::: "memory"); __builtin_amdgcn_sched_barrier(0);
        u32x4 pw0, pw1, pw2, pw3;
        qk_mma(sB0, sB1, kf, qr);
        softmax_b(sA0, sA1, m_run, l_run, pw0, pw1, pw2, pw3);
#pragma unroll
        for (int i = 0; i < 12; ++i) { __builtin_amdgcn_sched_group_barrier(0x008, 1, 0); __builtin_amdgcn_sched_group_barrier(0x002, 10, 0); }
        pv_mma(o, vlo, vhi, __builtin_bit_cast(bf16x8, pw0), __builtin_bit_cast(bf16x8, pw1), __builtin_bit_cast(bf16x8, pw2), __builtin_bit_cast(bf16x8, pw3));
        sA0 = sB0; sA1 = sB1;
        { const int r_ = s0; s0 = s1; s1 = s2; s2 = r_; }
    }
    for (; t < NT; ++t) {
        asm volatile("s_waitcnt vmcnt(0) lgkmcnt(0)" ::: "memory"); bar4(cnt, gen, lane);
        if (t + 3 < NT) HDMA(t + 3, s0);
        if (t + 2 < NT) HDMAV(t + 2, s2);
        const int jb = t - (NT - 2), jbn = jb + 1;
        const bool pn = (t + 1 < NT) && (jbn < 0 || 2 * jbn <= wid);
        if (pn) qk_tile(sB0, sB1, kp0 + s1 * KSLOT, qr);
        if (jb < 0 || 2 * jb <= wid) { softmax_a(sA0, sA1, jb, qrel, hi, r32, m_run, l_run, o, wsf); u32x4 pw0, pw1, pw2, pw3; softmax_b(sA0, sA1, m_run, l_run, pw0, pw1, pw2, pw3);
            pv(o, vb0 + s0 * VSLOT, __builtin_bit_cast(bf16x8, pw0), __builtin_bit_cast(bf16x8, pw1), __builtin_bit_cast(bf16x8, pw2), __builtin_bit_cast(bf16x8, pw3)); }
        sA0 = sB0; sA1 = sB1;
        { const int r_ = s0; s0 = s1; s1 = s2; s2 = r_; }
    }
    l_run = swap32_sum(l_run);
    if (hi == 0) wsf[32 + r32] = l_run;
    asm volatile("s_waitcnt lgkmcnt(0)" ::: "memory");
    float rli[16];
#pragma unroll
    for (int r = 0; r < 16; ++r) rli[r] = 1.0f / wsf[32 + crow(r, hi)];
    bf16* Ow = O + (rowbase + q0 + wid * 32) * DM + h * 64;
    { LAS bf16* stg = (LAS bf16*)(shm3 + H_OST) + wid * 2048;
#pragma unroll
      for (int r = 0; r < 16; ++r) { const int orow = crow(r, hi);
#pragma unroll
          for (int d0 = 0; d0 < 2; ++d0) stg[orow * 64 + d0 * 32 + r32] = (bf16)f2bf(o[d0][r] * rli[r]); }
      asm volatile("s_waitcnt lgkmcnt(0)" ::: "memory");
#pragma unroll
      for (int i = 0; i < 4; ++i) { const int row = i * 8 + (lane >> 3), ch = lane & 7; const u32x4 v = *(const LAS u32x4*)(stg + row * 64 + ch * 8); *(u32x4*)(Ow + (long)row * DM + ch * 8) = v; } }
    asm volatile("s_waitcnt vmcnt(0) lgkmcnt(0)" ::: "memory"); bar4(cnt, gen, lane);
#undef HDMA
#undef HDMAV
}
}
namespace ret {
using bf16x8 = __attribute__((ext_vector_type(8))) short;
using s16x4 = __attribute__((ext_vector_type(4))) short;
using f32x16 = __attribute__((ext_vector_type(16))) float;
typedef short v4i16_t __attribute__((ext_vector_type(4)));
constexpr int TPB = 288, TB = 128 * TPB;
constexpr int OTP = 132;
static_assert(3 * TB <= RING_BYTES && 128 * OTP * 4 <= 2 * TB, "retention LDS");
__device__ __forceinline__ int crow(int r, int hi) { return (r & 3) + 8 * (r >> 2) + 4 * hi; }
__device__ __forceinline__ void stage_tile(LAS unsigned char* tile, const bf16* src, int pitch, int tid) {
#pragma unroll
    for (int i = 0; i < 4; ++i) { const int idx = tid + 512 * i, row = idx >> 4, ch = idx & 15;
        *(LAS v4u*)(tile + row * TPB + ch * 16) = *(const v4u*)(src + (size_t)row * pitch + ch * 8); }
}
__device__ __forceinline__ bf16x8 rowfrag(const LAS unsigned char* tile, int row0, int k0, int r32, int hi) { return *(const LAS bf16x8*)(tile + (row0 + r32) * TPB + (k0 + 8 * hi) * 2); }
__device__ __forceinline__ bf16x8 trfrag(const LAS unsigned char* tile, int k0, int c0, int lane) {
    const int h = lane >> 5, blk = (lane >> 4) & 1, q = (lane & 15) >> 2, p = lane & 3;
    const LAS unsigned char* a = tile + (k0 + 8 * h + q) * TPB + (c0 + 16 * blk + 4 * p) * 2;
    const s16x4 lo = __builtin_bit_cast(s16x4, __builtin_amdgcn_ds_read_tr16_b64_v4i16((LAS v4i16_t*)a));
    const s16x4 hi4 = __builtin_bit_cast(s16x4, __builtin_amdgcn_ds_read_tr16_b64_v4i16((LAS v4i16_t*)(a + 4 * TPB)));
    return (bf16x8){lo[0], lo[1], lo[2], lo[3], hi4[0], hi4[1], hi4[2], hi4[3]};
}

__device__ __forceinline__ void kv_unit(int u, const bf16* KR, const bf16* RV, float* KVC, LAS unsigned char* lds) {
    int tid_ = threadIdx.x; asm volatile("" : "+v"(tid_)); const int tid = tid_, lane = tid & 63, r32 = lane & 31, hi = lane >> 5, wid = __builtin_amdgcn_readfirstlane(tid >> 6), wi = wid >> 1, wj = wid & 1;
    const int bh = u >> 6, c = u & 63, b = bh >> 2, h = bh & 3; const size_t row0 = (size_t)b * TSEQ + c * 128;
    LAS unsigned char* T0 = lds; LAS unsigned char* T1 = lds + TB;
    stage_tile(T0, KR + row0 * 512 + h * 128, 512, tid); stage_tile(T1, RV + row0 * 512 + h * 128, 512, tid);
    __syncthreads();
    f32x16 acc[2]; acc[0] = f32x16{}; acc[1] = f32x16{};
#pragma unroll
    for (int ks = 0; ks < 8; ++ks) { const bf16x8 A = trfrag(T0, 16 * ks, 32 * wi, lane);
#pragma unroll
        for (int n = 0; n < 2; ++n) acc[n] = __builtin_amdgcn_mfma_f32_32x32x16_bf16(A, trfrag(T1, 16 * ks, 64 * wj + 32 * n, lane), acc[n], 0, 0, 0); }
    const float g127 = __builtin_amdgcn_exp2f(127.0f * lg2gamma(h));
    float* out = KVC + (size_t)u * 16384;
#pragma unroll
    for (int n = 0; n < 2; ++n)
#pragma unroll
        for (int r = 0; r < 16; ++r) out[(32 * wi + crow(r, hi)) * 128 + 64 * wj + 32 * n + r32] = acc[n][r] * g127;
    __syncthreads();
}

__device__ __forceinline__ void scan_items(int gtid, int gthreads, const float* KVC, bf16* SC, float* dout) {
    for (int e = gtid; e < 8 * 16384; e += gthreads) { const int bh = e >> 14, el = e & 16383; const float g128 = __builtin_amdgcn_exp2f(128.0f * lg2gamma(bh & 3));
        float s = 0.f;
        for (int c0 = 0; c0 < 64; c0 += 8) { float kv[8];
#pragma unroll
            for (int i = 0; i < 8; ++i) kv[i] = KVC[(size_t)(bh * 64 + c0 + i) * 16384 + el];
#pragma unroll
            for (int i = 0; i < 8; ++i) { SC[(size_t)(bh * 64 + c0 + i) * 16384 + el] = (bf16)f2bf(s); s = g128 * s + kv[i]; } }
        dout[O_RETP + e] = s; }
}

__device__ __forceinline__ void out_unit(int u, const bf16* QR, const bf16* KR, const bf16* RV, const bf16* SC, const bf16* RGS, const float* gnorm, bf16* OCAT, LAS unsigned char* lds) {
    int tid_ = threadIdx.x; asm volatile("" : "+v"(tid_)); const int tid = tid_, lane = tid & 63, r32 = lane & 31, hi = lane >> 5, wid = __builtin_amdgcn_readfirstlane(tid >> 6), wi = wid >> 1, wj = wid & 1;
    const int bh = u >> 6, c = u & 63, b = bh >> 2, h = bh & 3; const size_t row0 = (size_t)b * TSEQ + c * 128;
    LAS unsigned char* T0 = lds; LAS unsigned char* T1 = lds + TB; LAS unsigned char* T2 = lds + 2 * TB;
    stage_tile(T0, QR + row0 * 512 + h * 128, 512, tid); stage_tile(T1, KR + row0 * 512 + h * 128, 512, tid); stage_tile(T2, RV + row0 * 512 + h * 128, 512, tid);
    __syncthreads();
    f32x16 sr[2];
#pragma unroll
    for (int n = 0; n < 2; ++n) { const int jb = 2 * wj + n; sr[n] = f32x16{};
        if (jb <= wi) {
#pragma unroll
            for (int ks = 0; ks < 8; ++ks) sr[n] = __builtin_amdgcn_mfma_f32_32x32x16_bf16(rowfrag(T1, 32 * jb, 16 * ks, r32, hi), rowfrag(T0, 32 * wi, 16 * ks, r32, hi), sr[n], 0, 0, 0);
            if (jb == wi) {
#pragma unroll
                for (int r = 0; r < 16; ++r) if (crow(r, hi) > r32) sr[n][r] = 0.f; } } }
    __syncthreads();
#pragma unroll
    for (int n = 0; n < 2; ++n) { const int jb = 2 * wj + n;
        if (jb <= wi) {
#pragma unroll
            for (int r4 = 0; r4 < 4; ++r4) { v2u w; w.x = pg8::cvt_pk_bf16(sr[n][4 * r4], sr[n][4 * r4 + 1]); w.y = pg8::cvt_pk_bf16(sr[n][4 * r4 + 2], sr[n][4 * r4 + 3]);
                *(LAS v2u*)(T1 + (32 * wi + r32) * TPB + (32 * jb + 8 * r4 + 4 * hi) * 2) = w; } } }
    __syncthreads();
    f32x16 o1[2]; o1[0] = f32x16{}; o1[1] = f32x16{};
    for (int ks = 0; ks < 2 * (wi + 1); ++ks) { const bf16x8 A = rowfrag(T1, 32 * wi, 16 * ks, r32, hi);
#pragma unroll
        for (int n = 0; n < 2; ++n) o1[n] = __builtin_amdgcn_mfma_f32_32x32x16_bf16(A, trfrag(T2, 16 * ks, 64 * wj + 32 * n, lane), o1[n], 0, 0, 0); }
    __syncthreads();
    stage_tile(T2, SC + (size_t)u * 16384, 128, tid);
    __syncthreads();
    f32x16 o2[2]; o2[0] = f32x16{}; o2[1] = f32x16{};
#pragma unroll
    for (int ks = 0; ks < 8; ++ks) { const bf16x8 A = rowfrag(T0, 32 * wi, 16 * ks, r32, hi);
#pragma unroll
        for (int n = 0; n < 2; ++n) o2[n] = __builtin_amdgcn_mfma_f32_32x32x16_bf16(A, trfrag(T2, 16 * ks, 64 * wj + 32 * n, lane), o2[n], 0, 0, 0); }
    __syncthreads();
    const float gam = __builtin_amdgcn_exp2f(lg2gamma(h));
    LAS float* OT = (LAS float*)lds;
#pragma unroll
    for (int n = 0; n < 2; ++n)
#pragma unroll
        for (int r = 0; r < 16; ++r) OT[(32 * wi + crow(r, hi)) * OTP + 64 * wj + 32 * n + r32] = o1[n][r] + gam * o2[n][r];
    __syncthreads();
    { const int row = tid >> 2, part = tid & 3; const LAS float* orow = OT + row * OTP + part * 32; float v[32]; float s = 0.f;
#pragma unroll
      for (int k = 0; k < 32; ++k) { v[k] = orow[k]; s += v[k]; }
      s += __shfl_xor(s, 1); s += __shfl_xor(s, 2); const float mu = s * (1.0f / 128.0f); float q = 0.f;
#pragma unroll
      for (int k = 0; k < 32; ++k) { v[k] -= mu; q += v[k] * v[k]; }
      q += __shfl_xor(q, 1); q += __shfl_xor(q, 2); const float rstd = 1.0f / sqrtf(q * (1.0f / 128.0f) + EPS);
      const bf16* rg = RGS + (row0 + row) * 512 + h * 128 + part * 32; const float* gn = gnorm + h * 128 + part * 32; bf16* dst = OCAT + (row0 + row) * DM + 512 + h * 128 + part * 32;
#pragma unroll
      for (int k8 = 0; k8 < 4; ++k8) { const v4u g = *(const v4u*)(rg + 8 * k8); v4u w;
#pragma unroll
          for (int j = 0; j < 4; ++j) { const int k = 8 * k8 + 2 * j; w[j] = pk2(v[k] * rstd * gn[k] * bflo(g[j]), v[k + 1] * rstd * gn[k + 1] * bfhi(g[j])); }
          *(v4u*)(dst + 8 * k8) = w; } }
    __syncthreads();
}

__device__ __forceinline__ void sample_unit(int u, const bf16* QR, const bf16* KR, const bf16* RV, const bf16* RGS, const float* gnorm, const float* state, float* dout, bf16* OCAT, LAS unsigned char* lds) {
    int tid_ = threadIdx.x; asm volatile("" : "+v"(tid_)); const int tid = tid_, s = u >> 2, h = u & 3; const size_t row = (size_t)MP + s;
    LAS float* qf = (LAS float*)lds; LAS float* kf = qf + 128; LAS float* vf = kf + 128; LAS float* red = vf + 128; LAS float* ob = red + 512;
    if (tid < 128) { qf[tid] = bf2f(QR[row * 512 + h * 128 + tid]); kf[tid] = bf2f(KR[row * 512 + h * 128 + tid]); vf[tid] = bf2f(RV[row * 512 + h * 128 + tid]); }
    __syncthreads();
    const int dv = tid & 127, g = tid >> 7; const float gam = __builtin_amdgcn_exp2f(lg2gamma(h)); const float vv = vf[dv];
    const float* S0 = state + (size_t)u * 16384; float* Sn = dout + O_RETS + (size_t)u * 16384; float acc = 0.f;
#pragma unroll 8
    for (int i = 0; i < 32; ++i) { const int dk = 32 * g + i; const float s0 = S0[dk * 128 + dv]; acc += qf[dk] * s0; Sn[dk * 128 + dv] = gam * s0 + kf[dk] * vv; }
    red[tid] = acc;
    __syncthreads();
    if (tid < 128) { float qk = 0.f;
        for (int d = 0; d < 128; ++d) qk += qf[d] * kf[d];
        ob[tid] = qk * vv + gam * ((red[tid] + red[128 + tid]) + (red[256 + tid] + red[384 + tid])); }
    __syncthreads();
    if (tid < 128) { float sm = 0.f;
        for (int d = 0; d < 128; ++d) sm += ob[d];
        const float mu = sm * (1.0f / 128.0f); float q = 0.f;
        for (int d = 0; d < 128; ++d) { const float t = ob[d] - mu; q += t * t; }
        const float rstd = 1.0f / sqrtf(q * (1.0f / 128.0f) + EPS);
        OCAT[row * DM + 512 + h * 128 + tid] = (bf16)f2bf((ob[tid] - mu) * rstd * gnorm[h * 128 + tid] * bf2f(RGS[row * 512 + h * 128 + tid])); }
    __syncthreads();
}
__device__ __forceinline__ void sample_unit4(int u, int w4, int lane_, const bf16* QR, const bf16* KR, const bf16* RV, const bf16* RGS, const float* gnorm, const float* state, float* dout, bf16* OCAT, LAS float* tl, volatile LAS unsigned* cnt, unsigned& gen) {
    int lane = lane_; asm volatile("" : "+v"(lane));
    const int tid = w4 * 64 + lane, s = u >> 2, h = u & 3; const size_t row = (size_t)MP + s;
    LAS float* qf = tl; LAS float* kf = qf + 128; LAS float* vf = kf + 128; LAS float* red = vf + 128; LAS float* ob = red + 256;
    if (tid < 128) { qf[tid] = bf2f(QR[row * 512 + h * 128 + tid]); kf[tid] = bf2f(KR[row * 512 + h * 128 + tid]); vf[tid] = bf2f(RV[row * 512 + h * 128 + tid]); }
    asm volatile("s_waitcnt lgkmcnt(0)" ::: "memory"); att::bar4(cnt, gen, lane);
    const int dv = tid & 127, g = tid >> 7; const float gam = __builtin_amdgcn_exp2f(lg2gamma(h)); const float vv = vf[dv];
    const float* S0 = state + (size_t)u * 16384; float* Sn = dout + O_RETS + (size_t)u * 16384; float acc = 0.f;
#pragma unroll 16
    for (int i = 0; i < 64; ++i) { const int dk = 64 * g + i; const float s0 = S0[dk * 128 + dv]; acc += qf[dk] * s0; Sn[dk * 128 + dv] = gam * s0 + kf[dk] * vv; }
    red[tid] = acc;
    asm volatile("s_waitcnt lgkmcnt(0)" ::: "memory"); att::bar4(cnt, gen, lane);
    if (tid < 128) { float qk = 0.f;
        for (int d = 0; d < 128; ++d) qk += qf[d] * kf[d];
        ob[tid] = qk * vv + gam * (red[tid] + red[128 + tid]); }
    asm volatile("s_waitcnt lgkmcnt(0)" ::: "memory"); att::bar4(cnt, gen, lane);
    if (tid < 128) { float sm = 0.f;
        for (int d = 0; d < 128; ++d) sm += ob[d];
        const float mu = sm * (1.0f / 128.0f); float q = 0.f;
        for (int d = 0; d < 128; ++d) { const float t = ob[d] - mu; q += t * t; }
        const float rstd = 1.0f / sqrtf(q * (1.0f / 128.0f) + EPS);
        OCAT[row * DM + 512 + h * 128 + tid] = (bf16)f2bf((ob[tid] - mu) * rstd * gnorm[h * 128 + tid] * bf2f(RGS[row * 512 + h * 128 + tid])); }
    asm volatile("s_waitcnt lgkmcnt(0)" ::: "memory"); att::bar4(cnt, gen, lane);
}
}
namespace sk {
using bf16x8 = __attribute__((ext_vector_type(8))) short;
using f32x4 = __attribute__((ext_vector_type(4))) float;
using f32x2 = __attribute__((ext_vector_type(2))) float;
template <int K, bool DUAL, bool STAT, class Epi>
__device__ __forceinline__ void skinny_unit(int u, const bf16* A, const bf16* Bt, float* ssq, LAS float* lds, const Epi E) {
    int tid_ = threadIdx.x; asm volatile("" : "+v"(tid_)); const int tid = tid_, lane = tid & 63, wave = __builtin_amdgcn_readfirstlane(tid >> 6), fr = lane & 15, fq = lane >> 4;
    const int rb = u >> 4, cg = u & 15;
    constexpr int KW = K / 8, NS = KW / 32; static_assert(KW % 32 == 0, "K split");
    const bf16* ap = A + (size_t)(MP + 16 * rb + fr) * K + wave * KW + 8 * fq;
    const bf16* bp = Bt + (size_t)(64 * cg + fr) * K + wave * KW + 8 * fq;
    f32x4 acc[4];
#pragma unroll
    for (int n = 0; n < 4; ++n) acc[n] = (f32x4){0.f, 0.f, 0.f, 0.f};
#pragma unroll 4
    for (int s = 0; s < NS; ++s) { const bf16x8 a = *(const bf16x8*)(ap + 32 * s);
#pragma unroll
        for (int n = 0; n < 4; ++n) acc[n] = __builtin_amdgcn_mfma_f32_16x16x32_bf16(a, *(const bf16x8*)(bp + (size_t)16 * n * K + 32 * s), acc[n], 0, 0, 0); }
    LAS float* P = lds + wave * 1024;
#pragma unroll
    for (int n = 0; n < 4; ++n)
#pragma unroll
        for (int r = 0; r < 4; ++r) P[(4 * fq + r) * 64 + 16 * n + fr] = acc[n][r];
    __syncthreads();
    { const int row = tid >> 5, c2 = (tid & 31) * 2; float a0 = 0.f, a1 = 0.f, b0 = 0.f, b1 = 0.f;
#pragma unroll
      for (int w = 0; w < 8; ++w) { const f32x2 v = *(const LAS f32x2*)(lds + w * 1024 + row * 64 + c2); if (DUAL && w >= 4) { b0 += v[0]; b1 += v[1]; } else { a0 += v[0]; a1 += v[1]; } }
      const f32x2 h = E(MP + 16 * rb + row, 64 * cg + c2, a0, a1, b0, b1);
      if (STAT) { float s = h[0] * h[0] + h[1] * h[1];
#pragma unroll
          for (int o = 1; o < 32; o <<= 1) s += __shfl_xor(s, o);
          if ((tid & 31) == 0) ssq[(size_t)(MP + 16 * rb + row) * 16 + cg] = s; } }
    __syncthreads();
}
struct SkResid { const bf16* R; float alpha; bf16* Hb;
    __device__ __forceinline__ f32x2 operator()(int row, int col, float a0, float a1, float, float) const {
        const unsigned r = *(const unsigned*)(R + (size_t)row * DM + col); const f32x2 h = {bflo(r) + alpha * a0, bfhi(r) + alpha * a1};
        *(unsigned*)(Hb + (size_t)row * DM + col) = pg8::cvt_pk_bf16(h[0], h[1]); return h; } };
struct SkResidX { const float* xs; bf16* Hb;
    __device__ __forceinline__ f32x2 operator()(int row, int col, float a0, float a1, float, float) const {
        const f32x2 r = *(const f32x2*)(xs + (size_t)(row - MP) * DM + col); const f32x2 h = {r[0] + 0.5f * a0, r[1] + 0.5f * a1};
        *(unsigned*)(Hb + (size_t)row * DM + col) = pg8::cvt_pk_bf16(h[0], h[1]); return h; } };
struct SkMerge { const bf16* SGA; const bf16* SGR; bf16* O;
    __device__ __forceinline__ f32x2 operator()(int row, int col, float a0, float a1, float b0, float b1) const {
        const unsigned ga = *(const unsigned*)(SGA + (size_t)row * DM + col), gr = *(const unsigned*)(SGR + (size_t)row * DM + col);
        const f32x2 m = {bflo(ga) * a0 + bflo(gr) * b0, bfhi(ga) * a1 + bfhi(gr) * b1};
        *(unsigned*)(O + (size_t)row * DM + col) = pg8::cvt_pk_bf16(m[0], m[1]); return m; } };
struct SkPlain { bf16* O;
    __device__ __forceinline__ f32x2 operator()(int row, int col, float a0, float a1, float, float) const {
        *(unsigned*)(O + (size_t)row * DM + col) = pg8::cvt_pk_bf16(a0, a1); return (f32x2){a0, a1}; } };
struct SkPle { const bf16* H3; const bf16* PP; const float* ssq3; bf16* H4;
    __device__ __forceinline__ f32x2 operator()(int row, int col, float a0, float a1, float, float) const {
        const float rs = pg8::rstd_of<16>(ssq3, row, 1.0f / DM); const unsigned r = *(const unsigned*)(H3 + (size_t)row * DM + col); const unsigned p = *(const unsigned*)(PP + (size_t)row * DM + col);
        const f32x2 h = {bflo(r) + sigm(a0 * rs) * bflo(p), bfhi(r) + sigm(a1 * rs) * bfhi(p)};
        *(unsigned*)(H4 + (size_t)row * DM + col) = pg8::cvt_pk_bf16(h[0], h[1]); return h; } };
}
namespace dec {
using bf16x2 = __attribute__((ext_vector_type(2))) __bf16;
using u32x4 = __attribute__((ext_vector_type(4))) unsigned;
using f32x4 = __attribute__((ext_vector_type(4))) float;
using f32x2 = __attribute__((ext_vector_type(2))) float;
constexpr int NSPLIT = 16, PPS = NPAGES / NSPLIT;
constexpr int HPL = 2, GE = 8;
constexpr int L_QL = 0, L_P = 8 * 128, L_MRG = L_P + 8 * 64 * HPL, MRG_REC = 4 + 128, L_END = L_MRG + 8 * GE * MRG_REC;
static_assert(L_END * 4 <= RING_BYTES, "decode LDS");
__device__ __forceinline__ float dot2(unsigned k, unsigned q, float acc) { return __builtin_amdgcn_fdot2_f32_bf16(__builtin_bit_cast(bf16x2, k), __builtin_bit_cast(bf16x2, q), acc, false); }
__device__ __forceinline__ unsigned cvtpk(float lo, float hi) { return pg8::cvt_pk_bf16(lo, hi); }
template <int CTRL> __device__ __forceinline__ float dpp(float x) { return __builtin_bit_cast(float, __builtin_amdgcn_mov_dpp(__builtin_bit_cast(int, x), CTRL, 0xf, 0xf, true)); }
constexpr int XOR1 = 0xB1, XOR2 = 0x4E, XOR7 = 0x141, XOR8 = 0x128, ROR4 = 0x124;
__device__ __forceinline__ float xrow16_max(float x) {
    auto s = __builtin_amdgcn_permlane16_swap(__float_as_uint(x), __float_as_uint(x), false, false); x = fmaxf(__uint_as_float(s[0]), __uint_as_float(s[1]));
    auto t = __builtin_amdgcn_permlane32_swap(__float_as_uint(x), __float_as_uint(x), false, false); return fmaxf(__uint_as_float(t[0]), __uint_as_float(t[1])); }
__device__ __forceinline__ float xrow16_sum(float x) {
    auto s = __builtin_amdgcn_permlane16_swap(__float_as_uint(x), __float_as_uint(x), false, false); x = __uint_as_float(s[0]) + __uint_as_float(s[1]);
    auto t = __builtin_amdgcn_permlane32_swap(__float_as_uint(x), __float_as_uint(x), false, false); return __uint_as_float(t[0]) + __uint_as_float(t[1]); }

__device__ __forceinline__ void qlat_token(int s, const bf16* QB, const float* wkvb, LAS float* QLs, float* QLATg, bool store) {
    int tid_ = threadIdx.x; asm volatile("" : "+v"(tid_)); const int tid = tid_, lane = tid & 63, h = __builtin_amdgcn_readfirstlane(tid >> 6);
    const bf16* q = QB + (size_t)(MP + s) * 768 + h * QKD;
#pragma unroll
    for (int cc = 0; cc < 2; ++cc) { const int c = lane + 64 * cc; const float* w = wkvb + (size_t)c * 1024 + h * 128; float a = 0.f;
#pragma unroll 4
        for (int d = 0; d < 64; d += 4) { const f32x4 wv = *(const f32x4*)(w + d); a += bf2f(q[d]) * wv[0] + bf2f(q[d + 1]) * wv[1] + bf2f(q[d + 2]) * wv[2] + bf2f(q[d + 3]) * wv[3]; }
        QLs[h * 128 + c] = a; if (store) QLATg[(size_t)s * 1024 + h * 128 + c] = a; }
}

__device__ __forceinline__ void split_unit(int s, int sp, const bf16* QB, const float* cache_ckv, const float* cache_kpe, const int* page_table, float* DPO, float* DML, LAS float* lds) {
    int tid_ = threadIdx.x; asm volatile("" : "+v"(tid_)); const int tid = tid_, lane = tid & 63, wave = __builtin_amdgcn_readfirstlane(tid >> 6), r = lane >> 4, c = lane & 15;
    const LAS float* QL = lds + L_QL;
    u32x4 qpk[GE]; unsigned qpe[GE];
#pragma unroll
    for (int g = 0; g < GE; ++g) { const LAS float* ql = QL + g * 128 + 8 * c; qpk[g] = (u32x4){cvtpk(ql[0], ql[1]), cvtpk(ql[2], ql[3]), cvtpk(ql[4], ql[5]), cvtpk(ql[6], ql[7])};
        qpe[g] = *(const unsigned*)(QB + (size_t)(MP + s) * 768 + g * QKD + 64 + 2 * c); }
    float m[HPL], l[HPL], acc[GE * 8];
#pragma unroll
    for (int j = 0; j < HPL; ++j) { m[j] = -INFINITY; l[j] = 0.f; }
#pragma unroll
    for (int k = 0; k < GE * 8; ++k) acc[k] = 0.f;
    const int ph0 = page_table[s * NPAGES + PPS * sp + wave], ph1 = page_table[s * NPAGES + PPS * sp + wave + 8];
    f32x4 Kn[4][2]; f32x2 Pn[4];
#define DEC_ISSUE(i_) do { const int ph_ = ((i_) >> 3) ? ph1 : ph0; const size_t tok_ = (size_t)ph_ * PAGE + 16 * ((i_) & 7) + r; \
        _Pragma("unroll") for (int t_ = 0; t_ < 4; ++t_) { const float* kp_ = cache_ckv + (tok_ + 4 * t_) * KVL + 8 * c; \
            Kn[t_][0] = __builtin_nontemporal_load((const f32x4*)kp_); Kn[t_][1] = __builtin_nontemporal_load((const f32x4*)(kp_ + 4)); \
            Pn[t_] = __builtin_nontemporal_load((const f32x2*)(cache_kpe + (tok_ + 4 * t_) * RPE + 2 * c)); } } while (0)
    DEC_ISSUE(0);
#pragma nounroll
    for (int i = 0; i < 16; ++i) {
        u32x4 Kc[4]; unsigned Pc[4];
#pragma unroll
        for (int t = 0; t < 4; ++t) {
            Kc[t] = (u32x4){cvtpk(Kn[t][0][0], Kn[t][0][1]), cvtpk(Kn[t][0][2], Kn[t][0][3]), cvtpk(Kn[t][1][0], Kn[t][1][1]), cvtpk(Kn[t][1][2], Kn[t][1][3])}; Pc[t] = cvtpk(Pn[t][0], Pn[t][1]); }
        if (i + 1 < 16) DEC_ISSUE(i + 1);
        float x[4 * GE];
#pragma unroll
        for (int t = 0; t < 4; ++t)
#pragma unroll
            for (int g = 0; g < GE; ++g) { float d = dot2(Pc[t], qpe[g], 0.f);
#pragma unroll
                for (int k = 0; k < 4; ++k) d = dot2(Kc[t][k], qpk[g][k], d);
                x[t * GE + g] = d; }
#define TR_STEP(HALF, CTRL, BIT) _Pragma("unroll") for (int h = 0; h < (HALF); ++h) _Pragma("unroll") for (int j = 0; j < HPL; ++j) { \
        const float lo_ = x[h * HPL + j], hi_ = x[(h + (HALF)) * HPL + j]; const float t1_ = lo_ + dpp<CTRL>(lo_), t2_ = hi_ + dpp<CTRL>(hi_); \
        x[h * HPL + j] = (c & (BIT)) ? t2_ : t1_; }
        TR_STEP(8, XOR8, 8) TR_STEP(4, XOR7, 4) TR_STEP(2, XOR2, 2) TR_STEP(1, XOR1, 1)
#undef TR_STEP
        float p[HPL], alpha[HPL];
#pragma unroll
        for (int j = 0; j < HPL; ++j) { const float sc = x[j];
            float pm = sc; pm = fmaxf(pm, dpp<ROR4>(pm)); pm = fmaxf(pm, dpp<XOR8>(pm)); pm = xrow16_max(pm);
            const float mn = fmaxf(m[j], pm);
            alpha[j] = __builtin_amdgcn_exp2f(m[j] - mn); p[j] = __builtin_amdgcn_exp2f(sc - mn);
            l[j] = fmaf(l[j], alpha[j], p[j]); m[j] = mn; }
#pragma unroll
        for (int q4 = 0; q4 < 4; ++q4)
#pragma unroll
            for (int j = 0; j < HPL; ++j) { const float al = q4 == 0 ? dpp<0x00>(alpha[j]) : q4 == 1 ? dpp<0x55>(alpha[j]) : q4 == 2 ? dpp<0xAA>(alpha[j]) : dpp<0xFF>(alpha[j]);
#pragma unroll
                for (int k = 0; k < 8; ++k) acc[(q4 * HPL + j) * 8 + k] *= al; }
        LAS float* prow = lds + L_P + (wave * 4 + r) * 16 * HPL;
#pragma unroll
        for (int j = 0; j < HPL; ++j) prow[c * HPL + j] = p[j];
        asm volatile("s_waitcnt lgkmcnt(0)" ::: "memory");
#pragma unroll
        for (int t = 0; t < 4; ++t) { float vf[8]; f32x4 pr[2]; pr[0] = *(const LAS f32x4*)(prow + 8 * t); pr[1] = *(const LAS f32x4*)(prow + 8 * t + 4);
#pragma unroll
            for (int k = 0; k < 4; ++k) { vf[2 * k] = bflo(Kc[t][k]); vf[2 * k + 1] = bfhi(Kc[t][k]); }
#pragma unroll
            for (int g = 0; g < GE; ++g) { const float pg_ = pr[g >> 2][g & 3];
#pragma unroll
                for (int k = 0; k < 8; ++k) acc[g * 8 + k] = fmaf(pg_, vf[k], acc[g * 8 + k]); } }
        asm volatile("s_waitcnt lgkmcnt(0)" ::: "memory");
    }
#undef DEC_ISSUE
#pragma unroll
    for (int k = 0; k < GE * 8; ++k) acc[k] = xrow16_sum(acc[k]);
#pragma unroll
    for (int j = 0; j < HPL; ++j) { float t = l[j]; t += dpp<ROR4>(t); t += dpp<XOR8>(t); l[j] = xrow16_sum(t); }
    LAS float* mrg = lds + L_MRG;
    if (r == 0) {
#pragma unroll
        for (int g = 0; g < GE; ++g) { LAS float* rec = mrg + (wave * GE + g) * MRG_REC;
#pragma unroll
            for (int k = 0; k < 8; k += 4) *(LAS f32x4*)(rec + 4 + 8 * c + k) = (f32x4){acc[g * 8 + k], acc[g * 8 + k + 1], acc[g * 8 + k + 2], acc[g * 8 + k + 3]};
            if (c == g / HPL) { rec[0] = m[g % HPL]; rec[1] = l[g % HPL]; } } }
    __syncthreads();
    { const int g = wave, d0 = 2 * lane;
      float M = -INFINITY;
#pragma unroll
      for (int w = 0; w < 8; ++w) M = fmaxf(M, mrg[(w * GE + g) * MRG_REC]);
      float L = 0.f, o0 = 0.f, o1 = 0.f;
#pragma unroll
      for (int w = 0; w < 8; ++w) { const LAS float* rec = mrg + (w * GE + g) * MRG_REC; const float wt = __builtin_amdgcn_exp2f(rec[0] - M);
          L = fmaf(wt, rec[1], L); o0 = fmaf(wt, rec[4 + d0], o0); o1 = fmaf(wt, rec[4 + d0 + 1], o1); }
      const size_t slot = ((size_t)s * NSPLIT + sp) * GE + g;
      *(f32x2*)(DPO + slot * 128 + d0) = (f32x2){o0, o1};
      if (lane == 0) *(f32x2*)(DML + slot * 2) = (f32x2){M, L}; }
    __syncthreads();
}

constexpr int D_BASE = 78848;
constexpr int D4_QL = 0, D4_P = 8 * 128, D4_MRG = D4_P + 4 * 64 * HPL, D4_END = D4_MRG + 4 * GE * MRG_REC;
static_assert(D_BASE + D4_END * 4 <= PH5_BYTES, "decode-half LDS");
__device__ __forceinline__ void qlat_token4(int s, int w4, int lane_, const bf16* QB, const float* wkvb, LAS float* QLs, float* QLATg, bool store) {
    int lane = lane_; asm volatile("" : "+v"(lane));
#pragma unroll
    for (int hh = 0; hh < 2; ++hh) { const int h = w4 + 4 * hh; const bf16* q = QB + (size_t)(MP + s) * 768 + h * QKD;
#pragma unroll
        for (int cc = 0; cc < 2; ++cc) { const int c = lane + 64 * cc; const float* w = wkvb + (size_t)c * 1024 + h * 128; float a = 0.f;
#pragma unroll 4
            for (int d = 0; d < 64; d += 4) { const f32x4 wv = *(const f32x4*)(w + d); a += bf2f(q[d]) * wv[0] + bf2f(q[d + 1]) * wv[1] + bf2f(q[d + 2]) * wv[2] + bf2f(q[d + 3]) * wv[3]; }
            QLs[h * 128 + c] = a; if (store) QLATg[(size_t)s * 1024 + h * 128 + c] = a; } }
}
__device__ __forceinline__ void split_unit4(int s, int sp, int w4, int lane_, const bf16* QB, const float* cache_ckv, const float* cache_kpe, const int* page_table, float* DPO, float* DML, LAS float* lds, volatile LAS unsigned* cnt, unsigned& gen) {
    int lane = lane_; asm volatile("" : "+v"(lane));
    const int r = lane >> 4, c = lane & 15;
    const LAS float* QL = lds + D4_QL;
    u32x4 qpk[GE]; unsigned qpe[GE];
#pragma unroll
    for (int g = 0; g < GE; ++g) { const LAS float* ql = QL + g * 128 + 8 * c; qpk[g] = (u32x4){cvtpk(ql[0], ql[1]), cvtpk(ql[2], ql[3]), cvtpk(ql[4], ql[5]), cvtpk(ql[6], ql[7])};
        qpe[g] = *(const unsigned*)(QB + (size_t)(MP + s) * 768 + g * QKD + 64 + 2 * c); }
    float m[HPL], l[HPL], acc[GE * 8];
#pragma unroll
    for (int j = 0; j < HPL; ++j) { m[j] = -INFINITY; l[j] = 0.f; }
#pragma unroll
    for (int k = 0; k < GE * 8; ++k) acc[k] = 0.f;
    const int* pt = page_table + s * NPAGES + PPS * sp + w4;
    f32x4 Kn[4][2]; f32x2 Pn[4];
#define DEC_ISSUE(i_) do { const int ph_ = pt[4 * ((i_) >> 3)]; const size_t tok_ = (size_t)ph_ * PAGE + 16 * ((i_) & 7) + r; \
        _Pragma("unroll") for (int t_ = 0; t_ < 4; ++t_) { const float* kp_ = cache_ckv + (tok_ + 4 * t_) * KVL + 8 * c; \
            Kn[t_][0] = __builtin_nontemporal_load((const f32x4*)kp_); Kn[t_][1] = __builtin_nontemporal_load((const f32x4*)(kp_ + 4)); \
            Pn[t_] = __builtin_nontemporal_load((const f32x2*)(cache_kpe + (tok_ + 4 * t_) * RPE + 2 * c)); } } while (0)
    DEC_ISSUE(0);
#pragma nounroll
    for (int i = 0; i < 16; ++i) {
        u32x4 Kc[4]; unsigned Pc[4];
#pragma unroll
        for (int t = 0; t < 4; ++t) {
            Kc[t] = (u32x4){cvtpk(Kn[t][0][0], Kn[t][0][1]), cvtpk(Kn[t][0][2], Kn[t][0][3]), cvtpk(Kn[t][1][0], Kn[t][1][1]), cvtpk(Kn[t][1][2], Kn[t][1][3])}; Pc[t] = cvtpk(Pn[t][0], Pn[t][1]); }
        if (i + 1 < 16) DEC_ISSUE(i + 1);
        float x[4 * GE];
#pragma unroll
        for (int t = 0; t < 4; ++t)
#pragma unroll
            for (int g = 0; g < GE; ++g) { float d = dot2(Pc[t], qpe[g], 0.f);
#pragma unroll
                for (int k = 0; k < 4; ++k) d = dot2(Kc[t][k], qpk[g][k], d);
                x[t * GE + g] = d; }
#define TR_STEP(HALF, CTRL, BIT) _Pragma("unroll") for (int h = 0; h < (HALF); ++h) _Pragma("unroll") for (int j = 0; j < HPL; ++j) { \
        const float lo_ = x[h * HPL + j], hi_ = x[(h + (HALF)) * HPL + j]; const float t1_ = lo_ + dpp<CTRL>(lo_), t2_ = hi_ + dpp<CTRL>(hi_); \
        x[h * HPL + j] = (c & (BIT)) ? t2_ : t1_; }
        TR_STEP(8, XOR8, 8) TR_STEP(4, XOR7, 4) TR_STEP(2, XOR2, 2) TR_STEP(1, XOR1, 1)
#undef TR_STEP
        float p[HPL], alpha[HPL];
#pragma unroll
        for (int j = 0; j < HPL; ++j) { const float sc = x[j];
            float pm = sc; pm = fmaxf(pm, dpp<ROR4>(pm)); pm = fmaxf(pm, dpp<XOR8>(pm)); pm = xrow16_max(pm);
            const float mn = fmaxf(m[j], pm);
            alpha[j] = __builtin_amdgcn_exp2f(m[j] - mn); p[j] = __builtin_amdgcn_exp2f(sc - mn);
            l[j] = fmaf(l[j], alpha[j], p[j]); m[j] = mn; }
#pragma unroll
        for (int q4 = 0; q4 < 4; ++q4)
#pragma unroll
            for (int j = 0; j < HPL; ++j) { const float al = q4 == 0 ? dpp<0x00>(alpha[j]) : q4 == 1 ? dpp<0x55>(alpha[j]) : q4 == 2 ? dpp<0xAA>(alpha[j]) : dpp<0xFF>(alpha[j]);
#pragma unroll
                for (int k = 0; k < 8; ++k) acc[(q4 * HPL + j) * 8 + k] *= al; }
        LAS float* prow = lds + D4_P + (w4 * 4 + r) * 16 * HPL;
#pragma unroll
        for (int j = 0; j < HPL; ++j) prow[c * HPL + j] = p[j];
        asm volatile("s_waitcnt lgkmcnt(0)" ::: "memory");
#pragma unroll
        for (int t = 0; t < 4; ++t) { float vf[8]; f32x4 pr[2]; pr[0] = *(const LAS f32x4*)(prow + 8 * t); pr[1] = *(const LAS f32x4*)(prow + 8 * t + 4);
#pragma unroll
            for (int k = 0; k < 4; ++k) { vf[2 * k] = bflo(Kc[t][k]); vf[2 * k + 1] = bfhi(Kc[t][k]); }
#pragma unroll
            for (int g = 0; g < GE; ++g) { const float pg_ = pr[g >> 2][g & 3];
#pragma unroll
                for (int k = 0; k < 8; ++k) acc[g * 8 + k] = fmaf(pg_, vf[k], acc[g * 8 + k]); } }
        asm volatile("s_waitcnt lgkmcnt(0)" ::: "memory");
    }
#undef DEC_ISSUE
#pragma unroll
    for (int k = 0; k < GE * 8; ++k) acc[k] = xrow16_sum(acc[k]);
#pragma unroll
    for (int j = 0; j < HPL; ++j) { float t = l[j]; t += dpp<ROR4>(t); t += dpp<XOR8>(t); l[j] = xrow16_sum(t); }
    LAS float* mrg = lds + D4_MRG;
    if (r == 0) {
#pragma unroll
        for (int g = 0; g < GE; ++g) { LAS float* rec = mrg + (w4 * GE + g) * MRG_REC;
#pragma unroll
            for (int k = 0; k < 8; k += 4) *(LAS f32x4*)(rec + 4 + 8 * c + k) = (f32x4){acc[g * 8 + k], acc[g * 8 + k + 1], acc[g * 8 + k + 2], acc[g * 8 + k + 3]};
            if (c == g / HPL) { rec[0] = m[g % HPL]; rec[1] = l[g % HPL]; } } }
    asm volatile("s_waitcnt lgkmcnt(0)" ::: "memory"); att::bar4(cnt, gen, lane);
#pragma unroll
    for (int hh = 0; hh < 2; ++hh) { const int g = w4 + 4 * hh, d0 = 2 * lane;
      float M = -INFINITY;
#pragma unroll
      for (int w = 0; w < 4; ++w) M = fmaxf(M, mrg[(w * GE + g) * MRG_REC]);
      float L = 0.f, o0 = 0.f, o1 = 0.f;
#pragma unroll
      for (int w = 0; w < 4; ++w) { const LAS float* rec = mrg + (w * GE + g) * MRG_REC; const float wt = __builtin_amdgcn_exp2f(rec[0] - M);
          L = fmaf(wt, rec[1], L); o0 = fmaf(wt, rec[4 + d0], o0); o1 = fmaf(wt, rec[4 + d0 + 1], o1); }
      const size_t slot = ((size_t)s * NSPLIT + sp) * GE + g;
      *(f32x2*)(DPO + slot * 128 + d0) = (f32x2){o0, o1};
      if (lane == 0) *(f32x2*)(DML + slot * 2) = (f32x2){M, L}; }
    asm volatile("s_waitcnt lgkmcnt(0)" ::: "memory"); att::bar4(cnt, gen, lane);
}

using bf16x8 = __attribute__((ext_vector_type(8))) short;
typedef short dv4i16_t __attribute__((ext_vector_type(4)));
constexpr int VP = 272, VTILE = 32 * VP;
constexpr int M4_QL = 0, M4_VT = 4096, M4_END = M4_VT + 4 * VTILE;
static_assert(2 * D_BASE <= PH5_BYTES && M4_END <= D_BASE && 8 * MRG_REC * 4 <= VTILE, "P5 LDS (MFMA form)");
__device__ __forceinline__ bf16x8 pk8(f32x4 a, f32x4 b) { const u32x4 w = {pg8::cvt_pk_bf16(a[0], a[1]), pg8::cvt_pk_bf16(a[2], a[3]), pg8::cvt_pk_bf16(b[0], b[1]), pg8::cvt_pk_bf16(b[2], b[3])}; return __builtin_bit_cast(bf16x8, w); }
__device__ __forceinline__ void split_unit4m(int s, int sp, int w4, int lane_, const bf16* QB, const float* cache_ckv, const float* cache_kpe, const int* page_table, float* DPO, float* DML, LAS unsigned char* tl, volatile LAS unsigned* cnt, unsigned& gen) {
    int lane = lane_; asm volatile("" : "+v"(lane));
    const int t16 = lane & 15, kg = lane >> 4;
    const LAS float* QL = (const LAS float*)(tl + M4_QL);
    LAS unsigned char* vt = tl + M4_VT + w4 * VTILE;
    bf16x8 qf[5];
    if (t16 < 8) {
#pragma unroll
        for (int ks = 0; ks < 4; ++ks) { const LAS float* q = QL + t16 * 128 + 64 * (ks >> 1) + 32 * (ks & 1) + 4 * kg; qf[ks] = pk8(*(const LAS f32x4*)q, *(const LAS f32x4*)(q + 16)); }
        { const bf16* qp = QB + (size_t)(MP + s) * 768 + t16 * QKD + 64 + 4 * kg; const v2u a = *(const v2u*)qp, b = *(const v2u*)(qp + 16); const u32x4 w = {a.x, a.y, b.x, b.y}; qf[4] = __builtin_bit_cast(bf16x8, w); }
    } else {
#pragma unroll
        for (int ks = 0; ks < 5; ++ks) qf[ks] = (bf16x8){0, 0, 0, 0, 0, 0, 0, 0};
    }
    float m = -INFINITY, l = 0.f; f32x4 O[8];
#pragma unroll
    for (int c = 0; c < 8; ++c) O[c] = (f32x4){0.f, 0.f, 0.f, 0.f};
    const int* pt = page_table + s * NPAGES + PPS * sp + w4;
    const int ph0 = __builtin_amdgcn_readfirstlane(pt[0]), ph1 = __builtin_amdgcn_readfirstlane(pt[4]);
    f32x4 Cn[2][2][4], Pn[2][2];
#define DEC_ISSUE(i_) do { const int ph_ = ((i_) >> 2) ? ph1 : ph0; const size_t tok_ = (size_t)ph_ * PAGE + 32 * ((i_) & 3) + t16; \
        _Pragma("unroll") for (int g_ = 0; g_ < 2; ++g_) { const float* cp_ = cache_ckv + (tok_ + 16 * g_) * KVL + 4 * kg; const float* pp_ = cache_kpe + (tok_ + 16 * g_) * RPE + 4 * kg; \
            _Pragma("unroll") for (int b_ = 0; b_ < 2; ++b_) _Pragma("unroll") for (int j_ = 0; j_ < 4; ++j_) Cn[g_][b_][j_] = __builtin_nontemporal_load((const f32x4*)(cp_ + 64 * b_ + 16 * j_)); \
            Pn[g_][0] = __builtin_nontemporal_load((const f32x4*)pp_); Pn[g_][1] = __builtin_nontemporal_load((const f32x4*)(pp_ + 16)); } } while (0)
    DEC_ISSUE(0);
#pragma nounroll
    for (int i = 0; i < 8; ++i) {
        bf16x8 kf[2][5];
#pragma unroll
        for (int g = 0; g < 2; ++g) {
#pragma unroll
            for (int b = 0; b < 2; ++b) { kf[g][2 * b] = pk8(Cn[g][b][0], Cn[g][b][1]); kf[g][2 * b + 1] = pk8(Cn[g][b][2], Cn[g][b][3]); }
            kf[g][4] = pk8(Pn[g][0], Pn[g][1]); }
        if (i + 1 < 8) DEC_ISSUE(i + 1);
#pragma unroll
        for (int g = 0; g < 2; ++g)
#pragma unroll
            for (int ks = 0; ks < 4; ++ks) { const u32x4 w = __builtin_bit_cast(u32x4, kf[g][ks]); LAS unsigned char* d = vt + (16 * g + t16) * VP + 128 * (ks >> 1) + 64 * (ks & 1) + 8 * kg;
                *(LAS v2u*)d = (v2u){w[0], w[1]}; *(LAS v2u*)(d + 32) = (v2u){w[2], w[3]}; }
        f32x4 S[2];
#pragma unroll
        for (int g = 0; g < 2; ++g) { S[g] = (f32x4){0.f, 0.f, 0.f, 0.f};
#pragma unroll
            for (int ks = 0; ks < 5; ++ks) S[g] = __builtin_amdgcn_mfma_f32_16x16x32_bf16(kf[g][ks], qf[ks], S[g], 0, 0, 0); }
        float pm = fmaxf(fmaxf(fmaxf(S[0][0], S[0][1]), fmaxf(S[0][2], S[0][3])), fmaxf(fmaxf(S[1][0], S[1][1]), fmaxf(S[1][2], S[1][3])));
        pm = xrow16_max(pm);
        const float mn = (pm > m + 8.0f) ? pm : m;
        if (__any(mn > m)) {
            const float alpha = __builtin_amdgcn_exp2f(m - mn); l *= alpha; m = mn;
            float a4[4];
#pragma unroll
            for (int r = 0; r < 4; ++r) a4[r] = __shfl(alpha, 4 * kg + r);
#pragma unroll
            for (int c = 0; c < 8; ++c)
#pragma unroll
                for (int r = 0; r < 4; ++r) O[c][r] *= a4[r];
        }
        f32x4 p0, p1;
#pragma unroll
        for (int r = 0; r < 4; ++r) { p0[r] = __builtin_amdgcn_exp2f(S[0][r] - m); p1[r] = __builtin_amdgcn_exp2f(S[1][r] - m); }
        l += ((p0[0] + p0[1]) + (p0[2] + p0[3])) + ((p1[0] + p1[1]) + (p1[2] + p1[3]));
        const bf16x8 pa = pk8(p0, p1);
        const LAS unsigned char* vr = vt + (4 * kg + (t16 >> 2)) * VP + (t16 & 3) * 8;
#pragma unroll
        for (int c = 0; c < 8; ++c) {
            const dv4i16_t lo = __builtin_amdgcn_ds_read_tr16_b64_v4i16((LAS dv4i16_t*)(vr + 32 * c));
            const dv4i16_t hi = __builtin_amdgcn_ds_read_tr16_b64_v4i16((LAS dv4i16_t*)(vr + 16 * VP + 32 * c));
            const bf16x8 vb = {lo[0], lo[1], lo[2], lo[3], hi[0], hi[1], hi[2], hi[3]};
            O[c] = __builtin_amdgcn_mfma_f32_16x16x32_bf16(pa, vb, O[c], 0, 0, 0); }
    }
#undef DEC_ISSUE
    l = xrow16_sum(l);
    asm volatile("s_waitcnt lgkmcnt(0)" ::: "memory");
    LAS float* rec0 = (LAS float*)vt;
    if (kg < 2) {
#pragma unroll
        for (int c = 0; c < 8; ++c)
#pragma unroll
            for (int r = 0; r < 4; ++r) rec0[(4 * kg + r) * MRG_REC + 4 + 16 * c + t16] = O[c][r]; }
    if (kg == 0 && t16 < 8) { rec0[t16 * MRG_REC] = m; rec0[t16 * MRG_REC + 1] = l; }
    asm volatile("s_waitcnt lgkmcnt(0)" ::: "memory"); att::bar4(cnt, gen, lane);
#pragma unroll
    for (int hh = 0; hh < 2; ++hh) { const int g = w4 + 4 * hh, d0 = 2 * lane;
      float M = -INFINITY;
#pragma unroll
      for (int w = 0; w < 4; ++w) M = fmaxf(M, ((const LAS float*)(tl + M4_VT + w * VTILE))[g * MRG_REC]);
      float L = 0.f, o0 = 0.f, o1 = 0.f;
#pragma unroll
      for (int w = 0; w < 4; ++w) { const LAS float* rec = (const LAS float*)(tl + M4_VT + w * VTILE) + g * MRG_REC; const float wt = __builtin_amdgcn_exp2f(rec[0] - M);
          L = fmaf(wt, rec[1], L); o0 = fmaf(wt, rec[4 + d0], o0); o1 = fmaf(wt, rec[4 + d0 + 1], o1); }
      const size_t slot = ((size_t)s * NSPLIT + sp) * GE + g;
      *(f32x2*)(DPO + slot * 128 + d0) = (f32x2){o0, o1};
      if (lane == 0) *(f32x2*)(DML + slot * 2) = (f32x2){M, L}; }
    asm volatile("s_waitcnt lgkmcnt(0)" ::: "memory"); att::bar4(cnt, gen, lane);
}

__device__ __forceinline__ void combine_unit(int s, const bf16* QB, const float* QLATg, const float* DPO, const float* DML, const float* dout, const float* wkvb, bf16* OCAT, LAS float* lds) {
    int tid_ = threadIdx.x; asm volatile("" : "+v"(tid_)); const int tid = tid_, lane = tid & 63, g = __builtin_amdgcn_readfirstlane(tid >> 6), d0 = 2 * lane;
    const float* ck = dout + O_CKVS + (size_t)s * KVL; const float* kp = dout + O_KPES + (size_t)s * RPE;
    const f32x2 ckv = *(const f32x2*)(ck + d0); const f32x2 ql = *(const f32x2*)(QLATg + (size_t)s * 1024 + g * 128 + d0);
    float part = ql[0] * ckv[0] + ql[1] * ckv[1];
    if (lane < 16) { const unsigned qp = *(const unsigned*)(QB + (size_t)(MP + s) * 768 + g * QKD + 64 + d0); part += bflo(qp) * kp[d0] + bfhi(qp) * kp[d0 + 1]; }
    const float sself = wave_sum(part);
    float M = sself;
#pragma unroll
    for (int sp = 0; sp < NSPLIT; ++sp) M = fmaxf(M, DML[(((size_t)s * NSPLIT + sp) * GE + g) * 2]);
    float L = __builtin_amdgcn_exp2f(sself - M), o0 = L * ckv[0], o1 = L * ckv[1];
#pragma unroll
    for (int sp = 0; sp < NSPLIT; ++sp) { const size_t slot = ((size_t)s * NSPLIT + sp) * GE + g; const float wt = __builtin_amdgcn_exp2f(DML[slot * 2] - M);
        const f32x2 po = *(const f32x2*)(DPO + slot * 128 + d0); L = fmaf(wt, DML[slot * 2 + 1], L); o0 = fmaf(wt, po[0], o0); o1 = fmaf(wt, po[1], o1); }
    const float inv = 1.0f / L;
    LAS float* ol = lds + g * 128;
    ol[d0] = o0 * inv; ol[d0 + 1] = o1 * inv;
    asm volatile("s_waitcnt lgkmcnt(0)" ::: "memory");
    float a = 0.f;
#pragma unroll 8
    for (int cc = 0; cc < 128; ++cc) a = fmaf(ol[cc], wkvb[(size_t)cc * 1024 + g * 128 + 64 + lane], a);
    OCAT[(size_t)(MP + s) * DM + g * 64 + lane] = (bf16)f2bf(a);
    __syncthreads();
}
}
#define XB_TMO      128
#define XB_XCNT(j)  (256  + 64 * (j))
#define XB_XSUB(j)  (1280 + 64 * (j))
#define XB_XGEN(j)  (2304 + 64 * (j))
#define XB_TOP      3328
#define XB_TOPGEN   3392
#define XCD_BAR_WORDS 3456
#define XB_SPIN_CAP (1u << 18)

__device__ __forceinline__ unsigned xb_ld(unsigned* p)              { return __hip_atomic_load(p, __ATOMIC_RELAXED, __HIP_MEMORY_SCOPE_AGENT); }
__device__ __forceinline__ unsigned xb_add(unsigned* p, unsigned v) { return __hip_atomic_fetch_add(p, v, __ATOMIC_RELAXED, __HIP_MEMORY_SCOPE_AGENT); }
__device__ __forceinline__ unsigned xb_xcc_id() { return (unsigned)__builtin_amdgcn_s_getreg((3 << 11) | 20) & 0xFu; }
#define XB_SPIN(cond, bar) do { unsigned _sp = 0; while (cond) { __builtin_amdgcn_s_sleep(1); \
    if ((++_sp & 255u) == 0u) { if (xb_ld(&(bar)[XB_TMO])) break; if (_sp > XB_SPIN_CAP) { atomicAdd(&(bar)[XB_TMO], 1u); break; } } } } while (0)

struct XcdBarrier {
    unsigned* bar; unsigned x;
    volatile LAS unsigned* st;
};

__device__ __forceinline__ XcdBarrier xcd_barrier_post(unsigned* bar, volatile LAS unsigned* st) {
    XcdBarrier b; b.bar = bar; b.x = xb_xcc_id(); b.st = st;
    if (threadIdx.x == 0) (void)xb_add(&bar[XB_XCNT(b.x)], 1u);
    return b;
}
__device__ __forceinline__ void xcd_barrier_complete(unsigned* bar, unsigned x, unsigned& nloc, unsigned& nx) {
    const unsigned G = gridDim.x * gridDim.y * gridDim.z;
    unsigned sum, cnt, mine, sp = 0u;
    for (;;) {
        sum = 0u; cnt = 0u; mine = 0u;
#pragma unroll
        for (unsigned j = 0; j < 16; ++j) { const unsigned c = xb_ld(&bar[XB_XCNT(j)]); sum += c; cnt += (c > 0u) ? 1u : 0u; mine = (j == x) ? c : mine; }
        if (sum == G) break;
        __builtin_amdgcn_s_sleep(1);
        if ((++sp & 255u) == 0u) { if (xb_ld(&bar[XB_TMO])) break; if (sp > XB_SPIN_CAP) { atomicAdd(&bar[XB_TMO], 1u); break; } }
    }
    nloc = mine > 0u ? mine : 1u; nx = cnt > 0u ? cnt : 1u;
}

__device__ __forceinline__ void xcd_barrier(const XcdBarrier& b) {
    asm volatile("s_waitcnt vmcnt(0)" ::: "memory");
    __syncthreads();
    if (threadIdx.x == 0) {
        unsigned* bar = b.bar;
        __builtin_amdgcn_s_waitcnt(0);
        unsigned nloc = b.st[0], nx = b.st[1];
        if (nloc == 0u) { xcd_barrier_complete(bar, b.x, nloc, nx); b.st[0] = nloc; b.st[1] = nx; }
        const unsigned old = xb_add(&bar[XB_XSUB(b.x)], 1u);
        const unsigned gen = old / nloc;
        if (old + 1u == (gen + 1u) * nloc) {
            __builtin_amdgcn_fence(__ATOMIC_RELEASE, "agent");
            asm volatile("s_waitcnt vmcnt(0)" ::: "memory");
            const unsigned og = xb_add(&bar[XB_TOP], 1u);
            const unsigned tg = og / nx;
            if (og + 1u == (tg + 1u) * nx) xb_add(&bar[XB_TOPGEN], 1u);
            else XB_SPIN(xb_ld(&bar[XB_TOPGEN]) == tg, bar);
            __builtin_amdgcn_fence(__ATOMIC_ACQUIRE, "agent");
            xb_add(&bar[XB_XGEN(b.x)], 1u);
            asm volatile("s_waitcnt vmcnt(0)" ::: "memory");
        } else {
            XB_SPIN(xb_ld(&bar[XB_XGEN(b.x)]) == gen, bar);
            __builtin_amdgcn_fence(__ATOMIC_ACQUIRE, "agent");
            asm volatile("s_waitcnt vmcnt(0)" ::: "memory");
        }
    }
    __syncthreads();
}
constexpr int NWAVES = 8, NPHASE = 13;
struct Args {
    const float *x_prompt, *x_sample, *cache_ckv, *cache_kpe, *state_ret; const int* page_table; const float *p_prompt, *p_sample;
    const float *ffn1_norm, *ffn1_w_gate, *ffn1_w_up, *ffn1_w_down, *mix_norm, *w_in, *q_a_norm, *w_q_b, *kv_a_norm, *w_kv_b, *ret_norm, *w_branch_att, *w_branch_ret, *w_out;
    const float *ffn2_norm, *ffn2_w_gate, *ffn2_w_up, *ffn2_w_down, *ple_norm, *w_ple_gate, *w_ple_proj, *final_norm;
    float* out; unsigned char* ws; int ph_lo, ph_hi;
};
static_assert(sizeof(Args) == 32 * 8 + 8, "Args has no padding holes");

enum { RM_ID = 0, RM_GATE, RM_UP, RM_WIN, RM_QB, RM_KVB };
__device__ __forceinline__ int rowmap(int kind, int n) {
    switch (kind) {
    case RM_GATE: return (n >> 7) * 256 + (n & 127);
    case RM_UP:   return (n >> 7) * 256 + 128 + (n & 127);
    case RM_WIN: {
        if (n < 384) return n;
        if (n < 416) { const int j = n - 384, jj = j & 15; return 384 + 8 * (jj >> 2) + 4 * (j >> 4) + (jj & 3); }
        if (n < 1440) { const bool isk = n >= 928; const int j = n - (isk ? 928 : 416), hh = j >> 7, d = j & 127, i = d & 63, n_ = d >> 6;
            return (isk ? 1024 : 512) + hh * 128 + 32 * (i >> 4) + 8 * ((i >> 2) & 3) + 4 * n_ + (i & 3); }
        if (n < 1952) return 1536 + (n - 1440);
        if (n < 2464) return 2048 + (n - 1952);
        if (n < 3488) return 2560 + (n - 2464);
        return 3584 + (n - 3488); }
    case RM_QB: { const int hh = n / 96, d = n % 96; if (d < 64) return hh * 64 + d; const int j = d - 64, jj = j & 15; return 512 + hh * 32 + 8 * (jj >> 2) + 4 * (j >> 4) + (jj & 3); }
    case RM_KVB: { const int hh = n >> 7, d = n & 127; return d < 64 ? hh * 64 + d : 512 + hh * 64 + (d - 64); }
    default: return n; }
}
__device__ __forceinline__ void tr_item2(const float* W, int N, bf16* WT, int Kd, int koff, const float* gain, float scale, int kind, LAS float* scr, int item, int lane) {
    const int nblk = N / 32, kb = item / nblk, nb = item % nblk, k0 = 128 * kb, n0 = 32 * nb, kr = lane >> 3, n4 = (lane & 7) * 4, c = lane & 7;
    pg8::f32x4 v[16];
#pragma unroll
    for (int i = 0; i < 16; ++i) v[i] = *(const pg8::f32x4*)(W + (size_t)(k0 + 8 * i + kr) * N + n0 + n4);
#pragma unroll
    for (int h = 0; h < 2; ++h) {
#pragma unroll
        for (int i = 0; i < 8; ++i) { const int kk = 8 * i + kr; const float g = gain ? gain[k0 + 64 * h + kk] * scale : scale; LAS float* d = scr + kk * 33 + n4;
            d[0] = v[8 * h + i][0] * g; d[1] = v[8 * h + i][1] * g; d[2] = v[8 * h + i][2] * g; d[3] = v[8 * h + i][3] * g; }
        LDS_WAIT(); asm volatile("" ::: "memory");
#pragma unroll
        for (int q = 0; q < 4; ++q) { const int n = (lane >> 3) + 8 * q; const LAS float* s = scr + (8 * c) * 33 + n;
            v4u o; o.x = pk2(s[0 * 33], s[1 * 33]); o.y = pk2(s[2 * 33], s[3 * 33]); o.z = pk2(s[4 * 33], s[5 * 33]); o.w = pk2(s[6 * 33], s[7 * 33]);
            *(GAS v4u*)(WT + (size_t)rowmap(kind, n0 + n) * Kd + koff + k0 + 64 * h + 8 * c) = o; }
        LDS_WAIT(); asm volatile("" ::: "memory"); }
}
__device__ __forceinline__ void sincos_d(double a, float& c, float& s) {
    const double k = __builtin_rint(a * 0.63661977236758134308);
    double r = __builtin_fma(-k, 1.5707963267948966, a); r = __builtin_fma(-k, 6.123233995736766e-17, r);
    const double r2 = r * r;
    const double sp = r * (1.0 + r2 * (-1.0 / 6 + r2 * (1.0 / 120 + r2 * (-1.0 / 5040 + r2 * (1.0 / 362880 + r2 * (-1.0 / 39916800 + r2 * (1.0 / 6227020800.0)))))));
    const double cp = 1.0 + r2 * (-0.5 + r2 * (1.0 / 24 + r2 * (-1.0 / 720 + r2 * (1.0 / 40320 + r2 * (-1.0 / 3628800 + r2 * (1.0 / 479001600.0 + r2 * (-1.0 / 87178291200.0)))))));
    const int q = (int)((long long)k & 3);
    const double cc = q == 0 ? cp : q == 1 ? -sp : q == 2 ? -cp : sp, ss = q == 0 ? sp : q == 1 ? cp : q == 2 ? -sp : -cp;
    c = (float)cc; s = (float)ss;
}

__device__ __forceinline__ int fresh_tid() { int t = threadIdx.x; asm volatile("" : "+v"(t)); return t; }
#define FTID fresh_tid()
#define FLANE (fresh_tid() & 63)
#define FWAVE __builtin_amdgcn_readfirstlane(fresh_tid() >> 6)
struct Frame {
    LAS unsigned char* lds; volatile LAS unsigned* MISC; gu32* ctl; int G, bid;
};

__device__ __forceinline__ void p0_prologue(const Args& a, Frame& F) {
    unsigned char* ws = a.ws;
    LAS float* scr = (LAS float*)(F.lds + FWAVE * 16384);
    const int gw = F.bid * NWAVES + FWAVE, NGW = F.G * NWAVES;
    constexpr int I_FF = 8 * 88, I_DN = 22 * 32, I_IN = 8 * 141, I_QB = 2 * 24, I_KVB = 1 * 32, I_BR = 4 * 32, I_SQ = 8 * 32, I_PP = 2 * 32;
    constexpr int NITEMS = 4 * I_FF + 2 * I_DN + I_IN + I_QB + I_KVB + 2 * I_BR + 2 * I_SQ + I_PP;
#ifndef REP_P0A
#define REP_P0A 1
#define REP_P0B 1
#endif
    for (int rpa_ = 0; rpa_ < REP_P0A; ++rpa_)
    for (int it = gw; it < NITEMS; it += NGW) {
        int r = it;
        if (r < I_FF) { tr_item2(a.ffn1_w_gate, DFF, (bf16*)(ws + WS_WGU1), DM, 0, nullptr, 1.f, RM_GATE, scr, r, FLANE); continue; } r -= I_FF;
        if (r < I_FF) { tr_item2(a.ffn1_w_up, DFF, (bf16*)(ws + WS_WGU1), DM, 0, nullptr, 1.f, RM_UP, scr, r, FLANE); continue; } r -= I_FF;
        if (r < I_FF) { tr_item2(a.ffn2_w_gate, DFF, (bf16*)(ws + WS_WGU2), DM, 0, a.ffn2_norm, 1.f, RM_GATE, scr, r, FLANE); continue; } r -= I_FF;
        if (r < I_FF) { tr_item2(a.ffn2_w_up, DFF, (bf16*)(ws + WS_WGU2), DM, 0, a.ffn2_norm, 1.f, RM_UP, scr, r, FLANE); continue; } r -= I_FF;
        if (r < I_DN) { tr_item2(a.ffn1_w_down, DM, (bf16*)(ws + WS_WD1), DFF, 0, nullptr, 1.f, RM_ID, scr, r, FLANE); continue; } r -= I_DN;
        if (r < I_DN) { tr_item2(a.ffn2_w_down, DM, (bf16*)(ws + WS_WD2), DFF, 0, nullptr, 1.f, RM_ID, scr, r, FLANE); continue; } r -= I_DN;
        if (r < I_IN) { tr_item2(a.w_in, 4512, (bf16*)(ws + WS_WIN), DM, 0, a.mix_norm, 1.f, RM_WIN, scr, r, FLANE); continue; } r -= I_IN;
        if (r < I_QB) { tr_item2(a.w_q_b, 768, (bf16*)(ws + WS_WQB), QL, 0, a.q_a_norm, C2, RM_QB, scr, r, FLANE); continue; } r -= I_QB;
        if (r < I_KVB) { tr_item2(a.w_kv_b, 1024, (bf16*)(ws + WS_WKVB), KVL, 0, a.kv_a_norm, 1.f, RM_KVB, scr, r, FLANE); continue; } r -= I_KVB;
        if (r < I_BR) { tr_item2(a.w_branch_att, DM, (bf16*)(ws + WS_WBC), DM, 0, nullptr, 1.f, RM_ID, scr, r, FLANE); continue; } r -= I_BR;
        if (r < I_BR) { tr_item2(a.w_branch_ret, DM, (bf16*)(ws + WS_WBC), DM, 512, nullptr, 1.f, RM_ID, scr, r, FLANE); continue; } r -= I_BR;
        if (r < I_SQ) { tr_item2(a.w_out, DM, (bf16*)(ws + WS_WOUT), DM, 0, nullptr, 1.f, RM_ID, scr, r, FLANE); continue; } r -= I_SQ;
        if (r < I_SQ) { tr_item2(a.w_ple_gate, DM, (bf16*)(ws + WS_WPG), DM, 0, a.ple_norm, 1.f, RM_ID, scr, r, FLANE); continue; } r -= I_SQ;
        tr_item2(a.w_ple_proj, DM, (bf16*)(ws + WS_WPP), PLE, 0, nullptr, 1.f, RM_ID, scr, r, FLANE);
    }
    const int gt = F.bid * (NWAVES * 64) + FTID, NGT = F.G * NWAVES * 64;
    for (int i = gt; i < 96 * 128; i += NGT) *(v4u*)((bf16*)(ws + WS_WIN) + (size_t)416 * DM + (size_t)i * 8) = (v4u){0u, 0u, 0u, 0u};
    for (int i = gt; i < 8193 * 64; i += NGT) { const int pi = i >> 6, fi = i & 63; double inv = 1.0; for (int k = 0; k < fi; ++k) inv *= 0.8659643233600653;
        float c, s; sincos_d((double)(pi == 8192 ? 16384 : pi) * inv, c, s); ((float2*)(ws + WS_ROPE))[i] = make_float2(c, s); }
    for (int rpb_ = 0; rpb_ < REP_P0B; ++rpb_)
    for (int m = gw; m < MT; m += NGW) {
        bf16* orow = (bf16*)(ws + WS_XN1) + (size_t)m * DM; bf16* prow = (bf16*)(ws + WS_PB) + (size_t)m * PLE;
        if (m >= MP + MS) {
#pragma unroll
            for (int j = 0; j < 4; ++j) ((unsigned long long*)orow)[FLANE + 64 * j] = 0ull;
            ((unsigned long long*)prow)[FLANE] = 0ull; continue; }
        const float* xrow = m < MP ? a.x_prompt + (size_t)m * DM : a.x_sample + (size_t)(m - MP) * DM;
        const float* pr = m < MP ? a.p_prompt + (size_t)m * PLE : a.p_sample + (size_t)(m - MP) * PLE;
        const pg8::f32x4* xr = (const pg8::f32x4*)xrow + FLANE; pg8::f32x4 v[4]; float s = 0.f;
#pragma unroll
        for (int j = 0; j < 4; ++j) { v[j] = xr[64 * j]; s += (v[j].x * v[j].x + v[j].y * v[j].y) + (v[j].z * v[j].z + v[j].w * v[j].w); }
        const float rstd = 1.0f / sqrtf(wave_sum(s) * (1.f / DM) + EPS);
#pragma unroll
        for (int j = 0; j < 4; ++j) { const pg8::f32x4 g = ((const pg8::f32x4*)a.ffn1_norm)[FLANE + 64 * j];
            ((unsigned long long*)orow)[FLANE + 64 * j] = (unsigned long long)pk2(v[j].x * rstd * g.x, v[j].y * rstd * g.y) | ((unsigned long long)pk2(v[j].z * rstd * g.z, v[j].w * rstd * g.w) << 32); }
        const pg8::f32x4 pv = ((const pg8::f32x4*)pr)[FLANE];
        ((unsigned long long*)prow)[FLANE] = (unsigned long long)pk2(pv.x, pv.y) | ((unsigned long long)pk2(pv.z, pv.w) << 32);
    }
}

__global__ void __launch_bounds__(NWAVES * 64, 2) mk_fwd(Args args) {
    extern __shared__ __attribute__((aligned(16))) unsigned char lds[];
    Frame F;
    F.lds = (LAS unsigned char*)lds; F.MISC = (volatile LAS unsigned*)(F.lds + MISC_OFF);
    F.G = gridDim.x; F.bid = blockIdx.x;
    unsigned char* ws = args.ws;
    F.ctl = (gu32*)(ws + WS_CTL);
    for (int u = FTID; u < (LDS_BYTES - LDSCTL_OFF) / 4; u += NWAVES * 64) ((LAS unsigned*)(F.lds + LDSCTL_OFF))[u] = 0u;
    __syncthreads();
    XcdBarrier bar; bar.bar = (unsigned*)(ws + WS_CTL) + CW_BAR; bar.x = 0; bar.st = nullptr;
    if (!MK_PER_PHASE) bar = xcd_barrier_post((unsigned*)(ws + WS_CTL) + CW_BAR, F.MISC + 8);
    const int lo = args.ph_lo, hi = args.ph_hi;
#ifndef PHASE_MASK
#define PHASE_MASK 0xFFFF
#endif
#define IN(k) (((PHASE_MASK >> (k)) & 1) && lo <= (k) && (k) < hi)
#ifndef REP_PHASE
#define REP_PHASE -1
#endif
#define REPK(k) ((k) == REP_PHASE ? 2 : 1)
#define SEAM(k) do { if (IN(k) && IN((k) + 1)) { if (MK_PER_PHASE) { if (FTID == 0) __hip_atomic_store(F.ctl + CW_TMO, 0xBADBA0u, RLX_AGENT); } else xcd_barrier(bar); } } while (0)
    float* ssq_h1 = (float*)(ws + WS_SSQ); float* ssq_h2 = (float*)(ws + WS_SSQ + SSQ16_BYTES); float* ssq_h3 = (float*)(ws + WS_SSQ + 2 * SSQ16_BYTES); float* ssq_h4 = (float*)(ws + WS_SSQ + 3 * SSQ16_BYTES);
    float* ssq_cq = (float*)(ws + WS_SSQ + 4 * SSQ16_BYTES); float* ssq_kv = (float*)(ws + WS_SSQ + 4 * SSQ16_BYTES + SSQ4_BYTES);
    const float2* rope = (const float2*)(ws + WS_ROPE);
    bf16 *XN1 = (bf16*)(ws + WS_XN1), *ACT = (bf16*)(ws + WS_ACT), *H1B = (bf16*)(ws + WS_H1B), *CQB = (bf16*)(ws + WS_CQB), *CKVB = (bf16*)(ws + WS_CKVB), *KPEB = (bf16*)(ws + WS_KPEB);
    bf16 *QR = (bf16*)(ws + WS_QR), *KR = (bf16*)(ws + WS_KR), *RV = (bf16*)(ws + WS_RV), *RGS = (bf16*)(ws + WS_RGS), *SGA = (bf16*)(ws + WS_SGA), *SGR = (bf16*)(ws + WS_SGR);
    bf16 *QB = (bf16*)(ws + WS_QB), *KN = (bf16*)(ws + WS_KN), *VB = (bf16*)(ws + WS_VB), *OCAT = (bf16*)(ws + WS_OCAT), *SC = (bf16*)(ws + WS_SC), *MRG = (bf16*)(ws + WS_MRG);
    bf16 *H2B = (bf16*)(ws + WS_H2B), *H3B = (bf16*)(ws + WS_H3B), *PB = (bf16*)(ws + WS_PB), *PP = (bf16*)(ws + WS_PP);
    bf16* H4B = (bf16*)(ws + WS_H4); float *CKVF = (float*)(ws + WS_CKVF), *KVC = (float*)(ws + WS_KVC);
    float *DPO = (float*)(ws + WS_DPO), *DML = (float*)(ws + WS_DML), *QLAT = (float*)(ws + WS_QLAT);
    const int NGT = F.G * NWAVES * 64, NGW = F.G * NWAVES;

    for (int rp_ = 0; rp_ < REPK(0); ++rp_) if (IN(0)) { p0_prologue(args, F); }
    SEAM(0);
    for (int rp_ = 0; rp_ < REPK(1); ++rp_) if (IN(1)) { pg8::Gemm g{XN1, (const bf16*)(ws + WS_WGU1), MT, NGU, DM}; pg8::StaticOrder S; S.init(MT, NGU, F.G, F.bid);
        pg8::EpiSwiGLU E{0, ACT, nullptr}; pg8::gemm_phase<pg8::EpiSwiGLU, pg8::StaticOrder, true, true>(F.lds, g, S, E);
        constexpr int NB6 = (MT / 256) * (NGU / 256) - 5 * 256;
        (void)NB6; }
    SEAM(1);
    for (int rp_ = 0; rp_ < REPK(2); ++rp_) if (IN(2)) { pg8::Gemm g{ACT, (const bf16*)(ws + WS_WD1), MP, DM, DFF}; pg8::StaticOrder S; S.init(MP, DM, F.G, F.bid);
        pg8::EpiResid<true, true> E{0, args.x_prompt, H1B, ssq_h1}; pg8::gemm_phase<pg8::EpiResid<true, true>, pg8::StaticOrder, true, true>(F.lds, g, S, E);
        for (int u = F.bid; u < 128; u += F.G) sk::skinny_unit<DFF, false, true>(u, ACT, (const bf16*)(ws + WS_WD1), ssq_h1, (LAS float*)F.lds, sk::SkResidX{args.x_sample, H1B}); }
    SEAM(2);
    for (int rp_ = 0; rp_ < REPK(3); ++rp_) if (IN(3)) { pg8::Gemm g{H1B, (const bf16*)(ws + WS_WIN), MT, NIN, DM}; pg8::StaticOrder S; S.init(MT, NIN, F.G, F.bid);
        pg8::rst_fill<16>(F.lds, S, ssq_h1, 1.0f / DM, FTID); pg8::EpiWin E{0, (const LAS float*)(F.lds + pg8::RST_OFF), ssq_cq, ssq_kv, rope, args.out, CQB, CKVB, KPEB, QR, KR, RV, RGS, SGA, SGR, CKVF};
        pg8::gemm_phase<pg8::EpiWin, pg8::StaticOrder, true, true>(F.lds, g, S, E);
        constexpr int NB5 = (MT / 256) * (NIN / 256) - 4 * 256; const int ng = (F.G == 256) ? 256 - NB5 : F.G, cg = (F.G == 256) ? F.bid - NB5 : F.bid;
        if (cg >= 0) { pg8::Gemm g2{PB, (const bf16*)(ws + WS_WPP), MP, DM, PLE}; pg8::StaticOrder S2; S2.init(MP, DM, ng, cg);
          pg8::EpiPlain E2{0, PP, PP, DM, 4, nullptr}; pg8::gemm_phase<pg8::EpiPlain, pg8::StaticOrder, true, true>(F.lds, g2, S2, E2);
          for (int u = cg; u < 128; u += ng) sk::skinny_unit<PLE, false, false>(u, PB, (const bf16*)(ws + WS_WPP), nullptr, (LAS float*)F.lds, sk::SkPlain{PP}); } }
    SEAM(3);
    for (int rp_ = 0; rp_ < REPK(4); ++rp_) if (IN(4)) {
#ifndef P4_MASK
#define P4_MASK 31
#endif
        if (P4_MASK & 1) { pg8::Gemm g{CQB, (const bf16*)(ws + WS_WQB), MT, 768, QL}; pg8::StaticOrder S; S.init(MT, 768, F.G, F.bid);
          pg8::rst_fill<4>(F.lds, S, ssq_cq, 1.0f / QL, FTID); pg8::EpiQB E{0, (const LAS float*)(F.lds + pg8::RST_OFF), rope, QB}; pg8::gemm_phase<pg8::EpiQB, pg8::StaticOrder, true, true>(F.lds, g, S, E); }
        if (P4_MASK & 2) { pg8::Gemm g{CKVB, (const bf16*)(ws + WS_WKVB), MP, DM, KVL}; pg8::StaticOrder S; S.init(MP, DM, F.G, F.bid);
          pg8::rst_fill<4>(F.lds, S, ssq_kv, 1.0f / KVL, FTID); pg8::EpiPlain E{0, KN, VB, 512, 2, (const LAS float*)(F.lds + pg8::RST_OFF)}; pg8::gemm_phase<pg8::EpiPlain, pg8::StaticOrder, true, true>(F.lds, g, S, E); }
        if (P4_MASK & 8) for (int i = F.bid * (NWAVES * 64) + FTID; i < (MP + MS) * 32; i += NGT) { const int row = i >> 5, c4 = (i & 31) * 4; const float rs = pg8::rstd_of<4>(ssq_kv, row, 1.0f / KVL);
            const pg8::f32x4 v = *(const pg8::f32x4*)(CKVF + (size_t)row * KVL + c4), g = *(const pg8::f32x4*)(args.kv_a_norm + c4);
            float* o = row < MP ? args.out + O_CKVP + (size_t)row * KVL : args.out + O_CKVS + (size_t)(row - MP) * KVL;
            *(pg8::f32x4*)(o + c4) = v * rs * g; }
        if (P4_MASK & 16) for (int u = F.bid; u < 512; u += F.G) ret::kv_unit(u, KR, RV, KVC, F.lds);
    }
    SEAM(4);
    for (int rp_ = 0; rp_ < REPK(5); ++rp_) if (IN(5)) {
#ifndef P5_MASK
#define P5_MASK 7
#endif
        { volatile LAS unsigned* cntA = F.MISC + 16; volatile LAS unsigned* cntD = F.MISC + 17; volatile LAS unsigned* nextw = F.MISC + 18; unsigned genA = cntA[0], genD = cntD[0];
          __syncthreads();
#ifdef PROBE_T
          unsigned long long t0_ = __builtin_amdgcn_s_memrealtime();
#endif
          for (int v = F.bid; v < 256; v += F.G) {
            const int s = v >> 1, sg = v & 1; const bool teamA = FWAVE < 4; const int w4 = FWAVE & 3;
            { const int bh = v >> 4, j = v & 15;
              if (teamA) {
                __builtin_amdgcn_s_setprio(3);
                att::attn_half_unit(bh >> 3, bh & 7, 63 - 2 * j, QB, KN, KPEB, VB, OCAT, (char*)lds, cntA, genA);
                att::attn_half_unit(bh >> 3, bh & 7, 2 * j + 1, QB, KN, KPEB, VB, OCAT, (char*)lds, cntA, genA);
                att::attn_half_unit(bh >> 3, bh & 7, 2 * j, QB, KN, KPEB, VB, OCAT, (char*)lds, cntA, genA);
                att::attn_half_unit(bh >> 3, bh & 7, 62 - 2 * j, QB, KN, KPEB, VB, OCAT, (char*)lds, cntA, genA);
                __builtin_amdgcn_s_setprio(0);
              } }
            { volatile LAS unsigned* cnt = teamA ? cntA : cntD; unsigned gen = teamA ? genA : genD; volatile LAS unsigned* bw = F.MISC + (teamA ? 20 : 21);
              LAS unsigned char* tl = F.lds + (teamA ? 0 : dec::D_BASE);
              if (!teamA) ret::scan_items(v * 256 + (FTID - 256), F.G * 256, KVC, SC, args.out);
              if (!teamA) { for (int u = 2 * v; u < 2 * v + 2; ++u) ret::sample_unit4(u, w4, FLANE, QR, KR, RV, RGS, args.ret_norm, args.state_ret, args.out, OCAT, (LAS float*)tl, cnt, gen); }
              dec::qlat_token4(s, w4, FLANE, QB, args.w_kv_b, (LAS float*)(tl + dec::M4_QL), QLAT, sg == 0 && !teamA);
              for (;;) {
                  if (w4 == 0 && FLANE == 0) bw[0] = __hip_atomic_fetch_add((LAS unsigned*)nextw, 1u, __ATOMIC_RELAXED, __HIP_MEMORY_SCOPE_WORKGROUP);
                  asm volatile("s_waitcnt lgkmcnt(0)" ::: "memory"); att::bar4(cnt, gen, FLANE);
                  const int it = (int)bw[0];
                  if (it >= 8) break;
                  dec::split_unit4m(s, sg * 8 + it, w4, FLANE, QB, args.cache_ckv, args.cache_kpe, args.page_table, DPO, DML, tl, cnt, gen);
              }
              if (teamA) genA = gen; else genD = gen; }
          }
#ifdef PROBE_T
          { const unsigned long long t1_ = __builtin_amdgcn_s_memrealtime(); if (F.bid == PROBE_BLK && FLANE == 0 && FWAVE == PROBE_T) ((volatile unsigned*)(ws + WS_CTL))[2] = (unsigned)(t1_ - t0_); }
#endif
          __syncthreads(); }
    }
    SEAM(5);
    for (int rp_ = 0; rp_ < REPK(6); ++rp_) if (IN(6)) {
        for (int u = F.bid; u < 512; u += F.G) ret::out_unit(u, QR, KR, RV, SC, RGS, args.ret_norm, OCAT, F.lds);
        for (int s = F.bid; s < MS; s += F.G) dec::combine_unit(s, QB, QLAT, DPO, DML, args.out, args.w_kv_b, OCAT, (LAS float*)F.lds);
    }
    SEAM(6);
    for (int rp_ = 0; rp_ < REPK(7); ++rp_) if (IN(7)) { pg8::Gemm g{OCAT, (const bf16*)(ws + WS_WBC), MP, DM, DM}; pg8::StaticOrder S; S.init(MP, DM, F.G, F.bid);
        pg8::EpiMerge E{8, SGA, SGR, MRG}; pg8::gemm_phase<pg8::EpiMerge, pg8::StaticOrder, true, true>(F.lds, g, S, E);
        for (int u = F.bid; u < 128; u += F.G) sk::skinny_unit<DM, true, false>(u, OCAT, (const bf16*)(ws + WS_WBC), nullptr, (LAS float*)F.lds, sk::SkMerge{SGA, SGR, MRG}); }
    SEAM(7);
    for (int rp_ = 0; rp_ < REPK(8); ++rp_) if (IN(8)) { pg8::Gemm g{MRG, (const bf16*)(ws + WS_WOUT), MP, DM, DM}; pg8::StaticOrder S; S.init(MP, DM, F.G, F.bid);
        pg8::EpiResid<false, false> E{0, H1B, H2B, ssq_h2}; pg8::gemm_phase<pg8::EpiResid<false, false>, pg8::StaticOrder, true, true>(F.lds, g, S, E);
        for (int u = F.bid; u < 128; u += F.G) sk::skinny_unit<DM, false, true>(u, MRG, (const bf16*)(ws + WS_WOUT), ssq_h2, (LAS float*)F.lds, sk::SkResid{H1B, 1.0f, H2B}); }
    SEAM(8);
    for (int rp_ = 0; rp_ < REPK(9); ++rp_) if (IN(9)) { pg8::Gemm g{H2B, (const bf16*)(ws + WS_WGU2), MT, NGU, DM}; pg8::StaticOrder S; S.init(MT, NGU, F.G, F.bid);
        pg8::rst_fill<16>(F.lds, S, ssq_h2, 1.0f / DM, FTID); pg8::EpiSwiGLU E{0, ACT, (const LAS float*)(F.lds + pg8::RST_OFF)}; pg8::gemm_phase<pg8::EpiSwiGLU, pg8::StaticOrder, true, true>(F.lds, g, S, E); }
    SEAM(9);
    for (int rp_ = 0; rp_ < REPK(10); ++rp_) if (IN(10)) { pg8::Gemm g{ACT, (const bf16*)(ws + WS_WD2), MP, DM, DFF}; pg8::StaticOrder S; S.init(MP, DM, F.G, F.bid);
        pg8::EpiResid<true, false> E{0, H2B, H3B, ssq_h3}; pg8::gemm_phase<pg8::EpiResid<true, false>, pg8::StaticOrder, true, true>(F.lds, g, S, E);
        for (int u = F.bid; u < 128; u += F.G) sk::skinny_unit<DFF, false, true>(u, ACT, (const bf16*)(ws + WS_WD2), ssq_h3, (LAS float*)F.lds, sk::SkResid{H2B, 0.5f, H3B}); }
    SEAM(10);
    for (int rp_ = 0; rp_ < REPK(11); ++rp_) if (IN(11)) { pg8::Gemm g{H3B, (const bf16*)(ws + WS_WPG), MP, DM, DM}; pg8::StaticOrder S; S.init(MP, DM, F.G, F.bid);
        pg8::rst_fill<16>(F.lds, S, ssq_h3, 1.0f / DM, FTID); pg8::EpiPle E{0, H3B, PP, (const LAS float*)(F.lds + pg8::RST_OFF), H4B, ssq_h4}; pg8::gemm_phase<pg8::EpiPle, pg8::StaticOrder, true, true>(F.lds, g, S, E);
        for (int u = F.bid; u < 128; u += F.G) sk::skinny_unit<DM, false, true>(u, H3B, (const bf16*)(ws + WS_WPG), ssq_h4, (LAS float*)F.lds, sk::SkPle{H3B, PP, ssq_h3, H4B}); }
    SEAM(11);
    for (int rp_ = 0; rp_ < REPK(12); ++rp_) if (IN(12)) {
        const int lane12 = FLANE;
        for (int m = F.bid * NWAVES + FWAVE; m < MP + MS; m += NGW) { const float rs = pg8::rstd_of<16>(ssq_h4, m, 1.0f / DM);
            const unsigned long long* hr = (const unsigned long long*)(H4B + (size_t)m * DM) + lane12; pg8::f32x4* o = (pg8::f32x4*)(args.out + (m < MP ? O_YP + (size_t)m * DM : O_YS + (size_t)(m - MP) * DM)) + lane12;
#pragma unroll
            for (int j = 0; j < 4; ++j) { const unsigned long long w = hr[64 * j]; const unsigned lo = (unsigned)w, hi = (unsigned)(w >> 32);
                o[64 * j] = (pg8::f32x4){bflo(lo), bfhi(lo), bflo(hi), bfhi(hi)} * rs * ((const pg8::f32x4*)args.final_norm)[lane12 + 64 * j]; } }
#ifdef PROBE_T
        VM_WAIT(); if (F.bid == 0 && FWAVE == 0 && lane12 == 0) args.out[O_YS + 5] = 2.0f * __builtin_rintf(0.01f * (float)((volatile unsigned*)(ws + WS_CTL))[2] * (1.0f / 20.0f));
#endif
    }
#undef IN
#undef SEAM
}

#ifdef DBG_LAST
__global__ void dbg_dump(const unsigned char* ws, float* out) {
    const size_t n = (size_t)MP * DM;
    for (size_t i = (size_t)blockIdx.x * blockDim.x + threadIdx.x; i < n; i += (size_t)gridDim.x * blockDim.x) { const size_t r = i >> 10, c = i & 1023; float v = 0.f;
        if (c < DBG_NCOLS) { if (DBG_F32) v = ((const float*)(ws + DBG_SRC))[r * DBG_PITCH + c]; else v = bf2f(((const bf16*)(ws + DBG_SRC))[r * DBG_PITCH + c]); }
#ifdef DBG_SRC2
        else v = bf2f(((const bf16*)(ws + DBG_SRC2))[r * DBG_PITCH + (c - DBG_NCOLS)]);
#endif
        out[i] = v; }
}
#endif
extern "C" void kernel_launch(void* const* d_in, const int* in_sizes, int n_in, void* d_out, int out_size, void* d_ws, size_t ws_size, hipStream_t stream) {
    static int grid = 0;
    if (grid == 0) {
        if (n_in != 30 || out_size != (int)O_END || ws_size < WS_END) { fprintf(stderr, "kernel_launch: built for 30 inputs, %zu outputs, >= %zu bytes of workspace; got n_in %d, out %d, ws %zu; nothing launched\n", (size_t)O_END, (size_t)WS_END, n_in, out_size, ws_size); grid = -1; return; }
        int dev = 0, cus = 0, per_cu = 0;
        if (hipGetDevice(&dev) != hipSuccess || hipDeviceGetAttribute(&cus, hipDeviceAttributeMultiprocessorCount, dev) != hipSuccess) { fprintf(stderr, "kernel_launch: device query failed\n"); grid = -1; return; }
        if (hipFuncSetAttribute((const void*)mk_fwd, hipFuncAttributeMaxDynamicSharedMemorySize, LDS_BYTES) != hipSuccess) { fprintf(stderr, "kernel_launch: hipFuncSetAttribute failed\n"); grid = -1; return; }
        if (hipOccupancyMaxActiveBlocksPerMultiprocessor(&per_cu, (const void*)mk_fwd, NWAVES * 64, LDS_BYTES) != hipSuccess || per_cu < 1)
            fprintf(stderr, "kernel_launch: note: occupancy query reports %d workgroups per CU\n", per_cu);
        (void)hipGetLastError();
        grid = cus;
    }
    if (grid < 0) return;
    if (hipMemsetAsync((char*)d_ws + WS_CTL, 0, CTL_ZERO_BYTES, stream) != hipSuccess) { fprintf(stderr, "kernel_launch: memset failed\n"); return; }
    Args a{};
    const float** fp = (const float**)&a;
    for (int i = 0; i < 30; ++i) fp[i] = (const float*)d_in[i];
    a.out = (float*)d_out; a.ws = (unsigned char*)d_ws;
#if MK_PER_PHASE
#ifdef DBG_LAST
    for (int k = 0; k <= DBG_LAST; ++k) { a.ph_lo = k; a.ph_hi = k + 1; hipLaunchKernelGGL(mk_fwd, dim3(grid), dim3(NWAVES * 64), LDS_BYTES, stream, a); }
    hipLaunchKernelGGL(dbg_dump, dim3(1024), dim3(256), 0, stream, (const unsigned char*)d_ws, (float*)d_out);
#else
    for (int k = 0; k < NPHASE; ++k) { a.ph_lo = k; a.ph_hi = k + 1; hipLaunchKernelGGL(mk_fwd, dim3(grid), dim3(NWAVES * 64), LDS_BYTES, stream, a); }
#endif
#else
    a.ph_lo = 0; a.ph_hi = NPHASE; hipLaunchKernelGGL(mk_fwd, dim3(grid), dim3(NWAVES * 64), LDS_BYTES, stream, a);
#endif
    const hipError_t le = hipPeekAtLastError();
    if (le != hipSuccess) fprintf(stderr, "kernel_launch: launch failed: %s\n", hipGetErrorName(le));
}
```

```cpp
#include <hip/hip_runtime.h>
#include <cstdio>
#include <cstdint>

#ifndef MK_PER_PHASE
#define MK_PER_PHASE 0
#endif

constexpr int DM = 1024, TSEQ = 8192, MP = 16384, MS = 128, MT = 16640, NPAN = MT / 256;
constexpr int DFF = 2816, NGU = 2 * DFF, NIN = 4608, PLE = 256;
constexpr int NH = 8, QKD = 96, KVL = 128, RPE = 32, QL = 256;
constexpr int RH = 4, RDK = 128, RDV = 128;
constexpr int NPAGES = 128, PAGE = 128;
constexpr float EPS = 1e-6f;
constexpr float C2 = 0.10206207261596575f * 1.4426950408889634f;
constexpr size_t O_YP = 0, O_YS = 16777216, O_CKVP = 16908288, O_KPEP = 19005440, O_RETP = 19529728, O_CKVS = 19660800, O_KPES = 19677184, O_RETS = 19681280, O_END = 28069888;

constexpr size_t MiB = 1u << 20;
constexpr size_t al1(size_t x) { return (x + MiB - 1) & ~(MiB - 1); }
constexpr size_t WS_CTL = 0, CTL_ZERO_BYTES = 1 * MiB;
constexpr size_t WS_WGU1 = 2 * MiB;
constexpr size_t WS_WD1  = WS_WGU1 + al1((size_t)NGU * DM * 2);
constexpr size_t WS_WIN  = WS_WD1 + al1((size_t)DM * DFF * 2);
constexpr size_t WS_WQB  = WS_WIN + al1((size_t)NIN * DM * 2);
constexpr size_t WS_WKVB = WS_WQB + al1((size_t)768 * 256 * 2);
constexpr size_t WS_WBC  = WS_WKVB + al1((size_t)1024 * 128 * 2);
constexpr size_t WS_WOUT = WS_WBC + al1((size_t)DM * DM * 2);
constexpr size_t WS_WGU2 = WS_WOUT + al1((size_t)DM * DM * 2);
constexpr size_t WS_WD2  = WS_WGU2 + al1((size_t)NGU * DM * 2);
constexpr size_t WS_WPG  = WS_WD2 + al1((size_t)DM * DFF * 2);
constexpr size_t WS_WPP  = WS_WPG + al1((size_t)DM * DM * 2);
constexpr size_t WS_ROPE = WS_WPP + al1((size_t)DM * PLE * 2);
constexpr size_t WS_XN1  = WS_ROPE + al1((size_t)8193 * 64 * 8);
constexpr size_t WS_ACT  = WS_XN1 + al1((size_t)MT * DM * 2);
constexpr size_t WS_H1   = WS_ACT + al1((size_t)MT * DFF * 2);
constexpr size_t WS_H1B  = WS_H1 + al1((size_t)MT * DM * 4);
constexpr size_t WS_CQB  = WS_H1B + al1((size_t)MT * DM * 2);
constexpr size_t WS_CKVF = WS_CQB + al1((size_t)MT * 256 * 2);
constexpr size_t WS_CKVB = WS_CKVF + al1((size_t)MT * 128 * 4);
constexpr size_t WS_KPEB = WS_CKVB + al1((size_t)MT * 128 * 2);
constexpr size_t WS_QR   = WS_KPEB + al1((size_t)MT * 32 * 2);
constexpr size_t WS_KR   = WS_QR + al1((size_t)MT * 512 * 2);
constexpr size_t WS_RV   = WS_KR + al1((size_t)MT * 512 * 2);
constexpr size_t WS_RGS  = WS_RV + al1((size_t)MT * 512 * 2);
constexpr size_t WS_SGA  = WS_RGS + al1((size_t)MT * 512 * 2);
constexpr size_t WS_SGR  = WS_SGA + al1((size_t)MT * DM * 2);
constexpr size_t WS_QB   = WS_SGR + al1((size_t)MT * DM * 2);
constexpr size_t WS_KN   = WS_QB + al1((size_t)MT * 768 * 2);
constexpr size_t WS_VB   = WS_KN + al1((size_t)MP * 512 * 2);
constexpr size_t WS_OCAT = WS_VB + al1((size_t)MP * 512 * 2);
constexpr size_t WS_KVC  = WS_OCAT + al1((size_t)MT * DM * 2);
constexpr size_t WS_SC   = WS_KVC + al1((size_t)512 * 16384 * 4);
constexpr size_t WS_MRG  = WS_SC + al1((size_t)512 * 16384 * 2);
constexpr size_t WS_H2   = WS_MRG + al1((size_t)MT * DM * 2);
constexpr size_t WS_H2B  = WS_H2 + al1((size_t)MT * DM * 4);
constexpr size_t WS_H3   = WS_H2B + al1((size_t)MT * DM * 2);
constexpr size_t WS_H3B  = WS_H3 + al1((size_t)MT * DM * 4);
constexpr size_t WS_PB   = WS_H3B + al1((size_t)MT * DM * 2);
constexpr size_t WS_PP   = WS_PB + al1((size_t)MT * PLE * 2);
constexpr size_t WS_H4   = WS_PP + al1((size_t)MT * DM * 2);
constexpr size_t WS_DPO  = WS_H4 + al1((size_t)MT * DM * 4);
constexpr size_t WS_DML  = WS_DPO + al1((size_t)128 * 32 * 8 * 128 * 4);
constexpr size_t WS_QLAT = WS_DML + MiB;
constexpr size_t WS_SSQ  = WS_QLAT + MiB;
constexpr size_t SSQ16_BYTES = (size_t)MT * 16 * 4, SSQ4_BYTES = (size_t)MT * 4 * 4;
constexpr size_t WS_END  = WS_SSQ + al1(4 * SSQ16_BYTES + 2 * SSQ4_BYTES);
constexpr int CW_TMO = 0, CW_BAR = 4096;

constexpr int RING_BYTES = 131072, PH5_BYTES = 157696, LDSCTL_OFF = PH5_BYTES, MISC_OFF = LDSCTL_OFF + 320, LDS_BYTES = 163840;

#define GAS __attribute__((address_space(1)))
#define LAS __attribute__((address_space(3)))
typedef unsigned short bf16;
typedef unsigned v4u __attribute__((ext_vector_type(4)));
typedef unsigned v2u __attribute__((ext_vector_type(2)));
typedef GAS unsigned gu32;
#define RLX_AGENT __ATOMIC_RELAXED, __HIP_MEMORY_SCOPE_AGENT
#define LDS_WAIT() asm volatile("s_waitcnt lgkmcnt(0)" ::: "memory")
#define VM_WAIT() asm volatile("s_waitcnt vmcnt(0)" ::: "memory")
__device__ __forceinline__ unsigned f2bf(float f) { unsigned u = __builtin_bit_cast(unsigned, f); return (u + 0x7fffu + ((u >> 16) & 1u)) >> 16; }
__device__ __forceinline__ unsigned pk2(float lo, float hi) { return f2bf(lo) | (f2bf(hi) << 16); }
__device__ __forceinline__ float bflo(unsigned w) { return __builtin_bit_cast(float, w << 16); }
__device__ __forceinline__ float bfhi(unsigned w) { return __builtin_bit_cast(float, w & 0xffff0000u); }
__device__ __forceinline__ float bf2f(bf16 h) { return __builtin_bit_cast(float, (unsigned)h << 16); }
__device__ __forceinline__ float sigm(float x) { return __builtin_amdgcn_rcpf(1.f + __builtin_amdgcn_exp2f(-1.4426950408889634f * x)); }
__device__ __forceinline__ float wave_sum(float v) {
#pragma unroll
    for (int o = 1; o < 64; o <<= 1) v += __shfl_xor(v, o);
    return v;
}
__device__ __forceinline__ float lg2gamma(int h) { return h == 0 ? -0.04580368961312479f : h == 1 ? -0.02272007650008353f : h == 2 ? -0.011315313227834146f : -0.005646563141142063f; }
namespace pg8 {
#define PG8_LAS __attribute__((address_space(3)))
typedef unsigned short bf16_t;
typedef short bf16x8 __attribute__((ext_vector_type(8)));
typedef float f32x4 __attribute__((ext_vector_type(4)));
typedef unsigned u32x4 __attribute__((ext_vector_type(4)));
constexpr int BM = 256, BK = 64, HALF = 128, HTB = HALF * BK * 2  , STAGE_BYTES = 8 * HTB, NXCD = 8, WGM = 8;

__host__ __device__ __forceinline__ int lds_byte(int r, int c) { const int st = (r >> 4) * 2 + (c >> 5), rr = r & 15, cc = c & 31, ob = rr * 64 + cc * 2; return st * 1024 + (ob ^ (((ob >> 9) & 1) << 5)); }
__host__ __device__ __forceinline__ void stage_rc(int b, int& R, int& C) { const int st = b / 1024, sb = b % 1024, swz = sb ^ (((sb >> 9) & 1) << 5); R = (st >> 1) * 16 + swz / 64; C = (st & 1) * 32 + (swz % 64) / 2; }
__host__ __device__ __forceinline__ int perm32(int rho) { const int n = rho >> 4, i = rho & 15; return 8 * (i >> 2) + 4 * n + (i & 3); }

struct Unit { int pm, pn, idx; };
struct Gemm { const bf16_t* A; const bf16_t* Bt; int M, N, K; };

struct StaticOrder {
    int nM, nN, nwg, G, c;
    __host__ __device__ void init(int M, int N, int G_, int c_) { nM = M / BM; nN = N / BM; nwg = nM * nN; G = G_; c = c_; }
    __host__ __device__ bool next(int i, Unit& u) const {
        const long L = (long)i * G + c; if (L >= nwg) return false;
        int wgid = (int)L; { const int q = nwg / NXCD, r = nwg % NXCD, xcd = wgid % NXCD, off = wgid / NXCD; wgid = (xcd < r ? xcd * (q + 1) : r * (q + 1) + (xcd - r) * q) + off; }
        const int nig = WGM * nN, gid = wgid / nig, fm = gid * WGM, gsz = (nM - fm) < WGM ? (nM - fm) : WGM;
        u.pm = fm + ((wgid % nig) % gsz); u.pn = (wgid % nig) / gsz; u.idx = i; return true;
    }
    __device__ __forceinline__ void a_ready(const Unit&) const {}
    __device__ __forceinline__ void done(const Unit&) const {}
};

typedef float cvt_f32x2_t __attribute__((ext_vector_type(2))); typedef __bf16 cvt_bf16x2_t __attribute__((ext_vector_type(2)));
__device__ __forceinline__ unsigned cvt_pk_bf16(float lo, float hi) { cvt_f32x2_t v = {lo, hi}; cvt_bf16x2_t b = __builtin_convertvector(v, cvt_bf16x2_t); return __builtin_bit_cast(unsigned, b); }
typedef float f32x2 __attribute__((ext_vector_type(2)));
template <class Epi, class Sched, bool ALIGN_EPI = false, bool SP2 = false>
__device__ __forceinline__ void gemm_phase(PG8_LAS unsigned char* lds, const Gemm g, const Sched S, const Epi E) {
    int tid_ = threadIdx.x; asm volatile("" : "+v"(tid_));
    const int tid = tid_, wid = __builtin_amdgcn_readfirstlane(tid >> 6), lane = tid & 63, wr = wid >> 2, wc = wid & 3, fr = lane & 15, fq = lane >> 4;
    const int K = g.K, nt = K / BK;
    unsigned voffA[2], voffB[2];
#pragma unroll
    for (int i = 0; i < 2; ++i) { int R, C; stage_rc(tid * 16 + i * 8192, R, C); const int Rb = Epi::PERM ? ((R & ~31) + perm32(R & 31)) : R;
        voffA[i] = (unsigned)(R * K + C) * 2u; voffB[i] = (unsigned)(Rb * K + C) * 2u; }
    const size_t kstep = (size_t)(BK * 2);
    const size_t hstep = (size_t)HALF * K * 2;
    const size_t tstep = 2 * hstep;
    const unsigned ldsw = (unsigned)wid * 1024u;
    const int aoff = lds_byte(wr * 64 + fr, fq * 8), boff = lds_byte(wc * 32 + fr, fq * 8);
#define PG8_SA(b, h) (((b) * 2 + (h)) * HTB)
#define PG8_SB(b, h) ((4 + (b) * 2 + (h)) * HTB)
#define PG8_STAGE(bufoff, gbase, voff) do { _Pragma("unroll") for (int _i = 0; _i < 2; ++_i) \
        __builtin_amdgcn_global_load_lds((const unsigned*)((const char*)(gbase) + (voff)[_i]), (PG8_LAS unsigned*)(lds + (bufoff) + ldsw + _i * 8192), 16, 0, 0); } while (0)
#define PG8_LDA(dst, b, h) do { _Pragma("unroll") for (int m = 0; m < 4; ++m) _Pragma("unroll") for (int k = 0; k < 2; ++k) dst[m][k] = *(const PG8_LAS bf16x8*)(lds + PG8_SA(b, h) + aoff + m * 2048 + k * 1024); } while (0)
#define PG8_LDB(dst, b, h) do { _Pragma("unroll") for (int n = 0; n < 2; ++n) _Pragma("unroll") for (int k = 0; k < 2; ++k) dst[n][k] = *(const PG8_LAS bf16x8*)(lds + PG8_SB(b, h) + boff + n * 2048 + k * 1024); } while (0)
#define PG8_MMA(ai, bj, At, Bt) do { __builtin_amdgcn_s_setprio(1); _Pragma("unroll") for (int m = 0; m < 4; ++m) _Pragma("unroll") for (int n = 0; n < 2; ++n) _Pragma("unroll") for (int k = 0; k < 2; ++k) \
        acc[ai][bj][m][n] = __builtin_amdgcn_mfma_f32_16x16x32_bf16(Bt[n][k], At[m][k], acc[ai][bj][m][n], 0, 0, 0); __builtin_amdgcn_s_setprio(0); } while (0)
#define PG8_WAIT_V(n) asm volatile("s_waitcnt vmcnt(" #n ")" ::: "memory")
#define PG8_WAIT_L(n) asm volatile("s_waitcnt lgkmcnt(" #n ")" ::: "memory")
#define PG8_BAR __builtin_amdgcn_s_barrier()
#define PG8_SCHED __builtin_amdgcn_sched_barrier(0)
    Unit cur, nxt; int ui = 0;
    if (!S.next(0, cur)) return;
    f32x4 acc[2][2][4][2];
#pragma unroll
    for (int a = 0; a < 2; ++a)
#pragma unroll
        for (int b = 0; b < 2; ++b)
#pragma unroll
            for (int m = 0; m < 4; ++m)
#pragma unroll
                for (int n = 0; n < 2; ++n) acc[a][b][m][n] = (f32x4){0.f, 0.f, 0.f, 0.f};
    bf16x8 At[4][2], B0[2][2], B1[2][2];
    const char* cA = (const char*)g.A + (size_t)cur.pm * tstep; const char* cB = (const char*)g.Bt + (size_t)cur.pn * tstep;
    S.a_ready(cur);
    if constexpr (SP2) {
        PG8_STAGE(PG8_SB(0, 0), cB, voffB); PG8_STAGE(PG8_SB(0, 1), cB + hstep, voffB); PG8_STAGE(PG8_SA(0, 0), cA, voffA); PG8_STAGE(PG8_SA(0, 1), cA + hstep, voffA);
        if (wr == 1) PG8_BAR;
        PG8_WAIT_V(2); PG8_BAR;
        PG8_STAGE(PG8_SB(1, 0), cB + kstep, voffB); PG8_STAGE(PG8_SA(1, 0), cA + kstep, voffA); PG8_STAGE(PG8_SB(1, 1), cB + hstep + kstep, voffB);
        PG8_WAIT_V(6); PG8_BAR;
    } else {
        PG8_STAGE(PG8_SB(0, 0), cB, voffB); PG8_STAGE(PG8_SA(0, 0), cA, voffA); PG8_STAGE(PG8_SB(0, 1), cB + hstep, voffB); PG8_STAGE(PG8_SA(0, 1), cA + hstep, voffA);
        if (wr == 1) PG8_BAR;
        PG8_WAIT_V(4); PG8_BAR;
        PG8_STAGE(PG8_SB(1, 0), cB + kstep, voffB); PG8_STAGE(PG8_SA(1, 0), cA + kstep, voffA); PG8_STAGE(PG8_SB(1, 1), cB + hstep + kstep, voffB);
        PG8_WAIT_V(6); PG8_BAR;
    }
    for (;;) {
        const bool has_next = S.next(ui + 1, nxt);
        const char* nA = has_next ? (const char*)g.A + (size_t)nxt.pm * tstep : cA; const char* nB = has_next ? (const char*)g.Bt + (size_t)nxt.pn * tstep : cB;
#pragma nounroll
        for (int t = 0; t < nt; t += 2) {
            if constexpr (Epi::HAS_MID) { if (t == E.mid_t) E.mid(acc, cur, wr, wc, fr, fq); }
            const bool last = (t == nt - 2);
            const char* a1 = cA + (size_t)(t + 1) * kstep;
            const char* a2 = last ? nA : cA + (size_t)(t + 2) * kstep; const char* b2 = last ? nB : cB + (size_t)(t + 2) * kstep;
            const char* a3 = a2 + kstep; const char* b3 = b2 + kstep;
            if (last && has_next) S.a_ready(nxt);
            if constexpr (SP2) {
            PG8_LDB(B0, 0, 0); PG8_LDB(B1, 0, 1); PG8_SCHED; PG8_LDA(At, 0, 0); PG8_STAGE(PG8_SA(1, 1), a1 + hstep, voffA);
            PG8_WAIT_V(8); PG8_WAIT_L(0); PG8_BAR; PG8_MMA(0, 0, At, B0); PG8_MMA(0, 1, At, B1); PG8_BAR; PG8_SCHED;
            PG8_LDA(At, 0, 1); PG8_STAGE(PG8_SB(0, 0), b2, voffB); PG8_STAGE(PG8_SB(0, 1), b2 + hstep, voffB); PG8_STAGE(PG8_SA(0, 0), a2, voffA);
            PG8_WAIT_V(8); PG8_WAIT_L(0); PG8_BAR; PG8_MMA(1, 0, At, B0); PG8_MMA(1, 1, At, B1); PG8_BAR; PG8_SCHED;
            PG8_LDB(B0, 1, 0); PG8_LDB(B1, 1, 1); PG8_SCHED; PG8_LDA(At, 1, 0); PG8_STAGE(PG8_SA(0, 1), a2 + hstep, voffA);
            PG8_WAIT_V(8); PG8_WAIT_L(0); PG8_BAR; PG8_MMA(0, 0, At, B0); PG8_MMA(0, 1, At, B1); PG8_BAR; PG8_SCHED;
            PG8_LDA(At, 1, 1); PG8_STAGE(PG8_SB(1, 0), b3, voffB); PG8_STAGE(PG8_SB(1, 1), b3 + hstep, voffB); PG8_STAGE(PG8_SA(1, 0), a3, voffA);
            PG8_WAIT_V(8); PG8_WAIT_L(0); PG8_BAR; PG8_MMA(1, 0, At, B0); PG8_MMA(1, 1, At, B1); PG8_BAR; PG8_SCHED;
            } else {
            PG8_LDB(B0, 0, 0); PG8_SCHED; PG8_LDA(At, 0, 0); PG8_STAGE(PG8_SA(1, 1), a1 + hstep, voffA);
            PG8_WAIT_L(8); PG8_BAR; PG8_WAIT_L(0); PG8_MMA(0, 0, At, B0); PG8_BAR; PG8_SCHED;
            PG8_LDB(B1, 0, 1); PG8_STAGE(PG8_SB(0, 0), b2, voffB);
            PG8_BAR; PG8_WAIT_L(0); PG8_MMA(0, 1, At, B1); PG8_BAR;
            PG8_LDA(At, 0, 1); PG8_STAGE(PG8_SA(0, 0), a2, voffA);
            PG8_BAR; PG8_WAIT_L(0); PG8_MMA(1, 0, At, B0); PG8_BAR; PG8_SCHED;
            PG8_STAGE(PG8_SB(0, 1), b2 + hstep, voffB);
            PG8_WAIT_V(6); PG8_BAR; PG8_MMA(1, 1, At, B1); PG8_BAR;
            PG8_LDB(B0, 1, 0); PG8_SCHED; PG8_LDA(At, 1, 0); PG8_STAGE(PG8_SA(0, 1), a2 + hstep, voffA);
            PG8_WAIT_L(8); PG8_BAR; PG8_WAIT_L(0); PG8_MMA(0, 0, At, B0); PG8_BAR; PG8_SCHED;
            PG8_LDB(B1, 1, 1); PG8_STAGE(PG8_SB(1, 0), b3, voffB);
            PG8_BAR; PG8_WAIT_L(0); PG8_MMA(0, 1, At, B1); PG8_BAR;
            PG8_LDA(At, 1, 1); PG8_STAGE(PG8_SA(1, 0), a3, voffA);
            PG8_BAR; PG8_WAIT_L(0); PG8_MMA(1, 0, At, B0); PG8_BAR; PG8_SCHED;
            PG8_STAGE(PG8_SB(1, 1), b3 + hstep, voffB);
            PG8_WAIT_V(6); PG8_BAR; PG8_MMA(1, 1, At, B1); PG8_BAR;
            }
        }
        if constexpr (ALIGN_EPI) { if (wr == 0) PG8_BAR; }
        if constexpr (!Epi::AFTER_DRAIN) { E(acc, cur, wr, wc, fr, fq); S.done(cur); }
        if (!has_next) break;
#pragma unroll
        for (int a = 0; a < 2; ++a)
#pragma unroll
            for (int b = 0; b < 2; ++b)
#pragma unroll
                for (int m = 0; m < 4; ++m)
#pragma unroll
                    for (int n = 0; n < 2; ++n) acc[a][b][m][n] = (f32x4){0.f, 0.f, 0.f, 0.f};
        cur = nxt; cA = nA; cB = nB; ++ui;
        if constexpr (ALIGN_EPI) { if (wr == 1) PG8_BAR; }
    }
    PG8_WAIT_V(0);
    if constexpr (!ALIGN_EPI) { if (wr == 0) PG8_BAR; }
    PG8_BAR;
    if constexpr (Epi::AFTER_DRAIN) { E.fused(acc, cur, wr, wc, fr, fq, lds, wid, lane); S.done(cur); }
#undef PG8_SA
#undef PG8_SB
#undef PG8_STAGE
#undef PG8_LDA
#undef PG8_LDB
#undef PG8_MMA
#undef PG8_WAIT_V
#undef PG8_WAIT_L
#undef PG8_BAR
#undef PG8_SCHED
}
}
namespace pg8 {
#define EPI_ROWS(ai, m) (u.pm * BM + (ai) * HALF + wr * 64 + (m) * 16 + fr)
#define EPI_OPAQUE int fr = fr_, fq = fq_; asm volatile("" : "+v"(fr), "+v"(fq))
__device__ __forceinline__ u32x4 pack8(f32x4 a, f32x4 b) { u32x4 w; w.x = cvt_pk_bf16(a[0], a[1]); w.y = cvt_pk_bf16(a[2], a[3]); w.z = cvt_pk_bf16(b[0], b[1]); w.w = cvt_pk_bf16(b[2], b[3]); return w; }
__device__ __forceinline__ float sq4(f32x4 a) { return (a[0] * a[0] + a[1] * a[1]) + (a[2] * a[2] + a[3] * a[3]); }
template <int NS> __device__ __forceinline__ float rstd_of(const float* part, int row, float invn) {
    float s = 0.f;
#pragma unroll
    for (int i = 0; i < NS; i += 4) { const f32x4 v = *(const f32x4*)(part + (size_t)row * NS + i); s += (v[0] + v[1]) + (v[2] + v[3]); }
    return 1.0f / sqrtf(s * invn + EPS);
}
constexpr int RST_OFF = 131072;
template <int NS, class Sched> __device__ __forceinline__ void rst_fill(PG8_LAS unsigned char* lds, const Sched& S, const float* part, float invn, int) {
    int tid = threadIdx.x; asm volatile("" : "+v"(tid));
    PG8_LAS float* tab = (PG8_LAS float*)(lds + RST_OFF);
    for (int idx = tid; idx < 6 * 256; idx += 512) { Unit u; if (!S.next(idx >> 8, u)) break; tab[idx] = rstd_of<NS>(part, u.pm * BM + (idx & 255), invn); }
    __syncthreads();
}
#define EPI_RS(ai, m) (rst[u.idx * 256 + (ai) * HALF + wr * 64 + (m) * 16 + fr])
template <int NS> __device__ __forceinline__ void ssq_put(float* part, int row, int slot, float s, int fq) { s += __shfl_xor(s, 16); s += __shfl_xor(s, 32); if (fq == 0) part[(size_t)row * NS + slot] = s; }
__device__ __forceinline__ float silu_f(float x) { return x * sigm(x); }
__device__ __forceinline__ int pos_of_row(int row) { return row < MP ? (row & (TSEQ - 1)) : TSEQ; }

struct EpiSwiGLU {
    static constexpr bool PERM = true, AFTER_DRAIN = false, HAS_MID = false; int mid_t;
    bf16_t* O; const PG8_LAS float* rst;
    __device__ __forceinline__ void mid(f32x4 (&)[2][2][4][2], const Unit&, int, int, int, int) const {}
    __device__ __forceinline__ void operator()(const f32x4 (&acc)[2][2][4][2], const Unit& u, int wr, int wc, int fr_, int fq_) const { EPI_OPAQUE;
        const int col0 = u.pn * HALF + wc * 32 + 8 * fq;
#pragma unroll
        for (int ai = 0; ai < 2; ++ai)
#pragma unroll
            for (int m = 0; m < 4; ++m) { const int row = EPI_ROWS(ai, m); const float rs = rst ? EPI_RS(ai, m) : 1.0f;
                f32x4 o[2];
#pragma unroll
                for (int n = 0; n < 2; ++n)
#pragma unroll
                    for (int j = 0; j < 4; ++j) o[n][j] = silu_f(acc[ai][0][m][n][j] * rs) * (acc[ai][1][m][n][j] * rs);
                *(u32x4*)(O + (size_t)row * DFF + col0) = pack8(o[0], o[1]); }
    }
};

template <bool HALFA, bool XIN> struct EpiResid {
    static constexpr bool PERM = true, AFTER_DRAIN = false, HAS_MID = false; int mid_t; static constexpr float alpha = HALFA ? 0.5f : 1.0f;
    const void* R; bf16_t* Hb; float* ssq;
    __device__ __forceinline__ void mid(f32x4 (&)[2][2][4][2], const Unit&, int, int, int, int) const {}
    __device__ __forceinline__ void operator()(const f32x4 (&acc)[2][2][4][2], const Unit& u, int wr, int wc, int fr_, int fq_) const { EPI_OPAQUE;
        const int colb = u.pn * BM + wc * 32 + 8 * fq;
#pragma unroll
        for (int ai = 0; ai < 2; ++ai)
#pragma unroll
            for (int m = 0; m < 4; ++m) { const int row = EPI_ROWS(ai, m);
                float s = 0.f;
#pragma unroll
                for (int bj = 0; bj < 2; ++bj) { const int col = colb + bj * HALF; f32x4 r0, r1;
                    if (XIN) { const float* rp = (const float*)R + (size_t)row * DM + col; r0 = *(const f32x4*)rp; r1 = *(const f32x4*)(rp + 4); }
                    else { const u32x4 w = *(const u32x4*)((const bf16_t*)R + (size_t)row * DM + col); r0 = (f32x4){bflo(w[0]), bfhi(w[0]), bflo(w[1]), bfhi(w[1])}; r1 = (f32x4){bflo(w[2]), bfhi(w[2]), bflo(w[3]), bfhi(w[3])}; }
                    const f32x4 h0 = r0 + acc[ai][bj][m][0] * alpha, h1 = r1 + acc[ai][bj][m][1] * alpha;
                    *(u32x4*)(Hb + (size_t)row * DM + col) = pack8(h0, h1);
                    s += sq4(h0) + sq4(h1); }
                ssq_put<16>(ssq, row, u.pn * 4 + wc, s, fq); }
    }
};

__device__ __forceinline__ void rope4(const float2* tabrow, int i0, int istride, f32x4 x1, f32x4 x2, f32x4& y1, f32x4& y2) {
#pragma unroll
    for (int j = 0; j < 4; ++j) { const float2 cs = tabrow[(i0 + j) * istride]; y1[j] = x1[j] * cs.x - x2[j] * cs.y; y2[j] = x1[j] * cs.y + x2[j] * cs.x; }
}

struct EpiWin {
    static constexpr bool PERM = true, AFTER_DRAIN = false, HAS_MID = false; int mid_t;
    const PG8_LAS float* rst; float* ssq_cq; float* ssq_kv; const float2* rope; float* dout;
    bf16_t *CQB, *CKVB, *KPEB, *QR, *KR, *RV, *RGS, *SGA, *SGR; float* CKVF;
    __device__ __forceinline__ void mid(f32x4 (&)[2][2][4][2], const Unit&, int, int, int, int) const {}
    __device__ __forceinline__ void operator()(const f32x4 (&acc)[2][2][4][2], const Unit& u, int wr, int wc, int fr_, int fq_) const { EPI_OPAQUE;
        const int pn = u.pn, c8 = wc * 32 + 8 * fq;
#pragma unroll
        for (int ai = 0; ai < 2; ++ai)
#pragma unroll
            for (int m = 0; m < 4; ++m) { const int row = EPI_ROWS(ai, m); const float rs = EPI_RS(ai, m);
                if (pn == 0) {
                    float s = 0.f;
#pragma unroll
                    for (int bj = 0; bj < 2; ++bj) { const f32x4 a = acc[ai][bj][m][0] * rs, b = acc[ai][bj][m][1] * rs; s += sq4(a) + sq4(b);
                        *(u32x4*)(CQB + (size_t)row * QL + bj * HALF + c8) = pack8(a, b); }
                    ssq_put<4>(ssq_cq, row, wc, s, fq);
                } else if (pn == 1) {
                    { const f32x4 a = acc[ai][0][m][0] * rs, b = acc[ai][0][m][1] * rs;
                      *(f32x4*)(CKVF + (size_t)row * KVL + c8) = a; *(f32x4*)(CKVF + (size_t)row * KVL + c8 + 4) = b;
                      *(u32x4*)(CKVB + (size_t)row * KVL + c8) = pack8(a, b);
                      ssq_put<4>(ssq_kv, row, wc, sq4(a) + sq4(b), fq); }
                    if (wc == 0) { f32x4 y1, y2; rope4(rope + (size_t)pos_of_row(row) * 64, 4 * fq, 4, acc[ai][1][m][0] * rs, acc[ai][1][m][1] * rs, y1, y2);
                        float* o = row < MP ? dout + O_KPEP + (size_t)row * RPE : (row < MP + MS ? dout + O_KPES + (size_t)(row - MP) * RPE : nullptr);
                        if (o) { *(f32x4*)(o + 4 * fq) = y1; *(f32x4*)(o + 16 + 4 * fq) = y2; }
                        v2u w1, w2; w1.x = cvt_pk_bf16(y1[0], y1[1]); w1.y = cvt_pk_bf16(y1[2], y1[3]); w2.x = cvt_pk_bf16(y2[0], y2[1]); w2.y = cvt_pk_bf16(y2[2], y2[3]);
                        *(v2u*)(KPEB + (size_t)row * RPE + 4 * fq) = w1; *(v2u*)(KPEB + (size_t)row * RPE + 16 + 4 * fq) = w2; }
                } else if (pn < 6) {
                    const bool isk = pn >= 4; const int ic = row < MP ? (row & 127) : 0; const float2* tr = rope + (size_t)pos_of_row(row) * 64;
#pragma unroll
                    for (int bj = 0; bj < 2; ++bj) { const int hh = 2 * (pn - (isk ? 4 : 2)) + bj; const float lg = lg2gamma(hh) * (float)ic;
                        const float fs = rs * (isk ? __builtin_amdgcn_exp2f(-lg) * 0.08838834764831845f : __builtin_amdgcn_exp2f(lg));
                        f32x4 y1, y2; rope4(tr, 16 * wc + 4 * fq, 1, acc[ai][bj][m][0] * fs, acc[ai][bj][m][1] * fs, y1, y2);
                        bf16_t* o = (isk ? KR : QR) + (size_t)row * 512 + hh * 128 + 16 * wc + 4 * fq;
                        v2u w1, w2; w1.x = cvt_pk_bf16(y1[0], y1[1]); w1.y = cvt_pk_bf16(y1[2], y1[3]); w2.x = cvt_pk_bf16(y2[0], y2[1]); w2.y = cvt_pk_bf16(y2[2], y2[3]);
                        *(v2u*)o = w1; *(v2u*)(o + 64) = w2; }
                } else if (pn < 8) {
#pragma unroll
                    for (int bj = 0; bj < 2; ++bj) *(u32x4*)(RV + (size_t)row * 512 + (pn - 6) * BM + bj * HALF + c8) = pack8(acc[ai][bj][m][0] * rs, acc[ai][bj][m][1] * rs);
                } else if (pn < 10) {
#pragma unroll
                    for (int bj = 0; bj < 2; ++bj) { f32x4 a = acc[ai][bj][m][0] * rs, b = acc[ai][bj][m][1] * rs;
#pragma unroll
                        for (int j = 0; j < 4; ++j) { a[j] = silu_f(a[j]); b[j] = silu_f(b[j]); }
                        *(u32x4*)(RGS + (size_t)row * 512 + (pn - 8) * BM + bj * HALF + c8) = pack8(a, b); }
                } else {
                    bf16_t* base = pn < 14 ? SGA + (size_t)(pn - 10) * BM : SGR + (size_t)(pn - 14) * BM;
#pragma unroll
                    for (int bj = 0; bj < 2; ++bj) { f32x4 a = acc[ai][bj][m][0] * rs, b = acc[ai][bj][m][1] * rs;
#pragma unroll
                        for (int j = 0; j < 4; ++j) { a[j] = sigm(a[j]); b[j] = sigm(b[j]); }
                        *(u32x4*)(base + (size_t)row * DM + bj * HALF + c8) = pack8(a, b); }
                }
            }
    }
};

struct EpiQB {
    static constexpr bool PERM = true, AFTER_DRAIN = false, HAS_MID = false; int mid_t;
    const PG8_LAS float* rst; const float2* rope; bf16_t* QB;
    __device__ __forceinline__ void mid(f32x4 (&)[2][2][4][2], const Unit&, int, int, int, int) const {}
    __device__ __forceinline__ void operator()(const f32x4 (&acc)[2][2][4][2], const Unit& u, int wr, int wc, int fr_, int fq_) const { EPI_OPAQUE;
#pragma unroll
        for (int ai = 0; ai < 2; ++ai)
#pragma unroll
            for (int m = 0; m < 4; ++m) { const int row = EPI_ROWS(ai, m); const float rs = EPI_RS(ai, m);
                bf16_t* qrow = QB + (size_t)row * 768;
                if (u.pn < 2) {
#pragma unroll
                    for (int bj = 0; bj < 2; ++bj) { const int cidx = bj * HALF + wc * 32 + 8 * fq, hh = u.pn * 4 + (cidx >> 6), d = cidx & 63;
                        *(u32x4*)(qrow + hh * QKD + d) = pack8(acc[ai][bj][m][0] * rs, acc[ai][bj][m][1] * rs); }
                } else { const float2* tr = rope + (size_t)pos_of_row(row) * 64;
#pragma unroll
                    for (int bj = 0; bj < 2; ++bj) { const int hh = bj * 4 + wc; f32x4 y1, y2; rope4(tr, 4 * fq, 4, acc[ai][bj][m][0] * rs, acc[ai][bj][m][1] * rs, y1, y2);
                        v2u w1, w2; w1.x = cvt_pk_bf16(y1[0], y1[1]); w1.y = cvt_pk_bf16(y1[2], y1[3]); w2.x = cvt_pk_bf16(y2[0], y2[1]); w2.y = cvt_pk_bf16(y2[2], y2[3]);
                        *(v2u*)(qrow + hh * QKD + 64 + 4 * fq) = w1; *(v2u*)(qrow + hh * QKD + 80 + 4 * fq) = w2; }
                }
                asm volatile("" ::: "memory");
            }
    }
};

struct EpiPlain {
    static constexpr bool PERM = true, AFTER_DRAIN = false, HAS_MID = false; int mid_t;
    bf16_t* O0; bf16_t* O1; int ld; int split_tiles; const PG8_LAS float* rst;
    __device__ __forceinline__ void mid(f32x4 (&)[2][2][4][2], const Unit&, int, int, int, int) const {}
    __device__ __forceinline__ void operator()(const f32x4 (&acc)[2][2][4][2], const Unit& u, int wr, int wc, int fr_, int fq_) const { EPI_OPAQUE;
        bf16_t* base = u.pn < split_tiles ? O0 + (size_t)u.pn * BM : O1 + (size_t)(u.pn - split_tiles) * BM;
#pragma unroll
        for (int ai = 0; ai < 2; ++ai)
#pragma unroll
            for (int m = 0; m < 4; ++m) { const int row = EPI_ROWS(ai, m); const float rs = rst ? EPI_RS(ai, m) : 1.0f;
#pragma unroll
                for (int bj = 0; bj < 2; ++bj) *(u32x4*)(base + (size_t)row * ld + bj * HALF + wc * 32 + 8 * fq) = pack8(acc[ai][bj][m][0] * rs, acc[ai][bj][m][1] * rs); }
    }
};

struct EpiMerge {
    static constexpr bool PERM = true, AFTER_DRAIN = false, HAS_MID = true; int mid_t;
    const bf16_t* SGA; const bf16_t* SGR; bf16_t* O;
    __device__ __forceinline__ void mid(f32x4 (&acc)[2][2][4][2], const Unit& u, int wr, int wc, int fr_, int fq) const {
        int fr = fr_; asm volatile("" : "+v"(fr));
#pragma unroll
        for (int ai = 0; ai < 2; ++ai) { u32x4 ga[4][2], gr[4][2];
#pragma unroll
            for (int m = 0; m < 4; ++m) { const int row = EPI_ROWS(ai, m);
#pragma unroll
                for (int bj = 0; bj < 2; ++bj) { const size_t off = (size_t)row * DM + u.pn * BM + bj * HALF + wc * 32 + 8 * fq; ga[m][bj] = *(const u32x4*)(SGA + off); gr[m][bj] = *(const u32x4*)(SGR + off); } }
#pragma unroll
            for (int m = 0; m < 4; ++m)
#pragma unroll
                for (int bj = 0; bj < 2; ++bj)
#pragma unroll
                    for (int q = 0; q < 4; ++q) { const float alo = bflo(ga[m][bj][q]), ahi = bfhi(ga[m][bj][q]), rlo = fmaxf(bflo(gr[m][bj][q]), 1e-30f), rhi = fmaxf(bfhi(gr[m][bj][q]), 1e-30f);
                        acc[ai][bj][m][q >> 1][(q & 1) * 2] *= alo * __builtin_amdgcn_rcpf(rlo); acc[ai][bj][m][q >> 1][(q & 1) * 2 + 1] *= ahi * __builtin_amdgcn_rcpf(rhi); }
            asm volatile("" ::: "memory"); }
    }
    __device__ __forceinline__ void operator()(const f32x4 (&acc)[2][2][4][2], const Unit& u, int wr, int wc, int fr_, int fq_) const { EPI_OPAQUE;
#pragma unroll
        for (int ai = 0; ai < 2; ++ai)
#pragma unroll
            for (int m = 0; m < 4; ++m) { const int row = EPI_ROWS(ai, m);
#pragma unroll
                for (int bj = 0; bj < 2; ++bj) { const size_t off = (size_t)row * DM + u.pn * BM + bj * HALF + wc * 32 + 8 * fq;
                    const u32x4 r = *(const u32x4*)(SGR + off); f32x4 o0, o1;
                    o0[0] = acc[ai][bj][m][0][0] * fmaxf(bflo(r[0]), 1e-30f); o0[1] = acc[ai][bj][m][0][1] * fmaxf(bfhi(r[0]), 1e-30f);
                    o0[2] = acc[ai][bj][m][0][2] * fmaxf(bflo(r[1]), 1e-30f); o0[3] = acc[ai][bj][m][0][3] * fmaxf(bfhi(r[1]), 1e-30f);
                    o1[0] = acc[ai][bj][m][1][0] * fmaxf(bflo(r[2]), 1e-30f); o1[1] = acc[ai][bj][m][1][1] * fmaxf(bfhi(r[2]), 1e-30f);
                    o1[2] = acc[ai][bj][m][1][2] * fmaxf(bflo(r[3]), 1e-30f); o1[3] = acc[ai][bj][m][1][3] * fmaxf(bfhi(r[3]), 1e-30f);
                    *(u32x4*)(O + off) = pack8(o0, o1); } }
    }
};

struct EpiPle {
    static constexpr bool PERM = true, AFTER_DRAIN = false, HAS_MID = false; int mid_t;
    const bf16_t* H3; const bf16_t* PP; const PG8_LAS float* rst; bf16_t* H4; float* ssq4;
    __device__ __forceinline__ void mid(f32x4 (&)[2][2][4][2], const Unit&, int, int, int, int) const {}
    __device__ __forceinline__ void operator()(const f32x4 (&acc)[2][2][4][2], const Unit& u, int wr, int wc, int fr_, int fq_) const { EPI_OPAQUE;
#pragma unroll
        for (int ai = 0; ai < 2; ++ai)
#pragma unroll
            for (int m = 0; m < 4; ++m) { const int row = EPI_ROWS(ai, m); const float rs = EPI_RS(ai, m); float s = 0.f;
#pragma unroll
                for (int bj = 0; bj < 2; ++bj) { const size_t off = (size_t)row * DM + u.pn * BM + bj * HALF + wc * 32 + 8 * fq;
                    const u32x4 p = *(const u32x4*)(PP + off), r = *(const u32x4*)(H3 + off);
                    f32x4 h0, h1;
                    h0[0] = bflo(r[0]) + sigm(acc[ai][bj][m][0][0] * rs) * bflo(p[0]); h0[1] = bfhi(r[0]) + sigm(acc[ai][bj][m][0][1] * rs) * bfhi(p[0]);
                    h0[2] = bflo(r[1]) + sigm(acc[ai][bj][m][0][2] * rs) * bflo(p[1]); h0[3] = bfhi(r[1]) + sigm(acc[ai][bj][m][0][3] * rs) * bfhi(p[1]);
                    h1[0] = bflo(r[2]) + sigm(acc[ai][bj][m][1][0] * rs) * bflo(p[2]); h1[1] = bfhi(r[2]) + sigm(acc[ai][bj][m][1][1] * rs) * bfhi(p[2]);
                    h1[2] = bflo(r[3]) + sigm(acc[ai][bj][m][1][2] * rs) * bflo(p[3]); h1[3] = bfhi(r[3]) + sigm(acc[ai][bj][m][1][3] * rs) * bfhi(p[3]);
                    *(u32x4*)(H4 + off) = pack8(h0, h1); s += sq4(h0) + sq4(h1); }
                ssq_put<16>(ssq4, row, u.pn * 4 + wc, s, fq); }
    }
};
#undef EPI_ROWS
#undef EPI_OPAQUE
#undef EPI_RS
}
namespace att {
using bf16x8 = __attribute__((ext_vector_type(8))) short;
using s16x4 = __attribute__((ext_vector_type(4))) short;
using f32x16 = __attribute__((ext_vector_type(16))) float;
using u32x4 = __attribute__((ext_vector_type(4))) unsigned;
typedef __attribute__((address_space(3))) const char* lds_cptr;
typedef __attribute__((address_space(3))) char* lds_ptr;
constexpr int KSLOT = 12288, VSLOT = 8192;
constexpr int L_K = 0, L_V = 3 * KSLOT, L_WS = L_V + 3 * VSLOT, L_OST = L_WS + 8 * 256, L_END = L_OST + 8 * 4096;
static_assert(L_END <= RING_BYTES, "attention LDS");
__device__ __forceinline__ int crow(int r, int hi) { return (r & 3) + 8 * (r >> 2) + 4 * hi; }
__device__ __forceinline__ void glds16(const void* gsrc, unsigned lds_dst) { unsigned keep;
    asm volatile("s_mov_b32 %0, m0\n\ts_mov_b32 m0, %2\n\ts_nop 0\n\tglobal_load_lds_dwordx4 %1, off\n\ts_mov_b32 m0, %0" : "=&s"(keep) : "v"(gsrc), "s"(lds_dst) : "memory"); }
typedef float f32x2_t __attribute__((ext_vector_type(2))); typedef __bf16 bf16x2_t __attribute__((ext_vector_type(2)));
__device__ __forceinline__ unsigned cvtpk_s(float lo, float hi) { f32x2_t v = {lo, hi}; bf16x2_t b = __builtin_convertvector(v, bf16x2_t); return __builtin_bit_cast(unsigned, b); }
__device__ __forceinline__ float swap32_max(float m) { auto rr = __builtin_amdgcn_permlane32_swap(__float_as_uint(m), __float_as_uint(m), false, false); return fmaxf(__uint_as_float(rr[0]), __uint_as_float(rr[1])); }
__device__ __forceinline__ float swap32_sum(float m) { auto rr = __builtin_amdgcn_permlane32_swap(__float_as_uint(m), __float_as_uint(m), false, false); return __uint_as_float(rr[0]) + __uint_as_float(rr[1]); }

__device__ __forceinline__ void pv(f32x16* o, int vb, bf16x8 pa0, bf16x8 pa1, bf16x8 pa2, bf16x8 pa3) {
#pragma unroll
    for (int d0 = 0; d0 < 2; ++d0) { s16x4 lo[4], hi[4];
#pragma unroll
        for (int ks = 0; ks < 4; ++ks) {
            asm volatile("ds_read_b64_tr_b16 %0,%1 offset:%c2" : "=&v"(lo[ks]) : "v"(vb), "i"(d0 * 4096 + ks * 1024) : "memory");
            asm volatile("ds_read_b64_tr_b16 %0,%1 offset:%c2" : "=&v"(hi[ks]) : "v"(vb), "i"(d0 * 4096 + ks * 1024 + 512) : "memory"); }
        asm volatile("s_waitcnt lgkmcnt(0)" ::: "memory"); __builtin_amdgcn_sched_barrier(0);
#define PK(k) (bf16x8){lo[k][0], lo[k][1], lo[k][2], lo[k][3], hi[k][0], hi[k][1], hi[k][2], hi[k][3]}
        o[d0] = __builtin_amdgcn_mfma_f32_32x32x16_bf16(pa0, PK(0), o[d0], 0, 0, 0);
        o[d0] = __builtin_amdgcn_mfma_f32_32x32x16_bf16(pa1, PK(1), o[d0], 0, 0, 0);
        o[d0] = __builtin_amdgcn_mfma_f32_32x32x16_bf16(pa2, PK(2), o[d0], 0, 0, 0);
        o[d0] = __builtin_amdgcn_mfma_f32_32x32x16_bf16(pa3, PK(3), o[d0], 0, 0, 0);
#undef PK
    }
}

__device__ __forceinline__ void k_load(bf16x8 (&kf)[12], lds_cptr kp) {
#pragma unroll
    for (int d0 = 0; d0 < 6; ++d0) { kf[2 * d0] = *(const __attribute__((address_space(3))) bf16x8*)(kp + d0 * 2048); kf[2 * d0 + 1] = *(const __attribute__((address_space(3))) bf16x8*)(kp + d0 * 2048 + 512); }
}
__device__ __forceinline__ void qk_mma(f32x16& p0, f32x16& p1, const bf16x8 (&kf)[12], const bf16x8 (&qr)[6]) {
    p0 = f32x16{}; p1 = f32x16{};
#pragma unroll
    for (int d0 = 0; d0 < 6; ++d0) { p0 = __builtin_amdgcn_mfma_f32_32x32x16_bf16(kf[2 * d0], qr[d0], p0, 0, 0, 0); p1 = __builtin_amdgcn_mfma_f32_32x32x16_bf16(kf[2 * d0 + 1], qr[d0], p1, 0, 0, 0); }
}
__device__ __forceinline__ void v_load(s16x4 (&lo)[8], s16x4 (&hi)[8], int vb) {
#pragma unroll
    for (int i = 0; i < 8; ++i) {
        asm volatile("ds_read_b64_tr_b16 %0,%1 offset:%c2" : "=&v"(lo[i]) : "v"(vb), "i"((i >> 2) * 4096 + (i & 3) * 1024) : "memory");
        asm volatile("ds_read_b64_tr_b16 %0,%1 offset:%c2" : "=&v"(hi[i]) : "v"(vb), "i"((i >> 2) * 4096 + (i & 3) * 1024 + 512) : "memory"); }
}
__device__ __forceinline__ void pv_mma(f32x16* o, const s16x4 (&lo)[8], const s16x4 (&hi)[8], bf16x8 pa0, bf16x8 pa1, bf16x8 pa2, bf16x8 pa3) {
#define PK(k) (bf16x8){lo[k][0], lo[k][1], lo[k][2], lo[k][3], hi[k][0], hi[k][1], hi[k][2], hi[k][3]}
    o[0] = __builtin_amdgcn_mfma_f32_32x32x16_bf16(pa0, PK(0), o[0], 0, 0, 0); o[1] = __builtin_amdgcn_mfma_f32_32x32x16_bf16(pa0, PK(4), o[1], 0, 0, 0);
    o[0] = __builtin_amdgcn_mfma_f32_32x32x16_bf16(pa1, PK(1), o[0], 0, 0, 0); o[1] = __builtin_amdgcn_mfma_f32_32x32x16_bf16(pa1, PK(5), o[1], 0, 0, 0);
    o[0] = __builtin_amdgcn_mfma_f32_32x32x16_bf16(pa2, PK(2), o[0], 0, 0, 0); o[1] = __builtin_amdgcn_mfma_f32_32x32x16_bf16(pa2, PK(6), o[1], 0, 0, 0);
    o[0] = __builtin_amdgcn_mfma_f32_32x32x16_bf16(pa3, PK(3), o[0], 0, 0, 0); o[1] = __builtin_amdgcn_mfma_f32_32x32x16_bf16(pa3, PK(7), o[1], 0, 0, 0);
#undef PK
}
__device__ __forceinline__ void qk_tile(f32x16& p0, f32x16& p1, lds_cptr kp, const bf16x8 (&qr)[6]) {
    p0 = f32x16{}; p1 = f32x16{};
#pragma unroll
    for (int d0 = 0; d0 < 6; ++d0) {
        const bf16x8 k0 = *(const __attribute__((address_space(3))) bf16x8*)(kp + d0 * 2048);
        const bf16x8 k1 = *(const __attribute__((address_space(3))) bf16x8*)(kp + d0 * 2048 + 512);
        p0 = __builtin_amdgcn_mfma_f32_32x32x16_bf16(k0, qr[d0], p0, 0, 0, 0);
        p1 = __builtin_amdgcn_mfma_f32_32x32x16_bf16(k1, qr[d0], p1, 0, 0, 0); }
}
__device__ __forceinline__ float max3f(float a, float b, float c) { return __builtin_fmaxf(__builtin_fmaxf(a, b), c); }
__device__ __forceinline__ void softmax_a(f32x16& p0, f32x16& p1, int jb, int qrel, int hi, int r32, float& m_run, float& l_run, f32x16 (&o)[2], LAS float* wsf) {
    if (jb >= 0) { const int kb = 64 * jb + 4 * hi;
#pragma unroll
        for (int r = 0; r < 16; ++r) { const int kv = kb + (r & 3) + 8 * (r >> 2); if (kv > qrel) p0[r] = -INFINITY; if (kv + 32 > qrel) p1[r] = -INFINITY; } }
    float a = max3f(p0[0], p0[1], p1[0]), b = max3f(p0[2], p0[3], p1[1]); a = max3f(a, p1[2], p1[3]);
#pragma unroll
    for (int r = 4; r < 16; r += 4) { a = max3f(a, p0[r], p0[r + 1]); b = max3f(b, p0[r + 2], p0[r + 3]); a = max3f(a, p1[r], p1[r + 1]); b = max3f(b, p1[r + 2], p1[r + 3]); }
    const float rm = swap32_max(fmaxf(a, b));
    const float mnew = (rm > m_run + 8.0f) ? rm : m_run;
    if (__any(mnew > m_run)) {
        const float alpha = __builtin_amdgcn_exp2f(m_run - mnew);
        l_run *= alpha; m_run = mnew;
        if (hi == 0) wsf[r32] = alpha;
        asm volatile("s_waitcnt lgkmcnt(0)" ::: "memory");
        f32x16 av;
#pragma unroll
        for (int r = 0; r < 16; ++r) av[r] = wsf[crow(r, hi)];
        o[0] *= av; o[1] *= av;
    }
}
__device__ __forceinline__ void softmax_b(f32x16& p0, f32x16& p1, float m_run, float& l_run, u32x4& pw0, u32x4& pw1, u32x4& pw2, u32x4& pw3) {
    p0 = p0 - m_run; p1 = p1 - m_run;
#pragma unroll
    for (int r = 0; r < 16; ++r) { p0[r] = __builtin_amdgcn_exp2f(p0[r]); p1[r] = __builtin_amdgcn_exp2f(p1[r]); }
    const f32x16 ps = p0 + p1;
    typedef float f32x8_t __attribute__((ext_vector_type(8))); typedef float f32x4_t __attribute__((ext_vector_type(4))); typedef float f32x2_t2 __attribute__((ext_vector_type(2)));
    const f32x8_t s8 = __builtin_shufflevector(ps, ps, 0, 1, 2, 3, 4, 5, 6, 7) + __builtin_shufflevector(ps, ps, 8, 9, 10, 11, 12, 13, 14, 15);
    const f32x4_t s4 = __builtin_shufflevector(s8, s8, 0, 1, 2, 3) + __builtin_shufflevector(s8, s8, 4, 5, 6, 7);
    const f32x2_t2 s2 = __builtin_shufflevector(s4, s4, 0, 1) + __builtin_shufflevector(s4, s4, 2, 3);
    l_run += s2[0] + s2[1];
#define PKW(P, B) cvtpk_s(P[B], P[B + 1])
    pw0 = (u32x4){PKW(p0, 0), PKW(p0, 2), PKW(p0, 4), PKW(p0, 6)}; pw1 = (u32x4){PKW(p0, 8), PKW(p0, 10), PKW(p0, 12), PKW(p0, 14)};
    pw2 = (u32x4){PKW(p1, 0), PKW(p1, 2), PKW(p1, 4), PKW(p1, 6)}; pw3 = (u32x4){PKW(p1, 8), PKW(p1, 10), PKW(p1, 12), PKW(p1, 14)};
#undef PKW
}
__device__ __forceinline__ void attn_unit(int b, int h, int qb, const bf16* Q, const bf16* KN, const bf16* KPE, const bf16* VB, bf16* O, char* shm) {
    int tid_ = threadIdx.x; asm volatile("" : "+v"(tid_)); const int tid = tid_, lane = tid & 63, r32 = lane & 31, hi = lane >> 5; const int wid = __builtin_amdgcn_readfirstlane(tid >> 6);
    const long rowbase = (long)b * TSEQ; const int q0 = qb * 256;
    const bf16* Qw = Q + (rowbase + q0 + wid * 32) * 768 + h * QKD;
    const unsigned lds0 = (unsigned)(uintptr_t)shm;
    const lds_ptr shm3 = (lds_ptr)shm;
    LAS float* wsf = (LAS float*)(shm3 + L_WS) + wid * 64;
    const bf16* ksrc0 = KN + (rowbase + lane) * 512 + h * 64 + wid * 8;
    const bf16* ksrc1 = KPE + (rowbase + lane) * RPE + (wid & 3) * 8;
    const bf16* vsrc = VB + (rowbase + 16 * (wid & 3) + (lane >> 2)) * 512 + h * 64 + (wid >> 2) * 32 + (lane & 3) * 8;
    const unsigned kdst0 = lds0 + L_K + wid * 1024, kdst1 = lds0 + L_K + (8 + (wid & 3)) * 1024, vdst = lds0 + L_V + wid * 1024;
#define ATT_DMAK(t, s) do { glds16(ksrc0 + (long)(t) * 64 * 512, (unsigned)__builtin_amdgcn_readfirstlane(kdst0 + (s) * KSLOT)); \
                            glds16(ksrc1 + (long)(t) * 64 * RPE, (unsigned)__builtin_amdgcn_readfirstlane(kdst1 + (s) * KSLOT)); } while (0)
#define ATT_DMAV(t, s) glds16(vsrc + (long)(t) * 64 * 512, (unsigned)__builtin_amdgcn_readfirstlane(vdst + (s) * VSLOT))
    const int vb0 = (int)(lds0 + L_V) + ((lane >> 4) & 1) * 32 + (lane & 3) * 8 + (4 * hi + ((lane & 15) >> 2)) * 64;
    const lds_cptr kp0 = (lds_cptr)shm3 + L_K + hi * 1024 + r32 * 16;
    const int NT = (q0 + 256) / 64;
    ATT_DMAK(0, 0); ATT_DMAV(0, 0); ATT_DMAK(1, 1); ATT_DMAV(1, 1); ATT_DMAK(2, 2);
    bf16x8 qr[6];
#pragma unroll
    for (int d0 = 0; d0 < 6; ++d0) qr[d0] = *reinterpret_cast<const bf16x8*>(&Qw[(long)r32 * 768 + d0 * 16 + hi * 8]);
    float m_run = -INFINITY, l_run = 0.f; f32x16 o[2]; o[0] = f32x16{}; o[1] = f32x16{};
    const int qrel = wid * 32 + r32;
    asm volatile("s_waitcnt vmcnt(0) lgkmcnt(0)\n\ts_barrier" ::: "memory");
    f32x16 sA0, sA1, sB0, sB1;
    qk_tile(sA0, sA1, kp0, qr);
    int t = 0, s0 = 0, s1 = 1, s2 = 2;
    for (; t + 1 < NT - 4; ++t) {
        asm volatile("s_waitcnt vmcnt(3) lgkmcnt(0)\n\ts_barrier" ::: "memory");
        ATT_DMAK(t + 3, s0); ATT_DMAV(t + 2, s2);
        bf16x8 kf[12]; s16x4 vlo[8], vhi[8];
        k_load(kf, kp0 + s1 * KSLOT); v_load(vlo, vhi, vb0 + s0 * VSLOT);
        softmax_a(sA0, sA1, -1, qrel, hi, r32, m_run, l_run, o, wsf);
        asm volatile("s_waitcnt lgkmcnt(0)" ::: "memory"); __builtin_amdgcn_sched_barrier(0);
        u32x4 pw0, pw1, pw2, pw3;
        qk_mma(sB0, sB1, kf, qr);
        softmax_b(sA0, sA1, m_run, l_run, pw0, pw1, pw2, pw3);
#pragma unroll
        for (int i = 0; i < 12; ++i) { __builtin_amdgcn_sched_group_barrier(0x008, 1, 0); __builtin_amdgcn_sched_group_barrier(0x002, 10, 0); }
        pv_mma(o, vlo, vhi, __builtin_bit_cast(bf16x8, pw0), __builtin_bit_cast(bf16x8, pw1), __builtin_bit_cast(bf16x8, pw2), __builtin_bit_cast(bf16x8, pw3));
        sA0 = sB0; sA1 = sB1;
        { const int r_ = s0; s0 = s1; s1 = s2; s2 = r_; }
    }
    for (; t < NT; ++t) {
        asm volatile("s_waitcnt vmcnt(0) lgkmcnt(0)\n\ts_barrier" ::: "memory");
        if (t + 3 < NT) ATT_DMAK(t + 3, s0);
        if (t + 2 < NT) ATT_DMAV(t + 2, s2);
        const int jb = t - (NT - 4), jbn = jb + 1;
        const bool pn = (t + 1 < NT) && (jbn < 0 || 2 * jbn <= wid);
        if (pn) qk_tile(sB0, sB1, kp0 + s1 * KSLOT, qr);
        if (jb < 0 || 2 * jb <= wid) { softmax_a(sA0, sA1, jb, qrel, hi, r32, m_run, l_run, o, wsf); u32x4 pw0, pw1, pw2, pw3; softmax_b(sA0, sA1, m_run, l_run, pw0, pw1, pw2, pw3);
            pv(o, vb0 + s0 * VSLOT, __builtin_bit_cast(bf16x8, pw0), __builtin_bit_cast(bf16x8, pw1), __builtin_bit_cast(bf16x8, pw2), __builtin_bit_cast(bf16x8, pw3)); }
        sA0 = sB0; sA1 = sB1;
        { const int r_ = s0; s0 = s1; s1 = s2; s2 = r_; }
    }
    l_run = swap32_sum(l_run);
    if (hi == 0) wsf[32 + r32] = l_run;
    asm volatile("s_waitcnt lgkmcnt(0)" ::: "memory");
    float rli[16];
#pragma unroll
    for (int r = 0; r < 16; ++r) rli[r] = 1.0f / wsf[32 + crow(r, hi)];
    bf16* Ow = O + (rowbase + q0 + wid * 32) * DM + h * 64;
    { LAS bf16* stg = (LAS bf16*)(shm3 + L_OST) + wid * 2048;
#pragma unroll
      for (int r = 0; r < 16; ++r) { const int orow = crow(r, hi);
#pragma unroll
          for (int d0 = 0; d0 < 2; ++d0) stg[orow * 64 + d0 * 32 + r32] = (bf16)f2bf(o[d0][r] * rli[r]); }
      asm volatile("s_waitcnt lgkmcnt(0)" ::: "memory");
#pragma unroll
      for (int i = 0; i < 4; ++i) { const int row = i * 8 + (lane >> 3), ch = lane & 7; const u32x4 v = *(const LAS u32x4*)(stg + row * 64 + ch * 8); *(u32x4*)(Ow + (long)row * DM + ch * 8) = v; } }
    asm volatile("s_waitcnt vmcnt(0) lgkmcnt(0)\n\ts_barrier" ::: "memory");
#undef ATT_DMAK
#undef ATT_DMAV
}
__device__ __forceinline__ void bar4(volatile LAS unsigned* cnt, unsigned& gen, int lane) {
    gen += 4u;
    if (lane == 0) { unsigned seen = __hip_atomic_fetch_add((LAS unsigned*)cnt, 1u, __ATOMIC_RELAXED, __HIP_MEMORY_SCOPE_WORKGROUP) + 1u;
        while (seen < gen) seen = __hip_atomic_load((LAS unsigned*)cnt, __ATOMIC_RELAXED, __HIP_MEMORY_SCOPE_WORKGROUP); }
    asm volatile("" ::: "memory");
}
__device__ __forceinline__ void bar4_arrive(volatile LAS unsigned* cnt, unsigned& gen, int lane) {
    gen += 4u;
    if (lane == 0) __hip_atomic_fetch_add((LAS unsigned*)cnt, 1u, __ATOMIC_RELAXED, __HIP_MEMORY_SCOPE_WORKGROUP);
    asm volatile("" ::: "memory");
}
__device__ __forceinline__ void bar4_wait(volatile LAS unsigned* cnt, unsigned gen, int lane) {
    if (lane == 0) { while (__hip_atomic_load((LAS unsigned*)cnt, __ATOMIC_RELAXED, __HIP_MEMORY_SCOPE_WORKGROUP) < gen) {} }
    asm volatile("" ::: "memory");
}
constexpr int H_K = 0, H_V = 3 * KSLOT, H_WS = H_V + 3 * VSLOT, H_OST = H_WS + 4 * 256, H_END = H_OST + 4 * 4096;
__device__ __forceinline__ void attn_half_unit(int b, int h, int qb, const bf16* Q, const bf16* KN, const bf16* KPE, const bf16* VB, bf16* O, char* shm, volatile LAS unsigned* cnt, unsigned& gen, int wid  ) {
    int tid_ = threadIdx.x; asm volatile("" : "+v"(tid_)); const int tid = tid_, lane = tid & 63, r32 = lane & 31, hi = lane >> 5;
    const long rowbase = (long)b * TSEQ; const int q0 = qb * 128;
    const bf16* Qw = Q + (rowbase + q0 + wid * 32) * 768 + h * QKD;
    const unsigned lds0 = (unsigned)(uintptr_t)shm;
    const lds_ptr shm3 = (lds_ptr)shm;
    LAS float* wsf = (LAS float*)(shm3 + H_WS) + wid * 64;
    const bf16* ksrcA = KN + (rowbase + lane) * 512 + h * 64 + wid * 8;
    const bf16* ksrcC = KPE + (rowbase + lane) * RPE + wid * 8;
    const bf16* vsrc = VB + (rowbase + 16 * wid + (lane >> 2)) * 512 + h * 64 + (lane & 3) * 8;
    const unsigned kdst = lds0 + H_K + wid * 1024, vdst = lds0 + H_V + wid * 1024;
#define HDMA(t, s) do { glds16(ksrcA + (long)(t) * 64 * 512, (unsigned)__builtin_amdgcn_readfirstlane(kdst + (s) * KSLOT)); \
                        glds16(ksrcA + (long)(t) * 64 * 512 + 32, (unsigned)__builtin_amdgcn_readfirstlane(kdst + (s) * KSLOT + 4096)); \
                        glds16(ksrcC + (long)(t) * 64 * RPE, (unsigned)__builtin_amdgcn_readfirstlane(kdst + (s) * KSLOT + 8192)); } while (0)
#define HDMAV(t, s) do { glds16(vsrc + (long)(t) * 64 * 512, (unsigned)__builtin_amdgcn_readfirstlane(vdst + (s) * VSLOT)); \
                         glds16(vsrc + (long)(t) * 64 * 512 + 32, (unsigned)__builtin_amdgcn_readfirstlane(vdst + (s) * VSLOT + 4096)); } while (0)
    const int vb0 = (int)(lds0 + H_V) + ((lane >> 4) & 1) * 32 + (lane & 3) * 8 + (4 * hi + ((lane & 15) >> 2)) * 64;
    const lds_cptr kp0 = (lds_cptr)shm3 + H_K + hi * 1024 + r32 * 16;
    const int NT = (q0 + 128) / 64;
    HDMA(0, 0); HDMAV(0, 0); HDMA(1, 1); HDMAV(1, 1); if (NT > 2) HDMA(2, 2);
    bf16x8 qr[6];
#pragma unroll
    for (int d0 = 0; d0 < 6; ++d0) qr[d0] = *reinterpret_cast<const bf16x8*>(&Qw[(long)r32 * 768 + d0 * 16 + hi * 8]);
    float m_run = -INFINITY, l_run = 0.f; f32x16 o[2]; o[0] = f32x16{}; o[1] = f32x16{};
    const int qrel = wid * 32 + r32;
    asm volatile("s_waitcnt vmcnt(0) lgkmcnt(0)" ::: "memory"); bar4(cnt, gen, lane);
    f32x16 sA0, sA1, sB0, sB1;
    qk_tile(sA0, sA1, kp0, qr);
    int t = 0, s0 = 0, s1 = 1, s2 = 2;
    for (; t + 1 < NT - 2; ++t) {
        asm volatile("s_waitcnt vmcnt(5) lgkmcnt(0)" ::: "memory"); bar4(cnt, gen, lane);
        HDMA(t + 3, s0); HDMAV(t + 2, s2);
        bf16x8 kf[12]; s16x4 vlo[8], vhi[8];
        k_load(kf, kp0 + s1 * KSLOT); v_load(vlo, vhi, vb0 + s0 * VSLOT);
        softmax_a(sA0, sA1, -1, qrel, hi, r32, m_run, l_run, o, wsf);
        asm volatile("s_waitcnt lgkmcnt(0)" ::: "memory"); __builtin_amdgcn_sched_barrier(0);
        u32x4 pw0, pw1, pw2, pw3;
        qk_mma(sB0, sB1, kf, qr);
        softmax_b(sA0, sA1, m_run, l_run, pw0, pw1, pw2, pw3);
#pragma unroll
        for (int i = 0; i < 12; ++i) { __builtin_amdgcn_sched_group_barrier(0x008, 1, 0); __builtin_amdgcn_sched_group_barrier(0x002, 10, 0); }
        pv_mma(o, vlo, vhi, __builtin_bit_cast(bf16x8, pw0), __builtin_bit_cast(bf16x8, pw1), __builtin_bit_cast(bf16x8, pw2), __builtin_bit_cast(bf16x8, pw3));
        sA0 = sB0; sA1 = sB1;
        { const int r_ = s0; s0 = s1; s1 = s2; s2 = r_; }
    }
    for (; t < NT; ++t) {
        asm volatile("s_waitcnt vmcnt(0) lgkmcnt(0)" ::: "memory"); bar4(cnt, gen, lane);
        if (t + 3 < NT) HDMA(t + 3, s0);
        if (t + 2 < NT) HDMAV(t + 2, s2);
        const int jb = t - (NT - 2), jbn = jb + 1;
        const bool pn = (t + 1 < NT) && (jbn < 0 || 2 * jbn <= wid);
        if (pn) qk_tile(sB0, sB1, kp0 + s1 * KSLOT, qr);
        if (jb < 0 || 2 * jb <= wid) { softmax_a(sA0, sA1, jb, qrel, hi, r32, m_run, l_run, o, wsf); u32x4 pw0, pw1, pw2, pw3; softmax_b(sA0, sA1, m_run, l_run, pw0, pw1, pw2, pw3);
            pv(o, vb0 + s0 * VSLOT, __builtin_bit_cast(bf16x8, pw0), __builtin_bit_cast(bf16x8, pw1), __builtin_bit_cast(bf16x8, pw2), __builtin_bit_cast(bf16x8, pw3)); }
        sA0 = sB0; sA1 = sB1;
        { const int r_ = s0; s0 = s1; s1 = s2; s2 = r_; }
    }
    l_run = swap32_sum(l_run);
    if (hi == 0) wsf[32 + r32] = l_run;
    asm volatile("s_waitcnt lgkmcnt(0)" ::: "memory");
    float rli[16];
#pragma unroll
    for (int r = 0; r < 16; ++r) rli[r] = 1.0f / wsf[32 + crow(r, hi)];
    bf16* Ow = O + (rowbase + q0 + wid * 32) * DM + h * 64;
    { LAS bf16* stg = (LAS bf16*)(shm3 + H_OST) + wid * 2048;
#pragma unroll
      for (int r = 0; r < 16; ++r) { const int orow = crow(r, hi);
#pragma unroll
          for (int d0 = 0; d0 < 2; ++d0) stg[orow * 64 + d0 * 32 + r32] = (bf16)f2bf(o[d0][r] * rli[r]); }
      asm volatile("s_waitcnt lgkmcnt(0)" ::: "memory");
#pragma unroll
      for (int i = 0; i < 4; ++i) { const int row = i * 8 + (lane >> 3), ch = lane & 7; const u32x4 v = *(const LAS u32x4*)(stg + row * 64 + ch * 8); *(u32x4*)(Ow + (long)row * DM + ch * 8) = v; } }
    asm volatile("s_waitcnt vmcnt(0) lgkmcnt(0)" ::: "memory"); bar4(cnt, gen, lane);
#undef HDMA
#undef HDMAV
}
}
namespace ret {
using bf16x8 = __attribute__((ext_vector_type(8))) short;
using s16x4 = __attribute__((ext_vector_type(4))) short;
using f32x16 = __attribute__((ext_vector_type(16))) float;
typedef short v4i16_t __attribute__((ext_vector_type(4)));
constexpr int TPB = 288, TB = 128 * TPB;
constexpr int OTP = 132;
static_assert(3 * TB <= RING_BYTES && 128 * OTP * 4 <= 2 * TB, "retention LDS");
__device__ __forceinline__ int crow(int r, int hi) { return (r & 3) + 8 * (r >> 2) + 4 * hi; }
__device__ __forceinline__ void stage_tile(LAS unsigned char* tile, const bf16* src, int pitch, int tid) {
#pragma unroll
    for (int i = 0; i < 4; ++i) { const int idx = tid + 512 * i, row = idx >> 4, ch = idx & 15;
        *(LAS v4u*)(tile + row * TPB + ch * 16) = *(const v4u*)(src + (size_t)row * pitch + ch * 8); }
}
__device__ __forceinline__ bf16x8 rowfrag(const LAS unsigned char* tile, int row0, int k0, int r32, int hi) { return *(const LAS bf16x8*)(tile + (row0 + r32) * TPB + (k0 + 8 * hi) * 2); }
__device__ __forceinline__ bf16x8 trfrag(const LAS unsigned char* tile, int k0, int c0, int lane) {
    const int h = lane >> 5, blk = (lane >> 4) & 1, q = (lane & 15) >> 2, p = lane & 3;
    const LAS unsigned char* a = tile + (k0 + 8 * h + q) * TPB + (c0 + 16 * blk + 4 * p) * 2;
    const s16x4 lo = __builtin_bit_cast(s16x4, __builtin_amdgcn_ds_read_tr16_b64_v4i16((LAS v4i16_t*)a));
    const s16x4 hi4 = __builtin_bit_cast(s16x4, __builtin_amdgcn_ds_read_tr16_b64_v4i16((LAS v4i16_t*)(a + 4 * TPB)));
    return (bf16x8){lo[0], lo[1], lo[2], lo[3], hi4[0], hi4[1], hi4[2], hi4[3]};
}

__device__ __forceinline__ void kv_unit(int u, const bf16* KR, const bf16* RV, float* KVC, LAS unsigned char* lds) {
    int tid_ = threadIdx.x; asm volatile("" : "+v"(tid_)); const int tid = tid_, lane = tid & 63, r32 = lane & 31, hi = lane >> 5, wid = __builtin_amdgcn_readfirstlane(tid >> 6), wi = wid >> 1, wj = wid & 1;
    const int bh = u >> 6, c = u & 63, b = bh >> 2, h = bh & 3; const size_t row0 = (size_t)b * TSEQ + c * 128;
    LAS unsigned char* T0 = lds; LAS unsigned char* T1 = lds + TB;
    stage_tile(T0, KR + row0 * 512 + h * 128, 512, tid); stage_tile(T1, RV + row0 * 512 + h * 128, 512, tid);
    __syncthreads();
    f32x16 acc[2]; acc[0] = f32x16{}; acc[1] = f32x16{};
#pragma unroll
    for (int ks = 0; ks < 8; ++ks) { const bf16x8 A = trfrag(T0, 16 * ks, 32 * wi, lane);
#pragma unroll
        for (int n = 0; n < 2; ++n) acc[n] = __builtin_amdgcn_mfma_f32_32x32x16_bf16(A, trfrag(T1, 16 * ks, 64 * wj + 32 * n, lane), acc[n], 0, 0, 0); }
    const float g127 = __builtin_amdgcn_exp2f(127.0f * lg2gamma(h));
    float* out = KVC + (size_t)u * 16384;
#pragma unroll
    for (int n = 0; n < 2; ++n)
#pragma unroll
        for (int r = 0; r < 16; ++r) out[(32 * wi + crow(r, hi)) * 128 + 64 * wj + 32 * n + r32] = acc[n][r] * g127;
    __syncthreads();
}

__device__ __forceinline__ void scan_items(int gtid, int gthreads, const float* KVC, bf16* SC, float* dout) {
    for (int e = gtid; e < 8 * 16384; e += gthreads) { const int bh = e >> 14, el = e & 16383; const float g128 = __builtin_amdgcn_exp2f(128.0f * lg2gamma(bh & 3));
        float s = 0.f;
        for (int c0 = 0; c0 < 64; c0 += 8) { float kv[8];
#pragma unroll
            for (int i = 0; i < 8; ++i) kv[i] = KVC[(size_t)(bh * 64 + c0 + i) * 16384 + el];
#pragma unroll
            for (int i = 0; i < 8; ++i) { SC[(size_t)(bh * 64 + c0 + i) * 16384 + el] = (bf16)f2bf(s); s = g128 * s + kv[i]; } }
        dout[O_RETP + e] = s; }
}

__device__ __forceinline__ void out_unit(int u, const bf16* QR, const bf16* KR, const bf16* RV, const bf16* SC, const bf16* RGS, const float* gnorm, bf16* OCAT, LAS unsigned char* lds) {
    int tid_ = threadIdx.x; asm volatile("" : "+v"(tid_)); const int tid = tid_, lane = tid & 63, r32 = lane & 31, hi = lane >> 5, wid = __builtin_amdgcn_readfirstlane(tid >> 6), wi = wid >> 1, wj = wid & 1;
    const int bh = u >> 6, c = u & 63, b = bh >> 2, h = bh & 3; const size_t row0 = (size_t)b * TSEQ + c * 128;
    LAS unsigned char* T0 = lds; LAS unsigned char* T1 = lds + TB; LAS unsigned char* T2 = lds + 2 * TB;
    stage_tile(T0, QR + row0 * 512 + h * 128, 512, tid); stage_tile(T1, KR + row0 * 512 + h * 128, 512, tid); stage_tile(T2, RV + row0 * 512 + h * 128, 512, tid);
    __syncthreads();
    f32x16 sr[2];
#pragma unroll
    for (int n = 0; n < 2; ++n) { const int jb = 2 * wj + n; sr[n] = f32x16{};
        if (jb <= wi) {
#pragma unroll
            for (int ks = 0; ks < 8; ++ks) sr[n] = __builtin_amdgcn_mfma_f32_32x32x16_bf16(rowfrag(T1, 32 * jb, 16 * ks, r32, hi), rowfrag(T0, 32 * wi, 16 * ks, r32, hi), sr[n], 0, 0, 0);
            if (jb == wi) {
#pragma unroll
                for (int r = 0; r < 16; ++r) if (crow(r, hi) > r32) sr[n][r] = 0.f; } } }
    __syncthreads();
#pragma unroll
    for (int n = 0; n < 2; ++n) { const int jb = 2 * wj + n;
        if (jb <= wi) {
#pragma unroll
            for (int r4 = 0; r4 < 4; ++r4) { v2u w; w.x = pg8::cvt_pk_bf16(sr[n][4 * r4], sr[n][4 * r4 + 1]); w.y = pg8::cvt_pk_bf16(sr[n][4 * r4 + 2], sr[n][4 * r4 + 3]);
                *(LAS v2u*)(T1 + (32 * wi + r32) * TPB + (32 * jb + 8 * r4 + 4 * hi) * 2) = w; } } }
    __syncthreads();
    f32x16 o1[2]; o1[0] = f32x16{}; o1[1] = f32x16{};
    for (int ks = 0; ks < 2 * (wi + 1); ++ks) { const bf16x8 A = rowfrag(T1, 32 * wi, 16 * ks, r32, hi);
#pragma unroll
        for (int n = 0; n < 2; ++n) o1[n] = __builtin_amdgcn_mfma_f32_32x32x16_bf16(A, trfrag(T2, 16 * ks, 64 * wj + 32 * n, lane), o1[n], 0, 0, 0); }
    __syncthreads();
    stage_tile(T2, SC + (size_t)u * 16384, 128, tid);
    __syncthreads();
    f32x16 o2[2]; o2[0] = f32x16{}; o2[1] = f32x16{};
#pragma unroll
    for (int ks = 0; ks < 8; ++ks) { const bf16x8 A = rowfrag(T0, 32 * wi, 16 * ks, r32, hi);
#pragma unroll
        for (int n = 0; n < 2; ++n) o2[n] = __builtin_amdgcn_mfma_f32_32x32x16_bf16(A, trfrag(T2, 16 * ks, 64 * wj + 32 * n, lane), o2[n], 0, 0, 0); }
    __syncthreads();
    const float gam = __builtin_amdgcn_exp2f(lg2gamma(h));
    LAS float* OT = (LAS float*)lds;
#pragma unroll
    for (int n = 0; n < 2; ++n)
#pragma unroll
        for (int r = 0; r < 16; ++r) OT[(32 * wi + crow(r, hi)) * OTP + 64 * wj + 32 * n + r32] = o1[n][r] + gam * o2[n][r];
    __syncthreads();
    { const int row = tid >> 2, part = tid & 3; const LAS float* orow = OT + row * OTP + part * 32; float v[32]; float s = 0.f;
#pragma unroll
      for (int k = 0; k < 32; ++k) { v[k] = orow[k]; s += v[k]; }
      s += __shfl_xor(s, 1); s += __shfl_xor(s, 2); const float mu = s * (1.0f / 128.0f); float q = 0.f;
#pragma unroll
      for (int k = 0; k < 32; ++k) { v[k] -= mu; q += v[k] * v[k]; }
      q += __shfl_xor(q, 1); q += __shfl_xor(q, 2); const float rstd = 1.0f / sqrtf(q * (1.0f / 128.0f) + EPS);
      const bf16* rg = RGS + (row0 + row) * 512 + h * 128 + part * 32; const float* gn = gnorm + h * 128 + part * 32; bf16* dst = OCAT + (row0 + row) * DM + 512 + h * 128 + part * 32;
#pragma unroll
      for (int k8 = 0; k8 < 4; ++k8) { const v4u g = *(const v4u*)(rg + 8 * k8); v4u w;
#pragma unroll
          for (int j = 0; j < 4; ++j) { const int k = 8 * k8 + 2 * j; w[j] = pk2(v[k] * rstd * gn[k] * bflo(g[j]), v[k + 1] * rstd * gn[k + 1] * bfhi(g[j])); }
          *(v4u*)(dst + 8 * k8) = w; } }
    __syncthreads();
}

__device__ __forceinline__ void sample_unit(int u, const bf16* QR, const bf16* KR, const bf16* RV, const bf16* RGS, const float* gnorm, const float* state, float* dout, bf16* OCAT, LAS unsigned char* lds) {
    int tid_ = threadIdx.x; asm volatile("" : "+v"(tid_)); const int tid = tid_, s = u >> 2, h = u & 3; const size_t row = (size_t)MP + s;
    LAS float* qf = (LAS float*)lds; LAS float* kf = qf + 128; LAS float* vf = kf + 128; LAS float* red = vf + 128; LAS float* ob = red + 512;
    if (tid < 128) { qf[tid] = bf2f(QR[row * 512 + h * 128 + tid]); kf[tid] = bf2f(KR[row * 512 + h * 128 + tid]); vf[tid] = bf2f(RV[row * 512 + h * 128 + tid]); }
    __syncthreads();
    const int dv = tid & 127, g = tid >> 7; const float gam = __builtin_amdgcn_exp2f(lg2gamma(h)); const float vv = vf[dv];
    const float* S0 = state + (size_t)u * 16384; float* Sn = dout + O_RETS + (size_t)u * 16384; float acc = 0.f;
#pragma unroll 8
    for (int i = 0; i < 32; ++i) { const int dk = 32 * g + i; const float s0 = S0[dk * 128 + dv]; acc += qf[dk] * s0; Sn[dk * 128 + dv] = gam * s0 + kf[dk] * vv; }
    red[tid] = acc;
    __syncthreads();
    if (tid < 128) { float qk = 0.f;
        for (int d = 0; d < 128; ++d) qk += qf[d] * kf[d];
        ob[tid] = qk * vv + gam * ((red[tid] + red[128 + tid]) + (red[256 + tid] + red[384 + tid])); }
    __syncthreads();
    if (tid < 128) { float sm = 0.f;
        for (int d = 0; d < 128; ++d) sm += ob[d];
        const float mu = sm * (1.0f / 128.0f); float q = 0.f;
        for (int d = 0; d < 128; ++d) { const float t = ob[d] - mu; q += t * t; }
        const float rstd = 1.0f / sqrtf(q * (1.0f / 128.0f) + EPS);
        OCAT[row * DM + 512 + h * 128 + tid] = (bf16)f2bf((ob[tid] - mu) * rstd * gnorm[h * 128 + tid] * bf2f(RGS[row * 512 + h * 128 + tid])); }
    __syncthreads();
}
__device__ __forceinline__ void sample_unit4(int u, int w4, int lane_, const bf16* QR, const bf16* KR, const bf16* RV, const bf16* RGS, const float* gnorm, const float* state, float* dout, bf16* OCAT, LAS float* tl, volatile LAS unsigned* cnt, unsigned& gen) {
    int lane = lane_; asm volatile("" : "+v"(lane));
    const int tid = w4 * 64 + lane, s = u >> 2, h = u & 3; const size_t row = (size_t)MP + s;
    LAS float* qf = tl; LAS float* kf = qf + 128; LAS float* vf = kf + 128; LAS float* red = vf + 128; LAS float* ob = red + 256;
    if (tid < 128) { qf[tid] = bf2f(QR[row * 512 + h * 128 + tid]); kf[tid] = bf2f(KR[row * 512 + h * 128 + tid]); vf[tid] = bf2f(RV[row * 512 + h * 128 + tid]); }
    asm volatile("s_waitcnt lgkmcnt(0)" ::: "memory"); att::bar4(cnt, gen, lane);
    const int dv = tid & 127, g = tid >> 7; const float gam = __builtin_amdgcn_exp2f(lg2gamma(h)); const float vv = vf[dv];
    const float* S0 = state + (size_t)u * 16384; float* Sn = dout + O_RETS + (size_t)u * 16384; float acc = 0.f;
#pragma unroll 16
    for (int i = 0; i < 64; ++i) { const int dk = 64 * g + i; const float s0 = S0[dk * 128 + dv]; acc += qf[dk] * s0; Sn[dk * 128 + dv] = gam * s0 + kf[dk] * vv; }
    red[tid] = acc;
    asm volatile("s_waitcnt lgkmcnt(0)" ::: "memory"); att::bar4(cnt, gen, lane);
    if (tid < 128) { float qk = 0.f;
        for (int d = 0; d < 128; ++d) qk += qf[d] * kf[d];
        ob[tid] = qk * vv + gam * (red[tid] + red[128 + tid]); }
    asm volatile("s_waitcnt lgkmcnt(0)" ::: "memory"); att::bar4(cnt, gen, lane);
    if (tid < 128) { float sm = 0.f;
        for (int d = 0; d < 128; ++d) sm += ob[d];
        const float mu = sm * (1.0f / 128.0f); float q = 0.f;
        for (int d = 0; d < 128; ++d) { const float t = ob[d] - mu; q += t * t; }
        const float rstd = 1.0f / sqrtf(q * (1.0f / 128.0f) + EPS);
        OCAT[row * DM + 512 + h * 128 + tid] = (bf16)f2bf((ob[tid] - mu) * rstd * gnorm[h * 128 + tid] * bf2f(RGS[row * 512 + h * 128 + tid])); }
    asm volatile("s_waitcnt lgkmcnt(0)" ::: "memory"); att::bar4(cnt, gen, lane);
}
}
namespace sk {
using bf16x8 = __attribute__((ext_vector_type(8))) short;
using f32x4 = __attribute__((ext_vector_type(4))) float;
using f32x2 = __attribute__((ext_vector_type(2))) float;
template <int K, bool DUAL, bool STAT, class Epi>
__device__ __forceinline__ void skinny_unit(int u, const bf16* A, const bf16* Bt, float* ssq, LAS float* lds, const Epi E) {
    int tid_ = threadIdx.x; asm volatile("" : "+v"(tid_)); const int tid = tid_, lane = tid & 63, wave = __builtin_amdgcn_readfirstlane(tid >> 6), fr = lane & 15, fq = lane >> 4;
    const int rb = u >> 4, cg = u & 15;
    constexpr int KW = K / 8, NS = KW / 32; static_assert(KW % 32 == 0, "K split");
    const bf16* ap = A + (size_t)(MP + 16 * rb + fr) * K + wave * KW + 8 * fq;
    const bf16* bp = Bt + (size_t)(64 * cg + fr) * K + wave * KW + 8 * fq;
    f32x4 acc[4];
#pragma unroll
    for (int n = 0; n < 4; ++n) acc[n] = (f32x4){0.f, 0.f, 0.f, 0.f};
#pragma unroll 4
    for (int s = 0; s < NS; ++s) { const bf16x8 a = *(const bf16x8*)(ap + 32 * s);
#pragma unroll
        for (int n = 0; n < 4; ++n) acc[n] = __builtin_amdgcn_mfma_f32_16x16x32_bf16(a, *(const bf16x8*)(bp + (size_t)16 * n * K + 32 * s), acc[n], 0, 0, 0); }
    LAS float* P = lds + wave * 1024;
#pragma unroll
    for (int n = 0; n < 4; ++n)
#pragma unroll
        for (int r = 0; r < 4; ++r) P[(4 * fq + r) * 64 + 16 * n + fr] = acc[n][r];
    __syncthreads();
    { const int row = tid >> 5, c2 = (tid & 31) * 2; float a0 = 0.f, a1 = 0.f, b0 = 0.f, b1 = 0.f;
#pragma unroll
      for (int w = 0; w < 8; ++w) { const f32x2 v = *(const LAS f32x2*)(lds + w * 1024 + row * 64 + c2); if (DUAL && w >= 4) { b0 += v[0]; b1 += v[1]; } else { a0 += v[0]; a1 += v[1]; } }
      const f32x2 h = E(MP + 16 * rb + row, 64 * cg + c2, a0, a1, b0, b1);
      if (STAT) { float s = h[0] * h[0] + h[1] * h[1];
#pragma unroll
          for (int o = 1; o < 32; o <<= 1) s += __shfl_xor(s, o);
          if ((tid & 31) == 0) ssq[(size_t)(MP + 16 * rb + row) * 16 + cg] = s; } }
    __syncthreads();
}
struct SkResid { const bf16* R; float alpha; bf16* Hb;
    __device__ __forceinline__ f32x2 operator()(int row, int col, float a0, float a1, float, float) const {
        const unsigned r = *(const unsigned*)(R + (size_t)row * DM + col); const f32x2 h = {bflo(r) + alpha * a0, bfhi(r) + alpha * a1};
        *(unsigned*)(Hb + (size_t)row * DM + col) = pg8::cvt_pk_bf16(h[0], h[1]); return h; } };
struct SkResidX { const float* xs; bf16* Hb;
    __device__ __forceinline__ f32x2 operator()(int row, int col, float a0, float a1, float, float) const {
        const f32x2 r = *(const f32x2*)(xs + (size_t)(row - MP) * DM + col); const f32x2 h = {r[0] + 0.5f * a0, r[1] + 0.5f * a1};
        *(unsigned*)(Hb + (size_t)row * DM + col) = pg8::cvt_pk_bf16(h[0], h[1]); return h; } };
struct SkMerge { const bf16* SGA; const bf16* SGR; bf16* O;
    __device__ __forceinline__ f32x2 operator()(int row, int col, float a0, float a1, float b0, float b1) const {
        const unsigned ga = *(const unsigned*)(SGA + (size_t)row * DM + col), gr = *(const unsigned*)(SGR + (size_t)row * DM + col);
        const f32x2 m = {bflo(ga) * a0 + bflo(gr) * b0, bfhi(ga) * a1 + bfhi(gr) * b1};
        *(unsigned*)(O + (size_t)row * DM + col) = pg8::cvt_pk_bf16(m[0], m[1]); return m; } };
struct SkPlain { bf16* O;
    __device__ __forceinline__ f32x2 operator()(int row, int col, float a0, float a1, float, float) const {
        *(unsigned*)(O + (size_t)row * DM + col) = pg8::cvt_pk_bf16(a0, a1); return (f32x2){a0, a1}; } };
struct SkPle { const bf16* H3; const bf16* PP; const float* ssq3; bf16* H4;
    __device__ __forceinline__ f32x2 operator()(int row, int col, float a0, float a1, float, float) const {
        const float rs = pg8::rstd_of<16>(ssq3, row, 1.0f / DM); const unsigned r = *(const unsigned*)(H3 + (size_t)row * DM + col); const unsigned p = *(const unsigned*)(PP + (size_t)row * DM + col);
        const f32x2 h = {bflo(r) + sigm(a0 * rs) * bflo(p), bfhi(r) + sigm(a1 * rs) * bfhi(p)};
        *(unsigned*)(H4 + (size_t)row * DM + col) = pg8::cvt_pk_bf16(h[0], h[1]); return h; } };
}
namespace dec {
using bf16x2 = __attribute__((ext_vector_type(2))) __bf16;
using u32x4 = __attribute__((ext_vector_type(4))) unsigned;
using f32x4 = __attribute__((ext_vector_type(4))) float;
using f32x2 = __attribute__((ext_vector_type(2))) float;
constexpr int NSPLIT = 16, PPS = NPAGES / NSPLIT;
constexpr int DEC_STEPS = 4 * (PPS / 4), DEC_ITEMS = NSPLIT / 2;
constexpr int HPL = 2, GE = 8;
constexpr int L_QL = 0, L_P = 8 * 128, L_MRG = L_P + 8 * 64 * HPL, MRG_REC = 4 + 128, L_END = L_MRG + 8 * GE * MRG_REC;
static_assert(L_END * 4 <= RING_BYTES, "decode LDS");
__device__ __forceinline__ float dot2(unsigned k, unsigned q, float acc) { return __builtin_amdgcn_fdot2_f32_bf16(__builtin_bit_cast(bf16x2, k), __builtin_bit_cast(bf16x2, q), acc, false); }
__device__ __forceinline__ unsigned cvtpk(float lo, float hi) { return pg8::cvt_pk_bf16(lo, hi); }
template <int CTRL> __device__ __forceinline__ float dpp(float x) { return __builtin_bit_cast(float, __builtin_amdgcn_mov_dpp(__builtin_bit_cast(int, x), CTRL, 0xf, 0xf, true)); }
constexpr int XOR1 = 0xB1, XOR2 = 0x4E, XOR7 = 0x141, XOR8 = 0x128, ROR4 = 0x124;
__device__ __forceinline__ float xrow16_max(float x) {
    auto s = __builtin_amdgcn_permlane16_swap(__float_as_uint(x), __float_as_uint(x), false, false); x = fmaxf(__uint_as_float(s[0]), __uint_as_float(s[1]));
    auto t = __builtin_amdgcn_permlane32_swap(__float_as_uint(x), __float_as_uint(x), false, false); return fmaxf(__uint_as_float(t[0]), __uint_as_float(t[1])); }
__device__ __forceinline__ float xrow16_sum(float x) {
    auto s = __builtin_amdgcn_permlane16_swap(__float_as_uint(x), __float_as_uint(x), false, false); x = __uint_as_float(s[0]) + __uint_as_float(s[1]);
    auto t = __builtin_amdgcn_permlane32_swap(__float_as_uint(x), __float_as_uint(x), false, false); return __uint_as_float(t[0]) + __uint_as_float(t[1]); }

__device__ __forceinline__ void qlat_token(int s, const bf16* QB, const float* wkvb, LAS float* QLs, float* QLATg, bool store) {
    int tid_ = threadIdx.x; asm volatile("" : "+v"(tid_)); const int tid = tid_, lane = tid & 63, h = __builtin_amdgcn_readfirstlane(tid >> 6);
    const bf16* q = QB + (size_t)(MP + s) * 768 + h * QKD;
#pragma unroll
    for (int cc = 0; cc < 2; ++cc) { const int c = lane + 64 * cc; const float* w = wkvb + (size_t)c * 1024 + h * 128; float a = 0.f;
#pragma unroll 4
        for (int d = 0; d < 64; d += 4) { const f32x4 wv = *(const f32x4*)(w + d); a += bf2f(q[d]) * wv[0] + bf2f(q[d + 1]) * wv[1] + bf2f(q[d + 2]) * wv[2] + bf2f(q[d + 3]) * wv[3]; }
        QLs[h * 128 + c] = a; if (store) QLATg[(size_t)s * 1024 + h * 128 + c] = a; }
}

__device__ __forceinline__ void split_unit(int s, int sp, const bf16* QB, const float* cache_ckv, const float* cache_kpe, const int* page_table, float* DPO, float* DML, LAS float* lds) {
    int tid_ = threadIdx.x; asm volatile("" : "+v"(tid_)); const int tid = tid_, lane = tid & 63, wave = __builtin_amdgcn_readfirstlane(tid >> 6), r = lane >> 4, c = lane & 15;
    const LAS float* QL = lds + L_QL;
    u32x4 qpk[GE]; unsigned qpe[GE];
#pragma unroll
    for (int g = 0; g < GE; ++g) { const LAS float* ql = QL + g * 128 + 8 * c; qpk[g] = (u32x4){cvtpk(ql[0], ql[1]), cvtpk(ql[2], ql[3]), cvtpk(ql[4], ql[5]), cvtpk(ql[6], ql[7])};
        qpe[g] = *(const unsigned*)(QB + (size_t)(MP + s) * 768 + g * QKD + 64 + 2 * c); }
    float m[HPL], l[HPL], acc[GE * 8];
#pragma unroll
    for (int j = 0; j < HPL; ++j) { m[j] = -INFINITY; l[j] = 0.f; }
#pragma unroll
    for (int k = 0; k < GE * 8; ++k) acc[k] = 0.f;
    const int ph0 = page_table[s * NPAGES + PPS * sp + wave], ph1 = page_table[s * NPAGES + PPS * sp + wave + 8];
    f32x4 Kn[4][2]; f32x2 Pn[4];
#define DEC_ISSUE(i_) do { const int ph_ = ((i_) >> 3) ? ph1 : ph0; const size_t tok_ = (size_t)ph_ * PAGE + 16 * ((i_) & 7) + r; \
        _Pragma("unroll") for (int t_ = 0; t_ < 4; ++t_) { const float* kp_ = cache_ckv + (tok_ + 4 * t_) * KVL + 8 * c; \
            Kn[t_][0] = __builtin_nontemporal_load((const f32x4*)kp_); Kn[t_][1] = __builtin_nontemporal_load((const f32x4*)(kp_ + 4)); \
            Pn[t_] = __builtin_nontemporal_load((const f32x2*)(cache_kpe + (tok_ + 4 * t_) * RPE + 2 * c)); } } while (0)
    DEC_ISSUE(0);
#pragma nounroll
    for (int i = 0; i < 16; ++i) {
        u32x4 Kc[4]; unsigned Pc[4];
#pragma unroll
        for (int t = 0; t < 4; ++t) {
            Kc[t] = (u32x4){cvtpk(Kn[t][0][0], Kn[t][0][1]), cvtpk(Kn[t][0][2], Kn[t][0][3]), cvtpk(Kn[t][1][0], Kn[t][1][1]), cvtpk(Kn[t][1][2], Kn[t][1][3])}; Pc[t] = cvtpk(Pn[t][0], Pn[t][1]); }
        if (i + 1 < 16) DEC_ISSUE(i + 1);
        float x[4 * GE];
#pragma unroll
        for (int t = 0; t < 4; ++t)
#pragma unroll
            for (int g = 0; g < GE; ++g) { float d = dot2(Pc[t], qpe[g], 0.f);
#pragma unroll
                for (int k = 0; k < 4; ++k) d = dot2(Kc[t][k], qpk[g][k], d);
                x[t * GE + g] = d; }
#define TR_STEP(HALF, CTRL, BIT) _Pragma("unroll") for (int h = 0; h < (HALF); ++h) _Pragma("unroll") for (int j = 0; j < HPL; ++j) { \
        const float lo_ = x[h * HPL + j], hi_ = x[(h + (HALF)) * HPL + j]; const float t1_ = lo_ + dpp<CTRL>(lo_), t2_ = hi_ + dpp<CTRL>(hi_); \
        x[h * HPL + j] = (c & (BIT)) ? t2_ : t1_; }
        TR_STEP(8, XOR8, 8) TR_STEP(4, XOR7, 4) TR_STEP(2, XOR2, 2) TR_STEP(1, XOR1, 1)
#undef TR_STEP
        float p[HPL], alpha[HPL];
#pragma unroll
        for (int j = 0; j < HPL; ++j) { const float sc = x[j];
            float pm = sc; pm = fmaxf(pm, dpp<ROR4>(pm)); pm = fmaxf(pm, dpp<XOR8>(pm)); pm = xrow16_max(pm);
            const float mn = fmaxf(m[j], pm);
            alpha[j] = __builtin_amdgcn_exp2f(m[j] - mn); p[j] = __builtin_amdgcn_exp2f(sc - mn);
            l[j] = fmaf(l[j], alpha[j], p[j]); m[j] = mn; }
#pragma unroll
        for (int q4 = 0; q4 < 4; ++q4)
#pragma unroll
            for (int j = 0; j < HPL; ++j) { const float al = q4 == 0 ? dpp<0x00>(alpha[j]) : q4 == 1 ? dpp<0x55>(alpha[j]) : q4 == 2 ? dpp<0xAA>(alpha[j]) : dpp<0xFF>(alpha[j]);
#pragma unroll
                for (int k = 0; k < 8; ++k) acc[(q4 * HPL + j) * 8 + k] *= al; }
        LAS float* prow = lds + L_P + (wave * 4 + r) * 16 * HPL;
#pragma unroll
        for (int j = 0; j < HPL; ++j) prow[c * HPL + j] = p[j];
        asm volatile("s_waitcnt lgkmcnt(0)" ::: "memory");
#pragma unroll
        for (int t = 0; t < 4; ++t) { float vf[8]; f32x4 pr[2]; pr[0] = *(const LAS f32x4*)(prow + 8 * t); pr[1] = *(const LAS f32x4*)(prow + 8 * t + 4);
#pragma unroll
            for (int k = 0; k < 4; ++k) { vf[2 * k] = bflo(Kc[t][k]); vf[2 * k + 1] = bfhi(Kc[t][k]); }
#pragma unroll
            for (int g = 0; g < GE; ++g) { const float pg_ = pr[g >> 2][g & 3];
#pragma unroll
                for (int k = 0; k < 8; ++k) acc[g * 8 + k] = fmaf(pg_, vf[k], acc[g * 8 + k]); } }
        asm volatile("s_waitcnt lgkmcnt(0)" ::: "memory");
    }
#undef DEC_ISSUE
#pragma unroll
    for (int k = 0; k < GE * 8; ++k) acc[k] = xrow16_sum(acc[k]);
#pragma unroll
    for (int j = 0; j < HPL; ++j) { float t = l[j]; t += dpp<ROR4>(t); t += dpp<XOR8>(t); l[j] = xrow16_sum(t); }
    LAS float* mrg = lds + L_MRG;
    if (r == 0) {
#pragma unroll
        for (int g = 0; g < GE; ++g) { LAS float* rec = mrg + (wave * GE + g) * MRG_REC;
#pragma unroll
            for (int k = 0; k < 8; k += 4) *(LAS f32x4*)(rec + 4 + 8 * c + k) = (f32x4){acc[g * 8 + k], acc[g * 8 + k + 1], acc[g * 8 + k + 2], acc[g * 8 + k + 3]};
            if (c == g / HPL) { rec[0] = m[g % HPL]; rec[1] = l[g % HPL]; } } }
    __syncthreads();
    { const int g = wave, d0 = 2 * lane;
      float M = -INFINITY;
#pragma unroll
      for (int w = 0; w < 8; ++w) M = fmaxf(M, mrg[(w * GE + g) * MRG_REC]);
      float L = 0.f, o0 = 0.f, o1 = 0.f;
#pragma unroll
      for (int w = 0; w < 8; ++w) { const LAS float* rec = mrg + (w * GE + g) * MRG_REC; const float wt = __builtin_amdgcn_exp2f(rec[0] - M);
          L = fmaf(wt, rec[1], L); o0 = fmaf(wt, rec[4 + d0], o0); o1 = fmaf(wt, rec[4 + d0 + 1], o1); }
      const size_t slot = ((size_t)s * NSPLIT + sp) * GE + g;
      *(f32x2*)(DPO + slot * 128 + d0) = (f32x2){o0, o1};
      if (lane == 0) *(f32x2*)(DML + slot * 2) = (f32x2){M, L}; }
    __syncthreads();
}

constexpr int D_BASE = 78848;
constexpr int D4_QL = 0, D4_P = 8 * 128, D4_MRG = D4_P + 4 * 64 * HPL, D4_END = D4_MRG + 4 * GE * MRG_REC;
static_assert(D_BASE + D4_END * 4 <= PH5_BYTES, "decode-half LDS");
__device__ __forceinline__ void qlat_token4(int s, int w4, int lane_, const bf16* QB, const float* wkvb, LAS float* QLs, float* QLATg, bool store) {
    int lane = lane_; asm volatile("" : "+v"(lane));
#pragma unroll
    for (int hh = 0; hh < 2; ++hh) { const int h = w4 + 4 * hh; const bf16* q = QB + (size_t)(MP + s) * 768 + h * QKD;
#pragma unroll
        for (int cc = 0; cc < 2; ++cc) { const int c = lane + 64 * cc; const float* w = wkvb + (size_t)c * 1024 + h * 128; float a = 0.f;
#pragma unroll 4
            for (int d = 0; d < 64; d += 4) { const f32x4 wv = *(const f32x4*)(w + d); a += bf2f(q[d]) * wv[0] + bf2f(q[d + 1]) * wv[1] + bf2f(q[d + 2]) * wv[2] + bf2f(q[d + 3]) * wv[3]; }
            QLs[h * 128 + c] = a; if (store) QLATg[(size_t)s * 1024 + h * 128 + c] = a; } }
}
__device__ __forceinline__ void split_unit4(int s, int sp, int w4, int lane_, const bf16* QB, const float* cache_ckv, const float* cache_kpe, const int* page_table, float* DPO, float* DML, LAS float* lds, volatile LAS unsigned* cnt, unsigned& gen) {
    int lane = lane_; asm volatile("" : "+v"(lane));
    const int r = lane >> 4, c = lane & 15;
    const LAS float* QL = lds + D4_QL;
    u32x4 qpk[GE]; unsigned qpe[GE];
#pragma unroll
    for (int g = 0; g < GE; ++g) { const LAS float* ql = QL + g * 128 + 8 * c; qpk[g] = (u32x4){cvtpk(ql[0], ql[1]), cvtpk(ql[2], ql[3]), cvtpk(ql[4], ql[5]), cvtpk(ql[6], ql[7])};
        qpe[g] = *(const unsigned*)(QB + (size_t)(MP + s) * 768 + g * QKD + 64 + 2 * c); }
    float m[HPL], l[HPL], acc[GE * 8];
#pragma unroll
    for (int j = 0; j < HPL; ++j) { m[j] = -INFINITY; l[j] = 0.f; }
#pragma unroll
    for (int k = 0; k < GE * 8; ++k) acc[k] = 0.f;
    const int* pt = page_table + s * NPAGES + PPS * sp + w4;
    f32x4 Kn[4][2]; f32x2 Pn[4];
#define DEC_ISSUE(i_) do { const int ph_ = pt[4 * ((i_) >> 3)]; const size_t tok_ = (size_t)ph_ * PAGE + 16 * ((i_) & 7) + r; \
        _Pragma("unroll") for (int t_ = 0; t_ < 4; ++t_) { const float* kp_ = cache_ckv + (tok_ + 4 * t_) * KVL + 8 * c; \
            Kn[t_][0] = __builtin_nontemporal_load((const f32x4*)kp_); Kn[t_][1] = __builtin_nontemporal_load((const f32x4*)(kp_ + 4)); \
            Pn[t_] = __builtin_nontemporal_load((const f32x2*)(cache_kpe + (tok_ + 4 * t_) * RPE + 2 * c)); } } while (0)
    DEC_ISSUE(0);
#pragma nounroll
    for (int i = 0; i < 16; ++i) {
        u32x4 Kc[4]; unsigned Pc[4];
#pragma unroll
        for (int t = 0; t < 4; ++t) {
            Kc[t] = (u32x4){cvtpk(Kn[t][0][0], Kn[t][0][1]), cvtpk(Kn[t][0][2], Kn[t][0][3]), cvtpk(Kn[t][1][0], Kn[t][1][1]), cvtpk(Kn[t][1][2], Kn[t][1][3])}; Pc[t] = cvtpk(Pn[t][0], Pn[t][1]); }
        if (i + 1 < 16) DEC_ISSUE(i + 1);
        float x[4 * GE];
#pragma unroll
        for (int t = 0; t < 4; ++t)
#pragma unroll
            for (int g = 0; g < GE; ++g) { float d = dot2(Pc[t], qpe[g], 0.f);
#pragma unroll
                for (int k = 0; k < 4; ++k) d = dot2(Kc[t][k], qpk[g][k], d);
                x[t * GE + g] = d; }
#define TR_STEP(HALF, CTRL, BIT) _Pragma("unroll") for (int h = 0; h < (HALF); ++h) _Pragma("unroll") for (int j = 0; j < HPL; ++j) { \
        const float lo_ = x[h * HPL + j], hi_ = x[(h + (HALF)) * HPL + j]; const float t1_ = lo_ + dpp<CTRL>(lo_), t2_ = hi_ + dpp<CTRL>(hi_); \
        x[h * HPL + j] = (c & (BIT)) ? t2_ : t1_; }
        TR_STEP(8, XOR8, 8) TR_STEP(4, XOR7, 4) TR_STEP(2, XOR2, 2) TR_STEP(1, XOR1, 1)
#undef TR_STEP
        float p[HPL], alpha[HPL];
#pragma unroll
        for (int j = 0; j < HPL; ++j) { const float sc = x[j];
            float pm = sc; pm = fmaxf(pm, dpp<ROR4>(pm)); pm = fmaxf(pm, dpp<XOR8>(pm)); pm = xrow16_max(pm);
            const float mn = fmaxf(m[j], pm);
            alpha[j] = __builtin_amdgcn_exp2f(m[j] - mn); p[j] = __builtin_amdgcn_exp2f(sc - mn);
            l[j] = fmaf(l[j], alpha[j], p[j]); m[j] = mn; }
#pragma unroll
        for (int q4 = 0; q4 < 4; ++q4)
#pragma unroll
            for (int j = 0; j < HPL; ++j) { const float al = q4 == 0 ? dpp<0x00>(alpha[j]) : q4 == 1 ? dpp<0x55>(alpha[j]) : q4 == 2 ? dpp<0xAA>(alpha[j]) : dpp<0xFF>(alpha[j]);
#pragma unroll
                for (int k = 0; k < 8; ++k) acc[(q4 * HPL + j) * 8 + k] *= al; }
        LAS float* prow = lds + D4_P + (w4 * 4 + r) * 16 * HPL;
#pragma unroll
        for (int j = 0; j < HPL; ++j) prow[c * HPL + j] = p[j];
        asm volatile("s_waitcnt lgkmcnt(0)" ::: "memory");
#pragma unroll
        for (int t = 0; t < 4; ++t) { float vf[8]; f32x4 pr[2]; pr[0] = *(const LAS f32x4*)(prow + 8 * t); pr[1] = *(const LAS f32x4*)(prow + 8 * t + 4);
#pragma unroll
            for (int k = 0; k < 4; ++k) { vf[2 * k] = bflo(Kc[t][k]); vf[2 * k + 1] = bfhi(Kc[t][k]); }
#pragma unroll
            for (int g = 0; g < GE; ++g) { const float pg_ = pr[g >> 2][g & 3];
#pragma unroll
                for (int k = 0; k < 8; ++k) acc[g * 8 + k] = fmaf(pg_, vf[k], acc[g * 8 + k]); } }
        asm volatile("s_waitcnt lgkmcnt(0)" ::: "memory");
    }
#undef DEC_ISSUE
#pragma unroll
    for (int k = 0; k < GE * 8; ++k) acc[k] = xrow16_sum(acc[k]);
#pragma unroll
    for (int j = 0; j < HPL; ++j) { float t = l[j]; t += dpp<ROR4>(t); t += dpp<XOR8>(t); l[j] = xrow16_sum(t); }
    LAS float* mrg = lds + D4_MRG;
    if (r == 0) {
#pragma unroll
        for (int g = 0; g < GE; ++g) { LAS float* rec = mrg + (w4 * GE + g) * MRG_REC;
#pragma unroll
            for (int k = 0; k < 8; k += 4) *(LAS f32x4*)(rec + 4 + 8 * c + k) = (f32x4){acc[g * 8 + k], acc[g * 8 + k + 1], acc[g * 8 + k + 2], acc[g * 8 + k + 3]};
            if (c == g / HPL) { rec[0] = m[g % HPL]; rec[1] = l[g % HPL]; } } }
    asm volatile("s_waitcnt lgkmcnt(0)" ::: "memory"); att::bar4(cnt, gen, lane);
#pragma unroll
    for (int hh = 0; hh < 2; ++hh) { const int g = w4 + 4 * hh, d0 = 2 * lane;
      float M = -INFINITY;
#pragma unroll
      for (int w = 0; w < 4; ++w) M = fmaxf(M, mrg[(w * GE + g) * MRG_REC]);
      float L = 0.f, o0 = 0.f, o1 = 0.f;
#pragma unroll
      for (int w = 0; w < 4; ++w) { const LAS float* rec = mrg + (w * GE + g) * MRG_REC; const float wt = __builtin_amdgcn_exp2f(rec[0] - M);
          L = fmaf(wt, rec[1], L); o0 = fmaf(wt, rec[4 + d0], o0); o1 = fmaf(wt, rec[4 + d0 + 1], o1); }
      const size_t slot = ((size_t)s * NSPLIT + sp) * GE + g;
      *(f32x2*)(DPO + slot * 128 + d0) = (f32x2){o0, o1};
      if (lane == 0) *(f32x2*)(DML + slot * 2) = (f32x2){M, L}; }
    asm volatile("s_waitcnt lgkmcnt(0)" ::: "memory"); att::bar4(cnt, gen, lane);
}

using bf16x8 = __attribute__((ext_vector_type(8))) short;
typedef short dv4i16_t __attribute__((ext_vector_type(4)));
constexpr int VP = 272, VTILE = 32 * VP;
constexpr int M4_QL = 0, M4_VT = 4096, M4_END = M4_VT + 4 * VTILE;
static_assert(2 * D_BASE <= PH5_BYTES && M4_END <= D_BASE && 8 * MRG_REC * 4 <= VTILE, "P5 LDS (MFMA form)");
__device__ __forceinline__ bf16x8 pk8(f32x4 a, f32x4 b) { const u32x4 w = {pg8::cvt_pk_bf16(a[0], a[1]), pg8::cvt_pk_bf16(a[2], a[3]), pg8::cvt_pk_bf16(b[0], b[1]), pg8::cvt_pk_bf16(b[2], b[3])}; return __builtin_bit_cast(bf16x8, w); }
__device__ __forceinline__ void split_unit4m(int s, int sp, int w4, int lane_, const bf16* QB, const float* cache_ckv, const float* cache_kpe, const int* page_table, float* DPO, float* DML, LAS unsigned char* tl, volatile LAS unsigned* cnt, unsigned& gen) {
    int lane = lane_; asm volatile("" : "+v"(lane));
    const int t16 = lane & 15, kg = lane >> 4;
    const LAS float* QL = (const LAS float*)(tl + M4_QL);
    LAS unsigned char* vt = tl + M4_VT + w4 * VTILE;
    bf16x8 qf[5];
    if (t16 < 8) {
#pragma unroll
        for (int ks = 0; ks < 4; ++ks) { const LAS float* q = QL + t16 * 128 + 64 * (ks >> 1) + 32 * (ks & 1) + 4 * kg; qf[ks] = pk8(*(const LAS f32x4*)q, *(const LAS f32x4*)(q + 16)); }
        { const bf16* qp = QB + (size_t)(MP + s) * 768 + t16 * QKD + 64 + 4 * kg; const v2u a = *(const v2u*)qp, b = *(const v2u*)(qp + 16); const u32x4 w = {a.x, a.y, b.x, b.y}; qf[4] = __builtin_bit_cast(bf16x8, w); }
    } else {
#pragma unroll
        for (int ks = 0; ks < 5; ++ks) qf[ks] = (bf16x8){0, 0, 0, 0, 0, 0, 0, 0};
    }
    float m = -INFINITY, l = 0.f; f32x4 O[8];
#pragma unroll
    for (int c = 0; c < 8; ++c) O[c] = (f32x4){0.f, 0.f, 0.f, 0.f};
    const int* pt = page_table + s * NPAGES + PPS * sp + w4;
    const int ph0 = __builtin_amdgcn_readfirstlane(pt[0]), ph1 = __builtin_amdgcn_readfirstlane(pt[PPS >= 8 ? 4 : 0]), ph2 = __builtin_amdgcn_readfirstlane(pt[PPS >= 16 ? 8 : 0]), ph3 = __builtin_amdgcn_readfirstlane(pt[PPS >= 16 ? 12 : 0]);
    f32x4 Cn[2][2][4], Pn[2][2];
#define DEC_ISSUE(i_) do { const int pg_ = (i_) >> 2; const int ph_ = pg_ == 0 ? ph0 : pg_ == 1 ? ph1 : pg_ == 2 ? ph2 : ph3; const size_t tok_ = (size_t)ph_ * PAGE + 32 * ((i_) & 3) + t16; \
        _Pragma("unroll") for (int g_ = 0; g_ < 2; ++g_) { const float* cp_ = cache_ckv + (tok_ + 16 * g_) * KVL + 4 * kg; const float* pp_ = cache_kpe + (tok_ + 16 * g_) * RPE + 4 * kg; \
            _Pragma("unroll") for (int b_ = 0; b_ < 2; ++b_) _Pragma("unroll") for (int j_ = 0; j_ < 4; ++j_) Cn[g_][b_][j_] = __builtin_nontemporal_load((const f32x4*)(cp_ + 64 * b_ + 16 * j_)); \
            Pn[g_][0] = __builtin_nontemporal_load((const f32x4*)pp_); Pn[g_][1] = __builtin_nontemporal_load((const f32x4*)(pp_ + 16)); } } while (0)
    DEC_ISSUE(0);
#pragma nounroll
    for (int i = 0; i < DEC_STEPS; ++i) {
        bf16x8 kf[2][5];
#pragma unroll
        for (int g = 0; g < 2; ++g) {
#pragma unroll
            for (int b = 0; b < 2; ++b) { kf[g][2 * b] = pk8(Cn[g][b][0], Cn[g][b][1]); kf[g][2 * b + 1] = pk8(Cn[g][b][2], Cn[g][b][3]); }
            kf[g][4] = pk8(Pn[g][0], Pn[g][1]); }
        if (i + 1 < DEC_STEPS) DEC_ISSUE(i + 1);
#pragma unroll
        for (int g = 0; g < 2; ++g)
#pragma unroll
            for (int ks = 0; ks < 4; ++ks) { const u32x4 w = __builtin_bit_cast(u32x4, kf[g][ks]); LAS unsigned char* d = vt + (16 * g + t16) * VP + 128 * (ks >> 1) + 64 * (ks & 1) + 8 * kg;
                *(LAS v2u*)d = (v2u){w[0], w[1]}; *(LAS v2u*)(d + 32) = (v2u){w[2], w[3]}; }
        f32x4 S[2];
#pragma unroll
        for (int g = 0; g < 2; ++g) { S[g] = (f32x4){0.f, 0.f, 0.f, 0.f};
#pragma unroll
            for (int ks = 0; ks < 5; ++ks) S[g] = __builtin_amdgcn_mfma_f32_16x16x32_bf16(kf[g][ks], qf[ks], S[g], 0, 0, 0); }
        float pm = fmaxf(fmaxf(fmaxf(S[0][0], S[0][1]), fmaxf(S[0][2], S[0][3])), fmaxf(fmaxf(S[1][0], S[1][1]), fmaxf(S[1][2], S[1][3])));
        pm = xrow16_max(pm);
        const float mn = (pm > m + 8.0f) ? pm : m;
        if (__any(mn > m)) {
            const float alpha = __builtin_amdgcn_exp2f(m - mn); l *= alpha; m = mn;
            float a4[4];
#pragma unroll
            for (int r = 0; r < 4; ++r) a4[r] = __shfl(alpha, 4 * kg + r);
#pragma unroll
            for (int c = 0; c < 8; ++c)
#pragma unroll
                for (int r = 0; r < 4; ++r) O[c][r] *= a4[r];
        }
        f32x4 p0, p1;
#pragma unroll
        for (int r = 0; r < 4; ++r) { p0[r] = __builtin_amdgcn_exp2f(S[0][r] - m); p1[r] = __builtin_amdgcn_exp2f(S[1][r] - m); }
        l += ((p0[0] + p0[1]) + (p0[2] + p0[3])) + ((p1[0] + p1[1]) + (p1[2] + p1[3]));
        const bf16x8 pa = pk8(p0, p1);
        const LAS unsigned char* vr = vt + (4 * kg + (t16 >> 2)) * VP + (t16 & 3) * 8;
#pragma unroll
        for (int c = 0; c < 8; ++c) {
            const dv4i16_t lo = __builtin_amdgcn_ds_read_tr16_b64_v4i16((LAS dv4i16_t*)(vr + 32 * c));
            const dv4i16_t hi = __builtin_amdgcn_ds_read_tr16_b64_v4i16((LAS dv4i16_t*)(vr + 16 * VP + 32 * c));
            const bf16x8 vb = {lo[0], lo[1], lo[2], lo[3], hi[0], hi[1], hi[2], hi[3]};
            O[c] = __builtin_amdgcn_mfma_f32_16x16x32_bf16(pa, vb, O[c], 0, 0, 0); }
    }
#undef DEC_ISSUE
    l = xrow16_sum(l);
    asm volatile("s_waitcnt lgkmcnt(0)" ::: "memory");
    LAS float* rec0 = (LAS float*)vt;
    if (kg < 2) {
#pragma unroll
        for (int c = 0; c < 8; ++c)
#pragma unroll
            for (int r = 0; r < 4; ++r) rec0[(4 * kg + r) * MRG_REC + 4 + 16 * c + t16] = O[c][r]; }
    if (kg == 0 && t16 < 8) { rec0[t16 * MRG_REC] = m; rec0[t16 * MRG_REC + 1] = l; }
    asm volatile("s_waitcnt lgkmcnt(0)" ::: "memory"); att::bar4(cnt, gen, lane);
#pragma unroll
    for (int hh = 0; hh < 2; ++hh) { const int g = w4 + 4 * hh, d0 = 2 * lane;
      float M = -INFINITY;
#pragma unroll
      for (int w = 0; w < 4; ++w) M = fmaxf(M, ((const LAS float*)(tl + M4_VT + w * VTILE))[g * MRG_REC]);
      float L = 0.f, o0 = 0.f, o1 = 0.f;
#pragma unroll
      for (int w = 0; w < 4; ++w) { const LAS float* rec = (const LAS float*)(tl + M4_VT + w * VTILE) + g * MRG_REC; const float wt = __builtin_amdgcn_exp2f(rec[0] - M);
          L = fmaf(wt, rec[1], L); o0 = fmaf(wt, rec[4 + d0], o0); o1 = fmaf(wt, rec[4 + d0 + 1], o1); }
      const size_t slot = ((size_t)s * NSPLIT + sp) * GE + g;
      *(f32x2*)(DPO + slot * 128 + d0) = (f32x2){o0, o1};
      if (lane == 0) *(f32x2*)(DML + slot * 2) = (f32x2){M, L}; }
    asm volatile("s_waitcnt lgkmcnt(0)" ::: "memory"); att::bar4(cnt, gen, lane);
}

__device__ __forceinline__ void combine_unit(int s, const bf16* QB, const float* QLATg, const float* DPO, const float* DML, const float* dout, const float* wkvb, bf16* OCAT, LAS float* lds) {
    int tid_ = threadIdx.x; asm volatile("" : "+v"(tid_)); const int tid = tid_, lane = tid & 63, g = __builtin_amdgcn_readfirstlane(tid >> 6), d0 = 2 * lane;
    const float* ck = dout + O_CKVS + (size_t)s * KVL; const float* kp = dout + O_KPES + (size_t)s * RPE;
    const f32x2 ckv = *(const f32x2*)(ck + d0); const f32x2 ql = *(const f32x2*)(QLATg + (size_t)s * 1024 + g * 128 + d0);
    float part = ql[0] * ckv[0] + ql[1] * ckv[1];
    if (lane < 16) { const unsigned qp = *(const unsigned*)(QB + (size_t)(MP + s) * 768 + g * QKD + 64 + d0); part += bflo(qp) * kp[d0] + bfhi(qp) * kp[d0 + 1]; }
    const float sself = wave_sum(part);
    float M = sself;
#pragma unroll
    for (int sp = 0; sp < NSPLIT; ++sp) M = fmaxf(M, DML[(((size_t)s * NSPLIT + sp) * GE + g) * 2]);
    float L = __builtin_amdgcn_exp2f(sself - M), o0 = L * ckv[0], o1 = L * ckv[1];
#pragma unroll
    for (int sp = 0; sp < NSPLIT; ++sp) { const size_t slot = ((size_t)s * NSPLIT + sp) * GE + g; const float wt = __builtin_amdgcn_exp2f(DML[slot * 2] - M);
        const f32x2 po = *(const f32x2*)(DPO + slot * 128 + d0); L = fmaf(wt, DML[slot * 2 + 1], L); o0 = fmaf(wt, po[0], o0); o1 = fmaf(wt, po[1], o1); }
    const float inv = 1.0f / L;
    LAS float* ol = lds + g * 128;
    ol[d0] = o0 * inv; ol[d0 + 1] = o1 * inv;
    asm volatile("s_waitcnt lgkmcnt(0)" ::: "memory");
    float a = 0.f;
#pragma unroll 8
    for (int cc = 0; cc < 128; ++cc) a = fmaf(ol[cc], wkvb[(size_t)cc * 1024 + g * 128 + 64 + lane], a);
    OCAT[(size_t)(MP + s) * DM + g * 64 + lane] = (bf16)f2bf(a);
    __syncthreads();
}
}
#define XB_TMO      128
#define XB_XCNT(j)  (256  + 64 * (j))
#define XB_XSUB(j)  (1280 + 64 * (j))
#define XB_XGEN(j)  (2304 + 64 * (j))
#define XB_TOP      3328
#define XB_TOPGEN   3392
#define XCD_BAR_WORDS 3456
#define XB_SPIN_CAP (1u << 18)

__device__ __forceinline__ unsigned xb_ld(unsigned* p)              { return __hip_atomic_load(p, __ATOMIC_RELAXED, __HIP_MEMORY_SCOPE_AGENT); }
__device__ __forceinline__ unsigned xb_add(unsigned* p, unsigned v) { return __hip_atomic_fetch_add(p, v, __ATOMIC_RELAXED, __HIP_MEMORY_SCOPE_AGENT); }
__device__ __forceinline__ unsigned xb_xcc_id() { return (unsigned)__builtin_amdgcn_s_getreg((3 << 11) | 20) & 0xFu; }
#define XB_SPIN(cond, bar) do { unsigned _sp = 0; while (cond) { __builtin_amdgcn_s_sleep(1); \
    if ((++_sp & 255u) == 0u) { if (xb_ld(&(bar)[XB_TMO])) break; if (_sp > XB_SPIN_CAP) { atomicAdd(&(bar)[XB_TMO], 1u); break; } } } } while (0)

struct XcdBarrier {
    unsigned* bar; unsigned x;
    volatile LAS unsigned* st;
};

__device__ __forceinline__ XcdBarrier xcd_barrier_post(unsigned* bar, volatile LAS unsigned* st) {
    XcdBarrier b; b.bar = bar; b.x = xb_xcc_id(); b.st = st;
    if (threadIdx.x == 0) (void)xb_add(&bar[XB_XCNT(b.x)], 1u);
    return b;
}
__device__ __forceinline__ void xcd_barrier_complete(unsigned* bar, unsigned x, unsigned& nloc, unsigned& nx) {
    const unsigned G = gridDim.x * gridDim.y * gridDim.z;
    unsigned sum, cnt, mine, sp = 0u;
    for (;;) {
        sum = 0u; cnt = 0u; mine = 0u;
#pragma unroll
        for (unsigned j = 0; j < 16; ++j) { const unsigned c = xb_ld(&bar[XB_XCNT(j)]); sum += c; cnt += (c > 0u) ? 1u : 0u; mine = (j == x) ? c : mine; }
        if (sum == G) break;
        __builtin_amdgcn_s_sleep(1);
        if ((++sp & 255u) == 0u) { if (xb_ld(&bar[XB_TMO])) break; if (sp > XB_SPIN_CAP) { atomicAdd(&bar[XB_TMO], 1u); break; } }
    }
    nloc = mine > 0u ? mine : 1u; nx = cnt > 0u ? cnt : 1u;
}

__device__ __forceinline__ void xcd_barrier(const XcdBarrier& b) {
    asm volatile("s_waitcnt vmcnt(0)" ::: "memory");
    __syncthreads();
    if (threadIdx.x == 0) {
        unsigned* bar = b.bar;
        __builtin_amdgcn_s_waitcnt(0);
        unsigned nloc = b.st[0], nx = b.st[1];
        if (nloc == 0u) { xcd_barrier_complete(bar, b.x, nloc, nx); b.st[0] = nloc; b.st[1] = nx; }
        const unsigned old = xb_add(&bar[XB_XSUB(b.x)], 1u);
        const unsigned gen = old / nloc;
        if (old + 1u == (gen + 1u) * nloc) {
            __builtin_amdgcn_fence(__ATOMIC_RELEASE, "agent");
            asm volatile("s_waitcnt vmcnt(0)" ::: "memory");
            const unsigned og = xb_add(&bar[XB_TOP], 1u);
            const unsigned tg = og / nx;
            if (og + 1u == (tg + 1u) * nx) xb_add(&bar[XB_TOPGEN], 1u);
            else XB_SPIN(xb_ld(&bar[XB_TOPGEN]) == tg, bar);
            __builtin_amdgcn_fence(__ATOMIC_ACQUIRE, "agent");
            xb_add(&bar[XB_XGEN(b.x)], 1u);
            asm volatile("s_waitcnt vmcnt(0)" ::: "memory");
        } else {
            XB_SPIN(xb_ld(&bar[XB_XGEN(b.x)]) == gen, bar);
            __builtin_amdgcn_fence(__ATOMIC_ACQUIRE, "agent");
            asm volatile("s_waitcnt vmcnt(0)" ::: "memory");
        }
    }
    __syncthreads();
}
constexpr int NWAVES = 8, NPHASE = 13;
struct Args {
    const float *x_prompt, *x_sample, *cache_ckv, *cache_kpe, *state_ret; const int* page_table; const float *p_prompt, *p_sample;
    const float *ffn1_norm, *ffn1_w_gate, *ffn1_w_up, *ffn1_w_down, *mix_norm, *w_in, *q_a_norm, *w_q_b, *kv_a_norm, *w_kv_b, *ret_norm, *w_branch_att, *w_branch_ret, *w_out;
    const float *ffn2_norm, *ffn2_w_gate, *ffn2_w_up, *ffn2_w_down, *ple_norm, *w_ple_gate, *w_ple_proj, *final_norm;
    float* out; unsigned char* ws; int ph_lo, ph_hi;
};
static_assert(sizeof(Args) == 32 * 8 + 8, "Args has no padding holes");

enum { RM_ID = 0, RM_GATE, RM_UP, RM_WIN, RM_QB, RM_KVB };
__device__ __forceinline__ int rowmap(int kind, int n) {
    switch (kind) {
    case RM_GATE: return (n >> 7) * 256 + (n & 127);
    case RM_UP:   return (n >> 7) * 256 + 128 + (n & 127);
    case RM_WIN: {
        if (n < 384) return n;
        if (n < 416) { const int j = n - 384, jj = j & 15; return 384 + 8 * (jj >> 2) + 4 * (j >> 4) + (jj & 3); }
        if (n < 1440) { const bool isk = n >= 928; const int j = n - (isk ? 928 : 416), hh = j >> 7, d = j & 127, i = d & 63, n_ = d >> 6;
            return (isk ? 1024 : 512) + hh * 128 + 32 * (i >> 4) + 8 * ((i >> 2) & 3) + 4 * n_ + (i & 3); }
        if (n < 1952) return 1536 + (n - 1440);
        if (n < 2464) return 2048 + (n - 1952);
        if (n < 3488) return 2560 + (n - 2464);
        return 3584 + (n - 3488); }
    case RM_QB: { const int hh = n / 96, d = n % 96; if (d < 64) return hh * 64 + d; const int j = d - 64, jj = j & 15; return 512 + hh * 32 + 8 * (jj >> 2) + 4 * (j >> 4) + (jj & 3); }
    case RM_KVB: { const int hh = n >> 7, d = n & 127; return d < 64 ? hh * 64 + d : 512 + hh * 64 + (d - 64); }
    default: return n; }
}
__device__ __forceinline__ void tr_item2(const float* W, int N, bf16* WT, int Kd, int koff, const float* gain, float scale, int kind, LAS float* scr, int item, int lane) {
    const int nblk = N / 32, kb = item / nblk, nb = item % nblk, k0 = 128 * kb, n0 = 32 * nb, kr = lane >> 3, n4 = (lane & 7) * 4, c = lane & 7;
    pg8::f32x4 v[16];
#pragma unroll
    for (int i = 0; i < 16; ++i) v[i] = *(const pg8::f32x4*)(W + (size_t)(k0 + 8 * i + kr) * N + n0 + n4);
#pragma unroll
    for (int h = 0; h < 2; ++h) {
#pragma unroll
        for (int i = 0; i < 8; ++i) { const int kk = 8 * i + kr; const float g = gain ? gain[k0 + 64 * h + kk] * scale : scale; LAS float* d = scr + kk * 33 + n4;
            d[0] = v[8 * h + i][0] * g; d[1] = v[8 * h + i][1] * g; d[2] = v[8 * h + i][2] * g; d[3] = v[8 * h + i][3] * g; }
        LDS_WAIT(); asm volatile("" ::: "memory");
#pragma unroll
        for (int q = 0; q < 4; ++q) { const int n = (lane >> 3) + 8 * q; const LAS float* s = scr + (8 * c) * 33 + n;
            v4u o; o.x = pk2(s[0 * 33], s[1 * 33]); o.y = pk2(s[2 * 33], s[3 * 33]); o.z = pk2(s[4 * 33], s[5 * 33]); o.w = pk2(s[6 * 33], s[7 * 33]);
            *(GAS v4u*)(WT + (size_t)rowmap(kind, n0 + n) * Kd + koff + k0 + 64 * h + 8 * c) = o; }
        LDS_WAIT(); asm volatile("" ::: "memory"); }
}
__device__ __forceinline__ void sincos_d(double a, float& c, float& s) {
    const double k = __builtin_rint(a * 0.63661977236758134308);
    double r = __builtin_fma(-k, 1.5707963267948966, a); r = __builtin_fma(-k, 6.123233995736766e-17, r);
    const double r2 = r * r;
    const double sp = r * (1.0 + r2 * (-1.0 / 6 + r2 * (1.0 / 120 + r2 * (-1.0 / 5040 + r2 * (1.0 / 362880 + r2 * (-1.0 / 39916800 + r2 * (1.0 / 6227020800.0)))))));
    const double cp = 1.0 + r2 * (-0.5 + r2 * (1.0 / 24 + r2 * (-1.0 / 720 + r2 * (1.0 / 40320 + r2 * (-1.0 / 3628800 + r2 * (1.0 / 479001600.0 + r2 * (-1.0 / 87178291200.0)))))));
    const int q = (int)((long long)k & 3);
    const double cc = q == 0 ? cp : q == 1 ? -sp : q == 2 ? -cp : sp, ss = q == 0 ? sp : q == 1 ? cp : q == 2 ? -sp : -cp;
    c = (float)cc; s = (float)ss;
}

__device__ __forceinline__ int fresh_tid() { int t = threadIdx.x; asm volatile("" : "+v"(t)); return t; }
#define FTID fresh_tid()
#define FLANE (fresh_tid() & 63)
#define FWAVE __builtin_amdgcn_readfirstlane(fresh_tid() >> 6)
struct Frame {
    LAS unsigned char* lds; volatile LAS unsigned* MISC; gu32* ctl; int G, bid;
};

__device__ __forceinline__ void p0_prologue(const Args& a, Frame& F) {
    unsigned char* ws = a.ws;
    LAS float* scr = (LAS float*)(F.lds + FWAVE * 16384);
    const int gw = F.bid * NWAVES + FWAVE, NGW = F.G * NWAVES;
    constexpr int I_FF = 8 * 88, I_DN = 22 * 32, I_IN = 8 * 141, I_QB = 2 * 24, I_KVB = 1 * 32, I_BR = 4 * 32, I_SQ = 8 * 32, I_PP = 2 * 32;
    constexpr int NITEMS = 4 * I_FF + 2 * I_DN + I_IN + I_QB + I_KVB + 2 * I_BR + 2 * I_SQ + I_PP;
#ifndef REP_P0A
#define REP_P0A 1
#define REP_P0B 1
#endif
    for (int rpa_ = 0; rpa_ < REP_P0A; ++rpa_)
    for (int it = gw; it < NITEMS; it += NGW) {
        int r = it;
        if (r < I_FF) { tr_item2(a.ffn1_w_gate, DFF, (bf16*)(ws + WS_WGU1), DM, 0, nullptr, 1.f, RM_GATE, scr, r, FLANE); continue; } r -= I_FF;
        if (r < I_FF) { tr_item2(a.ffn1_w_up, DFF, (bf16*)(ws + WS_WGU1), DM, 0, nullptr, 1.f, RM_UP, scr, r, FLANE); continue; } r -= I_FF;
        if (r < I_FF) { tr_item2(a.ffn2_w_gate, DFF, (bf16*)(ws + WS_WGU2), DM, 0, a.ffn2_norm, 1.f, RM_GATE, scr, r, FLANE); continue; } r -= I_FF;
        if (r < I_FF) { tr_item2(a.ffn2_w_up, DFF, (bf16*)(ws + WS_WGU2), DM, 0, a.ffn2_norm, 1.f, RM_UP, scr, r, FLANE); continue; } r -= I_FF;
        if (r < I_DN) { tr_item2(a.ffn1_w_down, DM, (bf16*)(ws + WS_WD1), DFF, 0, nullptr, 1.f, RM_ID, scr, r, FLANE); continue; } r -= I_DN;
        if (r < I_DN) { tr_item2(a.ffn2_w_down, DM, (bf16*)(ws + WS_WD2), DFF, 0, nullptr, 1.f, RM_ID, scr, r, FLANE); continue; } r -= I_DN;
        if (r < I_IN) { tr_item2(a.w_in, 4512, (bf16*)(ws + WS_WIN), DM, 0, a.mix_norm, 1.f, RM_WIN, scr, r, FLANE); continue; } r -= I_IN;
        if (r < I_QB) { tr_item2(a.w_q_b, 768, (bf16*)(ws + WS_WQB), QL, 0, a.q_a_norm, C2, RM_QB, scr, r, FLANE); continue; } r -= I_QB;
        if (r < I_KVB) { tr_item2(a.w_kv_b, 1024, (bf16*)(ws + WS_WKVB), KVL, 0, a.kv_a_norm, 1.f, RM_KVB, scr, r, FLANE); continue; } r -= I_KVB;
        if (r < I_BR) { tr_item2(a.w_branch_att, DM, (bf16*)(ws + WS_WBC), DM, 0, nullptr, 1.f, RM_ID, scr, r, FLANE); continue; } r -= I_BR;
        if (r < I_BR) { tr_item2(a.w_branch_ret, DM, (bf16*)(ws + WS_WBC), DM, 512, nullptr, 1.f, RM_ID, scr, r, FLANE); continue; } r -= I_BR;
        if (r < I_SQ) { tr_item2(a.w_out, DM, (bf16*)(ws + WS_WOUT), DM, 0, nullptr, 1.f, RM_ID, scr, r, FLANE); continue; } r -= I_SQ;
        if (r < I_SQ) { tr_item2(a.w_ple_gate, DM, (bf16*)(ws + WS_WPG), DM, 0, a.ple_norm, 1.f, RM_ID, scr, r, FLANE); continue; } r -= I_SQ;
        tr_item2(a.w_ple_proj, DM, (bf16*)(ws + WS_WPP), PLE, 0, nullptr, 1.f, RM_ID, scr, r, FLANE);
    }
    const int gt = F.bid * (NWAVES * 64) + FTID, NGT = F.G * NWAVES * 64;
    for (int i = gt; i < 96 * 128; i += NGT) *(v4u*)((bf16*)(ws + WS_WIN) + (size_t)416 * DM + (size_t)i * 8) = (v4u){0u, 0u, 0u, 0u};
    for (int i = gt; i < 8193 * 64; i += NGT) { const int pi = i >> 6, fi = i & 63; double inv = 1.0; for (int k = 0; k < fi; ++k) inv *= 0.8659643233600653;
        float c, s; sincos_d((double)(pi == 8192 ? 16384 : pi) * inv, c, s); ((float2*)(ws + WS_ROPE))[i] = make_float2(c, s); }
    for (int rpb_ = 0; rpb_ < REP_P0B; ++rpb_)
    for (int m = gw; m < MT; m += NGW) {
        bf16* orow = (bf16*)(ws + WS_XN1) + (size_t)m * DM; bf16* prow = (bf16*)(ws + WS_PB) + (size_t)m * PLE;
        if (m >= MP + MS) {
#pragma unroll
            for (int j = 0; j < 4; ++j) ((unsigned long long*)orow)[FLANE + 64 * j] = 0ull;
            ((unsigned long long*)prow)[FLANE] = 0ull; continue; }
        const float* xrow = m < MP ? a.x_prompt + (size_t)m * DM : a.x_sample + (size_t)(m - MP) * DM;
        const float* pr = m < MP ? a.p_prompt + (size_t)m * PLE : a.p_sample + (size_t)(m - MP) * PLE;
        const int ln = FLANE; pg8::f32x4 v[4]; float s = 0.f;
#pragma unroll
        for (int j = 0; j < 4; ++j) { v[j] = *(const pg8::f32x4*)(xrow + 512 * (j >> 1) + 8 * ln + 4 * (j & 1)); s += (v[j].x * v[j].x + v[j].y * v[j].y) + (v[j].z * v[j].z + v[j].w * v[j].w); }
        const float rstd = 1.0f / sqrtf(wave_sum(s) * (1.f / DM) + EPS);
#pragma unroll
        for (int h = 0; h < 2; ++h) { const pg8::f32x4 g0 = *(const pg8::f32x4*)(a.ffn1_norm + 512 * h + 8 * ln), g1 = *(const pg8::f32x4*)(a.ffn1_norm + 512 * h + 8 * ln + 4);
            const pg8::f32x4 a0 = v[2 * h] * rstd * g0, a1 = v[2 * h + 1] * rstd * g1;
            *(v4u*)(orow + 512 * h + 8 * ln) = (v4u){pk2(a0.x, a0.y), pk2(a0.z, a0.w), pk2(a1.x, a1.y), pk2(a1.z, a1.w)}; }
        const pg8::f32x4 pv = ((const pg8::f32x4*)pr)[FLANE];
        ((unsigned long long*)prow)[FLANE] = (unsigned long long)pk2(pv.x, pv.y) | ((unsigned long long)pk2(pv.z, pv.w) << 32);
    }
}

__global__ void __launch_bounds__(NWAVES * 64, 2) mk_fwd(Args args) {
    extern __shared__ __attribute__((aligned(16))) unsigned char lds[];
    Frame F;
    F.lds = (LAS unsigned char*)lds; F.MISC = (volatile LAS unsigned*)(F.lds + MISC_OFF);
    F.G = gridDim.x; F.bid = blockIdx.x;
    unsigned char* ws = args.ws;
    F.ctl = (gu32*)(ws + WS_CTL);
    for (int u = FTID; u < (LDS_BYTES - LDSCTL_OFF) / 4; u += NWAVES * 64) ((LAS unsigned*)(F.lds + LDSCTL_OFF))[u] = 0u;
    __syncthreads();
    XcdBarrier bar; bar.bar = (unsigned*)(ws + WS_CTL) + CW_BAR; bar.x = 0; bar.st = nullptr;
    if (!MK_PER_PHASE) bar = xcd_barrier_post((unsigned*)(ws + WS_CTL) + CW_BAR, F.MISC + 8);
    const int lo = args.ph_lo, hi = args.ph_hi;
#ifndef PHASE_MASK
#define PHASE_MASK 0xFFFF
#endif
#define IN(k) (((PHASE_MASK >> (k)) & 1) && lo <= (k) && (k) < hi)
#ifndef REP_PHASE
#define REP_PHASE -1
#endif
#define REPK(k) ((k) == REP_PHASE ? 2 : 1)
#ifdef PROBE_PH
    unsigned long long tprev_ = __builtin_amdgcn_s_memrealtime();
#define PROBE_SEAM(k) do { const unsigned long long tn_ = __builtin_amdgcn_s_memrealtime(); if ((k) == PROBE_PH && F.bid == 0 && FTID == 0) ((volatile unsigned*)(ws + WS_CTL))[2] = (unsigned)(tn_ - tprev_); tprev_ = tn_; } while (0)
#else
#define PROBE_SEAM(k) do {} while (0)
#endif
#define SEAM(k) do { if (IN(k) && IN((k) + 1)) { if (MK_PER_PHASE) { if (FTID == 0) __hip_atomic_store(F.ctl + CW_TMO, 0xBADBA0u, RLX_AGENT); } else xcd_barrier(bar); } PROBE_SEAM(k); } while (0)
    float* ssq_h1 = (float*)(ws + WS_SSQ); float* ssq_h2 = (float*)(ws + WS_SSQ + SSQ16_BYTES); float* ssq_h3 = (float*)(ws + WS_SSQ + 2 * SSQ16_BYTES); float* ssq_h4 = (float*)(ws + WS_SSQ + 3 * SSQ16_BYTES);
    float* ssq_cq = (float*)(ws + WS_SSQ + 4 * SSQ16_BYTES); float* ssq_kv = (float*)(ws + WS_SSQ + 4 * SSQ16_BYTES + SSQ4_BYTES);
    const float2* rope = (const float2*)(ws + WS_ROPE);
    bf16 *XN1 = (bf16*)(ws + WS_XN1), *ACT = (bf16*)(ws + WS_ACT), *H1B = (bf16*)(ws + WS_H1B), *CQB = (bf16*)(ws + WS_CQB), *CKVB = (bf16*)(ws + WS_CKVB), *KPEB = (bf16*)(ws + WS_KPEB);
    bf16 *QR = (bf16*)(ws + WS_QR), *KR = (bf16*)(ws + WS_KR), *RV = (bf16*)(ws + WS_RV), *RGS = (bf16*)(ws + WS_RGS), *SGA = (bf16*)(ws + WS_SGA), *SGR = (bf16*)(ws + WS_SGR);
    bf16 *QB = (bf16*)(ws + WS_QB), *KN = (bf16*)(ws + WS_KN), *VB = (bf16*)(ws + WS_VB), *OCAT = (bf16*)(ws + WS_OCAT), *SC = (bf16*)(ws + WS_SC), *MRG = (bf16*)(ws + WS_MRG);
    bf16 *H2B = (bf16*)(ws + WS_H2B), *H3B = (bf16*)(ws + WS_H3B), *PB = (bf16*)(ws + WS_PB), *PP = (bf16*)(ws + WS_PP);
    bf16* H4B = (bf16*)(ws + WS_H4); float *CKVF = (float*)(ws + WS_CKVF), *KVC = (float*)(ws + WS_KVC);
    float *DPO = (float*)(ws + WS_DPO), *DML = (float*)(ws + WS_DML), *QLAT = (float*)(ws + WS_QLAT);
    const int NGT = F.G * NWAVES * 64, NGW = F.G * NWAVES;

    for (int rp_ = 0; rp_ < REPK(0); ++rp_) if (IN(0)) { p0_prologue(args, F); }
    SEAM(0);
    for (int rp_ = 0; rp_ < REPK(1); ++rp_) if (IN(1)) { pg8::Gemm g{XN1, (const bf16*)(ws + WS_WGU1), MT, NGU, DM}; pg8::StaticOrder S; S.init(MT, NGU, F.G, F.bid);
        pg8::EpiSwiGLU E{0, ACT, nullptr}; pg8::gemm_phase<pg8::EpiSwiGLU, pg8::StaticOrder, true, true>(F.lds, g, S, E);
        constexpr int NB6 = (MT / 256) * (NGU / 256) - 5 * 256;
        (void)NB6; }
    SEAM(1);
    for (int rp_ = 0; rp_ < REPK(2); ++rp_) if (IN(2)) { pg8::Gemm g{ACT, (const bf16*)(ws + WS_WD1), MP, DM, DFF}; pg8::StaticOrder S; S.init(MP, DM, F.G, F.bid);
        pg8::EpiResid<true, true> E{0, args.x_prompt, H1B, ssq_h1}; pg8::gemm_phase<pg8::EpiResid<true, true>, pg8::StaticOrder, true, true>(F.lds, g, S, E);
        for (int u = F.bid; u < 128; u += F.G) sk::skinny_unit<DFF, false, true>(u, ACT, (const bf16*)(ws + WS_WD1), ssq_h1, (LAS float*)F.lds, sk::SkResidX{args.x_sample, H1B}); }
    SEAM(2);
    for (int rp_ = 0; rp_ < REPK(3); ++rp_) if (IN(3)) { pg8::Gemm g{H1B, (const bf16*)(ws + WS_WIN), MT, NIN, DM}; pg8::StaticOrder S; S.init(MT, NIN, F.G, F.bid);
        pg8::rst_fill<16>(F.lds, S, ssq_h1, 1.0f / DM, FTID); pg8::EpiWin E{0, (const LAS float*)(F.lds + pg8::RST_OFF), ssq_cq, ssq_kv, rope, args.out, CQB, CKVB, KPEB, QR, KR, RV, RGS, SGA, SGR, CKVF};
        pg8::gemm_phase<pg8::EpiWin, pg8::StaticOrder, true, true>(F.lds, g, S, E);
        constexpr int NB5 = (MT / 256) * (NIN / 256) - 4 * 256; const int ng = (F.G == 256) ? 256 - NB5 : F.G, cg = (F.G == 256) ? F.bid - NB5 : F.bid;
        if (cg >= 0) { pg8::Gemm g2{PB, (const bf16*)(ws + WS_WPP), MP, DM, PLE}; pg8::StaticOrder S2; S2.init(MP, DM, ng, cg);
          pg8::EpiPlain E2{0, PP, PP, DM, 4, nullptr}; pg8::gemm_phase<pg8::EpiPlain, pg8::StaticOrder, true, true>(F.lds, g2, S2, E2);
          for (int u = cg; u < 128; u += ng) sk::skinny_unit<PLE, false, false>(u, PB, (const bf16*)(ws + WS_WPP), nullptr, (LAS float*)F.lds, sk::SkPlain{PP}); } }
    SEAM(3);
    for (int rp_ = 0; rp_ < REPK(4); ++rp_) if (IN(4)) {
#ifndef P4_MASK
#define P4_MASK 31
#endif
        if (P4_MASK & 1) { pg8::Gemm g{CQB, (const bf16*)(ws + WS_WQB), MT, 768, QL}; pg8::StaticOrder S; S.init(MT, 768, F.G, F.bid);
          pg8::rst_fill<4>(F.lds, S, ssq_cq, 1.0f / QL, FTID); pg8::EpiQB E{0, (const LAS float*)(F.lds + pg8::RST_OFF), rope, QB}; pg8::gemm_phase<pg8::EpiQB, pg8::StaticOrder, true, true>(F.lds, g, S, E); }
        if (P4_MASK & 2) { pg8::Gemm g{CKVB, (const bf16*)(ws + WS_WKVB), MP, DM, KVL}; pg8::StaticOrder S; S.init(MP, DM, F.G, F.bid);
          pg8::rst_fill<4>(F.lds, S, ssq_kv, 1.0f / KVL, FTID); pg8::EpiPlain E{0, KN, VB, 512, 2, (const LAS float*)(F.lds + pg8::RST_OFF)}; pg8::gemm_phase<pg8::EpiPlain, pg8::StaticOrder, true, true>(F.lds, g, S, E); }
        if (P4_MASK & 8) for (int i = F.bid * (NWAVES * 64) + FTID; i < (MP + MS) * 32; i += NGT) { const int row = i >> 5, c4 = (i & 31) * 4; const float rs = pg8::rstd_of<4>(ssq_kv, row, 1.0f / KVL);
            const pg8::f32x4 v = *(const pg8::f32x4*)(CKVF + (size_t)row * KVL + c4), g = *(const pg8::f32x4*)(args.kv_a_norm + c4);
            float* o = row < MP ? args.out + O_CKVP + (size_t)row * KVL : args.out + O_CKVS + (size_t)(row - MP) * KVL;
            *(pg8::f32x4*)(o + c4) = v * rs * g; }
        if (P4_MASK & 16) for (int u = F.bid; u < 512; u += F.G) ret::kv_unit(u, KR, RV, KVC, F.lds);
    }
    SEAM(4);
    for (int rp_ = 0; rp_ < REPK(5); ++rp_) if (IN(5)) {
#ifndef P5_MASK
#define P5_MASK 7
#endif
        { volatile LAS unsigned* cntA = F.MISC + 16; volatile LAS unsigned* cntD = F.MISC + 17; volatile LAS unsigned* nextw = F.MISC + 18; unsigned genA = cntA[0], genD = cntD[0];
          __syncthreads();
#ifdef PROBE_T
          unsigned long long t0_ = __builtin_amdgcn_s_memrealtime();
#endif
          for (int v = F.bid; v < 256; v += F.G) {
            const int s = v >> 1, sg = v & 1; const int wv_ = FWAVE;
#ifdef TEAM_BY_SIMD_PAIR
            const bool teamA = ((wv_ >> 1) & 1) == 0; const int w4 = (wv_ & 1) | ((wv_ >> 2) << 1);
#else
            const bool teamA = wv_ < 4; const int w4 = wv_ & 3;
#endif
            { const int bh = v >> 4, j = v & 15;
              if (teamA) {
                __builtin_amdgcn_s_setprio(3);
                att::attn_half_unit(bh >> 3, bh & 7, 63 - 2 * j, QB, KN, KPEB, VB, OCAT, (char*)lds, cntA, genA, w4);
                att::attn_half_unit(bh >> 3, bh & 7, 2 * j + 1, QB, KN, KPEB, VB, OCAT, (char*)lds, cntA, genA, w4);
                att::attn_half_unit(bh >> 3, bh & 7, 2 * j, QB, KN, KPEB, VB, OCAT, (char*)lds, cntA, genA, w4);
                att::attn_half_unit(bh >> 3, bh & 7, 62 - 2 * j, QB, KN, KPEB, VB, OCAT, (char*)lds, cntA, genA, w4);
                __builtin_amdgcn_s_setprio(0);
              } }
            { volatile LAS unsigned* cnt = teamA ? cntA : cntD; unsigned gen = teamA ? genA : genD; volatile LAS unsigned* bw = F.MISC + (teamA ? 20 : 21);
              LAS unsigned char* tl = F.lds + (teamA ? 0 : dec::D_BASE);
              if (!teamA) ret::scan_items(v * 256 + w4 * 64 + FLANE, F.G * 256, KVC, SC, args.out);
              if (!teamA) { for (int u = 2 * v; u < 2 * v + 2; ++u) ret::sample_unit4(u, w4, FLANE, QR, KR, RV, RGS, args.ret_norm, args.state_ret, args.out, OCAT, (LAS float*)tl, cnt, gen); }
              dec::qlat_token4(s, w4, FLANE, QB, args.w_kv_b, (LAS float*)(tl + dec::M4_QL), QLAT, sg == 0 && !teamA);
              for (;;) {
                  if (w4 == 0 && FLANE == 0) bw[0] = __hip_atomic_fetch_add((LAS unsigned*)nextw, 1u, __ATOMIC_RELAXED, __HIP_MEMORY_SCOPE_WORKGROUP);
                  asm volatile("s_waitcnt lgkmcnt(0)" ::: "memory"); att::bar4(cnt, gen, FLANE);
                  const int it = (int)bw[0];
                  if (it >= dec::DEC_ITEMS) break;
                  dec::split_unit4m(s, sg * dec::DEC_ITEMS + it, w4, FLANE, QB, args.cache_ckv, args.cache_kpe, args.page_table, DPO, DML, tl, cnt, gen);
              }
              if (teamA) genA = gen; else genD = gen; }
          }
#ifdef PROBE_T
          { const unsigned long long t1_ = __builtin_amdgcn_s_memrealtime(); if (F.bid == PROBE_BLK && FLANE == 0 && FWAVE == PROBE_T) ((volatile unsigned*)(ws + WS_CTL))[2] = (unsigned)(t1_ - t0_); }
#endif
          __syncthreads(); }
    }
    SEAM(5);
    for (int rp_ = 0; rp_ < REPK(6); ++rp_) if (IN(6)) {
        for (int u = F.bid; u < 512; u += F.G) ret::out_unit(u, QR, KR, RV, SC, RGS, args.ret_norm, OCAT, F.lds);
        for (int s = F.bid; s < MS; s += F.G) dec::combine_unit(s, QB, QLAT, DPO, DML, args.out, args.w_kv_b, OCAT, (LAS float*)F.lds);
    }
    SEAM(6);
    for (int rp_ = 0; rp_ < REPK(7); ++rp_) if (IN(7)) { pg8::Gemm g{OCAT, (const bf16*)(ws + WS_WBC), MP, DM, DM}; pg8::StaticOrder S; S.init(MP, DM, F.G, F.bid);
        pg8::EpiMerge E{8, SGA, SGR, MRG}; pg8::gemm_phase<pg8::EpiMerge, pg8::StaticOrder, true, true>(F.lds, g, S, E);
        for (int u = F.bid; u < 128; u += F.G) sk::skinny_unit<DM, true, false>(u, OCAT, (const bf16*)(ws + WS_WBC), nullptr, (LAS float*)F.lds, sk::SkMerge{SGA, SGR, MRG}); }
    SEAM(7);
    for (int rp_ = 0; rp_ < REPK(8); ++rp_) if (IN(8)) { pg8::Gemm g{MRG, (const bf16*)(ws + WS_WOUT), MP, DM, DM}; pg8::StaticOrder S; S.init(MP, DM, F.G, F.bid);
        pg8::EpiResid<false, false> E{0, H1B, H2B, ssq_h2}; pg8::gemm_phase<pg8::EpiResid<false, false>, pg8::StaticOrder, true, true>(F.lds, g, S, E);
        for (int u = F.bid; u < 128; u += F.G) sk::skinny_unit<DM, false, true>(u, MRG, (const bf16*)(ws + WS_WOUT), ssq_h2, (LAS float*)F.lds, sk::SkResid{H1B, 1.0f, H2B}); }
    SEAM(8);
    for (int rp_ = 0; rp_ < REPK(9); ++rp_) if (IN(9)) { pg8::Gemm g{H2B, (const bf16*)(ws + WS_WGU2), MT, NGU, DM}; pg8::StaticOrder S; S.init(MT, NGU, F.G, F.bid);
        pg8::rst_fill<16>(F.lds, S, ssq_h2, 1.0f / DM, FTID); pg8::EpiSwiGLU E{0, ACT, (const LAS float*)(F.lds + pg8::RST_OFF)}; pg8::gemm_phase<pg8::EpiSwiGLU, pg8::StaticOrder, true, true>(F.lds, g, S, E); }
    SEAM(9);
    for (int rp_ = 0; rp_ < REPK(10); ++rp_) if (IN(10)) { pg8::Gemm g{ACT, (const bf16*)(ws + WS_WD2), MP, DM, DFF}; pg8::StaticOrder S; S.init(MP, DM, F.G, F.bid);
        pg8::EpiResid<true, false> E{0, H2B, H3B, ssq_h3}; pg8::gemm_phase<pg8::EpiResid<true, false>, pg8::StaticOrder, true, true>(F.lds, g, S, E);
        for (int u = F.bid; u < 128; u += F.G) sk::skinny_unit<DFF, false, true>(u, ACT, (const bf16*)(ws + WS_WD2), ssq_h3, (LAS float*)F.lds, sk::SkResid{H2B, 0.5f, H3B}); }
    SEAM(10);
    for (int rp_ = 0; rp_ < REPK(11); ++rp_) if (IN(11)) { pg8::Gemm g{H3B, (const bf16*)(ws + WS_WPG), MP, DM, DM}; pg8::StaticOrder S; S.init(MP, DM, F.G, F.bid);
        pg8::rst_fill<16>(F.lds, S, ssq_h3, 1.0f / DM, FTID); pg8::EpiPle E{0, H3B, PP, (const LAS float*)(F.lds + pg8::RST_OFF), H4B, ssq_h4}; pg8::gemm_phase<pg8::EpiPle, pg8::StaticOrder, true, true>(F.lds, g, S, E);
        for (int u = F.bid; u < 128; u += F.G) sk::skinny_unit<DM, false, true>(u, H3B, (const bf16*)(ws + WS_WPG), ssq_h4, (LAS float*)F.lds, sk::SkPle{H3B, PP, ssq_h3, H4B}); }
    SEAM(11);
    for (int rp_ = 0; rp_ < REPK(12); ++rp_) if (IN(12)) {
        const int lane12 = FLANE;
        for (int m = F.bid * NWAVES + FWAVE; m < MP + MS; m += NGW) { const float rs = pg8::rstd_of<16>(ssq_h4, m, 1.0f / DM);
            float* orow = args.out + (m < MP ? O_YP + (size_t)m * DM : O_YS + (size_t)(m - MP) * DM);
#pragma unroll
            for (int h = 0; h < 2; ++h) { const v4u w = *(const v4u*)(H4B + (size_t)m * DM + 512 * h + 8 * lane12);
                const pg8::f32x4 g0 = *(const pg8::f32x4*)(args.final_norm + 512 * h + 8 * lane12), g1 = *(const pg8::f32x4*)(args.final_norm + 512 * h + 8 * lane12 + 4);
                *(pg8::f32x4*)(orow + 512 * h + 8 * lane12) = (pg8::f32x4){bflo(w.x), bfhi(w.x), bflo(w.y), bfhi(w.y)} * rs * g0;
                *(pg8::f32x4*)(orow + 512 * h + 8 * lane12 + 4) = (pg8::f32x4){bflo(w.z), bfhi(w.z), bflo(w.w), bfhi(w.w)} * rs * g1; } }
#if defined(PROBE_T) || defined(PROBE_PH)
        VM_WAIT(); if (F.bid == 0 && FWAVE == 0 && lane12 == 0) args.out[O_YS + 5] = 2.0f * __builtin_rintf(0.01f * (float)((volatile unsigned*)(ws + WS_CTL))[2] * (1.0f / 20.0f));
#endif
    }
#undef IN
#undef SEAM
}

#ifdef DBG_LAST
__global__ void dbg_dump(const unsigned char* ws, float* out) {
    const size_t n = (size_t)MP * DM;
    for (size_t i = (size_t)blockIdx.x * blockDim.x + threadIdx.x; i < n; i += (size_t)gridDim.x * blockDim.x) { const size_t r = i >> 10, c = i & 1023; float v = 0.f;
        if (c < DBG_NCOLS) { if (DBG_F32) v = ((const float*)(ws + DBG_SRC))[r * DBG_PITCH + c]; else v = bf2f(((const bf16*)(ws + DBG_SRC))[r * DBG_PITCH + c]); }
#ifdef DBG_SRC2
        else v = bf2f(((const bf16*)(ws + DBG_SRC2))[r * DBG_PITCH + (c - DBG_NCOLS)]);
#endif
        out[i] = v; }
}
#endif
extern "C" void kernel_launch(void* const* d_in, const int* in_sizes, int n_in, void* d_out, int out_size, void* d_ws, size_t ws_size, hipStream_t stream) {
    static int grid = 0;
    if (grid == 0) {
        if (n_in != 30 || out_size != (int)O_END || ws_size < WS_END) { fprintf(stderr, "kernel_launch: built for 30 inputs, %zu outputs, >= %zu bytes of workspace; got n_in %d, out %d, ws %zu; nothing launched\n", (size_t)O_END, (size_t)WS_END, n_in, out_size, ws_size); grid = -1; return; }
        int dev = 0, cus = 0, per_cu = 0;
        if (hipGetDevice(&dev) != hipSuccess || hipDeviceGetAttribute(&cus, hipDeviceAttributeMultiprocessorCount, dev) != hipSuccess) { fprintf(stderr, "kernel_launch: device query failed\n"); grid = -1; return; }
        if (hipFuncSetAttribute((const void*)mk_fwd, hipFuncAttributeMaxDynamicSharedMemorySize, LDS_BYTES) != hipSuccess) { fprintf(stderr, "kernel_launch: hipFuncSetAttribute failed\n"); grid = -1; return; }
        if (hipOccupancyMaxActiveBlocksPerMultiprocessor(&per_cu, (const void*)mk_fwd, NWAVES * 64, LDS_BYTES) != hipSuccess || per_cu < 1)
            fprintf(stderr, "kernel_launch: note: occupancy query reports %d workgroups per CU\n", per_cu);
        (void)hipGetLastError();
        grid = cus;
    }
    if (grid < 0) return;
    if (hipMemsetAsync((char*)d_ws + WS_CTL, 0, CTL_ZERO_BYTES, stream) != hipSuccess) { fprintf(stderr, "kernel_launch: memset failed\n"); return; }
    Args a{};
    const float** fp = (const float**)&a;
    for (int i = 0; i < 30; ++i) fp[i] = (const float*)d_in[i];
    a.out = (float*)d_out; a.ws = (unsigned char*)d_ws;
#if MK_PER_PHASE
#ifdef DBG_LAST
    for (int k = 0; k <= DBG_LAST; ++k) { a.ph_lo = k; a.ph_hi = k + 1; hipLaunchKernelGGL(mk_fwd, dim3(grid), dim3(NWAVES * 64), LDS_BYTES, stream, a); }
    hipLaunchKernelGGL(dbg_dump, dim3(1024), dim3(256), 0, stream, (const unsigned char*)d_ws, (float*)d_out);
#else
    for (int k = 0; k < NPHASE; ++k) { a.ph_lo = k; a.ph_hi = k + 1; hipLaunchKernelGGL(mk_fwd, dim3(grid), dim3(NWAVES * 64), LDS_BYTES, stream, a); }
#endif
#else
    a.ph_lo = 0; a.ph_hi = NPHASE; hipLaunchKernelGGL(mk_fwd, dim3(grid), dim3(NWAVES * 64), LDS_BYTES, stream, a);
#endif
    const hipError_t le = hipPeekAtLastError();
    if (le != hipSuccess) fprintf(stderr, "kernel_launch: launch failed: %s\n", hipGetErrorName(le));
}
```
